# Optimizing an MI355X kernel written in HIP

```python
import math
import jax, jax.numpy as jnp
from jax import lax
import numpy as np

D_MODEL = 4096
BATCH = 4
SEQ = 2048
DEPTH = 1

N_META = 16
DA_HEADS = D_MODEL // 256
DA_QK_DIM = 64
DA_V_DIM = 2 * DA_QK_DIM
ROPE_DIMS = DA_QK_DIM // 4
ROPE_THETA = 500000.0
Q_BLOCK = 128
HG_HEADS = D_MODEL // 256
HG_K_DIM = 128
HG_V_DIM = 128
HG_CHUNK = 64
DA_QK_WIDTH = DA_HEADS * 2 * DA_QK_DIM
DA_V_WIDTH = DA_HEADS * DA_V_DIM
HG_K_WIDTH = HG_HEADS * HG_K_DIM
HG_V_WIDTH = HG_HEADS * HG_V_DIM
IN_SPLITS = (DA_QK_WIDTH, DA_QK_WIDTH, DA_V_WIDTH,
             HG_K_WIDTH, HG_K_WIDTH, HG_V_WIDTH, HG_V_WIDTH,
             D_MODEL, D_MODEL)
IN_WIDTH = sum(IN_SPLITS)
D_FF = 4 * D_MODEL
EPS = 1e-6
NEG_INF = -1e30

kernel_name = "hybrid_diffattn_hgrn2_gated_block"


def _rmsnorm(x, g):
    xf = x.astype(jnp.float32)
    r = lax.rsqrt(jnp.mean(xf * xf, axis=-1, keepdims=True) + EPS)
    return (xf * r).astype(x.dtype) * g.astype(x.dtype)


def _partial_rope(x, pos):
    half = ROPE_DIMS // 2
    inv_freq = ROPE_THETA ** (-(jnp.arange(half, dtype=jnp.float32) * 2.0) / ROPE_DIMS)
    ang = pos.astype(jnp.float32)[:, None] * inv_freq[None, :]
    cos = jnp.cos(ang)[:, None, None, :].astype(x.dtype)
    sin = jnp.sin(ang)[:, None, None, :].astype(x.dtype)
    x1 = x[..., :half]
    x2 = x[..., half:ROPE_DIMS]
    rest = x[..., ROPE_DIMS:]
    return jnp.concatenate([x1 * cos - x2 * sin, x2 * cos + x1 * sin, rest], axis=-1)


def _diff_attention(q, k, v, q_norm, k_norm, lam_q1, lam_k1, lam_q2, lam_k2, subln, layer_idx):
    B, T = q.shape[0], q.shape[1]
    pad = (-T) % Q_BLOCK
    L = pad + T
    nb = L // Q_BLOCK
    lam_init = 0.8 - 0.6 * math.exp(-0.3 * layer_idx)
    lam = (jnp.exp(jnp.sum(lam_q1.astype(jnp.float32) * lam_k1.astype(jnp.float32)))
           - jnp.exp(jnp.sum(lam_q2.astype(jnp.float32) * lam_k2.astype(jnp.float32)))
           + lam_init)
    q = _rmsnorm(q, q_norm)
    k = _rmsnorm(k, k_norm)
    q = jnp.pad(q, ((0, 0), (pad, 0), (0, 0), (0, 0), (0, 0)))
    k = jnp.pad(k, ((0, 0), (pad, 0), (0, 0), (0, 0), (0, 0)))
    v = jnp.pad(v, ((0, 0), (pad, 0), (0, 0), (0, 0)))
    pos = jnp.arange(L, dtype=jnp.int32) - pad
    q = _partial_rope(q, pos)
    k = _partial_rope(k, pos)
    scale = DA_QK_DIM ** -0.5
    key_pos = jnp.arange(L, dtype=jnp.int32)
    key_valid = key_pos >= pad
    q_blocks = q.reshape(B, nb, Q_BLOCK, DA_HEADS, 2, DA_QK_DIM).transpose(1, 0, 2, 3, 4, 5)

    def block(args):
        qb, bi = args
        s = jnp.einsum('bqhcd,bkhcd->bhcqk', qb, k,
                       preferred_element_type=jnp.float32) * scale
        qpos = bi * Q_BLOCK + jnp.arange(Q_BLOCK, dtype=jnp.int32)
        mask = (key_pos[None, :] <= qpos[:, None]) & key_valid[None, :]
        s = jnp.where(mask, s, NEG_INF)
        p = jax.nn.softmax(s, axis=-1)
        a = p[:, :, 0] - lam * p[:, :, 1]
        return jnp.einsum('bhqk,bkhe->bqhe', a.astype(v.dtype), v)

    out = lax.map(block, (q_blocks, jnp.arange(nb, dtype=jnp.int32)))
    out = out.transpose(1, 0, 2, 3, 4).reshape(B, L, DA_HEADS, DA_V_DIM)[:, pad:]
    out = _rmsnorm(out, subln) * (1.0 - lam_init)
    return out.reshape(B, T, DA_V_WIDTH)


def _hgrn2(q, f_logit, i, gate, lower_bound, out_norm, layer_idx):
    B, T = q.shape[0], q.shape[1]
    dt = q.dtype
    C = HG_CHUNK
    pad = (-T) % C
    L = pad + T
    nc = L // C
    lb_all = jnp.cumsum(jax.nn.softmax(lower_bound.astype(jnp.float32), axis=0), axis=0)
    lb = lb_all[layer_idx].reshape(HG_HEADS, HG_K_DIM)
    f = lb + (1.0 - lb) * jax.nn.sigmoid(f_logit.astype(jnp.float32))
    g = jnp.log(f)
    kk = 1.0 - f
    qf = q.astype(jnp.float32)
    vf = i.astype(jnp.float32)

    def to_chunks(a):
        a = jnp.pad(a, ((0, 0), (pad, 0), (0, 0), (0, 0)))
        return a.reshape(B, nc, C, HG_HEADS, a.shape[-1]).transpose(0, 3, 1, 2, 4)

    qc, gc, kc, vc = to_chunks(qf), to_chunks(g), to_chunks(kk), to_chunks(vf)
    b = jnp.cumsum(gc, axis=3)
    b_ref = b[:, :, :, C // 2 - 1:C // 2]
    b_last = b[:, :, :, C - 1:C]
    q_in = qc * jnp.exp(b - b_ref)
    k_in = kc * jnp.exp(b_ref - b)
    A = jnp.einsum('bhntd,bhnsd->bhnts', q_in, k_in)
    causal = jnp.tril(jnp.ones((C, C), dtype=bool))
    A = jnp.where(causal, A, 0.0)
    o_intra = jnp.einsum('bhnts,bhnsv->bhntv', A, vc)
    k_dec = kc * jnp.exp(b_last - b)
    U = jnp.einsum('bhnsd,bhnsv->bhndv', k_dec, vc)
    decay = jnp.exp(b_last[:, :, :, 0])

    def step(S, inp):
        U_c, d_c = inp
        return d_c[..., None] * S + U_c, S

    S0 = jnp.zeros((B, HG_HEADS, HG_K_DIM, HG_V_DIM), jnp.float32)
    _, S_start = lax.scan(step, S0, (U.transpose(2, 0, 1, 3, 4), decay.transpose(2, 0, 1, 3)))
    S_start = S_start.transpose(1, 2, 0, 3, 4)
    o_inter = jnp.einsum('bhntd,bhndv->bhntv', qc * jnp.exp(b), S_start)
    o = (o_intra + o_inter).transpose(0, 2, 3, 1, 4).reshape(B, L, HG_HEADS, HG_V_DIM)[:, pad:]
    o = _rmsnorm(o, out_norm.astype(jnp.float32)) * jax.nn.sigmoid(gate.astype(jnp.float32))
    return o.astype(dt).reshape(B, T, HG_V_WIDTH)


def setup_inputs(seed: int = 0) -> dict:
    key = jax.random.key(seed)
    ks = jax.random.split(key, 20)
    nrm = jax.random.normal
    f32 = jnp.float32
    return {
        "x": nrm(ks[0], (BATCH, SEQ, D_MODEL), f32),
        "meta_tokens": nrm(ks[1], (N_META, D_MODEL), f32),
        "norm_mix": 1.0 + 0.02 * nrm(ks[2], (DEPTH, D_MODEL), f32),
        "w_in": nrm(ks[3], (DEPTH, D_MODEL, IN_WIDTH), f32) * D_MODEL ** -0.5,
        "da_q_norm": 1.0 + 0.02 * nrm(ks[4], (DEPTH, DA_QK_DIM), f32),
        "da_k_norm": 1.0 + 0.02 * nrm(ks[5], (DEPTH, DA_QK_DIM), f32),
        "da_lambda_q1": 0.1 * nrm(ks[6], (DEPTH, DA_QK_DIM), f32),
        "da_lambda_k1": 0.1 * nrm(ks[7], (DEPTH, DA_QK_DIM), f32),
        "da_lambda_q2": 0.1 * nrm(ks[8], (DEPTH, DA_QK_DIM), f32),
        "da_lambda_k2": 0.1 * nrm(ks[9], (DEPTH, DA_QK_DIM), f32),
        "da_subln": 1.0 + 0.02 * nrm(ks[10], (DEPTH, DA_V_DIM), f32),
        "hg_lower_bound": 0.1 * nrm(ks[11], (DEPTH + 1, HG_K_WIDTH), f32),
        "hg_out_norm": 1.0 + 0.02 * nrm(ks[12], (DEPTH, HG_V_DIM), f32),
        "w_up_a": nrm(ks[13], (DEPTH, DA_V_WIDTH, D_MODEL), f32) * DA_V_WIDTH ** -0.5,
        "w_up_b": nrm(ks[14], (DEPTH, HG_V_WIDTH, D_MODEL), f32) * HG_V_WIDTH ** -0.5,
        "w_out": nrm(ks[15], (DEPTH, D_MODEL, D_MODEL), f32) * D_MODEL ** -0.5,
        "norm_mlp": 1.0 + 0.02 * nrm(ks[16], (DEPTH, D_MODEL), f32),
        "w_ff1": nrm(ks[17], (DEPTH, D_MODEL, D_FF), f32) * D_MODEL ** -0.5,
        "w_ff2": nrm(ks[18], (DEPTH, D_FF, D_MODEL), f32) * D_FF ** -0.5,
    }


def reference(x, meta_tokens, norm_mix, w_in, da_q_norm, da_k_norm, da_lambda_q1, da_lambda_k1,
              da_lambda_q2, da_lambda_k2, da_subln, hg_lower_bound, hg_out_norm, w_up_a, w_up_b,
              w_out, norm_mlp, w_ff1, w_ff2):
    B = x.shape[0]
    meta = jnp.broadcast_to(meta_tokens.astype(x.dtype)[None], (B, N_META, D_MODEL))
    h = jnp.concatenate([meta, x], axis=1)
    T = h.shape[1]
    split_points = tuple(int(s) for s in np.cumsum(IN_SPLITS)[:-1])
    for l in range(DEPTH):
        u = _rmsnorm(h, norm_mix[l])
        proj = jnp.einsum('btd,de->bte', u, w_in[l])
        da_q, da_k, da_v, hg_q, hg_f, hg_i, hg_g, gate_a, gate_b = jnp.split(proj, split_points, axis=-1)
        y_a = _diff_attention(
            da_q.reshape(B, T, DA_HEADS, 2, DA_QK_DIM),
            da_k.reshape(B, T, DA_HEADS, 2, DA_QK_DIM),
            da_v.reshape(B, T, DA_HEADS, DA_V_DIM),
            da_q_norm[l], da_k_norm[l], da_lambda_q1[l], da_lambda_k1[l],
            da_lambda_q2[l], da_lambda_k2[l], da_subln[l], l)
        y_b = _hgrn2(
            hg_q.reshape(B, T, HG_HEADS, HG_K_DIM),
            hg_f.reshape(B, T, HG_HEADS, HG_K_DIM),
            hg_i.reshape(B, T, HG_HEADS, HG_V_DIM),
            hg_g.reshape(B, T, HG_HEADS, HG_V_DIM),
            hg_lower_bound, hg_out_norm[l], l)
        y_a = jnp.einsum('bte,ed->btd', y_a, w_up_a[l])
        y_b = jnp.einsum('bte,ed->btd', y_b, w_up_b[l])
        merged = jax.nn.sigmoid(gate_a) * y_a + jax.nn.sigmoid(gate_b) * y_b
        h = h + jnp.einsum('btd,de->bte', merged, w_out[l])
        v = _rmsnorm(h, norm_mlp[l])
        hid = jnp.square(jax.nn.relu(jnp.einsum('btd,df->btf', v, w_ff1[l])))
        h = h + jnp.einsum('btf,fd->btd', hid, w_ff2[l])
    return h[:, N_META:]
```

```cpp
#include <hip/hip_runtime.h>
#include <cstdio>
#include <cstdint>
namespace pg8 {
#define PG8_LAS __attribute__((address_space(3)))
typedef unsigned short bf16_t;
typedef short bf16x8 __attribute__((ext_vector_type(8)));
typedef float f32x4 __attribute__((ext_vector_type(4)));
typedef unsigned u32x4 __attribute__((ext_vector_type(4)));
constexpr int BM = 256, BK = 64, HALF = 128, HTB = HALF * BK * 2  , STAGE_BYTES = 8 * HTB, NXCD = 8, WGM = 8;

__host__ __device__ __forceinline__ int lds_byte(int r, int c) { const int st = (r >> 4) * 2 + (c >> 5), rr = r & 15, cc = c & 31, ob = rr * 64 + cc * 2; return st * 1024 + (ob ^ (((ob >> 9) & 1) << 5)); }
__host__ __device__ __forceinline__ void stage_rc(int b, int& R, int& C) { const int st = b / 1024, sb = b % 1024, swz = sb ^ (((sb >> 9) & 1) << 5); R = (st >> 1) * 16 + swz / 64; C = (st & 1) * 32 + (swz % 64) / 2; }
__host__ __device__ __forceinline__ int perm32(int rho) { const int n = rho >> 4, i = rho & 15; return 8 * (i >> 2) + 4 * n + (i & 3); }

struct Unit { int pm, pn; };
struct Gemm { const bf16_t* A; const bf16_t* Bt; int M, N, K; };

struct StaticOrder {
    int nM, nN, nwg, G, c;
    __host__ __device__ void init(int M, int N, int G_, int c_) { nM = M / BM; nN = N / BM; nwg = nM * nN; G = G_; c = c_; }
    __host__ __device__ bool next(int i, Unit& u) const {
        const long L = (long)i * G + c; if (L >= nwg) return false;
        int wgid = (int)L; { const int q = nwg / NXCD, r = nwg % NXCD, xcd = wgid % NXCD, off = wgid / NXCD; wgid = (xcd < r ? xcd * (q + 1) : r * (q + 1) + (xcd - r) * q) + off; }
        const int nig = WGM * nN, gid = wgid / nig, fm = gid * WGM, gsz = (nM - fm) < WGM ? (nM - fm) : WGM;
        u.pm = fm + ((wgid % nig) % gsz); u.pn = (wgid % nig) / gsz; return true;
    }
    __device__ __forceinline__ void a_ready(const Unit&) const {}
    __device__ __forceinline__ void done(const Unit&) const {}
};

__device__ __forceinline__ unsigned cvt_pk_bf16(float lo, float hi) { unsigned r; asm volatile("v_cvt_pk_bf16_f32 %0, %1, %2" : "=v"(r) : "v"(lo), "v"(hi)); return r; }
typedef float f32x2 __attribute__((ext_vector_type(2)));
template <class Epi, class Sched, bool ALIGN_EPI = false, bool SP2 = false>
__device__ __forceinline__ void gemm_phase(PG8_LAS unsigned char* lds, const Gemm g, const Sched& S, const Epi& E) {
    const int tid = threadIdx.x, wid = __builtin_amdgcn_readfirstlane(tid >> 6), lane = tid & 63, wr = wid >> 2, wc = wid & 3, fr = lane & 15, fq = lane >> 4;
    const int K = g.K, nt = K / BK;
    unsigned voffA[2], voffB[2];
#pragma unroll
    for (int i = 0; i < 2; ++i) { int R, C; stage_rc(tid * 16 + i * 8192, R, C); const int Rb = Epi::PERM ? ((R & ~31) + perm32(R & 31)) : R;
        voffA[i] = (unsigned)(R * K + C) * 2u; voffB[i] = (unsigned)(Rb * K + C) * 2u; }
    const size_t kstep = (size_t)(BK * 2);
    const size_t hstep = (size_t)HALF * K * 2;
    const size_t tstep = 2 * hstep;
    const unsigned ldsw = (unsigned)wid * 1024u;
    const int aoff = lds_byte(wr * 64 + fr, fq * 8), boff = lds_byte(wc * 32 + fr, fq * 8);
#define PG8_SA(b, h) (((b) * 2 + (h)) * HTB)
#define PG8_SB(b, h) ((4 + (b) * 2 + (h)) * HTB)
#define PG8_STAGE(bufoff, gbase, voff) do { _Pragma("unroll") for (int _i = 0; _i < 2; ++_i) \
        __builtin_amdgcn_global_load_lds((const unsigned*)((const char*)(gbase) + (voff)[_i]), (PG8_LAS unsigned*)(lds + (bufoff) + ldsw + _i * 8192), 16, 0, 0); } while (0)
#define PG8_LDA(dst, b, h) do { _Pragma("unroll") for (int m = 0; m < 4; ++m) _Pragma("unroll") for (int k = 0; k < 2; ++k) dst[m][k] = *(const PG8_LAS bf16x8*)(lds + PG8_SA(b, h) + aoff + m * 2048 + k * 1024); } while (0)
#define PG8_LDB(dst, b, h) do { _Pragma("unroll") for (int n = 0; n < 2; ++n) _Pragma("unroll") for (int k = 0; k < 2; ++k) dst[n][k] = *(const PG8_LAS bf16x8*)(lds + PG8_SB(b, h) + boff + n * 2048 + k * 1024); } while (0)
#define PG8_MMA(ai, bj, At, Bt) do { __builtin_amdgcn_s_setprio(1); _Pragma("unroll") for (int m = 0; m < 4; ++m) _Pragma("unroll") for (int n = 0; n < 2; ++n) _Pragma("unroll") for (int k = 0; k < 2; ++k) \
        acc[ai][bj][m][n] = __builtin_amdgcn_mfma_f32_16x16x32_bf16(Bt[n][k], At[m][k], acc[ai][bj][m][n], 0, 0, 0); __builtin_amdgcn_s_setprio(0); } while (0)
#define PG8_WAIT_V(n) asm volatile("s_waitcnt vmcnt(" #n ")" ::: "memory")
#define PG8_WAIT_L(n) asm volatile("s_waitcnt lgkmcnt(" #n ")" ::: "memory")
#define PG8_BAR __builtin_amdgcn_s_barrier()
#define PG8_SCHED __builtin_amdgcn_sched_barrier(0)
    Unit cur, nxt; int ui = 0;
    if (!S.next(0, cur)) return;
    f32x4 acc[2][2][4][2];
#pragma unroll
    for (int a = 0; a < 2; ++a)
#pragma unroll
        for (int b = 0; b < 2; ++b)
#pragma unroll
            for (int m = 0; m < 4; ++m)
#pragma unroll
                for (int n = 0; n < 2; ++n) acc[a][b][m][n] = (f32x4){0.f, 0.f, 0.f, 0.f};
    bf16x8 At[4][2], B0[2][2], B1[2][2];
    const char* cA = (const char*)g.A + (size_t)cur.pm * tstep; const char* cB = (const char*)g.Bt + (size_t)cur.pn * tstep;
    S.a_ready(cur);
    if constexpr (SP2) {
        PG8_STAGE(PG8_SB(0, 0), cB, voffB); PG8_STAGE(PG8_SB(0, 1), cB + hstep, voffB); PG8_STAGE(PG8_SA(0, 0), cA, voffA); PG8_STAGE(PG8_SA(0, 1), cA + hstep, voffA);
        if (wr == 1) PG8_BAR;
        PG8_WAIT_V(2); PG8_BAR;
        PG8_STAGE(PG8_SB(1, 0), cB + kstep, voffB); PG8_STAGE(PG8_SA(1, 0), cA + kstep, voffA); PG8_STAGE(PG8_SB(1, 1), cB + hstep + kstep, voffB);
        PG8_WAIT_V(6); PG8_BAR;
    } else {
        PG8_STAGE(PG8_SB(0, 0), cB, voffB); PG8_STAGE(PG8_SA(0, 0), cA, voffA); PG8_STAGE(PG8_SB(0, 1), cB + hstep, voffB); PG8_STAGE(PG8_SA(0, 1), cA + hstep, voffA);
        if (wr == 1) PG8_BAR;
        PG8_WAIT_V(4); PG8_BAR;
        PG8_STAGE(PG8_SB(1, 0), cB + kstep, voffB); PG8_STAGE(PG8_SA(1, 0), cA + kstep, voffA); PG8_STAGE(PG8_SB(1, 1), cB + hstep + kstep, voffB);
        PG8_WAIT_V(6); PG8_BAR;
    }
    for (;;) {
        const bool has_next = S.next(ui + 1, nxt);
        const char* nA = has_next ? (const char*)g.A + (size_t)nxt.pm * tstep : cA; const char* nB = has_next ? (const char*)g.Bt + (size_t)nxt.pn * tstep : cB;
        for (int t = 0; t < nt; t += 2) {
            const bool last = (t == nt - 2);
            const char* a1 = cA + (size_t)(t + 1) * kstep;
            const char* a2 = last ? nA : cA + (size_t)(t + 2) * kstep; const char* b2 = last ? nB : cB + (size_t)(t + 2) * kstep;
            const char* a3 = a2 + kstep; const char* b3 = b2 + kstep;
            if (last && has_next) S.a_ready(nxt);
            if constexpr (SP2) {
            PG8_LDB(B0, 0, 0); PG8_LDB(B1, 0, 1); PG8_SCHED; PG8_LDA(At, 0, 0); PG8_STAGE(PG8_SA(1, 1), a1 + hstep, voffA);
            PG8_WAIT_V(8); PG8_WAIT_L(0); PG8_BAR; PG8_MMA(0, 0, At, B0); PG8_MMA(0, 1, At, B1); PG8_BAR; PG8_SCHED;
            PG8_LDA(At, 0, 1); PG8_STAGE(PG8_SB(0, 0), b2, voffB); PG8_STAGE(PG8_SB(0, 1), b2 + hstep, voffB); PG8_STAGE(PG8_SA(0, 0), a2, voffA);
            PG8_WAIT_V(8); PG8_WAIT_L(0); PG8_BAR; PG8_MMA(1, 0, At, B0); PG8_MMA(1, 1, At, B1); PG8_BAR; PG8_SCHED;
            PG8_LDB(B0, 1, 0); PG8_LDB(B1, 1, 1); PG8_SCHED; PG8_LDA(At, 1, 0); PG8_STAGE(PG8_SA(0, 1), a2 + hstep, voffA);
            PG8_WAIT_V(8); PG8_WAIT_L(0); PG8_BAR; PG8_MMA(0, 0, At, B0); PG8_MMA(0, 1, At, B1); PG8_BAR; PG8_SCHED;
            PG8_LDA(At, 1, 1); PG8_STAGE(PG8_SB(1, 0), b3, voffB); PG8_STAGE(PG8_SB(1, 1), b3 + hstep, voffB); PG8_STAGE(PG8_SA(1, 0), a3, voffA);
            PG8_WAIT_V(8); PG8_WAIT_L(0); PG8_BAR; PG8_MMA(1, 0, At, B0); PG8_MMA(1, 1, At, B1); PG8_BAR; PG8_SCHED;
            } else {
            PG8_LDB(B0, 0, 0); PG8_SCHED; PG8_LDA(At, 0, 0); PG8_STAGE(PG8_SA(1, 1), a1 + hstep, voffA);
            PG8_WAIT_L(8); PG8_BAR; PG8_WAIT_L(0); PG8_MMA(0, 0, At, B0); PG8_BAR; PG8_SCHED;
            PG8_LDB(B1, 0, 1); PG8_STAGE(PG8_SB(0, 0), b2, voffB);
            PG8_BAR; PG8_WAIT_L(0); PG8_MMA(0, 1, At, B1); PG8_BAR;
            PG8_LDA(At, 0, 1); PG8_STAGE(PG8_SA(0, 0), a2, voffA);
            PG8_BAR; PG8_WAIT_L(0); PG8_MMA(1, 0, At, B0); PG8_BAR; PG8_SCHED;
            PG8_STAGE(PG8_SB(0, 1), b2 + hstep, voffB);
            PG8_WAIT_V(6); PG8_BAR; PG8_MMA(1, 1, At, B1); PG8_BAR;
            PG8_LDB(B0, 1, 0); PG8_SCHED; PG8_LDA(At, 1, 0); PG8_STAGE(PG8_SA(0, 1), a2 + hstep, voffA);
            PG8_WAIT_L(8); PG8_BAR; PG8_WAIT_L(0); PG8_MMA(0, 0, At, B0); PG8_BAR; PG8_SCHED;
            PG8_LDB(B1, 1, 1); PG8_STAGE(PG8_SB(1, 0), b3, voffB);
            PG8_BAR; PG8_WAIT_L(0); PG8_MMA(0, 1, At, B1); PG8_BAR;
            PG8_LDA(At, 1, 1); PG8_STAGE(PG8_SA(1, 0), a3, voffA);
            PG8_BAR; PG8_WAIT_L(0); PG8_MMA(1, 0, At, B0); PG8_BAR; PG8_SCHED;
            PG8_STAGE(PG8_SB(1, 1), b3 + hstep, voffB);
            PG8_WAIT_V(6); PG8_BAR; PG8_MMA(1, 1, At, B1); PG8_BAR;
            }
        }
        if constexpr (ALIGN_EPI) { if (wr == 0) PG8_BAR; }
        if constexpr (!Epi::AFTER_DRAIN) { E(acc, cur, wr, wc, fr, fq); S.done(cur); }
        if (!has_next) break;
#pragma unroll
        for (int a = 0; a < 2; ++a)
#pragma unroll
            for (int b = 0; b < 2; ++b)
#pragma unroll
                for (int m = 0; m < 4; ++m)
#pragma unroll
                    for (int n = 0; n < 2; ++n) acc[a][b][m][n] = (f32x4){0.f, 0.f, 0.f, 0.f};
        cur = nxt; cA = nA; cB = nB; ++ui;
        if constexpr (ALIGN_EPI) { if (wr == 1) PG8_BAR; }
    }
    PG8_WAIT_V(0);
    if constexpr (!ALIGN_EPI) { if (wr == 0) PG8_BAR; }
    PG8_BAR;
    if constexpr (Epi::AFTER_DRAIN) { E.fused(acc, cur, wr, wc, fr, fq, lds, wid, lane); S.done(cur); }
#undef PG8_SA
#undef PG8_SB
#undef PG8_STAGE
#undef PG8_LDA
#undef PG8_LDB
#undef PG8_MMA
#undef PG8_WAIT_V
#undef PG8_WAIT_L
#undef PG8_BAR
#undef PG8_SCHED
}
}
#define GAS __attribute__((address_space(1)))
#define LAS __attribute__((address_space(3)))
typedef unsigned short bf16;
typedef unsigned v4u __attribute__((ext_vector_type(4)));
typedef float f32x4 __attribute__((ext_vector_type(4)));
typedef short bf16x8 __attribute__((ext_vector_type(8)));
typedef GAS unsigned gu32;
typedef GAS unsigned long long gu64;
#define RLX_AGENT __ATOMIC_RELAXED, __HIP_MEMORY_SCOPE_AGENT
#define LDS_WAIT() asm volatile("s_waitcnt lgkmcnt(0)" ::: "memory")
#define VM_WAIT() asm volatile("s_waitcnt vmcnt(0)" ::: "memory")
__device__ __forceinline__ unsigned long long rt() { return __builtin_amdgcn_s_memrealtime(); }
__device__ __forceinline__ unsigned f2bf(float f) { unsigned u = __builtin_bit_cast(unsigned, f); return (u + 0x7fffu + ((u >> 16) & 1u)) >> 16; }
__device__ __forceinline__ unsigned pk2(float lo, float hi) { return f2bf(lo) | (f2bf(hi) << 16); }
#define XB_TMO      128
#define XB_XCNT(j)  (256  + 64 * (j))
#define XB_XSUB(j)  (1280 + 64 * (j))
#define XB_XGEN(j)  (2304 + 64 * (j))
#define XB_TOP      3328
#define XB_TOPGEN   3392
#define XCD_BAR_WORDS 3456
#define XB_SPIN_CAP (1u << 22)

__device__ __forceinline__ unsigned xb_ld(unsigned* p)              { return __hip_atomic_load(p, __ATOMIC_RELAXED, __HIP_MEMORY_SCOPE_AGENT); }
__device__ __forceinline__ unsigned xb_add(unsigned* p, unsigned v) { return __hip_atomic_fetch_add(p, v, __ATOMIC_RELAXED, __HIP_MEMORY_SCOPE_AGENT); }
__device__ __forceinline__ unsigned xb_xcc_id() { return (unsigned)__builtin_amdgcn_s_getreg((3 << 11) | 20) & 0xFu; }
#define XB_SPIN(cond, bar) do { unsigned _sp = 0; while (cond) { __builtin_amdgcn_s_sleep(1); \
    if ((++_sp & 255u) == 0u) { if (xb_ld(&(bar)[XB_TMO])) break; if (_sp > XB_SPIN_CAP) { atomicAdd(&(bar)[XB_TMO], 1u); break; } } } } while (0)

struct XcdBarrier {
    unsigned* bar; unsigned x;
    volatile LAS unsigned* st;
};

__device__ __forceinline__ XcdBarrier xcd_barrier_post(unsigned* bar, volatile LAS unsigned* st) {
    XcdBarrier b; b.bar = bar; b.x = xb_xcc_id(); b.st = st;
    if (threadIdx.x == 0) (void)xb_add(&bar[XB_XCNT(b.x)], 1u);
    return b;
}
__device__ __forceinline__ void xcd_barrier_complete(unsigned* bar, unsigned x, unsigned& nloc, unsigned& nx) {
    const unsigned G = gridDim.x * gridDim.y * gridDim.z;
    unsigned sum, cnt, mine, sp = 0u;
    for (;;) {
        sum = 0u; cnt = 0u; mine = 0u;
#pragma unroll
        for (unsigned j = 0; j < 16; ++j) { const unsigned c = xb_ld(&bar[XB_XCNT(j)]); sum += c; cnt += (c > 0u) ? 1u : 0u; mine = (j == x) ? c : mine; }
        if (sum == G) break;
        __builtin_amdgcn_s_sleep(1);
        if ((++sp & 255u) == 0u) { if (xb_ld(&bar[XB_TMO])) break; if (sp > XB_SPIN_CAP) { atomicAdd(&bar[XB_TMO], 1u); break; } }
    }
    nloc = mine > 0u ? mine : 1u; nx = cnt > 0u ? cnt : 1u;
}

__device__ __forceinline__ void xcd_barrier(const XcdBarrier& b) {
    asm volatile("s_waitcnt vmcnt(0)" ::: "memory");
    __syncthreads();
    if (threadIdx.x == 0) {
        unsigned* bar = b.bar;
        __builtin_amdgcn_s_waitcnt(0);
        unsigned nloc = b.st[0], nx = b.st[1];
        if (nloc == 0u) { xcd_barrier_complete(bar, b.x, nloc, nx); b.st[0] = nloc; b.st[1] = nx; }
        const unsigned old = xb_add(&bar[XB_XSUB(b.x)], 1u);
        const unsigned gen = old / nloc;
        if (old + 1u == (gen + 1u) * nloc) {
            __builtin_amdgcn_fence(__ATOMIC_RELEASE, "agent");
            asm volatile("s_waitcnt vmcnt(0)" ::: "memory");
            const unsigned og = xb_add(&bar[XB_TOP], 1u);
            const unsigned tg = og / nx;
            if (og + 1u == (tg + 1u) * nx) xb_add(&bar[XB_TOPGEN], 1u);
            else XB_SPIN(xb_ld(&bar[XB_TOPGEN]) == tg, bar);
            __builtin_amdgcn_fence(__ATOMIC_ACQUIRE, "agent");
            xb_add(&bar[XB_XGEN(b.x)], 1u);
            asm volatile("s_waitcnt vmcnt(0)" ::: "memory");
        } else {
            XB_SPIN(xb_ld(&bar[XB_XGEN(b.x)]) == gen, bar);
            __builtin_amdgcn_fence(__ATOMIC_ACQUIRE, "agent");
            asm volatile("s_waitcnt vmcnt(0)" ::: "memory");
        }
    }
    __syncthreads();
}
constexpr int NWAVES = 8;
constexpr int DM = 4096, NB = 4, SEQ = 2048, NMETA = 16, TT = SEQ + NMETA;
constexpr int MR = NB * SEQ;
constexpr int NIN = 22528, DFF = 16384, NH = 16, WHD = 2048;
constexpr int C_Q = 0, C_K = 2048, C_V = 4096, C_HQ = 6144, C_HF = 8192, C_HI = 10240, C_HG = 12288, C_GA = 14336, C_GB = 18432;
constexpr float EPS = 1e-6f;
constexpr float C2 = 0.18033688011112042f;
constexpr float LAM_INIT = 0.2f;

constexpr size_t MiB = 1u << 20;
constexpr size_t WS_CTL = 0, CTL_ZERO_BYTES = 1 * MiB;
constexpr size_t WS_WIN = 2 * MiB, WS_WUPA = 178 * MiB, WS_WUPB = 194 * MiB, WS_WOUT = 210 * MiB, WS_WFF1 = 242 * MiB, WS_WFF2 = 370 * MiB;
constexpr size_t WS_U = 498 * MiB;
constexpr size_t WS_UMETA = 562 * MiB;
constexpr size_t WS_PM = 563 * MiB;
constexpr size_t WS_ROPE = 564 * MiB;
constexpr size_t WS_RSTD = 565 * MiB;
constexpr size_t WS_SSQ = 566 * MiB;
constexpr size_t WS_P = 568 * MiB;
constexpr size_t WS_YA = 920 * MiB, WS_YB = 952 * MiB, WS_MG = 984 * MiB, WS_END = 1048 * MiB;
constexpr int CW_BAR = 4096;

constexpr int RING_BYTES = 131072, LDSCTL_OFF = 146432, LDS_BYTES = 147456;

__device__ __forceinline__ float bf2f(bf16 v) { return __builtin_bit_cast(float, (unsigned)v << 16); }
__device__ __forceinline__ float bflo(unsigned w) { return __builtin_bit_cast(float, w << 16); }
__device__ __forceinline__ float bfhi(unsigned w) { return __builtin_bit_cast(float, w & 0xffff0000u); }
__device__ __forceinline__ float wave_sum(float v) {
#pragma unroll
    for (int o = 1; o < 64; o <<= 1) v += __shfl_xor(v, o);
    return v;
}
__device__ __forceinline__ float wave_max(float v) {
#pragma unroll
    for (int o = 1; o < 64; o <<= 1) v = fmaxf(v, __shfl_xor(v, o));
    return v;
}
__device__ __forceinline__ float sigmoidf_(float x) { return __builtin_amdgcn_rcpf(1.0f + __expf(-x)); }

__device__ __forceinline__ void p0_transpose_item(const float* W, int K, int N, bf16* WT, LAS float* scr, int item, int lane) {
    const int nblk = N / 32, kb = item / nblk, nb = item % nblk, k0 = 64 * kb, n0 = 32 * nb;
#pragma unroll 8
    for (int i = 0; i < 32; ++i) { const int kk = 2 * i + (lane >> 5); scr[kk * 33 + (lane & 31)] = W[(size_t)(k0 + kk) * N + n0 + (lane & 31)]; }
    LDS_WAIT(); asm volatile("" ::: "memory");
    const int c = lane & 7;
#pragma unroll
    for (int j = 0; j < 4; ++j) { const int n = (lane >> 3) + 8 * j; const LAS float* s = scr + (8 * c) * 33 + n;
        v4u o; o.x = pk2(s[0 * 33], s[1 * 33]); o.y = pk2(s[2 * 33], s[3 * 33]); o.z = pk2(s[4 * 33], s[5 * 33]); o.w = pk2(s[6 * 33], s[7 * 33]);
        *(GAS v4u*)(WT + (size_t)(n0 + n) * K + k0 + 8 * c) = o; }
    LDS_WAIT(); asm volatile("" ::: "memory");
}
__device__ __forceinline__ void rms_row_to_bf16(const float* xrow, const float* g, bf16* orow, int lane) {
    const GAS f32x4* xr = (const GAS f32x4*)xrow + lane; const GAS f32x4* gr = (const GAS f32x4*)g + lane;
    f32x4 v[16]; float s = 0.f;
#pragma unroll
    for (int j = 0; j < 16; ++j) { v[j] = xr[64 * j]; s += (v[j].x * v[j].x + v[j].y * v[j].y) + (v[j].z * v[j].z + v[j].w * v[j].w); }
    const float rstd = 1.f / sqrtf(wave_sum(s) * (1.f / DM) + EPS);
    GAS unsigned long long* o8 = (GAS unsigned long long*)orow + lane;
#pragma unroll
    for (int j = 0; j < 16; ++j) { const f32x4 gg = gr[64 * j];
        o8[64 * j] = (unsigned long long)pk2(v[j].x * rstd * gg.x, v[j].y * rstd * gg.y) | ((unsigned long long)pk2(v[j].z * rstd * gg.z, v[j].w * rstd * gg.w) << 32); }
}
__device__ __forceinline__ void sincos_d(double a, float& sn, float& cs) {
    const double PI = 3.14159265358979323846;
    const double k = rint(a / PI); const double r = a - k * PI; const double r2 = r * r;
    double s = 1.0, c = 1.0, ts = 1.0, tc = 1.0;
#pragma unroll
    for (int i = 1; i <= 11; ++i) { tc *= -r2 / (double)((2 * i - 1) * (2 * i)); ts *= -r2 / (double)((2 * i) * (2 * i + 1)); c += tc; s += ts; }
    s *= r;
    const bool odd = ((long long)k) & 1;
    sn = (float)(odd ? -s : s); cs = (float)(odd ? -c : c);
}

struct Ptrs {
    const float* in[19]; float* out; unsigned char* ws;
};

__device__ __forceinline__ const bf16* rowptr(const bf16* P, const bf16* Pm, int b, int t) {
    return t < NMETA ? Pm + (size_t)t * NIN : P + (size_t)(b * SEQ + t - NMETA) * NIN;
}

struct EpiProj {
    static constexpr bool PERM = true, AFTER_DRAIN = false;
    bf16* O; int ldc; int sig_tile;
    __device__ __forceinline__ void operator()(const pg8::f32x4 (&acc)[2][2][4][2], const pg8::Unit& u, int wr, int wc, int fr, int fq) const {
        const int row0 = u.pm * 256 + wr * 64 + fr, col0 = u.pn * 256 + wc * 32 + 8 * fq; const bool sg = u.pn >= sig_tile;
#pragma unroll
        for (int ai = 0; ai < 2; ++ai)
#pragma unroll
            for (int m = 0; m < 4; ++m) { bf16* rowp = O + (size_t)(row0 + ai * 128 + m * 16) * ldc + col0;
#pragma unroll
                for (int bj = 0; bj < 2; ++bj) { pg8::f32x4 v0 = acc[ai][bj][m][0], v1 = acc[ai][bj][m][1];
                    if (sg) { for (int e = 0; e < 4; ++e) { v0[e] = sigmoidf_(v0[e]); v1[e] = sigmoidf_(v1[e]); } }
                    v4u w; w.x = pg8::cvt_pk_bf16(v0[0], v0[1]); w.y = pg8::cvt_pk_bf16(v0[2], v0[3]); w.z = pg8::cvt_pk_bf16(v1[0], v1[1]); w.w = pg8::cvt_pk_bf16(v1[2], v1[3]);
                    *(v4u*)(rowp + bj * 128) = w; } }
    }
};
struct EpiUpA {
    static constexpr bool PERM = true, AFTER_DRAIN = false;
    float* T; const bf16* P;
    __device__ __forceinline__ void operator()(const pg8::f32x4 (&acc)[2][2][4][2], const pg8::Unit& u, int wr, int wc, int fr, int fq) const {
        const int row0 = u.pm * 256 + wr * 64 + fr, col0 = u.pn * 256 + wc * 32 + 8 * fq;
#pragma unroll
        for (int ai = 0; ai < 2; ++ai)
#pragma unroll
            for (int m = 0; m < 4; ++m) { const int row = row0 + ai * 128 + m * 16;
#pragma unroll
                for (int bj = 0; bj < 2; ++bj) { const int col = col0 + bj * 128;
                    const v4u g = *(const v4u*)(P + (size_t)row * NIN + C_GA + col);
                    pg8::f32x4 v0 = acc[ai][bj][m][0], v1 = acc[ai][bj][m][1];
                    v0[0] *= bflo(g.x); v0[1] *= bfhi(g.x); v0[2] *= bflo(g.y); v0[3] *= bfhi(g.y); v1[0] *= bflo(g.z); v1[1] *= bfhi(g.z); v1[2] *= bflo(g.w); v1[3] *= bfhi(g.w);
                    float* tp = T + (size_t)row * DM + col; *(pg8::f32x4*)tp = v0; *(pg8::f32x4*)(tp + 4) = v1; } }
    }
};
struct EpiUpB {
    static constexpr bool PERM = true, AFTER_DRAIN = false;
    const float* T; const bf16* P; bf16* MG;
    __device__ __forceinline__ void operator()(const pg8::f32x4 (&acc)[2][2][4][2], const pg8::Unit& u, int wr, int wc, int fr, int fq) const {
        const int row0 = u.pm * 256 + wr * 64 + fr, col0 = u.pn * 256 + wc * 32 + 8 * fq;
#pragma unroll
        for (int ai = 0; ai < 2; ++ai)
#pragma unroll
            for (int m = 0; m < 4; ++m) { const int row = row0 + ai * 128 + m * 16;
#pragma unroll
                for (int bj = 0; bj < 2; ++bj) { const int col = col0 + bj * 128;
                    const v4u g = *(const v4u*)(P + (size_t)row * NIN + C_GB + col);
                    const float* tp = T + (size_t)row * DM + col; const pg8::f32x4 t0 = *(const pg8::f32x4*)tp, t1 = *(const pg8::f32x4*)(tp + 4);
                    pg8::f32x4 v0 = acc[ai][bj][m][0], v1 = acc[ai][bj][m][1];
                    v0[0] = t0[0] + v0[0] * bflo(g.x); v0[1] = t0[1] + v0[1] * bfhi(g.x); v0[2] = t0[2] + v0[2] * bflo(g.y); v0[3] = t0[3] + v0[3] * bfhi(g.y);
                    v1[0] = t1[0] + v1[0] * bflo(g.z); v1[1] = t1[1] + v1[1] * bfhi(g.z); v1[2] = t1[2] + v1[2] * bflo(g.w); v1[3] = t1[3] + v1[3] * bfhi(g.w);
                    v4u w; w.x = pg8::cvt_pk_bf16(v0[0], v0[1]); w.y = pg8::cvt_pk_bf16(v0[2], v0[3]); w.z = pg8::cvt_pk_bf16(v1[0], v1[1]); w.w = pg8::cvt_pk_bf16(v1[2], v1[3]);
                    *(v4u*)(MG + (size_t)row * DM + col) = w; } }
    }
};
struct EpiOut {
    static constexpr bool PERM = true, AFTER_DRAIN = false;
    const float* X; float* H1; bf16* A2; const float* G; float* SSQ;
    __device__ __forceinline__ void operator()(const pg8::f32x4 (&acc)[2][2][4][2], const pg8::Unit& u, int wr, int wc, int fr, int fq) const {
        const int row0 = u.pm * 256 + wr * 64 + fr, col0 = u.pn * 256 + wc * 32 + 8 * fq;
#pragma unroll
        for (int ai = 0; ai < 2; ++ai)
#pragma unroll
            for (int m = 0; m < 4; ++m) { const int row = row0 + ai * 128 + m * 16; float ss = 0.f;
#pragma unroll
                for (int bj = 0; bj < 2; ++bj) { const int col = col0 + bj * 128; const size_t off = (size_t)row * DM + col;
                    const pg8::f32x4 x0 = *(const pg8::f32x4*)(X + off), x1 = *(const pg8::f32x4*)(X + off + 4);
                    const pg8::f32x4 g0 = *(const pg8::f32x4*)(G + col), g1 = *(const pg8::f32x4*)(G + col + 4);
                    const pg8::f32x4 h0 = x0 + acc[ai][bj][m][0], h1 = x1 + acc[ai][bj][m][1];
                    *(pg8::f32x4*)(H1 + off) = h0; *(pg8::f32x4*)(H1 + off + 4) = h1;
                    ss += (h0[0] * h0[0] + h0[1] * h0[1]) + (h0[2] * h0[2] + h0[3] * h0[3]) + (h1[0] * h1[0] + h1[1] * h1[1]) + (h1[2] * h1[2] + h1[3] * h1[3]);
                    v4u w; w.x = pg8::cvt_pk_bf16(h0[0] * g0[0], h0[1] * g0[1]); w.y = pg8::cvt_pk_bf16(h0[2] * g0[2], h0[3] * g0[3]);
                    w.z = pg8::cvt_pk_bf16(h1[0] * g1[0], h1[1] * g1[1]); w.w = pg8::cvt_pk_bf16(h1[2] * g1[2], h1[3] * g1[3]);
                    *(v4u*)(A2 + off) = w; }
                ss += __shfl_xor(ss, 16); ss += __shfl_xor(ss, 32);
                if (fq == 0) SSQ[(size_t)row * 64 + u.pn * 4 + wc] = ss; }
    }
};
struct EpiFf1 {
    static constexpr bool PERM = true, AFTER_DRAIN = false;
    bf16* H; const float* RSTD;
    __device__ __forceinline__ void operator()(const pg8::f32x4 (&acc)[2][2][4][2], const pg8::Unit& u, int wr, int wc, int fr, int fq) const {
        const int row0 = u.pm * 256 + wr * 64 + fr, col0 = u.pn * 256 + wc * 32 + 8 * fq;
#pragma unroll
        for (int ai = 0; ai < 2; ++ai)
#pragma unroll
            for (int m = 0; m < 4; ++m) { const int row = row0 + ai * 128 + m * 16; const float rs = RSTD[row];
#pragma unroll
                for (int bj = 0; bj < 2; ++bj) { pg8::f32x4 v0 = acc[ai][bj][m][0] * rs, v1 = acc[ai][bj][m][1] * rs;
#pragma unroll
                    for (int e = 0; e < 4; ++e) { const float a = fmaxf(v0[e], 0.f), b = fmaxf(v1[e], 0.f); v0[e] = a * a; v1[e] = b * b; }
                    v4u w; w.x = pg8::cvt_pk_bf16(v0[0], v0[1]); w.y = pg8::cvt_pk_bf16(v0[2], v0[3]); w.z = pg8::cvt_pk_bf16(v1[0], v1[1]); w.w = pg8::cvt_pk_bf16(v1[2], v1[3]);
                    *(v4u*)(H + (size_t)row * DFF + col0 + bj * 128) = w; } }
    }
};
struct EpiFf2 {
    static constexpr bool PERM = false, AFTER_DRAIN = false;
    float* O;
    __device__ __forceinline__ void operator()(const pg8::f32x4 (&acc)[2][2][4][2], const pg8::Unit& u, int wr, int wc, int fr, int fq) const {
        const int row0 = u.pm * 256 + wr * 64 + fr, col0 = u.pn * 256 + wc * 32 + 4 * fq;
#pragma unroll
        for (int ai = 0; ai < 2; ++ai)
#pragma unroll
            for (int m = 0; m < 4; ++m) { float* rowp = O + (size_t)(row0 + ai * 128 + m * 16) * DM + col0;
#pragma unroll
                for (int bj = 0; bj < 2; ++bj)
#pragma unroll
                    for (int n = 0; n < 2; ++n) { pg8::f32x4* p = (pg8::f32x4*)(rowp + bj * 128 + n * 16); *p = *p + acc[ai][bj][m][n]; } }
    }
};

__global__ void __launch_bounds__(NWAVES * 64, 2) mk_fwd(Ptrs args) {
    extern __shared__ __attribute__((aligned(16))) unsigned char lds_raw[];
    LAS unsigned char* lds = (LAS unsigned char*)lds_raw;
    volatile LAS unsigned* MISC = (volatile LAS unsigned*)(lds + LDSCTL_OFF);
    const int tid = threadIdx.x, lane = tid & 63, wave = __builtin_amdgcn_readfirstlane(tid >> 6);
    const int G = gridDim.x, bx = blockIdx.x;
    const int vcu = (G % 8 == 0) ? (bx % 8) * (G / 8) + bx / 8 : bx;
    unsigned char* ws = args.ws;
    gu32* ctl = (gu32*)(ws + WS_CTL);
    const float* x = args.in[0]; const float* meta = args.in[1]; const float* norm_mix = args.in[2]; const float* w_in = args.in[3];
    const float* q_norm = args.in[4]; const float* k_norm = args.in[5];
    const float* lq1 = args.in[6]; const float* lk1 = args.in[7]; const float* lq2 = args.in[8]; const float* lk2 = args.in[9];
    const float* subln = args.in[10]; const float* hg_lb = args.in[11]; const float* hg_onorm = args.in[12];
    const float* w_up_a = args.in[13]; const float* w_up_b = args.in[14]; const float* w_out = args.in[15]; const float* norm_mlp = args.in[16];
    const float* w_ff1 = args.in[17]; const float* w_ff2 = args.in[18];
    float* out = args.out;
    bf16* Wt_in = (bf16*)(ws + WS_WIN); bf16* Wt_upa = (bf16*)(ws + WS_WUPA); bf16* Wt_upb = (bf16*)(ws + WS_WUPB); bf16* Wt_out = (bf16*)(ws + WS_WOUT);
    bf16* Wt_ff1 = (bf16*)(ws + WS_WFF1); bf16* Wt_ff2 = (bf16*)(ws + WS_WFF2);
    bf16* U = (bf16*)(ws + WS_U); bf16* Umeta = (bf16*)(ws + WS_UMETA); bf16* Pm = (bf16*)(ws + WS_PM); float* ROPE = (float*)(ws + WS_ROPE);
    float* RSTD = (float*)(ws + WS_RSTD); float* SSQ = (float*)(ws + WS_SSQ); bf16* P = (bf16*)(ws + WS_P); bf16* HID = (bf16*)(ws + WS_P);
    bf16* YA = (bf16*)(ws + WS_YA); bf16* YB = (bf16*)(ws + WS_YB); bf16* MG = (bf16*)(ws + WS_MG);

    for (int u = tid; u < (LDS_BYTES - LDSCTL_OFF) / 4; u += NWAVES * 64) ((LAS unsigned*)(lds + LDSCTL_OFF))[u] = 0u;
    __syncthreads();
    XcdBarrier bar = xcd_barrier_post((unsigned*)(ctl + CW_BAR), MISC + 8);
    if (wave == 0) {
        const float s1 = wave_sum(lq1[lane] * lk1[lane]), s2 = wave_sum(lq2[lane] * lk2[lane]);
        if (lane == 0) ((LAS float*)(lds + LDSCTL_OFF))[16] = expf(s1) - expf(s2) + LAM_INIT;
    }
    __syncthreads();
    const float lam = ((LAS float*)(lds + LDSCTL_OFF))[16];

    {
        LAS float* scr = (LAS float*)(lds + wave * 16384);
        const int gw = vcu * NWAVES + wave, NGW = G * NWAVES;
        constexpr int I_IN = (DM / 64) * (NIN / 32), I_UP = (WHD / 64) * (DM / 32), I_OUT = (DM / 64) * (DM / 32), I_F1 = (DM / 64) * (DFF / 32), I_F2 = (DFF / 64) * (DM / 32);
        constexpr int NITEMS = I_IN + 2 * I_UP + I_OUT + I_F1 + I_F2;
        for (int it = gw; it < NITEMS; it += NGW) {
            int r = it;
            if (r < I_IN) { p0_transpose_item(w_in, DM, NIN, Wt_in, scr, r, lane); continue; } r -= I_IN;
            if (r < I_UP) { p0_transpose_item(w_up_a, WHD, DM, Wt_upa, scr, r, lane); continue; } r -= I_UP;
            if (r < I_UP) { p0_transpose_item(w_up_b, WHD, DM, Wt_upb, scr, r, lane); continue; } r -= I_UP;
            if (r < I_OUT) { p0_transpose_item(w_out, DM, DM, Wt_out, scr, r, lane); continue; } r -= I_OUT;
            if (r < I_F1) { p0_transpose_item(w_ff1, DM, DFF, Wt_ff1, scr, r, lane); continue; } r -= I_F1;
            p0_transpose_item(w_ff2, DFF, DM, Wt_ff2, scr, r, lane);
        }
        for (int m = gw; m < MR + NMETA; m += NGW) {
            if (m < MR) rms_row_to_bf16(x + (size_t)m * DM, norm_mix, U + (size_t)m * DM, lane);
            else rms_row_to_bf16(meta + (size_t)(m - MR) * DM, norm_mix, Umeta + (size_t)(m - MR) * DM, lane);
        }
        const int gt = bx * (NWAVES * 64) + tid;
        if (gt < TT * 8) {
            const int pos = gt >> 3, j = gt & 7;
            const float invf[8] = {1.0f, 0.1939227432012558f, 0.03760603070259094f, 0.007292664609849453f, 0.0014142135623842478f, 0.00027424818836152554f, 5.3182957344688475e-05f, 1.0313385246263351e-05f};
            float inv = invf[0];
#pragma unroll
            for (int q = 1; q < 8; ++q) inv = (j == q) ? invf[q] : inv;
            const float ang = (float)pos * inv; float sn, cs; sincos_d((double)ang, sn, cs);
            ROPE[pos * 16 + j] = cs; ROPE[pos * 16 + 8 + j] = sn;
        }
    }
    xcd_barrier(bar);

    {
        for (int i = tid; i < NMETA * DM * 2 / 16; i += NWAVES * 64) ((LAS v4u*)lds)[i] = ((const GAS v4u*)Umeta)[i];
        __syncthreads();
        const int gw = vcu * NWAVES + wave, NGW = G * NWAVES;
        for (int ci = gw; ci < 8192; ci += NGW) {
            const int c = (ci < 4096) ? (C_K + ci) : (C_HF + (ci - 4096));
            const bf16* wrow = Wt_in + (size_t)c * DM;
            float acc[16];
#pragma unroll
            for (int r = 0; r < 16; ++r) acc[r] = 0.f;
#pragma unroll 1
            for (int i = 0; i < 8; ++i) {
                const int k = i * 512 + lane * 8;
                const v4u w = *(const GAS v4u*)(wrow + k);
                const float w0 = bflo(w.x), w1 = bfhi(w.x), w2 = bflo(w.y), w3 = bfhi(w.y), w4 = bflo(w.z), w5 = bfhi(w.z), w6 = bflo(w.w), w7 = bfhi(w.w);
#pragma unroll
                for (int r = 0; r < 16; ++r) { const v4u a = *(const LAS v4u*)(lds + (size_t)(r * DM + k) * 2);
                    acc[r] += (bflo(a.x) * w0 + bfhi(a.x) * w1) + (bflo(a.y) * w2 + bfhi(a.y) * w3) + (bflo(a.z) * w4 + bfhi(a.z) * w5) + (bflo(a.w) * w6 + bfhi(a.w) * w7); }
            }
            float mine = 0.f;
#pragma unroll
            for (int r = 0; r < 16; ++r) { const float s = wave_sum(acc[r]); mine = (lane == r) ? s : mine; }
            if (lane < 16) Pm[(size_t)lane * NIN + c] = (bf16)f2bf(mine);
        }
        __syncthreads();
        pg8::Gemm g{U, Wt_in, MR, NIN, DM}; pg8::StaticOrder S; S.init(MR, NIN, G, bx);
        EpiProj E{P, NIN, C_GA / 256};
        pg8::gemm_phase<EpiProj, pg8::StaticOrder, true, true>(lds, g, S, E);
    }
    xcd_barrier(bar);

    {
        const int gw = vcu * NWAVES + wave, NGW = G * NWAVES;
        for (int it = gw; it < 2 * MR + NMETA; it += NGW) {
            bf16* base; int pos; bool isk;
            if (it < 2 * MR) { const int row = it >> 1; isk = it & 1; base = P + (size_t)row * NIN + (isk ? C_K : C_Q); pos = NMETA + (row & (SEQ - 1)); }
            else { const int r = it - 2 * MR; isk = true; base = Pm + (size_t)r * NIN + C_K; pos = r; }
            const float* wv = isk ? k_norm : q_norm;
            const int d0 = (lane & 7) * 8, sub = lane & 7;
            float wn[8], cs[8], sn[8];
#pragma unroll
            for (int j = 0; j < 8; ++j) { wn[j] = wv[d0 + j]; cs[j] = ROPE[pos * 16 + j]; sn[j] = ROPE[pos * 16 + 8 + j]; }
#pragma unroll 1
            for (int i = 0; i < 4; ++i) {
                bf16* p = base + i * 512 + lane * 8;
                const v4u raw = *(const GAS v4u*)p;
                float xv[8] = {bflo(raw.x), bfhi(raw.x), bflo(raw.y), bfhi(raw.y), bflo(raw.z), bfhi(raw.z), bflo(raw.w), bfhi(raw.w)};
                float ss = 0.f;
#pragma unroll
                for (int j = 0; j < 8; ++j) ss += xv[j] * xv[j];
                ss += __shfl_xor(ss, 1); ss += __shfl_xor(ss, 2); ss += __shfl_xor(ss, 4);
                const float rstd = 1.f / sqrtf(ss * (1.f / 64.f) + EPS);
                float o[8];
#pragma unroll
                for (int j = 0; j < 8; ++j) {
                    const float xn = xv[j] * rstd * wn[j];
                    const float pr = __shfl_xor(xn, 1);
                    float v = xn;
                    if (sub == 0) v = xn * cs[j] - pr * sn[j];
                    else if (sub == 1) v = xn * cs[j] + pr * sn[j];
                    o[j] = isk ? v : v * C2;
                }
                v4u w; w.x = pk2(o[0], o[1]); w.y = pk2(o[2], o[3]); w.z = pk2(o[4], o[5]); w.w = pk2(o[6], o[7]);
                *(GAS v4u*)p = w;
            }
        }
    }
    xcd_barrier(bar);

    if (bx < 32) {
        const int sub = tid >> 7, j = tid & 127; const bool act = sub < 2;
        const int bh = bx * 2 + (sub & 1), b = bh >> 4, h = bh & 15;
        LAS float* fL = (LAS float*)(lds + sub * 33024); LAS float* kL = fL + 2048; LAS float* qL = kL + 2048; LAS float* oL = qL + 2048; LAS float* rsL = oL + 2048;
        const float l0 = hg_lb[h * 128 + j], l1 = hg_lb[WHD + h * 128 + j];
        const float lb = 1.f / (1.f + expf(l1 - l0));
        const float onw = hg_onorm[j];
        float S[128];
#pragma unroll
        for (int d = 0; d < 128; ++d) S[d] = 0.f;
#pragma unroll 1
        for (int blk = 0; blk < TT / 16; ++blk) {
            const int t0 = blk * 16;
            if (act) {
#pragma unroll 4
                for (int tt = 0; tt < 16; ++tt) { const int t = t0 + tt; const bf16* rp = rowptr(P, Pm, b, t) + h * 128 + j;
                    const float f = lb + (1.f - lb) * sigmoidf_(bf2f(rp[C_HF]));
                    fL[tt * 128 + j] = f; kL[tt * 128 + j] = 1.f - f; qL[tt * 128 + j] = (t >= NMETA) ? bf2f(rp[C_HQ]) : 0.f; }
            }
            __syncthreads();
            if (act) {
#pragma unroll 1
                for (int tt = 0; tt < 16; ++tt) { const int t = t0 + tt; const float iv = bf2f(rowptr(P, Pm, b, t)[C_HI + h * 128 + j]);
                    float o = 0.f;
#pragma unroll
                    for (int d = 0; d < 128; d += 4) {
                        const f32x4 f4 = *(const LAS f32x4*)(fL + tt * 128 + d), k4 = *(const LAS f32x4*)(kL + tt * 128 + d), q4 = *(const LAS f32x4*)(qL + tt * 128 + d);
                        S[d + 0] = fmaf(f4.x, S[d + 0], k4.x * iv); o = fmaf(S[d + 0], q4.x, o);
                        S[d + 1] = fmaf(f4.y, S[d + 1], k4.y * iv); o = fmaf(S[d + 1], q4.y, o);
                        S[d + 2] = fmaf(f4.z, S[d + 2], k4.z * iv); o = fmaf(S[d + 2], q4.z, o);
                        S[d + 3] = fmaf(f4.w, S[d + 3], k4.w * iv); o = fmaf(S[d + 3], q4.w, o);
                    }
                    oL[tt * 128 + j] = o; }
            }
            __syncthreads();
            if (act && t0 >= NMETA) {
                const int row = j >> 3, part = j & 7; float ss = 0.f;
#pragma unroll
                for (int i = 0; i < 16; ++i) { const float v = oL[row * 128 + part * 16 + i]; ss += v * v; }
                ss += __shfl_xor(ss, 1); ss += __shfl_xor(ss, 2); ss += __shfl_xor(ss, 4);
                if (part == 0) rsL[row] = 1.f / sqrtf(ss * (1.f / 128.f) + EPS);
            }
            __syncthreads();
            if (act && t0 >= NMETA) {
#pragma unroll 4
                for (int tt = 0; tt < 16; ++tt) { const int t = t0 + tt; const float gt = bf2f(rowptr(P, Pm, b, t)[C_HG + h * 128 + j]);
                    const float y = oL[tt * 128 + j] * rsL[tt] * onw * sigmoidf_(gt);
                    YB[(size_t)(b * SEQ + t - NMETA) * WHD + h * 128 + j] = (bf16)f2bf(y); }
            }
        }
    } else {
        LAS float* sc = (LAS float*)(lds + wave * 8448);
        LAS float* qs = (LAS float*)(lds + 8 * 8448 + wave * 512);
        const int nwg = G - 32, wgi = bx - 32;
        for (int u = wgi * NWAVES + wave; u < MR * NH; u += nwg * NWAVES) {
            const int s = u & (SEQ - 1), bh = u >> 11, h = bh & 15, b = bh >> 4;
            const int row = b * SEQ + s, nk = NMETA + s + 1;
            if (lane < 16) { const v4u qv = *(const GAS v4u*)(P + (size_t)row * NIN + C_Q + h * 128 + lane * 8);
                LAS float* qd = qs + lane * 8;
                qd[0] = bflo(qv.x); qd[1] = bfhi(qv.x); qd[2] = bflo(qv.y); qd[3] = bfhi(qv.y); qd[4] = bflo(qv.z); qd[5] = bfhi(qv.z); qd[6] = bflo(qv.w); qd[7] = bfhi(qv.w); }
            LDS_WAIT(); asm volatile("" ::: "memory");
            float oacc[8];
#pragma unroll
            for (int e = 0; e < 8; ++e) oacc[e] = 0.f;
            const int kq = lane >> 4, eg = lane & 15;
#pragma unroll 1
            for (int c = 0; c < 2; ++c) {
                float mx = -1e30f;
                for (int kb = 0; kb < nk; kb += 64) { const int key = kb + lane;
                    if (key < nk) { const bf16* kr = rowptr(P, Pm, b, key) + C_K + h * 128 + c * 64; float dsum = 0.f;
#pragma unroll
                        for (int dd = 0; dd < 8; ++dd) { const v4u kv = *(const GAS v4u*)(kr + dd * 8); const f32x4 qa = *(const LAS f32x4*)(qs + c * 64 + dd * 8), qb = *(const LAS f32x4*)(qs + c * 64 + dd * 8 + 4);
                            dsum += (bflo(kv.x) * qa.x + bfhi(kv.x) * qa.y) + (bflo(kv.y) * qa.z + bfhi(kv.y) * qa.w) + (bflo(kv.z) * qb.x + bfhi(kv.z) * qb.y) + (bflo(kv.w) * qb.z + bfhi(kv.w) * qb.w); }
                        sc[key] = dsum; mx = fmaxf(mx, dsum); } }
                mx = wave_max(mx);
                LDS_WAIT(); asm volatile("" ::: "memory");
                float l = 0.f;
                for (int kb = 0; kb < nk; kb += 64) { const int key = kb + lane; if (key < nk) { const float p = __builtin_amdgcn_exp2f(sc[key] - mx); sc[key] = p; l += p; } }
                l = wave_sum(l);
                LDS_WAIT(); asm volatile("" ::: "memory");
                const float coef = (c == 0 ? 1.f : -lam) / l;
                for (int k4 = 0; k4 < nk; k4 += 4) { const int key = k4 + kq;
                    if (key < nk) { const float p = sc[key] * coef; const v4u vv = *(const GAS v4u*)(rowptr(P, Pm, b, key) + C_V + h * 128 + eg * 8);
                        oacc[0] += p * bflo(vv.x); oacc[1] += p * bfhi(vv.x); oacc[2] += p * bflo(vv.y); oacc[3] += p * bfhi(vv.y);
                        oacc[4] += p * bflo(vv.z); oacc[5] += p * bfhi(vv.z); oacc[6] += p * bflo(vv.w); oacc[7] += p * bfhi(vv.w); } }
                LDS_WAIT(); asm volatile("" ::: "memory");
            }
            float ss = 0.f;
#pragma unroll
            for (int e = 0; e < 8; ++e) { oacc[e] += __shfl_xor(oacc[e], 16); oacc[e] += __shfl_xor(oacc[e], 32); ss += oacc[e] * oacc[e]; }
            ss += __shfl_xor(ss, 1); ss += __shfl_xor(ss, 2); ss += __shfl_xor(ss, 4); ss += __shfl_xor(ss, 8);
            const float rstd = 1.f / sqrtf(ss * (1.f / 128.f) + EPS);
            if (kq == 0) { float y[8];
#pragma unroll
                for (int e = 0; e < 8; ++e) y[e] = oacc[e] * rstd * subln[eg * 8 + e] * (1.f - LAM_INIT);
                v4u w; w.x = pk2(y[0], y[1]); w.y = pk2(y[2], y[3]); w.z = pk2(y[4], y[5]); w.w = pk2(y[6], y[7]);
                *(GAS v4u*)(YA + (size_t)row * WHD + h * 128 + eg * 8) = w; }
        }
    }
    xcd_barrier(bar);

    {
        { pg8::Gemm g{YA, Wt_upa, MR, DM, WHD}; pg8::StaticOrder S; S.init(MR, DM, G, bx); EpiUpA E{out, P};
          pg8::gemm_phase<EpiUpA, pg8::StaticOrder, true, true>(lds, g, S, E); }
        __syncthreads();
        { pg8::Gemm g{YB, Wt_upb, MR, DM, WHD}; pg8::StaticOrder S; S.init(MR, DM, G, bx); EpiUpB E{out, P, MG};
          pg8::gemm_phase<EpiUpB, pg8::StaticOrder, true, true>(lds, g, S, E); }
    }
    xcd_barrier(bar);

    {
        pg8::Gemm g{MG, Wt_out, MR, DM, DM}; pg8::StaticOrder S; S.init(MR, DM, G, bx); EpiOut E{x, out, U, norm_mlp, SSQ};
        pg8::gemm_phase<EpiOut, pg8::StaticOrder, true, true>(lds, g, S, E);
    }
    xcd_barrier(bar);
    {
        const int gt = bx * (NWAVES * 64) + tid;
        for (int row = gt; row < MR; row += G * NWAVES * 64) { float s = 0.f;
#pragma unroll
            for (int i = 0; i < 16; ++i) { const f32x4 v = *(const GAS f32x4*)(SSQ + (size_t)row * 64 + i * 4); s += (v.x + v.y) + (v.z + v.w); }
            RSTD[row] = 1.f / sqrtf(s * (1.f / DM) + EPS); }
    }
    xcd_barrier(bar);

    {
        pg8::Gemm g{U, Wt_ff1, MR, DFF, DM}; pg8::StaticOrder S; S.init(MR, DFF, G, bx); EpiFf1 E{HID, RSTD};
        pg8::gemm_phase<EpiFf1, pg8::StaticOrder, true, true>(lds, g, S, E);
    }
    xcd_barrier(bar);

    {
        pg8::Gemm g{HID, Wt_ff2, MR, DM, DFF}; pg8::StaticOrder S; S.init(MR, DM, G, bx); EpiFf2 E{out};
        pg8::gemm_phase<EpiFf2, pg8::StaticOrder, true, true>(lds, g, S, E);
    }
}

extern "C" void kernel_launch(void* const* d_in, const int* in_sizes, int n_in, void* d_out, int out_size, void* d_ws, size_t ws_size, hipStream_t stream) {
    static int grid = 0;
    if (grid == 0) {
        if (n_in != 19 || out_size != MR * DM || ws_size < WS_END) { fprintf(stderr, "kernel_launch: unexpected shapes (n_in %d out %d ws %zu)\n", n_in, out_size, ws_size); grid = -1; return; }
        int dev = 0, cus = 0, per_cu = 0;
        if (hipGetDevice(&dev) != hipSuccess || hipDeviceGetAttribute(&cus, hipDeviceAttributeMultiprocessorCount, dev) != hipSuccess) { grid = -1; return; }
        if (hipFuncSetAttribute((const void*)mk_fwd, hipFuncAttributeMaxDynamicSharedMemorySize, LDS_BYTES) != hipSuccess) { fprintf(stderr, "kernel_launch: hipFuncSetAttribute failed\n"); grid = -1; return; }
        if (hipOccupancyMaxActiveBlocksPerMultiprocessor(&per_cu, (const void*)mk_fwd, NWAVES * 64, LDS_BYTES) != hipSuccess || per_cu < 1) { fprintf(stderr, "kernel_launch: occupancy query says %d\n", per_cu); }
        (void)hipGetLastError();
        grid = cus;
    }
    if (grid < 0) return;
    if (hipMemsetAsync((char*)d_ws + WS_CTL, 0, CTL_ZERO_BYTES, stream) != hipSuccess) return;
    Ptrs a{};
    for (int i = 0; i < 19; ++i) a.in[i] = (const float*)d_in[i];
    a.out = (float*)d_out; a.ws = (unsigned char*)d_ws;
    hipLaunchKernelGGL(mk_fwd, dim3(grid), dim3(NWAVES * 64), LDS_BYTES, stream, a);
}
```

```cpp
#include <hip/hip_runtime.h>
#include <cstdio>
#include <cstdint>
namespace pg8 {
#define PG8_LAS __attribute__((address_space(3)))
typedef unsigned short bf16_t;
typedef short bf16x8 __attribute__((ext_vector_type(8)));
typedef float f32x4 __attribute__((ext_vector_type(4)));
typedef unsigned u32x4 __attribute__((ext_vector_type(4)));
constexpr int BM = 256, BK = 64, HALF = 128, HTB = HALF * BK * 2  , STAGE_BYTES = 8 * HTB, NXCD = 8, WGM = 8;

__host__ __device__ __forceinline__ int lds_byte(int r, int c) { const int st = (r >> 4) * 2 + (c >> 5), rr = r & 15, cc = c & 31, ob = rr * 64 + cc * 2; return st * 1024 + (ob ^ (((ob >> 9) & 1) << 5)); }
__host__ __device__ __forceinline__ void stage_rc(int b, int& R, int& C) { const int st = b / 1024, sb = b % 1024, swz = sb ^ (((sb >> 9) & 1) << 5); R = (st >> 1) * 16 + swz / 64; C = (st & 1) * 32 + (swz % 64) / 2; }
__host__ __device__ __forceinline__ int perm32(int rho) { const int n = rho >> 4, i = rho & 15; return 8 * (i >> 2) + 4 * n + (i & 3); }

struct Unit { int pm, pn; };
struct Gemm { const bf16_t* A; const bf16_t* Bt; int M, N, K; };

struct StaticOrder {
    int nM, nN, nwg, G, c;
    __host__ __device__ void init(int M, int N, int G_, int c_) { nM = M / BM; nN = N / BM; nwg = nM * nN; G = G_; c = c_; }
    __host__ __device__ bool next(int i, Unit& u) const {
        const long L = (long)i * G + c; if (L >= nwg) return false;
        int wgid = (int)L; { const int q = nwg / NXCD, r = nwg % NXCD, xcd = wgid % NXCD, off = wgid / NXCD; wgid = (xcd < r ? xcd * (q + 1) : r * (q + 1) + (xcd - r) * q) + off; }
        const int nig = WGM * nN, gid = wgid / nig, fm = gid * WGM, gsz = (nM - fm) < WGM ? (nM - fm) : WGM;
        u.pm = fm + ((wgid % nig) % gsz); u.pn = (wgid % nig) / gsz; return true;
    }
    __device__ __forceinline__ void a_ready(const Unit&) const {}
    __device__ __forceinline__ void done(const Unit&) const {}
};

__device__ __forceinline__ unsigned cvt_pk_bf16(float lo, float hi) { unsigned r; asm volatile("v_cvt_pk_bf16_f32 %0, %1, %2" : "=v"(r) : "v"(lo), "v"(hi)); return r; }
typedef float f32x2 __attribute__((ext_vector_type(2)));
template <class Epi, class Sched, bool ALIGN_EPI = false, bool SP2 = false>
__device__ __forceinline__ void gemm_phase(PG8_LAS unsigned char* lds, const Gemm g, const Sched& S, const Epi& E) {
    const int tid = threadIdx.x, wid = __builtin_amdgcn_readfirstlane(tid >> 6), lane = tid & 63, wr = wid >> 2, wc = wid & 3, fr = lane & 15, fq = lane >> 4;
    const int K = g.K, nt = K / BK;
    unsigned voffA[2], voffB[2];
#pragma unroll
    for (int i = 0; i < 2; ++i) { int R, C; stage_rc(tid * 16 + i * 8192, R, C); const int Rb = Epi::PERM ? ((R & ~31) + perm32(R & 31)) : R;
        voffA[i] = (unsigned)(R * K + C) * 2u; voffB[i] = (unsigned)(Rb * K + C) * 2u; }
    const size_t kstep = (size_t)(BK * 2);
    const size_t hstep = (size_t)HALF * K * 2;
    const size_t tstep = 2 * hstep;
    const unsigned ldsw = (unsigned)wid * 1024u;
    const int aoff = lds_byte(wr * 64 + fr, fq * 8), boff = lds_byte(wc * 32 + fr, fq * 8);
#define PG8_SA(b, h) (((b) * 2 + (h)) * HTB)
#define PG8_SB(b, h) ((4 + (b) * 2 + (h)) * HTB)
#define PG8_STAGE(bufoff, gbase, voff) do { _Pragma("unroll") for (int _i = 0; _i < 2; ++_i) \
        __builtin_amdgcn_global_load_lds((const unsigned*)((const char*)(gbase) + (voff)[_i]), (PG8_LAS unsigned*)(lds + (bufoff) + ldsw + _i * 8192), 16, 0, 0); } while (0)
#define PG8_LDA(dst, b, h) do { _Pragma("unroll") for (int m = 0; m < 4; ++m) _Pragma("unroll") for (int k = 0; k < 2; ++k) dst[m][k] = *(const PG8_LAS bf16x8*)(lds + PG8_SA(b, h) + aoff + m * 2048 + k * 1024); } while (0)
#define PG8_LDB(dst, b, h) do { _Pragma("unroll") for (int n = 0; n < 2; ++n) _Pragma("unroll") for (int k = 0; k < 2; ++k) dst[n][k] = *(const PG8_LAS bf16x8*)(lds + PG8_SB(b, h) + boff + n * 2048 + k * 1024); } while (0)
#define PG8_MMA(ai, bj, At, Bt) do { __builtin_amdgcn_s_setprio(1); _Pragma("unroll") for (int m = 0; m < 4; ++m) _Pragma("unroll") for (int n = 0; n < 2; ++n) _Pragma("unroll") for (int k = 0; k < 2; ++k) \
        acc[ai][bj][m][n] = __builtin_amdgcn_mfma_f32_16x16x32_bf16(Bt[n][k], At[m][k], acc[ai][bj][m][n], 0, 0, 0); __builtin_amdgcn_s_setprio(0); } while (0)
#define PG8_WAIT_V(n) asm volatile("s_waitcnt vmcnt(" #n ")" ::: "memory")
#define PG8_WAIT_L(n) asm volatile("s_waitcnt lgkmcnt(" #n ")" ::: "memory")
#define PG8_BAR __builtin_amdgcn_s_barrier()
#define PG8_SCHED __builtin_amdgcn_sched_barrier(0)
    Unit cur, nxt; int ui = 0;
    if (!S.next(0, cur)) return;
    f32x4 acc[2][2][4][2];
#pragma unroll
    for (int a = 0; a < 2; ++a)
#pragma unroll
        for (int b = 0; b < 2; ++b)
#pragma unroll
            for (int m = 0; m < 4; ++m)
#pragma unroll
                for (int n = 0; n < 2; ++n) acc[a][b][m][n] = (f32x4){0.f, 0.f, 0.f, 0.f};
    bf16x8 At[4][2], B0[2][2], B1[2][2];
    const char* cA = (const char*)g.A + (size_t)cur.pm * tstep; const char* cB = (const char*)g.Bt + (size_t)cur.pn * tstep;
    S.a_ready(cur);
    if constexpr (SP2) {
        PG8_STAGE(PG8_SB(0, 0), cB, voffB); PG8_STAGE(PG8_SB(0, 1), cB + hstep, voffB); PG8_STAGE(PG8_SA(0, 0), cA, voffA); PG8_STAGE(PG8_SA(0, 1), cA + hstep, voffA);
        if (wr == 1) PG8_BAR;
        PG8_WAIT_V(2); PG8_BAR;
        PG8_STAGE(PG8_SB(1, 0), cB + kstep, voffB); PG8_STAGE(PG8_SA(1, 0), cA + kstep, voffA); PG8_STAGE(PG8_SB(1, 1), cB + hstep + kstep, voffB);
        PG8_WAIT_V(6); PG8_BAR;
    } else {
        PG8_STAGE(PG8_SB(0, 0), cB, voffB); PG8_STAGE(PG8_SA(0, 0), cA, voffA); PG8_STAGE(PG8_SB(0, 1), cB + hstep, voffB); PG8_STAGE(PG8_SA(0, 1), cA + hstep, voffA);
        if (wr == 1) PG8_BAR;
        PG8_WAIT_V(4); PG8_BAR;
        PG8_STAGE(PG8_SB(1, 0), cB + kstep, voffB); PG8_STAGE(PG8_SA(1, 0), cA + kstep, voffA); PG8_STAGE(PG8_SB(1, 1), cB + hstep + kstep, voffB);
        PG8_WAIT_V(6); PG8_BAR;
    }
    for (;;) {
        const bool has_next = S.next(ui + 1, nxt);
        const char* nA = has_next ? (const char*)g.A + (size_t)nxt.pm * tstep : cA; const char* nB = has_next ? (const char*)g.Bt + (size_t)nxt.pn * tstep : cB;
        for (int t = 0; t < nt; t += 2) {
            const bool last = (t == nt - 2);
            const char* a1 = cA + (size_t)(t + 1) * kstep;
            const char* a2 = last ? nA : cA + (size_t)(t + 2) * kstep; const char* b2 = last ? nB : cB + (size_t)(t + 2) * kstep;
            const char* a3 = a2 + kstep; const char* b3 = b2 + kstep;
            if (last && has_next) S.a_ready(nxt);
            if constexpr (SP2) {
            PG8_LDB(B0, 0, 0); PG8_LDB(B1, 0, 1); PG8_SCHED; PG8_LDA(At, 0, 0); PG8_STAGE(PG8_SA(1, 1), a1 + hstep, voffA);
            PG8_WAIT_V(8); PG8_WAIT_L(0); PG8_BAR; PG8_MMA(0, 0, At, B0); PG8_MMA(0, 1, At, B1); PG8_BAR; PG8_SCHED;
            PG8_LDA(At, 0, 1); PG8_STAGE(PG8_SB(0, 0), b2, voffB); PG8_STAGE(PG8_SB(0, 1), b2 + hstep, voffB); PG8_STAGE(PG8_SA(0, 0), a2, voffA);
            PG8_WAIT_V(8); PG8_WAIT_L(0); PG8_BAR; PG8_MMA(1, 0, At, B0); PG8_MMA(1, 1, At, B1); PG8_BAR; PG8_SCHED;
            PG8_LDB(B0, 1, 0); PG8_LDB(B1, 1, 1); PG8_SCHED; PG8_LDA(At, 1, 0); PG8_STAGE(PG8_SA(0, 1), a2 + hstep, voffA);
            PG8_WAIT_V(8); PG8_WAIT_L(0); PG8_BAR; PG8_MMA(0, 0, At, B0); PG8_MMA(0, 1, At, B1); PG8_BAR; PG8_SCHED;
            PG8_LDA(At, 1, 1); PG8_STAGE(PG8_SB(1, 0), b3, voffB); PG8_STAGE(PG8_SB(1, 1), b3 + hstep, voffB); PG8_STAGE(PG8_SA(1, 0), a3, voffA);
            PG8_WAIT_V(8); PG8_WAIT_L(0); PG8_BAR; PG8_MMA(1, 0, At, B0); PG8_MMA(1, 1, At, B1); PG8_BAR; PG8_SCHED;
            } else {
            PG8_LDB(B0, 0, 0); PG8_SCHED; PG8_LDA(At, 0, 0); PG8_STAGE(PG8_SA(1, 1), a1 + hstep, voffA);
            PG8_WAIT_L(8); PG8_BAR; PG8_WAIT_L(0); PG8_MMA(0, 0, At, B0); PG8_BAR; PG8_SCHED;
            PG8_LDB(B1, 0, 1); PG8_STAGE(PG8_SB(0, 0), b2, voffB);
            PG8_BAR; PG8_WAIT_L(0); PG8_MMA(0, 1, At, B1); PG8_BAR;
            PG8_LDA(At, 0, 1); PG8_STAGE(PG8_SA(0, 0), a2, voffA);
            PG8_BAR; PG8_WAIT_L(0); PG8_MMA(1, 0, At, B0); PG8_BAR; PG8_SCHED;
            PG8_STAGE(PG8_SB(0, 1), b2 + hstep, voffB);
            PG8_WAIT_V(6); PG8_BAR; PG8_MMA(1, 1, At, B1); PG8_BAR;
            PG8_LDB(B0, 1, 0); PG8_SCHED; PG8_LDA(At, 1, 0); PG8_STAGE(PG8_SA(0, 1), a2 + hstep, voffA);
            PG8_WAIT_L(8); PG8_BAR; PG8_WAIT_L(0); PG8_MMA(0, 0, At, B0); PG8_BAR; PG8_SCHED;
            PG8_LDB(B1, 1, 1); PG8_STAGE(PG8_SB(1, 0), b3, voffB);
            PG8_BAR; PG8_WAIT_L(0); PG8_MMA(0, 1, At, B1); PG8_BAR;
            PG8_LDA(At, 1, 1); PG8_STAGE(PG8_SA(1, 0), a3, voffA);
            PG8_BAR; PG8_WAIT_L(0); PG8_MMA(1, 0, At, B0); PG8_BAR; PG8_SCHED;
            PG8_STAGE(PG8_SB(1, 1), b3 + hstep, voffB);
            PG8_WAIT_V(6); PG8_BAR; PG8_MMA(1, 1, At, B1); PG8_BAR;
            }
        }
        if constexpr (ALIGN_EPI) { if (wr == 0) PG8_BAR; }
        if constexpr (!Epi::AFTER_DRAIN) { E(acc, cur, wr, wc, fr, fq); S.done(cur); }
        if (!has_next) break;
#pragma unroll
        for (int a = 0; a < 2; ++a)
#pragma unroll
            for (int b = 0; b < 2; ++b)
#pragma unroll
                for (int m = 0; m < 4; ++m)
#pragma unroll
                    for (int n = 0; n < 2; ++n) acc[a][b][m][n] = (f32x4){0.f, 0.f, 0.f, 0.f};
        cur = nxt; cA = nA; cB = nB; ++ui;
        if constexpr (ALIGN_EPI) { if (wr == 1) PG8_BAR; }
    }
    PG8_WAIT_V(0);
    if constexpr (!ALIGN_EPI) { if (wr == 0) PG8_BAR; }
    PG8_BAR;
    if constexpr (Epi::AFTER_DRAIN) { E.fused(acc, cur, wr, wc, fr, fq, lds, wid, lane); S.done(cur); }
#undef PG8_SA
#undef PG8_SB
#undef PG8_STAGE
#undef PG8_LDA
#undef PG8_LDB
#undef PG8_MMA
#undef PG8_WAIT_V
#undef PG8_WAIT_L
#undef PG8_BAR
#undef PG8_SCHED
}
}
#define GAS __attribute__((address_space(1)))
#define LAS __attribute__((address_space(3)))
typedef unsigned short bf16;
typedef unsigned v4u __attribute__((ext_vector_type(4)));
typedef float f32x4 __attribute__((ext_vector_type(4)));
typedef short bf16x8 __attribute__((ext_vector_type(8)));
typedef GAS unsigned gu32;
typedef GAS unsigned long long gu64;
#define RLX_AGENT __ATOMIC_RELAXED, __HIP_MEMORY_SCOPE_AGENT
#define LDS_WAIT() asm volatile("s_waitcnt lgkmcnt(0)" ::: "memory")
#define VM_WAIT() asm volatile("s_waitcnt vmcnt(0)" ::: "memory")
__device__ __forceinline__ unsigned long long rt() { return __builtin_amdgcn_s_memrealtime(); }
__device__ __forceinline__ unsigned f2bf(float f) { unsigned u = __builtin_bit_cast(unsigned, f); return (u + 0x7fffu + ((u >> 16) & 1u)) >> 16; }
__device__ __forceinline__ unsigned pk2(float lo, float hi) { return f2bf(lo) | (f2bf(hi) << 16); }
#define XB_TMO      128
#define XB_XCNT(j)  (256  + 64 * (j))
#define XB_XSUB(j)  (1280 + 64 * (j))
#define XB_XGEN(j)  (2304 + 64 * (j))
#define XB_TOP      3328
#define XB_TOPGEN   3392
#define XCD_BAR_WORDS 3456
#define XB_SPIN_CAP (1u << 22)

__device__ __forceinline__ unsigned xb_ld(unsigned* p)              { return __hip_atomic_load(p, __ATOMIC_RELAXED, __HIP_MEMORY_SCOPE_AGENT); }
__device__ __forceinline__ unsigned xb_add(unsigned* p, unsigned v) { return __hip_atomic_fetch_add(p, v, __ATOMIC_RELAXED, __HIP_MEMORY_SCOPE_AGENT); }
__device__ __forceinline__ unsigned xb_xcc_id() { return (unsigned)__builtin_amdgcn_s_getreg((3 << 11) | 20) & 0xFu; }
#define XB_SPIN(cond, bar) do { unsigned _sp = 0; while (cond) { __builtin_amdgcn_s_sleep(1); \
    if ((++_sp & 255u) == 0u) { if (xb_ld(&(bar)[XB_TMO])) break; if (_sp > XB_SPIN_CAP) { atomicAdd(&(bar)[XB_TMO], 1u); break; } } } } while (0)

struct XcdBarrier {
    unsigned* bar; unsigned x;
    volatile LAS unsigned* st;
};

__device__ __forceinline__ XcdBarrier xcd_barrier_post(unsigned* bar, volatile LAS unsigned* st) {
    XcdBarrier b; b.bar = bar; b.x = xb_xcc_id(); b.st = st;
    if (threadIdx.x == 0) (void)xb_add(&bar[XB_XCNT(b.x)], 1u);
    return b;
}
__device__ __forceinline__ void xcd_barrier_complete(unsigned* bar, unsigned x, unsigned& nloc, unsigned& nx) {
    const unsigned G = gridDim.x * gridDim.y * gridDim.z;
    unsigned sum, cnt, mine, sp = 0u;
    for (;;) {
        sum = 0u; cnt = 0u; mine = 0u;
#pragma unroll
        for (unsigned j = 0; j < 16; ++j) { const unsigned c = xb_ld(&bar[XB_XCNT(j)]); sum += c; cnt += (c > 0u) ? 1u : 0u; mine = (j == x) ? c : mine; }
        if (sum == G) break;
        __builtin_amdgcn_s_sleep(1);
        if ((++sp & 255u) == 0u) { if (xb_ld(&bar[XB_TMO])) break; if (sp > XB_SPIN_CAP) { atomicAdd(&bar[XB_TMO], 1u); break; } }
    }
    nloc = mine > 0u ? mine : 1u; nx = cnt > 0u ? cnt : 1u;
}

__device__ __forceinline__ void xcd_barrier(const XcdBarrier& b) {
    asm volatile("s_waitcnt vmcnt(0)" ::: "memory");
    __syncthreads();
    if (threadIdx.x == 0) {
        unsigned* bar = b.bar;
        __builtin_amdgcn_s_waitcnt(0);
        unsigned nloc = b.st[0], nx = b.st[1];
        if (nloc == 0u) { xcd_barrier_complete(bar, b.x, nloc, nx); b.st[0] = nloc; b.st[1] = nx; }
        const unsigned old = xb_add(&bar[XB_XSUB(b.x)], 1u);
        const unsigned gen = old / nloc;
        if (old + 1u == (gen + 1u) * nloc) {
            __builtin_amdgcn_fence(__ATOMIC_RELEASE, "agent");
            asm volatile("s_waitcnt vmcnt(0)" ::: "memory");
            const unsigned og = xb_add(&bar[XB_TOP], 1u);
            const unsigned tg = og / nx;
            if (og + 1u == (tg + 1u) * nx) xb_add(&bar[XB_TOPGEN], 1u);
            else XB_SPIN(xb_ld(&bar[XB_TOPGEN]) == tg, bar);
            __builtin_amdgcn_fence(__ATOMIC_ACQUIRE, "agent");
            xb_add(&bar[XB_XGEN(b.x)], 1u);
            asm volatile("s_waitcnt vmcnt(0)" ::: "memory");
        } else {
            XB_SPIN(xb_ld(&bar[XB_XGEN(b.x)]) == gen, bar);
            __builtin_amdgcn_fence(__ATOMIC_ACQUIRE, "agent");
            asm volatile("s_waitcnt vmcnt(0)" ::: "memory");
        }
    }
    __syncthreads();
}
constexpr int NWAVES = 8;
constexpr int DM = 4096, NB = 4, SEQ = 2048, NMETA = 16, TT = SEQ + NMETA;
constexpr int MR = NB * SEQ;
constexpr int NIN = 22528, DFF = 16384, NH = 16, WHD = 2048;
constexpr int C_Q = 0, C_K = 2048, C_V = 4096, C_HQ = 6144, C_HF = 8192, C_HI = 10240, C_HG = 12288, C_GA = 14336, C_GB = 18432;
constexpr float EPS = 1e-6f;
constexpr float C2 = 0.18033688011112042f;
constexpr float LAM_INIT = 0.2f;

constexpr size_t MiB = 1u << 20;
constexpr size_t WS_CTL = 0, CTL_ZERO_BYTES = 1 * MiB;
constexpr size_t WS_WIN = 2 * MiB, WS_WUPA = 178 * MiB, WS_WUPB = 194 * MiB, WS_WOUT = 210 * MiB, WS_WFF1 = 242 * MiB, WS_WFF2 = 370 * MiB;
constexpr size_t WS_U = 498 * MiB;
constexpr size_t WS_UMETA = 562 * MiB;
constexpr size_t WS_PM = 563 * MiB;
constexpr size_t WS_ROPE = 564 * MiB;
constexpr size_t WS_RSTD = 565 * MiB;
constexpr size_t WS_SSQ = 566 * MiB;
constexpr size_t WS_P = 568 * MiB;
constexpr size_t WS_YA = 920 * MiB, WS_YB = 952 * MiB, WS_MG = 984 * MiB, WS_END = 1048 * MiB;
constexpr int CW_BAR = 4096;

constexpr int RING_BYTES = 131072, LDSCTL_OFF = 146432, LDS_BYTES = 147456;

__device__ __forceinline__ float bf2f(bf16 v) { return __builtin_bit_cast(float, (unsigned)v << 16); }
__device__ __forceinline__ float bflo(unsigned w) { return __builtin_bit_cast(float, w << 16); }
__device__ __forceinline__ float bfhi(unsigned w) { return __builtin_bit_cast(float, w & 0xffff0000u); }
__device__ __forceinline__ float wave_sum(float v) {
#pragma unroll
    for (int o = 1; o < 64; o <<= 1) v += __shfl_xor(v, o);
    return v;
}
__device__ __forceinline__ float wave_max(float v) {
#pragma unroll
    for (int o = 1; o < 64; o <<= 1) v = fmaxf(v, __shfl_xor(v, o));
    return v;
}
__device__ __forceinline__ float sigmoidf_(float x) { return __builtin_amdgcn_rcpf(1.0f + __expf(-x)); }

__device__ __forceinline__ void p0_transpose_item(const float* W, int K, int N, bf16* WT, LAS float* scr, int item, int lane) {
    const int nblk = N / 32, kb = item / nblk, nb = item % nblk, k0 = 64 * kb, n0 = 32 * nb;
#pragma unroll 8
    for (int i = 0; i < 32; ++i) { const int kk = 2 * i + (lane >> 5); scr[kk * 33 + (lane & 31)] = W[(size_t)(k0 + kk) * N + n0 + (lane & 31)]; }
    LDS_WAIT(); asm volatile("" ::: "memory");
    const int c = lane & 7;
#pragma unroll
    for (int j = 0; j < 4; ++j) { const int n = (lane >> 3) + 8 * j; const LAS float* s = scr + (8 * c) * 33 + n;
        v4u o; o.x = pk2(s[0 * 33], s[1 * 33]); o.y = pk2(s[2 * 33], s[3 * 33]); o.z = pk2(s[4 * 33], s[5 * 33]); o.w = pk2(s[6 * 33], s[7 * 33]);
        *(GAS v4u*)(WT + (size_t)(n0 + n) * K + k0 + 8 * c) = o; }
    LDS_WAIT(); asm volatile("" ::: "memory");
}
__device__ __forceinline__ void rms_row_to_bf16(const float* xrow, const float* g, bf16* orow, int lane) {
    const GAS f32x4* xr = (const GAS f32x4*)xrow + lane; const GAS f32x4* gr = (const GAS f32x4*)g + lane;
    f32x4 v[16]; float s = 0.f;
#pragma unroll
    for (int j = 0; j < 16; ++j) { v[j] = xr[64 * j]; s += (v[j].x * v[j].x + v[j].y * v[j].y) + (v[j].z * v[j].z + v[j].w * v[j].w); }
    const float rstd = 1.f / sqrtf(wave_sum(s) * (1.f / DM) + EPS);
    GAS unsigned long long* o8 = (GAS unsigned long long*)orow + lane;
#pragma unroll
    for (int j = 0; j < 16; ++j) { const f32x4 gg = gr[64 * j];
        o8[64 * j] = (unsigned long long)pk2(v[j].x * rstd * gg.x, v[j].y * rstd * gg.y) | ((unsigned long long)pk2(v[j].z * rstd * gg.z, v[j].w * rstd * gg.w) << 32); }
}
__device__ __forceinline__ void sincos_d(double a, float& sn, float& cs) {
    const double PI = 3.14159265358979323846;
    const double k = rint(a / PI); const double r = a - k * PI; const double r2 = r * r;
    double s = 1.0, c = 1.0, ts = 1.0, tc = 1.0;
#pragma unroll
    for (int i = 1; i <= 11; ++i) { tc *= -r2 / (double)((2 * i - 1) * (2 * i)); ts *= -r2 / (double)((2 * i) * (2 * i + 1)); c += tc; s += ts; }
    s *= r;
    const bool odd = ((long long)k) & 1;
    sn = (float)(odd ? -s : s); cs = (float)(odd ? -c : c);
}

struct Ptrs {
    const float* in[19]; float* out; unsigned char* ws;
};

__device__ __forceinline__ const bf16* rowptr(const bf16* P, const bf16* Pm, int b, int t) {
    return t < NMETA ? Pm + (size_t)t * NIN : P + (size_t)(b * SEQ + t - NMETA) * NIN;
}

struct EpiProj {
    static constexpr bool PERM = true, AFTER_DRAIN = false;
    bf16* O; int ldc; int sig_tile;
    __device__ __forceinline__ void operator()(const pg8::f32x4 (&acc)[2][2][4][2], const pg8::Unit& u, int wr, int wc, int fr, int fq) const {
        const int row0 = u.pm * 256 + wr * 64 + fr, col0 = u.pn * 256 + wc * 32 + 8 * fq; const bool sg = u.pn >= sig_tile;
#pragma unroll
        for (int ai = 0; ai < 2; ++ai)
#pragma unroll
            for (int m = 0; m < 4; ++m) { bf16* rowp = O + (size_t)(row0 + ai * 128 + m * 16) * ldc + col0;
#pragma unroll
                for (int bj = 0; bj < 2; ++bj) { pg8::f32x4 v0 = acc[ai][bj][m][0], v1 = acc[ai][bj][m][1];
                    if (sg) { for (int e = 0; e < 4; ++e) { v0[e] = sigmoidf_(v0[e]); v1[e] = sigmoidf_(v1[e]); } }
                    v4u w; w.x = pg8::cvt_pk_bf16(v0[0], v0[1]); w.y = pg8::cvt_pk_bf16(v0[2], v0[3]); w.z = pg8::cvt_pk_bf16(v1[0], v1[1]); w.w = pg8::cvt_pk_bf16(v1[2], v1[3]);
                    *(v4u*)(rowp + bj * 128) = w; } }
    }
};
struct EpiUpA {
    static constexpr bool PERM = true, AFTER_DRAIN = false;
    float* T; const bf16* P;
    __device__ __forceinline__ void operator()(const pg8::f32x4 (&acc)[2][2][4][2], const pg8::Unit& u, int wr, int wc, int fr, int fq) const {
        const int row0 = u.pm * 256 + wr * 64 + fr, col0 = u.pn * 256 + wc * 32 + 8 * fq;
#pragma unroll
        for (int ai = 0; ai < 2; ++ai)
#pragma unroll
            for (int m = 0; m < 4; ++m) { const int row = row0 + ai * 128 + m * 16;
#pragma unroll
                for (int bj = 0; bj < 2; ++bj) { const int col = col0 + bj * 128;
                    const v4u g = *(const v4u*)(P + (size_t)row * NIN + C_GA + col);
                    pg8::f32x4 v0 = acc[ai][bj][m][0], v1 = acc[ai][bj][m][1];
                    v0[0] *= bflo(g.x); v0[1] *= bfhi(g.x); v0[2] *= bflo(g.y); v0[3] *= bfhi(g.y); v1[0] *= bflo(g.z); v1[1] *= bfhi(g.z); v1[2] *= bflo(g.w); v1[3] *= bfhi(g.w);
                    float* tp = T + (size_t)row * DM + col; *(pg8::f32x4*)tp = v0; *(pg8::f32x4*)(tp + 4) = v1; } }
    }
};
struct EpiUpB {
    static constexpr bool PERM = true, AFTER_DRAIN = false;
    const float* T; const bf16* P; bf16* MG;
    __device__ __forceinline__ void operator()(const pg8::f32x4 (&acc)[2][2][4][2], const pg8::Unit& u, int wr, int wc, int fr, int fq) const {
        const int row0 = u.pm * 256 + wr * 64 + fr, col0 = u.pn * 256 + wc * 32 + 8 * fq;
#pragma unroll
        for (int ai = 0; ai < 2; ++ai)
#pragma unroll
            for (int m = 0; m < 4; ++m) { const int row = row0 + ai * 128 + m * 16;
#pragma unroll
                for (int bj = 0; bj < 2; ++bj) { const int col = col0 + bj * 128;
                    const v4u g = *(const v4u*)(P + (size_t)row * NIN + C_GB + col);
                    const float* tp = T + (size_t)row * DM + col; const pg8::f32x4 t0 = *(const pg8::f32x4*)tp, t1 = *(const pg8::f32x4*)(tp + 4);
                    pg8::f32x4 v0 = acc[ai][bj][m][0], v1 = acc[ai][bj][m][1];
                    v0[0] = t0[0] + v0[0] * bflo(g.x); v0[1] = t0[1] + v0[1] * bfhi(g.x); v0[2] = t0[2] + v0[2] * bflo(g.y); v0[3] = t0[3] + v0[3] * bfhi(g.y);
                    v1[0] = t1[0] + v1[0] * bflo(g.z); v1[1] = t1[1] + v1[1] * bfhi(g.z); v1[2] = t1[2] + v1[2] * bflo(g.w); v1[3] = t1[3] + v1[3] * bfhi(g.w);
                    v4u w; w.x = pg8::cvt_pk_bf16(v0[0], v0[1]); w.y = pg8::cvt_pk_bf16(v0[2], v0[3]); w.z = pg8::cvt_pk_bf16(v1[0], v1[1]); w.w = pg8::cvt_pk_bf16(v1[2], v1[3]);
                    *(v4u*)(MG + (size_t)row * DM + col) = w; } }
    }
};
struct EpiOut {
    static constexpr bool PERM = true, AFTER_DRAIN = false;
    const float* X; float* H1; bf16* A2; const float* G; float* SSQ;
    __device__ __forceinline__ void operator()(const pg8::f32x4 (&acc)[2][2][4][2], const pg8::Unit& u, int wr, int wc, int fr, int fq) const {
        const int row0 = u.pm * 256 + wr * 64 + fr, col0 = u.pn * 256 + wc * 32 + 8 * fq;
#pragma unroll
        for (int ai = 0; ai < 2; ++ai)
#pragma unroll
            for (int m = 0; m < 4; ++m) { const int row = row0 + ai * 128 + m * 16; float ss = 0.f;
#pragma unroll
                for (int bj = 0; bj < 2; ++bj) { const int col = col0 + bj * 128; const size_t off = (size_t)row * DM + col;
                    const pg8::f32x4 x0 = *(const pg8::f32x4*)(X + off), x1 = *(const pg8::f32x4*)(X + off + 4);
                    const pg8::f32x4 g0 = *(const pg8::f32x4*)(G + col), g1 = *(const pg8::f32x4*)(G + col + 4);
                    const pg8::f32x4 h0 = x0 + acc[ai][bj][m][0], h1 = x1 + acc[ai][bj][m][1];
                    *(pg8::f32x4*)(H1 + off) = h0; *(pg8::f32x4*)(H1 + off + 4) = h1;
                    ss += (h0[0] * h0[0] + h0[1] * h0[1]) + (h0[2] * h0[2] + h0[3] * h0[3]) + (h1[0] * h1[0] + h1[1] * h1[1]) + (h1[2] * h1[2] + h1[3] * h1[3]);
                    v4u w; w.x = pg8::cvt_pk_bf16(h0[0] * g0[0], h0[1] * g0[1]); w.y = pg8::cvt_pk_bf16(h0[2] * g0[2], h0[3] * g0[3]);
                    w.z = pg8::cvt_pk_bf16(h1[0] * g1[0], h1[1] * g1[1]); w.w = pg8::cvt_pk_bf16(h1[2] * g1[2], h1[3] * g1[3]);
                    *(v4u*)(A2 + off) = w; }
                ss += __shfl_xor(ss, 16); ss += __shfl_xor(ss, 32);
                if (fq == 0) SSQ[(size_t)row * 64 + u.pn * 4 + wc] = ss; }
    }
};
struct EpiFf1 {
    static constexpr bool PERM = true, AFTER_DRAIN = false;
    bf16* H; const float* RSTD;
    __device__ __forceinline__ void operator()(const pg8::f32x4 (&acc)[2][2][4][2], const pg8::Unit& u, int wr, int wc, int fr, int fq) const {
        const int row0 = u.pm * 256 + wr * 64 + fr, col0 = u.pn * 256 + wc * 32 + 8 * fq;
#pragma unroll
        for (int ai = 0; ai < 2; ++ai)
#pragma unroll
            for (int m = 0; m < 4; ++m) { const int row = row0 + ai * 128 + m * 16; const float rs = RSTD[row];
#pragma unroll
                for (int bj = 0; bj < 2; ++bj) { pg8::f32x4 v0 = acc[ai][bj][m][0] * rs, v1 = acc[ai][bj][m][1] * rs;
#pragma unroll
                    for (int e = 0; e < 4; ++e) { const float a = fmaxf(v0[e], 0.f), b = fmaxf(v1[e], 0.f); v0[e] = a * a; v1[e] = b * b; }
                    v4u w; w.x = pg8::cvt_pk_bf16(v0[0], v0[1]); w.y = pg8::cvt_pk_bf16(v0[2], v0[3]); w.z = pg8::cvt_pk_bf16(v1[0], v1[1]); w.w = pg8::cvt_pk_bf16(v1[2], v1[3]);
                    *(v4u*)(H + (size_t)row * DFF + col0 + bj * 128) = w; } }
    }
};
struct EpiFf2 {
    static constexpr bool PERM = false, AFTER_DRAIN = false;
    float* O;
    __device__ __forceinline__ void operator()(const pg8::f32x4 (&acc)[2][2][4][2], const pg8::Unit& u, int wr, int wc, int fr, int fq) const {
        const int row0 = u.pm * 256 + wr * 64 + fr, col0 = u.pn * 256 + wc * 32 + 4 * fq;
#pragma unroll
        for (int ai = 0; ai < 2; ++ai)
#pragma unroll
            for (int m = 0; m < 4; ++m) { float* rowp = O + (size_t)(row0 + ai * 128 + m * 16) * DM + col0;
#pragma unroll
                for (int bj = 0; bj < 2; ++bj)
#pragma unroll
                    for (int n = 0; n < 2; ++n) { pg8::f32x4* p = (pg8::f32x4*)(rowp + bj * 128 + n * 16); *p = *p + acc[ai][bj][m][n]; } }
    }
};


namespace da {
typedef float f32x16 __attribute__((ext_vector_type(16)));
typedef short s16x4 __attribute__((ext_vector_type(4)));
constexpr int KBUF = 16384, VBUF = 16384, K_OFF = 0, V_OFF = 32768;
constexpr float THR = 8.f;
__device__ __forceinline__ int crow(int r, int hi) { return (r & 3) + 8 * (r >> 2) + 4 * hi; }
__device__ __forceinline__ int kswz(int row, int colB) { return row * 256 + (colB ^ ((row & 7) << 4)); }
__device__ __forceinline__ int v_st(int k, int c) { return ((k >> 3) * 4 + (c >> 5)) * 512 + ((k & 7) * 32 + (c & 31)) * 2; }
__device__ __forceinline__ int v_rd_base(int lane) { return ((lane & 3) << 3) | (((lane >> 2) & 3) << 6) | (((lane >> 4) & 1) << 5) | (((lane >> 5) & 1) << 8); }
__device__ __forceinline__ s16x4 vtr(LAS const unsigned char* p) { return __builtin_bit_cast(s16x4, __builtin_amdgcn_ds_read_tr16_b64_v4i16((LAS s16x4*)p)); }
__device__ __forceinline__ float pl_max(float v) { auto rr = __builtin_amdgcn_permlane32_swap(__float_as_uint(v), __float_as_uint(v), false, false); return fmaxf(__uint_as_float(rr[0]), __uint_as_float(rr[1])); }
__device__ __forceinline__ float pl_sum(float v) { auto rr = __builtin_amdgcn_permlane32_swap(__float_as_uint(v), __float_as_uint(v), false, false); return __uint_as_float(rr[0]) + __uint_as_float(rr[1]); }
__device__ __forceinline__ bf16x8 pack8(const f32x16& p, int base) {
    v4u w; w.x = pg8::cvt_pk_bf16(p[base + 0], p[base + 1]); w.y = pg8::cvt_pk_bf16(p[base + 2], p[base + 3]); w.z = pg8::cvt_pk_bf16(p[base + 4], p[base + 5]); w.w = pg8::cvt_pk_bf16(p[base + 6], p[base + 7]);
    return __builtin_bit_cast(bf16x8, w);
}
template <bool META>
__device__ __forceinline__ void tile(LAS const unsigned char* Kb, LAS const unsigned char* Vb, const bf16x8 (&qr)[4], f32x16 (&o)[4], float& m_reg, float& l_reg, int c, int r32, int hi, int lane, bool diag, int rel) {
    f32x16 p0 = {}, p1 = {};
#pragma unroll
    for (int d0 = 0; d0 < 4; ++d0) { const int cb = (c * 64 + d0 * 16 + hi * 8) * 2;
        const bf16x8 b0 = *(LAS const bf16x8*)(Kb + kswz(r32, cb));
        p0 = __builtin_amdgcn_mfma_f32_32x32x16_bf16(b0, qr[d0], p0, 0, 0, 0);
        if (!META) { const bf16x8 b1 = *(LAS const bf16x8*)(Kb + kswz(32 + r32, cb)); p1 = __builtin_amdgcn_mfma_f32_32x32x16_bf16(b1, qr[d0], p1, 0, 0, 0); } }
    if (META) {
#pragma unroll
        for (int r = 0; r < 16; ++r) if (crow(r, hi) >= NMETA) p0[r] = -1e30f;
    } else if (diag) {
#pragma unroll
        for (int r = 0; r < 16; ++r) { if (crow(r, hi) > rel) p0[r] = -1e30f; if (32 + crow(r, hi) > rel) p1[r] = -1e30f; }
    }
    float pmax = p0[0];
#pragma unroll
    for (int r = 1; r < 16; ++r) pmax = fmaxf(pmax, p0[r]);
    if (!META) {
#pragma unroll
        for (int r = 0; r < 16; ++r) pmax = fmaxf(pmax, p1[r]); }
    pmax = pl_max(pmax);
    if (!__all(pmax - m_reg <= THR)) {
        const float mn = fmaxf(m_reg, pmax), alpha = __builtin_amdgcn_exp2f(m_reg - mn); m_reg = mn; l_reg *= alpha;
#pragma unroll
        for (int d = 0; d < 4; ++d)
#pragma unroll
            for (int r = 0; r < 16; ++r) o[d][r] *= alpha;
    }
    float ps = 0.f;
#pragma unroll
    for (int r = 0; r < 16; ++r) { p0[r] = __builtin_amdgcn_exp2f(p0[r] - m_reg); ps += p0[r]; }
    if (!META) {
#pragma unroll
        for (int r = 0; r < 16; ++r) { p1[r] = __builtin_amdgcn_exp2f(p1[r] - m_reg); ps += p1[r]; } }
    l_reg += pl_sum(ps);
    bf16x8 pb[4]; pb[0] = pack8(p0, 0);
    if (!META) { pb[1] = pack8(p0, 8); pb[2] = pack8(p1, 0); pb[3] = pack8(p1, 8); }
    LAS const unsigned char* vb = Vb + v_rd_base(lane);
#pragma unroll
    for (int d0 = 0; d0 < 4; ++d0)
#pragma unroll
        for (int ks = 0; ks < (META ? 1 : 4); ++ks) {
            const s16x4 lo = vtr(vb + d0 * 512 + ks * 4096), hh = vtr(vb + d0 * 512 + ks * 4096 + 2048);
            const bf16x8 a = (bf16x8){lo[0], lo[1], lo[2], lo[3], hh[0], hh[1], hh[2], hh[3]};
            o[d0] = __builtin_amdgcn_mfma_f32_32x32x16_bf16(a, pb[ks], o[d0], 0, 0, 0); }
}
__device__ __forceinline__ void unit(LAS unsigned char* lds, const bf16* P, const bf16* Pm, bf16* YA, const float* subln, float lam, int b, int h, int qb, int tid, int wave, int lane) {
    const int c = wave >> 2, jw = wave & 3, r32 = lane & 31, hi = lane >> 5, q0 = qb * 128, NT = 2 * qb + 2;
    bf16x8 qr[4];
    { const bf16* qp = P + (size_t)(b * SEQ + q0 + jw * 32 + r32) * NIN + C_Q + h * 128 + c * 64 + hi * 8;
#pragma unroll
      for (int d0 = 0; d0 < 4; ++d0) qr[d0] = *(const GAS bf16x8*)(qp + d0 * 16); }
    f32x16 o[4] = {}; float m_reg = -1e30f, l_reg = 0.f;
    const int sr = tid >> 4, sc = (tid & 15) * 8;
    { const int mr = sr & 15;
      if (tid < 256) { const v4u v = *(const GAS v4u*)(Pm + (size_t)mr * NIN + C_K + h * 128 + sc); *(LAS v4u*)(lds + K_OFF + KBUF + kswz(mr, sc * 2)) = v; }
      else           { const v4u v = *(const GAS v4u*)(Pm + (size_t)mr * NIN + C_V + h * 128 + sc); *(LAS v4u*)(lds + V_OFF + VBUF + v_st(mr, sc)) = v; } }
    const bf16* kg = P + (size_t)(b * SEQ + sr) * NIN + C_K + h * 128 + sc; const bf16* vg = P + (size_t)(b * SEQ + sr) * NIN + C_V + h * 128 + sc;
    v4u ks0 = *(const GAS v4u*)kg, ks1 = *(const GAS v4u*)(kg + (size_t)32 * NIN), vs0 = *(const GAS v4u*)vg, vs1 = *(const GAS v4u*)(vg + (size_t)32 * NIN);
    __syncthreads();
    tile<true>(lds + K_OFF + KBUF, lds + V_OFF + VBUF, qr, o, m_reg, l_reg, c, r32, hi, lane, false, 0);
#pragma unroll 1
    for (int kt = 0; kt < NT; ++kt) {
        const int buf = kt & 1;
        *(LAS v4u*)(lds + K_OFF + buf * KBUF + kswz(sr, sc * 2)) = ks0; *(LAS v4u*)(lds + K_OFF + buf * KBUF + kswz(32 + sr, sc * 2)) = ks1;
        *(LAS v4u*)(lds + V_OFF + buf * VBUF + v_st(sr, sc)) = vs0; *(LAS v4u*)(lds + V_OFF + buf * VBUF + v_st(32 + sr, sc)) = vs1;
        __syncthreads();
        if (kt + 1 < NT) { const size_t go = (size_t)(kt + 1) * 64 * NIN;
            ks0 = *(const GAS v4u*)(kg + go); ks1 = *(const GAS v4u*)(kg + go + (size_t)32 * NIN); vs0 = *(const GAS v4u*)(vg + go); vs1 = *(const GAS v4u*)(vg + go + (size_t)32 * NIN); }
        const int dt = kt - 2 * qb;
        const int rel = 32 * jw + r32 - 64 * dt;
        if (!(dt == 1 && jw < 2))
            tile<false>(lds + K_OFF + buf * KBUF, lds + V_OFF + buf * VBUF, qr, o, m_reg, l_reg, c, r32, hi, lane, dt >= 0, rel);
    }
    __syncthreads();
    LAS float* ex = (LAS float*)lds;
    if (c == 1) { const float s1 = -lam / l_reg;
#pragma unroll
        for (int d0 = 0; d0 < 4; ++d0)
#pragma unroll
            for (int r = 0; r < 16; ++r) ex[((jw * 4 + d0) * 16 + r) * 64 + lane] = o[d0][r] * s1; }
    __syncthreads();
    if (c == 0) { const float il = 1.f / l_reg; float ss = 0.f;
#pragma unroll
        for (int d0 = 0; d0 < 4; ++d0)
#pragma unroll
            for (int r = 0; r < 16; ++r) { const float v = o[d0][r] * il + ex[((jw * 4 + d0) * 16 + r) * 64 + lane]; o[d0][r] = v; ss += v * v; }
        ss = pl_sum(ss);
        const float rstd = (1.f - LAM_INIT) / sqrtf(ss * (1.f / 128.f) + EPS);
        bf16* yp = YA + (size_t)(b * SEQ + q0 + jw * 32 + r32) * WHD + h * 128;
#pragma unroll
        for (int d0 = 0; d0 < 4; ++d0)
#pragma unroll
            for (int g = 0; g < 4; ++g) { const int e = 32 * d0 + 8 * g + 4 * hi; const f32x4 sw = *(const GAS f32x4*)(subln + e);
                const unsigned w0 = pg8::cvt_pk_bf16(o[d0][4 * g + 0] * rstd * sw.x, o[d0][4 * g + 1] * rstd * sw.y), w1 = pg8::cvt_pk_bf16(o[d0][4 * g + 2] * rstd * sw.z, o[d0][4 * g + 3] * rstd * sw.w);
                *(GAS unsigned long long*)(yp + e) = (unsigned long long)w0 | ((unsigned long long)w1 << 32); }
    }
    __syncthreads();
}
}

__global__ void __launch_bounds__(NWAVES * 64, 2) mk_fwd(Ptrs args) {
    extern __shared__ __attribute__((aligned(16))) unsigned char lds_raw[];
    LAS unsigned char* lds = (LAS unsigned char*)lds_raw;
    volatile LAS unsigned* MISC = (volatile LAS unsigned*)(lds + LDSCTL_OFF);
    const int tid = threadIdx.x, lane = tid & 63, wave = __builtin_amdgcn_readfirstlane(tid >> 6);
    const int G = gridDim.x, bx = blockIdx.x;
    const int vcu = (G % 8 == 0) ? (bx % 8) * (G / 8) + bx / 8 : bx;
    unsigned char* ws = args.ws;
    gu32* ctl = (gu32*)(ws + WS_CTL);
    const float* x = args.in[0]; const float* meta = args.in[1]; const float* norm_mix = args.in[2]; const float* w_in = args.in[3];
    const float* q_norm = args.in[4]; const float* k_norm = args.in[5];
    const float* lq1 = args.in[6]; const float* lk1 = args.in[7]; const float* lq2 = args.in[8]; const float* lk2 = args.in[9];
    const float* subln = args.in[10]; const float* hg_lb = args.in[11]; const float* hg_onorm = args.in[12];
    const float* w_up_a = args.in[13]; const float* w_up_b = args.in[14]; const float* w_out = args.in[15]; const float* norm_mlp = args.in[16];
    const float* w_ff1 = args.in[17]; const float* w_ff2 = args.in[18];
    float* out = args.out;
    bf16* Wt_in = (bf16*)(ws + WS_WIN); bf16* Wt_upa = (bf16*)(ws + WS_WUPA); bf16* Wt_upb = (bf16*)(ws + WS_WUPB); bf16* Wt_out = (bf16*)(ws + WS_WOUT);
    bf16* Wt_ff1 = (bf16*)(ws + WS_WFF1); bf16* Wt_ff2 = (bf16*)(ws + WS_WFF2);
    bf16* U = (bf16*)(ws + WS_U); bf16* Umeta = (bf16*)(ws + WS_UMETA); bf16* Pm = (bf16*)(ws + WS_PM); float* ROPE = (float*)(ws + WS_ROPE);
    float* RSTD = (float*)(ws + WS_RSTD); float* SSQ = (float*)(ws + WS_SSQ); bf16* P = (bf16*)(ws + WS_P); bf16* HID = (bf16*)(ws + WS_P);
    bf16* YA = (bf16*)(ws + WS_YA); bf16* YB = (bf16*)(ws + WS_YB); bf16* MG = (bf16*)(ws + WS_MG);

    for (int u = tid; u < (LDS_BYTES - LDSCTL_OFF) / 4; u += NWAVES * 64) ((LAS unsigned*)(lds + LDSCTL_OFF))[u] = 0u;
    __syncthreads();
    XcdBarrier bar = xcd_barrier_post((unsigned*)(ctl + CW_BAR), MISC + 8);
    if (wave == 0) {
        const float s1 = wave_sum(lq1[lane] * lk1[lane]), s2 = wave_sum(lq2[lane] * lk2[lane]);
        if (lane == 0) ((LAS float*)(lds + LDSCTL_OFF))[16] = expf(s1) - expf(s2) + LAM_INIT;
    }
    __syncthreads();
    const float lam = ((LAS float*)(lds + LDSCTL_OFF))[16];

    {
        LAS float* scr = (LAS float*)(lds + wave * 16384);
        const int gw = vcu * NWAVES + wave, NGW = G * NWAVES;
        constexpr int I_IN = (DM / 64) * (NIN / 32), I_UP = (WHD / 64) * (DM / 32), I_OUT = (DM / 64) * (DM / 32), I_F1 = (DM / 64) * (DFF / 32), I_F2 = (DFF / 64) * (DM / 32);
        constexpr int NITEMS = I_IN + 2 * I_UP + I_OUT + I_F1 + I_F2;
        for (int it = gw; it < NITEMS; it += NGW) {
            int r = it;
            if (r < I_IN) { p0_transpose_item(w_in, DM, NIN, Wt_in, scr, r, lane); continue; } r -= I_IN;
            if (r < I_UP) { p0_transpose_item(w_up_a, WHD, DM, Wt_upa, scr, r, lane); continue; } r -= I_UP;
            if (r < I_UP) { p0_transpose_item(w_up_b, WHD, DM, Wt_upb, scr, r, lane); continue; } r -= I_UP;
            if (r < I_OUT) { p0_transpose_item(w_out, DM, DM, Wt_out, scr, r, lane); continue; } r -= I_OUT;
            if (r < I_F1) { p0_transpose_item(w_ff1, DM, DFF, Wt_ff1, scr, r, lane); continue; } r -= I_F1;
            p0_transpose_item(w_ff2, DFF, DM, Wt_ff2, scr, r, lane);
        }
        for (int m = gw; m < MR + NMETA; m += NGW) {
            if (m < MR) rms_row_to_bf16(x + (size_t)m * DM, norm_mix, U + (size_t)m * DM, lane);
            else rms_row_to_bf16(meta + (size_t)(m - MR) * DM, norm_mix, Umeta + (size_t)(m - MR) * DM, lane);
        }
        const int gt = bx * (NWAVES * 64) + tid;
        if (gt < TT * 8) {
            const int pos = gt >> 3, j = gt & 7;
            const float invf[8] = {1.0f, 0.1939227432012558f, 0.03760603070259094f, 0.007292664609849453f, 0.0014142135623842478f, 0.00027424818836152554f, 5.3182957344688475e-05f, 1.0313385246263351e-05f};
            float inv = invf[0];
#pragma unroll
            for (int q = 1; q < 8; ++q) inv = (j == q) ? invf[q] : inv;
            const float ang = (float)pos * inv; float sn, cs; sincos_d((double)ang, sn, cs);
            ROPE[pos * 16 + j] = cs; ROPE[pos * 16 + 8 + j] = sn;
        }
    }
    xcd_barrier(bar);

    {
        for (int i = tid; i < NMETA * DM * 2 / 16; i += NWAVES * 64) ((LAS v4u*)lds)[i] = ((const GAS v4u*)Umeta)[i];
        __syncthreads();
        const int gw = vcu * NWAVES + wave, NGW = G * NWAVES;
        for (int ci = gw; ci < 8192; ci += NGW) {
            const int c = (ci < 4096) ? (C_K + ci) : (C_HF + (ci - 4096));
            const bf16* wrow = Wt_in + (size_t)c * DM;
            float acc[16];
#pragma unroll
            for (int r = 0; r < 16; ++r) acc[r] = 0.f;
#pragma unroll 1
            for (int i = 0; i < 8; ++i) {
                const int k = i * 512 + lane * 8;
                const v4u w = *(const GAS v4u*)(wrow + k);
                const float w0 = bflo(w.x), w1 = bfhi(w.x), w2 = bflo(w.y), w3 = bfhi(w.y), w4 = bflo(w.z), w5 = bfhi(w.z), w6 = bflo(w.w), w7 = bfhi(w.w);
#pragma unroll
                for (int r = 0; r < 16; ++r) { const v4u a = *(const LAS v4u*)(lds + (size_t)(r * DM + k) * 2);
                    acc[r] += (bflo(a.x) * w0 + bfhi(a.x) * w1) + (bflo(a.y) * w2 + bfhi(a.y) * w3) + (bflo(a.z) * w4 + bfhi(a.z) * w5) + (bflo(a.w) * w6 + bfhi(a.w) * w7); }
            }
            float mine = 0.f;
#pragma unroll
            for (int r = 0; r < 16; ++r) { const float s = wave_sum(acc[r]); mine = (lane == r) ? s : mine; }
            if (lane < 16) Pm[(size_t)lane * NIN + c] = (bf16)f2bf(mine);
        }
        __syncthreads();
        pg8::Gemm g{U, Wt_in, MR, NIN, DM}; pg8::StaticOrder S; S.init(MR, NIN, G, bx);
        EpiProj E{P, NIN, C_GA / 256};
        pg8::gemm_phase<EpiProj, pg8::StaticOrder, true, true>(lds, g, S, E);
    }
    xcd_barrier(bar);

    {
        const int gw = vcu * NWAVES + wave, NGW = G * NWAVES;
        for (int it = gw; it < 2 * MR + NMETA; it += NGW) {
            bf16* base; int pos; bool isk;
            if (it < 2 * MR) { const int row = it >> 1; isk = it & 1; base = P + (size_t)row * NIN + (isk ? C_K : C_Q); pos = NMETA + (row & (SEQ - 1)); }
            else { const int r = it - 2 * MR; isk = true; base = Pm + (size_t)r * NIN + C_K; pos = r; }
            const float* wv = isk ? k_norm : q_norm;
            const int d0 = (lane & 7) * 8, sub = lane & 7;
            float wn[8], cs[8], sn[8];
#pragma unroll
            for (int j = 0; j < 8; ++j) { wn[j] = wv[d0 + j]; cs[j] = ROPE[pos * 16 + j]; sn[j] = ROPE[pos * 16 + 8 + j]; }
#pragma unroll 1
            for (int i = 0; i < 4; ++i) {
                bf16* p = base + i * 512 + lane * 8;
                const v4u raw = *(const GAS v4u*)p;
                float xv[8] = {bflo(raw.x), bfhi(raw.x), bflo(raw.y), bfhi(raw.y), bflo(raw.z), bfhi(raw.z), bflo(raw.w), bfhi(raw.w)};
                float ss = 0.f;
#pragma unroll
                for (int j = 0; j < 8; ++j) ss += xv[j] * xv[j];
                ss += __shfl_xor(ss, 1); ss += __shfl_xor(ss, 2); ss += __shfl_xor(ss, 4);
                const float rstd = 1.f / sqrtf(ss * (1.f / 64.f) + EPS);
                float o[8];
#pragma unroll
                for (int j = 0; j < 8; ++j) {
                    const float xn = xv[j] * rstd * wn[j];
                    const float pr = __shfl_xor(xn, 1);
                    float v = xn;
                    if (sub == 0) v = xn * cs[j] - pr * sn[j];
                    else if (sub == 1) v = xn * cs[j] + pr * sn[j];
                    o[j] = isk ? v : v * C2;
                }
                v4u w; w.x = pk2(o[0], o[1]); w.y = pk2(o[2], o[3]); w.z = pk2(o[4], o[5]); w.w = pk2(o[6], o[7]);
                *(GAS v4u*)p = w;
            }
        }
    }
    xcd_barrier(bar);

    if (bx < 32) {
        const int sub = tid >> 7, j = tid & 127; const bool act = sub < 2;
        const int bh = bx * 2 + (sub & 1), b = bh >> 4, h = bh & 15;
        LAS float* fL = (LAS float*)(lds + sub * 33024); LAS float* kL = fL + 2048; LAS float* qL = kL + 2048; LAS float* oL = qL + 2048; LAS float* rsL = oL + 2048;
        const float l0 = hg_lb[h * 128 + j], l1 = hg_lb[WHD + h * 128 + j];
        const float lb = 1.f / (1.f + expf(l1 - l0));
        const float onw = hg_onorm[j];
        float S[128];
#pragma unroll
        for (int d = 0; d < 128; ++d) S[d] = 0.f;
#pragma unroll 1
        for (int blk = 0; blk < TT / 16; ++blk) {
            const int t0 = blk * 16;
            if (act) {
#pragma unroll 4
                for (int tt = 0; tt < 16; ++tt) { const int t = t0 + tt; const bf16* rp = rowptr(P, Pm, b, t) + h * 128 + j;
                    const float f = lb + (1.f - lb) * sigmoidf_(bf2f(rp[C_HF]));
                    fL[tt * 128 + j] = f; kL[tt * 128 + j] = 1.f - f; qL[tt * 128 + j] = (t >= NMETA) ? bf2f(rp[C_HQ]) : 0.f; }
            }
            __syncthreads();
            if (act) {
#pragma unroll 1
                for (int tt = 0; tt < 16; ++tt) { const int t = t0 + tt; const float iv = bf2f(rowptr(P, Pm, b, t)[C_HI + h * 128 + j]);
                    float o = 0.f;
#pragma unroll
                    for (int d = 0; d < 128; d += 4) {
                        const f32x4 f4 = *(const LAS f32x4*)(fL + tt * 128 + d), k4 = *(const LAS f32x4*)(kL + tt * 128 + d), q4 = *(const LAS f32x4*)(qL + tt * 128 + d);
                        S[d + 0] = fmaf(f4.x, S[d + 0], k4.x * iv); o = fmaf(S[d + 0], q4.x, o);
                        S[d + 1] = fmaf(f4.y, S[d + 1], k4.y * iv); o = fmaf(S[d + 1], q4.y, o);
                        S[d + 2] = fmaf(f4.z, S[d + 2], k4.z * iv); o = fmaf(S[d + 2], q4.z, o);
                        S[d + 3] = fmaf(f4.w, S[d + 3], k4.w * iv); o = fmaf(S[d + 3], q4.w, o);
                    }
                    oL[tt * 128 + j] = o; }
            }
            __syncthreads();
            if (act && t0 >= NMETA) {
                const int row = j >> 3, part = j & 7; float ss = 0.f;
#pragma unroll
                for (int i = 0; i < 16; ++i) { const float v = oL[row * 128 + part * 16 + i]; ss += v * v; }
                ss += __shfl_xor(ss, 1); ss += __shfl_xor(ss, 2); ss += __shfl_xor(ss, 4);
                if (part == 0) rsL[row] = 1.f / sqrtf(ss * (1.f / 128.f) + EPS);
            }
            __syncthreads();
            if (act && t0 >= NMETA) {
#pragma unroll 4
                for (int tt = 0; tt < 16; ++tt) { const int t = t0 + tt; const float gt = bf2f(rowptr(P, Pm, b, t)[C_HG + h * 128 + j]);
                    const float y = oL[tt * 128 + j] * rsL[tt] * onw * sigmoidf_(gt);
                    YB[(size_t)(b * SEQ + t - NMETA) * WHD + h * 128 + j] = (bf16)f2bf(y); }
            }
        }
    } else {
        const int nwg = G - 32, wgi = bx - 32;
#pragma unroll 1
        for (int u = wgi; u < NB * NH * 16; u += nwg) {
            const int qb = 15 - (u >> 6), bh = u & 63, b = bh >> 4, h = bh & 15;
            da::unit(lds, P, Pm, YA, subln, lam, b, h, qb, tid, wave, lane);
        }
    }
    xcd_barrier(bar);

    {
        { pg8::Gemm g{YA, Wt_upa, MR, DM, WHD}; pg8::StaticOrder S; S.init(MR, DM, G, bx); EpiUpA E{out, P};
          pg8::gemm_phase<EpiUpA, pg8::StaticOrder, true, true>(lds, g, S, E); }
        __syncthreads();
        { pg8::Gemm g{YB, Wt_upb, MR, DM, WHD}; pg8::StaticOrder S; S.init(MR, DM, G, bx); EpiUpB E{out, P, MG};
          pg8::gemm_phase<EpiUpB, pg8::StaticOrder, true, true>(lds, g, S, E); }
    }
    xcd_barrier(bar);

    {
        pg8::Gemm g{MG, Wt_out, MR, DM, DM}; pg8::StaticOrder S; S.init(MR, DM, G, bx); EpiOut E{x, out, U, norm_mlp, SSQ};
        pg8::gemm_phase<EpiOut, pg8::StaticOrder, true, true>(lds, g, S, E);
    }
    xcd_barrier(bar);
    {
        const int gt = bx * (NWAVES * 64) + tid;
        for (int row = gt; row < MR; row += G * NWAVES * 64) { float s = 0.f;
#pragma unroll
            for (int i = 0; i < 16; ++i) { const f32x4 v = *(const GAS f32x4*)(SSQ + (size_t)row * 64 + i * 4); s += (v.x + v.y) + (v.z + v.w); }
            RSTD[row] = 1.f / sqrtf(s * (1.f / DM) + EPS); }
    }
    xcd_barrier(bar);

    {
        pg8::Gemm g{U, Wt_ff1, MR, DFF, DM}; pg8::StaticOrder S; S.init(MR, DFF, G, bx); EpiFf1 E{HID, RSTD};
        pg8::gemm_phase<EpiFf1, pg8::StaticOrder, true, true>(lds, g, S, E);
    }
    xcd_barrier(bar);

    {
        pg8::Gemm g{HID, Wt_ff2, MR, DM, DFF}; pg8::StaticOrder S; S.init(MR, DM, G, bx); EpiFf2 E{out};
        pg8::gemm_phase<EpiFf2, pg8::StaticOrder, true, true>(lds, g, S, E);
    }
}

extern "C" void kernel_launch(void* const* d_in, const int* in_sizes, int n_in, void* d_out, int out_size, void* d_ws, size_t ws_size, hipStream_t stream) {
    static int grid = 0;
    if (grid == 0) {
        if (n_in != 19 || out_size != MR * DM || ws_size < WS_END) { fprintf(stderr, "kernel_launch: unexpected shapes (n_in %d out %d ws %zu)\n", n_in, out_size, ws_size); grid = -1; return; }
        int dev = 0, cus = 0, per_cu = 0;
        if (hipGetDevice(&dev) != hipSuccess || hipDeviceGetAttribute(&cus, hipDeviceAttributeMultiprocessorCount, dev) != hipSuccess) { grid = -1; return; }
        if (hipFuncSetAttribute((const void*)mk_fwd, hipFuncAttributeMaxDynamicSharedMemorySize, LDS_BYTES) != hipSuccess) { fprintf(stderr, "kernel_launch: hipFuncSetAttribute failed\n"); grid = -1; return; }
        if (hipOccupancyMaxActiveBlocksPerMultiprocessor(&per_cu, (const void*)mk_fwd, NWAVES * 64, LDS_BYTES) != hipSuccess || per_cu < 1) { fprintf(stderr, "kernel_launch: occupancy query says %d\n", per_cu); }
        (void)hipGetLastError();
        grid = cus;
    }
    if (grid < 0) return;
    if (hipMemsetAsync((char*)d_ws + WS_CTL, 0, CTL_ZERO_BYTES, stream) != hipSuccess) return;
    Ptrs a{};
    for (int i = 0; i < 19; ++i) a.in[i] = (const float*)d_in[i];
    a.out = (float*)d_out; a.ws = (unsigned char*)d_ws;
    hipLaunchKernelGGL(mk_fwd, dim3(grid), dim3(NWAVES * 64), LDS_BYTES, stream, a);
}
```

```cpp
#include <hip/hip_runtime.h>
#include <cstdio>
#include <cstdint>
namespace pg8 {
#define PG8_LAS __attribute__((address_space(3)))
typedef unsigned short bf16_t;
typedef short bf16x8 __attribute__((ext_vector_type(8)));
typedef float f32x4 __attribute__((ext_vector_type(4)));
typedef unsigned u32x4 __attribute__((ext_vector_type(4)));
constexpr int BM = 256, BK = 64, HALF = 128, HTB = HALF * BK * 2  , STAGE_BYTES = 8 * HTB, NXCD = 8, WGM = 8;

__host__ __device__ __forceinline__ int lds_byte(int r, int c) { const int st = (r >> 4) * 2 + (c >> 5), rr = r & 15, cc = c & 31, ob = rr * 64 + cc * 2; return st * 1024 + (ob ^ (((ob >> 9) & 1) << 5)); }
__host__ __device__ __forceinline__ void stage_rc(int b, int& R, int& C) { const int st = b / 1024, sb = b % 1024, swz = sb ^ (((sb >> 9) & 1) << 5); R = (st >> 1) * 16 + swz / 64; C = (st & 1) * 32 + (swz % 64) / 2; }
__host__ __device__ __forceinline__ int perm32(int rho) { const int n = rho >> 4, i = rho & 15; return 8 * (i >> 2) + 4 * n + (i & 3); }

struct Unit { int pm, pn; };
struct Gemm { const bf16_t* A; const bf16_t* Bt; int M, N, K; };

struct StaticOrder {
    int nM, nN, nwg, G, c;
    __host__ __device__ void init(int M, int N, int G_, int c_) { nM = M / BM; nN = N / BM; nwg = nM * nN; G = G_; c = c_; }
    __host__ __device__ bool next(int i, Unit& u) const {
        const long L = (long)i * G + c; if (L >= nwg) return false;
        int wgid = (int)L; { const int q = nwg / NXCD, r = nwg % NXCD, xcd = wgid % NXCD, off = wgid / NXCD; wgid = (xcd < r ? xcd * (q + 1) : r * (q + 1) + (xcd - r) * q) + off; }
        const int nig = WGM * nN, gid = wgid / nig, fm = gid * WGM, gsz = (nM - fm) < WGM ? (nM - fm) : WGM;
        u.pm = fm + ((wgid % nig) % gsz); u.pn = (wgid % nig) / gsz; return true;
    }
    __device__ __forceinline__ void a_ready(const Unit&) const {}
    __device__ __forceinline__ void done(const Unit&) const {}
};

__device__ __forceinline__ unsigned cvt_pk_bf16(float lo, float hi) { unsigned r; asm volatile("v_cvt_pk_bf16_f32 %0, %1, %2" : "=v"(r) : "v"(lo), "v"(hi)); return r; }
typedef float f32x2 __attribute__((ext_vector_type(2)));
template <class Epi, class Sched, bool ALIGN_EPI = false, bool SP2 = false>
__device__ __forceinline__ void gemm_phase(PG8_LAS unsigned char* lds, const Gemm g, const Sched& S, const Epi& E) {
    const int tid = threadIdx.x, wid = __builtin_amdgcn_readfirstlane(tid >> 6), lane = tid & 63, wr = wid >> 2, wc = wid & 3, fr = lane & 15, fq = lane >> 4;
    const int K = g.K, nt = K / BK;
    unsigned voffA[2], voffB[2];
#pragma unroll
    for (int i = 0; i < 2; ++i) { int R, C; stage_rc(tid * 16 + i * 8192, R, C); const int Rb = Epi::PERM ? ((R & ~31) + perm32(R & 31)) : R;
        voffA[i] = (unsigned)(R * K + C) * 2u; voffB[i] = (unsigned)(Rb * K + C) * 2u; }
    const size_t kstep = (size_t)(BK * 2);
    const size_t hstep = (size_t)HALF * K * 2;
    const size_t tstep = 2 * hstep;
    const unsigned ldsw = (unsigned)wid * 1024u;
    const int aoff = lds_byte(wr * 64 + fr, fq * 8), boff = lds_byte(wc * 32 + fr, fq * 8);
#define PG8_SA(b, h) (((b) * 2 + (h)) * HTB)
#define PG8_SB(b, h) ((4 + (b) * 2 + (h)) * HTB)
#define PG8_STAGE(bufoff, gbase, voff) do { _Pragma("unroll") for (int _i = 0; _i < 2; ++_i) \
        __builtin_amdgcn_global_load_lds((const unsigned*)((const char*)(gbase) + (voff)[_i]), (PG8_LAS unsigned*)(lds + (bufoff) + ldsw + _i * 8192), 16, 0, 0); } while (0)
#define PG8_LDA(dst, b, h) do { _Pragma("unroll") for (int m = 0; m < 4; ++m) _Pragma("unroll") for (int k = 0; k < 2; ++k) dst[m][k] = *(const PG8_LAS bf16x8*)(lds + PG8_SA(b, h) + aoff + m * 2048 + k * 1024); } while (0)
#define PG8_LDB(dst, b, h) do { _Pragma("unroll") for (int n = 0; n < 2; ++n) _Pragma("unroll") for (int k = 0; k < 2; ++k) dst[n][k] = *(const PG8_LAS bf16x8*)(lds + PG8_SB(b, h) + boff + n * 2048 + k * 1024); } while (0)
#define PG8_MMA(ai, bj, At, Bt) do { __builtin_amdgcn_s_setprio(1); _Pragma("unroll") for (int m = 0; m < 4; ++m) _Pragma("unroll") for (int n = 0; n < 2; ++n) _Pragma("unroll") for (int k = 0; k < 2; ++k) \
        acc[ai][bj][m][n] = __builtin_amdgcn_mfma_f32_16x16x32_bf16(Bt[n][k], At[m][k], acc[ai][bj][m][n], 0, 0, 0); __builtin_amdgcn_s_setprio(0); } while (0)
#define PG8_WAIT_V(n) asm volatile("s_waitcnt vmcnt(" #n ")" ::: "memory")
#define PG8_WAIT_L(n) asm volatile("s_waitcnt lgkmcnt(" #n ")" ::: "memory")
#define PG8_BAR __builtin_amdgcn_s_barrier()
#define PG8_SCHED __builtin_amdgcn_sched_barrier(0)
    Unit cur, nxt; int ui = 0;
    if (!S.next(0, cur)) return;
    f32x4 acc[2][2][4][2];
#pragma unroll
    for (int a = 0; a < 2; ++a)
#pragma unroll
        for (int b = 0; b < 2; ++b)
#pragma unroll
            for (int m = 0; m < 4; ++m)
#pragma unroll
                for (int n = 0; n < 2; ++n) acc[a][b][m][n] = (f32x4){0.f, 0.f, 0.f, 0.f};
    bf16x8 At[4][2], B0[2][2], B1[2][2];
    const char* cA = (const char*)g.A + (size_t)cur.pm * tstep; const char* cB = (const char*)g.Bt + (size_t)cur.pn * tstep;
    S.a_ready(cur);
    if constexpr (SP2) {
        PG8_STAGE(PG8_SB(0, 0), cB, voffB); PG8_STAGE(PG8_SB(0, 1), cB + hstep, voffB); PG8_STAGE(PG8_SA(0, 0), cA, voffA); PG8_STAGE(PG8_SA(0, 1), cA + hstep, voffA);
        if (wr == 1) PG8_BAR;
        PG8_WAIT_V(2); PG8_BAR;
        PG8_STAGE(PG8_SB(1, 0), cB + kstep, voffB); PG8_STAGE(PG8_SA(1, 0), cA + kstep, voffA); PG8_STAGE(PG8_SB(1, 1), cB + hstep + kstep, voffB);
        PG8_WAIT_V(6); PG8_BAR;
    } else {
        PG8_STAGE(PG8_SB(0, 0), cB, voffB); PG8_STAGE(PG8_SA(0, 0), cA, voffA); PG8_STAGE(PG8_SB(0, 1), cB + hstep, voffB); PG8_STAGE(PG8_SA(0, 1), cA + hstep, voffA);
        if (wr == 1) PG8_BAR;
        PG8_WAIT_V(4); PG8_BAR;
        PG8_STAGE(PG8_SB(1, 0), cB + kstep, voffB); PG8_STAGE(PG8_SA(1, 0), cA + kstep, voffA); PG8_STAGE(PG8_SB(1, 1), cB + hstep + kstep, voffB);
        PG8_WAIT_V(6); PG8_BAR;
    }
    for (;;) {
        const bool has_next = S.next(ui + 1, nxt);
        const char* nA = has_next ? (const char*)g.A + (size_t)nxt.pm * tstep : cA; const char* nB = has_next ? (const char*)g.Bt + (size_t)nxt.pn * tstep : cB;
        for (int t = 0; t < nt; t += 2) {
            const bool last = (t == nt - 2);
            const char* a1 = cA + (size_t)(t + 1) * kstep;
            const char* a2 = last ? nA : cA + (size_t)(t + 2) * kstep; const char* b2 = last ? nB : cB + (size_t)(t + 2) * kstep;
            const char* a3 = a2 + kstep; const char* b3 = b2 + kstep;
            if (last && has_next) S.a_ready(nxt);
            if constexpr (SP2) {
            PG8_LDB(B0, 0, 0); PG8_LDB(B1, 0, 1); PG8_SCHED; PG8_LDA(At, 0, 0); PG8_STAGE(PG8_SA(1, 1), a1 + hstep, voffA);
            PG8_WAIT_V(8); PG8_WAIT_L(0); PG8_BAR; PG8_MMA(0, 0, At, B0); PG8_MMA(0, 1, At, B1); PG8_BAR; PG8_SCHED;
            PG8_LDA(At, 0, 1); PG8_STAGE(PG8_SB(0, 0), b2, voffB); PG8_STAGE(PG8_SB(0, 1), b2 + hstep, voffB); PG8_STAGE(PG8_SA(0, 0), a2, voffA);
            PG8_WAIT_V(8); PG8_WAIT_L(0); PG8_BAR; PG8_MMA(1, 0, At, B0); PG8_MMA(1, 1, At, B1); PG8_BAR; PG8_SCHED;
            PG8_LDB(B0, 1, 0); PG8_LDB(B1, 1, 1); PG8_SCHED; PG8_LDA(At, 1, 0); PG8_STAGE(PG8_SA(0, 1), a2 + hstep, voffA);
            PG8_WAIT_V(8); PG8_WAIT_L(0); PG8_BAR; PG8_MMA(0, 0, At, B0); PG8_MMA(0, 1, At, B1); PG8_BAR; PG8_SCHED;
            PG8_LDA(At, 1, 1); PG8_STAGE(PG8_SB(1, 0), b3, voffB); PG8_STAGE(PG8_SB(1, 1), b3 + hstep, voffB); PG8_STAGE(PG8_SA(1, 0), a3, voffA);
            PG8_WAIT_V(8); PG8_WAIT_L(0); PG8_BAR; PG8_MMA(1, 0, At, B0); PG8_MMA(1, 1, At, B1); PG8_BAR; PG8_SCHED;
            } else {
            PG8_LDB(B0, 0, 0); PG8_SCHED; PG8_LDA(At, 0, 0); PG8_STAGE(PG8_SA(1, 1), a1 + hstep, voffA);
            PG8_WAIT_L(8); PG8_BAR; PG8_WAIT_L(0); PG8_MMA(0, 0, At, B0); PG8_BAR; PG8_SCHED;
            PG8_LDB(B1, 0, 1); PG8_STAGE(PG8_SB(0, 0), b2, voffB);
            PG8_BAR; PG8_WAIT_L(0); PG8_MMA(0, 1, At, B1); PG8_BAR;
            PG8_LDA(At, 0, 1); PG8_STAGE(PG8_SA(0, 0), a2, voffA);
            PG8_BAR; PG8_WAIT_L(0); PG8_MMA(1, 0, At, B0); PG8_BAR; PG8_SCHED;
            PG8_STAGE(PG8_SB(0, 1), b2 + hstep, voffB);
            PG8_WAIT_V(6); PG8_BAR; PG8_MMA(1, 1, At, B1); PG8_BAR;
            PG8_LDB(B0, 1, 0); PG8_SCHED; PG8_LDA(At, 1, 0); PG8_STAGE(PG8_SA(0, 1), a2 + hstep, voffA);
            PG8_WAIT_L(8); PG8_BAR; PG8_WAIT_L(0); PG8_MMA(0, 0, At, B0); PG8_BAR; PG8_SCHED;
            PG8_LDB(B1, 1, 1); PG8_STAGE(PG8_SB(1, 0), b3, voffB);
            PG8_BAR; PG8_WAIT_L(0); PG8_MMA(0, 1, At, B1); PG8_BAR;
            PG8_LDA(At, 1, 1); PG8_STAGE(PG8_SA(1, 0), a3, voffA);
            PG8_BAR; PG8_WAIT_L(0); PG8_MMA(1, 0, At, B0); PG8_BAR; PG8_SCHED;
            PG8_STAGE(PG8_SB(1, 1), b3 + hstep, voffB);
            PG8_WAIT_V(6); PG8_BAR; PG8_MMA(1, 1, At, B1); PG8_BAR;
            }
        }
        if constexpr (ALIGN_EPI) { if (wr == 0) PG8_BAR; }
        if constexpr (!Epi::AFTER_DRAIN) { E(acc, cur, wr, wc, fr, fq); S.done(cur); }
        if (!has_next) break;
#pragma unroll
        for (int a = 0; a < 2; ++a)
#pragma unroll
            for (int b = 0; b < 2; ++b)
#pragma unroll
                for (int m = 0; m < 4; ++m)
#pragma unroll
                    for (int n = 0; n < 2; ++n) acc[a][b][m][n] = (f32x4){0.f, 0.f, 0.f, 0.f};
        cur = nxt; cA = nA; cB = nB; ++ui;
        if constexpr (ALIGN_EPI) { if (wr == 1) PG8_BAR; }
    }
    PG8_WAIT_V(0);
    if constexpr (!ALIGN_EPI) { if (wr == 0) PG8_BAR; }
    PG8_BAR;
    if constexpr (Epi::AFTER_DRAIN) { E.fused(acc, cur, wr, wc, fr, fq, lds, wid, lane); S.done(cur); }
#undef PG8_SA
#undef PG8_SB
#undef PG8_STAGE
#undef PG8_LDA
#undef PG8_LDB
#undef PG8_MMA
#undef PG8_WAIT_V
#undef PG8_WAIT_L
#undef PG8_BAR
#undef PG8_SCHED
}
}
#define GAS __attribute__((address_space(1)))
#define LAS __attribute__((address_space(3)))
typedef unsigned short bf16;
typedef unsigned v4u __attribute__((ext_vector_type(4)));
typedef float f32x4 __attribute__((ext_vector_type(4)));
typedef short bf16x8 __attribute__((ext_vector_type(8)));
typedef GAS unsigned gu32;
typedef GAS unsigned long long gu64;
#define RLX_AGENT __ATOMIC_RELAXED, __HIP_MEMORY_SCOPE_AGENT
#define LDS_WAIT() asm volatile("s_waitcnt lgkmcnt(0)" ::: "memory")
#define VM_WAIT() asm volatile("s_waitcnt vmcnt(0)" ::: "memory")
__device__ __forceinline__ unsigned long long rt() { return __builtin_amdgcn_s_memrealtime(); }
__device__ __forceinline__ unsigned f2bf(float f) { unsigned u = __builtin_bit_cast(unsigned, f); return (u + 0x7fffu + ((u >> 16) & 1u)) >> 16; }
__device__ __forceinline__ unsigned pk2(float lo, float hi) { return f2bf(lo) | (f2bf(hi) << 16); }
#define XB_TMO      128
#define XB_XCNT(j)  (256  + 64 * (j))
#define XB_XSUB(j)  (1280 + 64 * (j))
#define XB_XGEN(j)  (2304 + 64 * (j))
#define XB_TOP      3328
#define XB_TOPGEN   3392
#define XCD_BAR_WORDS 3456
#define XB_SPIN_CAP (1u << 22)

__device__ __forceinline__ unsigned xb_ld(unsigned* p)              { return __hip_atomic_load(p, __ATOMIC_RELAXED, __HIP_MEMORY_SCOPE_AGENT); }
__device__ __forceinline__ unsigned xb_add(unsigned* p, unsigned v) { return __hip_atomic_fetch_add(p, v, __ATOMIC_RELAXED, __HIP_MEMORY_SCOPE_AGENT); }
__device__ __forceinline__ unsigned xb_xcc_id() { return (unsigned)__builtin_amdgcn_s_getreg((3 << 11) | 20) & 0xFu; }
#define XB_SPIN(cond, bar) do { unsigned _sp = 0; while (cond) { __builtin_amdgcn_s_sleep(1); \
    if ((++_sp & 255u) == 0u) { if (xb_ld(&(bar)[XB_TMO])) break; if (_sp > XB_SPIN_CAP) { atomicAdd(&(bar)[XB_TMO], 1u); break; } } } } while (0)

struct XcdBarrier {
    unsigned* bar; unsigned x;
    volatile LAS unsigned* st;
};

__device__ __forceinline__ XcdBarrier xcd_barrier_post(unsigned* bar, volatile LAS unsigned* st) {
    XcdBarrier b; b.bar = bar; b.x = xb_xcc_id(); b.st = st;
    if (threadIdx.x == 0) (void)xb_add(&bar[XB_XCNT(b.x)], 1u);
    return b;
}
__device__ __forceinline__ void xcd_barrier_complete(unsigned* bar, unsigned x, unsigned& nloc, unsigned& nx) {
    const unsigned G = gridDim.x * gridDim.y * gridDim.z;
    unsigned sum, cnt, mine, sp = 0u;
    for (;;) {
        sum = 0u; cnt = 0u; mine = 0u;
#pragma unroll
        for (unsigned j = 0; j < 16; ++j) { const unsigned c = xb_ld(&bar[XB_XCNT(j)]); sum += c; cnt += (c > 0u) ? 1u : 0u; mine = (j == x) ? c : mine; }
        if (sum == G) break;
        __builtin_amdgcn_s_sleep(1);
        if ((++sp & 255u) == 0u) { if (xb_ld(&bar[XB_TMO])) break; if (sp > XB_SPIN_CAP) { atomicAdd(&bar[XB_TMO], 1u); break; } }
    }
    nloc = mine > 0u ? mine : 1u; nx = cnt > 0u ? cnt : 1u;
}

__device__ __forceinline__ void xcd_barrier(const XcdBarrier& b) {
    asm volatile("s_waitcnt vmcnt(0)" ::: "memory");
    __syncthreads();
    if (threadIdx.x == 0) {
        unsigned* bar = b.bar;
        __builtin_amdgcn_s_waitcnt(0);
        unsigned nloc = b.st[0], nx = b.st[1];
        if (nloc == 0u) { xcd_barrier_complete(bar, b.x, nloc, nx); b.st[0] = nloc; b.st[1] = nx; }
        const unsigned old = xb_add(&bar[XB_XSUB(b.x)], 1u);
        const unsigned gen = old / nloc;
        if (old + 1u == (gen + 1u) * nloc) {
            __builtin_amdgcn_fence(__ATOMIC_RELEASE, "agent");
            asm volatile("s_waitcnt vmcnt(0)" ::: "memory");
            const unsigned og = xb_add(&bar[XB_TOP], 1u);
            const unsigned tg = og / nx;
            if (og + 1u == (tg + 1u) * nx) xb_add(&bar[XB_TOPGEN], 1u);
            else XB_SPIN(xb_ld(&bar[XB_TOPGEN]) == tg, bar);
            __builtin_amdgcn_fence(__ATOMIC_ACQUIRE, "agent");
            xb_add(&bar[XB_XGEN(b.x)], 1u);
            asm volatile("s_waitcnt vmcnt(0)" ::: "memory");
        } else {
            XB_SPIN(xb_ld(&bar[XB_XGEN(b.x)]) == gen, bar);
            __builtin_amdgcn_fence(__ATOMIC_ACQUIRE, "agent");
            asm volatile("s_waitcnt vmcnt(0)" ::: "memory");
        }
    }
    __syncthreads();
}
constexpr int NWAVES = 8;
constexpr int DM = 4096, NB = 4, SEQ = 2048, NMETA = 16, TT = SEQ + NMETA;
constexpr int MR = NB * SEQ;
constexpr int NIN = 22528, DFF = 16384, NH = 16, WHD = 2048;
constexpr int C_Q = 0, C_K = 2048, C_V = 4096, C_HQ = 6144, C_HF = 8192, C_HI = 10240, C_HG = 12288, C_GA = 14336, C_GB = 18432;
constexpr float EPS = 1e-6f;
constexpr float C2 = 0.18033688011112042f;
constexpr float LAM_INIT = 0.2f;

constexpr size_t MiB = 1u << 20;
constexpr size_t WS_CTL = 0, CTL_ZERO_BYTES = 1 * MiB;
constexpr size_t WS_WIN = 2 * MiB, WS_WUPA = 178 * MiB, WS_WUPB = 194 * MiB, WS_WOUT = 210 * MiB, WS_WFF1 = 242 * MiB, WS_WFF2 = 370 * MiB;
constexpr size_t WS_U = 498 * MiB;
constexpr size_t WS_UMETA = 562 * MiB;
constexpr size_t WS_PM = 563 * MiB;
constexpr size_t WS_ROPE = 564 * MiB;
constexpr size_t WS_RSTD = 565 * MiB;
constexpr size_t WS_SSQ = 566 * MiB;
constexpr size_t WS_P = 568 * MiB;
constexpr size_t WS_YA = 920 * MiB, WS_YB = 952 * MiB, WS_MG = 984 * MiB, WS_END = 1048 * MiB;
constexpr int CW_BAR = 4096;

constexpr int RING_BYTES = 131072, LDSCTL_OFF = 146432, LDS_BYTES = 147456;

__device__ __forceinline__ float bf2f(bf16 v) { return __builtin_bit_cast(float, (unsigned)v << 16); }
__device__ __forceinline__ float bflo(unsigned w) { return __builtin_bit_cast(float, w << 16); }
__device__ __forceinline__ float bfhi(unsigned w) { return __builtin_bit_cast(float, w & 0xffff0000u); }
__device__ __forceinline__ float wave_sum(float v) {
#pragma unroll
    for (int o = 1; o < 64; o <<= 1) v += __shfl_xor(v, o);
    return v;
}
__device__ __forceinline__ float wave_max(float v) {
#pragma unroll
    for (int o = 1; o < 64; o <<= 1) v = fmaxf(v, __shfl_xor(v, o));
    return v;
}
__device__ __forceinline__ float sigmoidf_(float x) { return __builtin_amdgcn_rcpf(1.0f + __expf(-x)); }

__device__ __forceinline__ void p0_transpose_item(const float* W, int K, int N, bf16* WT, LAS float* scr, int item, int lane) {
    const int nblk = N / 32, kb = item / nblk, nb = item % nblk, k0 = 64 * kb, n0 = 32 * nb;
#pragma unroll 8
    for (int i = 0; i < 32; ++i) { const int kk = 2 * i + (lane >> 5); scr[kk * 33 + (lane & 31)] = W[(size_t)(k0 + kk) * N + n0 + (lane & 31)]; }
    LDS_WAIT(); asm volatile("" ::: "memory");
    const int c = lane & 7;
#pragma unroll
    for (int j = 0; j < 4; ++j) { const int n = (lane >> 3) + 8 * j; const LAS float* s = scr + (8 * c) * 33 + n;
        v4u o; o.x = pk2(s[0 * 33], s[1 * 33]); o.y = pk2(s[2 * 33], s[3 * 33]); o.z = pk2(s[4 * 33], s[5 * 33]); o.w = pk2(s[6 * 33], s[7 * 33]);
        *(GAS v4u*)(WT + (size_t)(n0 + n) * K + k0 + 8 * c) = o; }
    LDS_WAIT(); asm volatile("" ::: "memory");
}
__device__ __forceinline__ void rms_row_to_bf16(const float* xrow, const float* g, bf16* orow, int lane) {
    const GAS f32x4* xr = (const GAS f32x4*)xrow + lane; const GAS f32x4* gr = (const GAS f32x4*)g + lane;
    f32x4 v[16]; float s = 0.f;
#pragma unroll
    for (int j = 0; j < 16; ++j) { v[j] = xr[64 * j]; s += (v[j].x * v[j].x + v[j].y * v[j].y) + (v[j].z * v[j].z + v[j].w * v[j].w); }
    const float rstd = 1.f / sqrtf(wave_sum(s) * (1.f / DM) + EPS);
    GAS unsigned long long* o8 = (GAS unsigned long long*)orow + lane;
#pragma unroll
    for (int j = 0; j < 16; ++j) { const f32x4 gg = gr[64 * j];
        o8[64 * j] = (unsigned long long)pk2(v[j].x * rstd * gg.x, v[j].y * rstd * gg.y) | ((unsigned long long)pk2(v[j].z * rstd * gg.z, v[j].w * rstd * gg.w) << 32); }
}
__device__ __forceinline__ void sincos_d(double a, float& sn, float& cs) {
    const double PI = 3.14159265358979323846;
    const double k = rint(a / PI); const double r = a - k * PI; const double r2 = r * r;
    double s = 1.0, c = 1.0, ts = 1.0, tc = 1.0;
#pragma unroll
    for (int i = 1; i <= 11; ++i) { tc *= -r2 / (double)((2 * i - 1) * (2 * i)); ts *= -r2 / (double)((2 * i) * (2 * i + 1)); c += tc; s += ts; }
    s *= r;
    const bool odd = ((long long)k) & 1;
    sn = (float)(odd ? -s : s); cs = (float)(odd ? -c : c);
}

struct Ptrs {
    const float* in[19]; float* out; unsigned char* ws;
};

__device__ __forceinline__ const bf16* rowptr(const bf16* P, const bf16* Pm, int b, int t) {
    return t < NMETA ? Pm + (size_t)t * NIN : P + (size_t)(b * SEQ + t - NMETA) * NIN;
}

struct EpiProj {
    static constexpr bool PERM = true, AFTER_DRAIN = false;
    bf16* O; int ldc; int sig_tile;
    __device__ __forceinline__ void operator()(const pg8::f32x4 (&acc)[2][2][4][2], const pg8::Unit& u, int wr, int wc, int fr, int fq) const {
        const int row0 = u.pm * 256 + wr * 64 + fr, col0 = u.pn * 256 + wc * 32 + 8 * fq; const bool sg = u.pn >= sig_tile;
#pragma unroll
        for (int ai = 0; ai < 2; ++ai)
#pragma unroll
            for (int m = 0; m < 4; ++m) { bf16* rowp = O + (size_t)(row0 + ai * 128 + m * 16) * ldc + col0;
#pragma unroll
                for (int bj = 0; bj < 2; ++bj) { pg8::f32x4 v0 = acc[ai][bj][m][0], v1 = acc[ai][bj][m][1];
                    if (sg) { for (int e = 0; e < 4; ++e) { v0[e] = sigmoidf_(v0[e]); v1[e] = sigmoidf_(v1[e]); } }
                    v4u w; w.x = pg8::cvt_pk_bf16(v0[0], v0[1]); w.y = pg8::cvt_pk_bf16(v0[2], v0[3]); w.z = pg8::cvt_pk_bf16(v1[0], v1[1]); w.w = pg8::cvt_pk_bf16(v1[2], v1[3]);
                    *(v4u*)(rowp + bj * 128) = w; } }
    }
};
struct EpiUpA {
    static constexpr bool PERM = true, AFTER_DRAIN = false;
    float* T; const bf16* P;
    __device__ __forceinline__ void operator()(const pg8::f32x4 (&acc)[2][2][4][2], const pg8::Unit& u, int wr, int wc, int fr, int fq) const {
        const int row0 = u.pm * 256 + wr * 64 + fr, col0 = u.pn * 256 + wc * 32 + 8 * fq;
#pragma unroll
        for (int ai = 0; ai < 2; ++ai)
#pragma unroll
            for (int m = 0; m < 4; ++m) { const int row = row0 + ai * 128 + m * 16;
#pragma unroll
                for (int bj = 0; bj < 2; ++bj) { const int col = col0 + bj * 128;
                    const v4u g = *(const v4u*)(P + (size_t)row * NIN + C_GA + col);
                    pg8::f32x4 v0 = acc[ai][bj][m][0], v1 = acc[ai][bj][m][1];
                    v0[0] *= bflo(g.x); v0[1] *= bfhi(g.x); v0[2] *= bflo(g.y); v0[3] *= bfhi(g.y); v1[0] *= bflo(g.z); v1[1] *= bfhi(g.z); v1[2] *= bflo(g.w); v1[3] *= bfhi(g.w);
                    float* tp = T + (size_t)row * DM + col; *(pg8::f32x4*)tp = v0; *(pg8::f32x4*)(tp + 4) = v1; } }
    }
};
struct EpiUpB {
    static constexpr bool PERM = true, AFTER_DRAIN = false;
    const float* T; const bf16* P; bf16* MG;
    __device__ __forceinline__ void operator()(const pg8::f32x4 (&acc)[2][2][4][2], const pg8::Unit& u, int wr, int wc, int fr, int fq) const {
        const int row0 = u.pm * 256 + wr * 64 + fr, col0 = u.pn * 256 + wc * 32 + 8 * fq;
#pragma unroll
        for (int ai = 0; ai < 2; ++ai)
#pragma unroll
            for (int m = 0; m < 4; ++m) { const int row = row0 + ai * 128 + m * 16;
#pragma unroll
                for (int bj = 0; bj < 2; ++bj) { const int col = col0 + bj * 128;
                    const v4u g = *(const v4u*)(P + (size_t)row * NIN + C_GB + col);
                    const float* tp = T + (size_t)row * DM + col; const pg8::f32x4 t0 = *(const pg8::f32x4*)tp, t1 = *(const pg8::f32x4*)(tp + 4);
                    pg8::f32x4 v0 = acc[ai][bj][m][0], v1 = acc[ai][bj][m][1];
                    v0[0] = t0[0] + v0[0] * bflo(g.x); v0[1] = t0[1] + v0[1] * bfhi(g.x); v0[2] = t0[2] + v0[2] * bflo(g.y); v0[3] = t0[3] + v0[3] * bfhi(g.y);
                    v1[0] = t1[0] + v1[0] * bflo(g.z); v1[1] = t1[1] + v1[1] * bfhi(g.z); v1[2] = t1[2] + v1[2] * bflo(g.w); v1[3] = t1[3] + v1[3] * bfhi(g.w);
                    v4u w; w.x = pg8::cvt_pk_bf16(v0[0], v0[1]); w.y = pg8::cvt_pk_bf16(v0[2], v0[3]); w.z = pg8::cvt_pk_bf16(v1[0], v1[1]); w.w = pg8::cvt_pk_bf16(v1[2], v1[3]);
                    *(v4u*)(MG + (size_t)row * DM + col) = w; } }
    }
};
struct EpiOut {
    static constexpr bool PERM = true, AFTER_DRAIN = false;
    const float* X; float* H1; bf16* A2; const float* G; float* SSQ;
    __device__ __forceinline__ void operator()(const pg8::f32x4 (&acc)[2][2][4][2], const pg8::Unit& u, int wr, int wc, int fr, int fq) const {
        const int row0 = u.pm * 256 + wr * 64 + fr, col0 = u.pn * 256 + wc * 32 + 8 * fq;
#pragma unroll
        for (int ai = 0; ai < 2; ++ai)
#pragma unroll
            for (int m = 0; m < 4; ++m) { const int row = row0 + ai * 128 + m * 16; float ss = 0.f;
#pragma unroll
                for (int bj = 0; bj < 2; ++bj) { const int col = col0 + bj * 128; const size_t off = (size_t)row * DM + col;
                    const pg8::f32x4 x0 = *(const pg8::f32x4*)(X + off), x1 = *(const pg8::f32x4*)(X + off + 4);
                    const pg8::f32x4 g0 = *(const pg8::f32x4*)(G + col), g1 = *(const pg8::f32x4*)(G + col + 4);
                    const pg8::f32x4 h0 = x0 + acc[ai][bj][m][0], h1 = x1 + acc[ai][bj][m][1];
                    *(pg8::f32x4*)(H1 + off) = h0; *(pg8::f32x4*)(H1 + off + 4) = h1;
                    ss += (h0[0] * h0[0] + h0[1] * h0[1]) + (h0[2] * h0[2] + h0[3] * h0[3]) + (h1[0] * h1[0] + h1[1] * h1[1]) + (h1[2] * h1[2] + h1[3] * h1[3]);
                    v4u w; w.x = pg8::cvt_pk_bf16(h0[0] * g0[0], h0[1] * g0[1]); w.y = pg8::cvt_pk_bf16(h0[2] * g0[2], h0[3] * g0[3]);
                    w.z = pg8::cvt_pk_bf16(h1[0] * g1[0], h1[1] * g1[1]); w.w = pg8::cvt_pk_bf16(h1[2] * g1[2], h1[3] * g1[3]);
                    *(v4u*)(A2 + off) = w; }
                ss += __shfl_xor(ss, 16); ss += __shfl_xor(ss, 32);
                if (fq == 0) SSQ[(size_t)row * 64 + u.pn * 4 + wc] = ss; }
    }
};
struct EpiFf1 {
    static constexpr bool PERM = true, AFTER_DRAIN = false;
    bf16* H; const float* RSTD;
    __device__ __forceinline__ void operator()(const pg8::f32x4 (&acc)[2][2][4][2], const pg8::Unit& u, int wr, int wc, int fr, int fq) const {
        const int row0 = u.pm * 256 + wr * 64 + fr, col0 = u.pn * 256 + wc * 32 + 8 * fq;
#pragma unroll
        for (int ai = 0; ai < 2; ++ai)
#pragma unroll
            for (int m = 0; m < 4; ++m) { const int row = row0 + ai * 128 + m * 16; const float rs = RSTD[row];
#pragma unroll
                for (int bj = 0; bj < 2; ++bj) { pg8::f32x4 v0 = acc[ai][bj][m][0] * rs, v1 = acc[ai][bj][m][1] * rs;
#pragma unroll
                    for (int e = 0; e < 4; ++e) { const float a = fmaxf(v0[e], 0.f), b = fmaxf(v1[e], 0.f); v0[e] = a * a; v1[e] = b * b; }
                    v4u w; w.x = pg8::cvt_pk_bf16(v0[0], v0[1]); w.y = pg8::cvt_pk_bf16(v0[2], v0[3]); w.z = pg8::cvt_pk_bf16(v1[0], v1[1]); w.w = pg8::cvt_pk_bf16(v1[2], v1[3]);
                    *(v4u*)(H + (size_t)row * DFF + col0 + bj * 128) = w; } }
    }
};
struct EpiFf2 {
    static constexpr bool PERM = false, AFTER_DRAIN = false;
    float* O;
    __device__ __forceinline__ void operator()(const pg8::f32x4 (&acc)[2][2][4][2], const pg8::Unit& u, int wr, int wc, int fr, int fq) const {
        const int row0 = u.pm * 256 + wr * 64 + fr, col0 = u.pn * 256 + wc * 32 + 4 * fq;
#pragma unroll
        for (int ai = 0; ai < 2; ++ai)
#pragma unroll
            for (int m = 0; m < 4; ++m) { float* rowp = O + (size_t)(row0 + ai * 128 + m * 16) * DM + col0;
#pragma unroll
                for (int bj = 0; bj < 2; ++bj)
#pragma unroll
                    for (int n = 0; n < 2; ++n) { pg8::f32x4* p = (pg8::f32x4*)(rowp + bj * 128 + n * 16); *p = *p + acc[ai][bj][m][n]; } }
    }
};


namespace da {
typedef float f32x16 __attribute__((ext_vector_type(16)));
typedef short s16x4 __attribute__((ext_vector_type(4)));
constexpr int KBUF = 16384, VBUF = 16384, K_OFF = 0, V_OFF = 32768;
constexpr float THR = 8.f;
__device__ __forceinline__ int crow(int r, int hi) { return (r & 3) + 8 * (r >> 2) + 4 * hi; }
__device__ __forceinline__ int kswz(int row, int colB) { return row * 256 + (colB ^ ((row & 7) << 4)); }
__device__ __forceinline__ int v_st(int k, int c) { return ((k >> 3) * 4 + (c >> 5)) * 512 + ((k & 7) * 32 + (c & 31)) * 2; }
__device__ __forceinline__ int v_rd_base(int lane) { return ((lane & 3) << 3) | (((lane >> 2) & 3) << 6) | (((lane >> 4) & 1) << 5) | (((lane >> 5) & 1) << 8); }
__device__ __forceinline__ s16x4 vtr(LAS const unsigned char* p) { return __builtin_bit_cast(s16x4, __builtin_amdgcn_ds_read_tr16_b64_v4i16((LAS s16x4*)p)); }
__device__ __forceinline__ float pl_max(float v) { auto rr = __builtin_amdgcn_permlane32_swap(__float_as_uint(v), __float_as_uint(v), false, false); return fmaxf(__uint_as_float(rr[0]), __uint_as_float(rr[1])); }
__device__ __forceinline__ float pl_sum(float v) { auto rr = __builtin_amdgcn_permlane32_swap(__float_as_uint(v), __float_as_uint(v), false, false); return __uint_as_float(rr[0]) + __uint_as_float(rr[1]); }
__device__ __forceinline__ bf16x8 pack8(const f32x16& p, int base) {
    v4u w; w.x = pg8::cvt_pk_bf16(p[base + 0], p[base + 1]); w.y = pg8::cvt_pk_bf16(p[base + 2], p[base + 3]); w.z = pg8::cvt_pk_bf16(p[base + 4], p[base + 5]); w.w = pg8::cvt_pk_bf16(p[base + 6], p[base + 7]);
    return __builtin_bit_cast(bf16x8, w);
}
template <bool META>
__device__ __forceinline__ void tile(LAS const unsigned char* Kb, LAS const unsigned char* Vb, const bf16x8 (&qr)[4], f32x16 (&o)[4], float& m_reg, float& l_reg, int c, int r32, int hi, int lane, bool diag, int rel) {
    f32x16 p0 = {}, p1 = {};
#pragma unroll
    for (int d0 = 0; d0 < 4; ++d0) { const int cb = (c * 64 + d0 * 16 + hi * 8) * 2;
        const bf16x8 b0 = *(LAS const bf16x8*)(Kb + kswz(r32, cb));
        p0 = __builtin_amdgcn_mfma_f32_32x32x16_bf16(b0, qr[d0], p0, 0, 0, 0);
        if (!META) { const bf16x8 b1 = *(LAS const bf16x8*)(Kb + kswz(32 + r32, cb)); p1 = __builtin_amdgcn_mfma_f32_32x32x16_bf16(b1, qr[d0], p1, 0, 0, 0); } }
    if (META) {
#pragma unroll
        for (int r = 0; r < 16; ++r) if (crow(r, hi) >= NMETA) p0[r] = -1e30f;
    } else if (diag) {
#pragma unroll
        for (int r = 0; r < 16; ++r) { if (crow(r, hi) > rel) p0[r] = -1e30f; if (32 + crow(r, hi) > rel) p1[r] = -1e30f; }
    }
    float pmax = p0[0];
#pragma unroll
    for (int r = 1; r < 16; ++r) pmax = fmaxf(pmax, p0[r]);
    if (!META) {
#pragma unroll
        for (int r = 0; r < 16; ++r) pmax = fmaxf(pmax, p1[r]); }
    pmax = pl_max(pmax);
    if (!__all(pmax - m_reg <= THR)) {
        const float mn = fmaxf(m_reg, pmax), alpha = __builtin_amdgcn_exp2f(m_reg - mn); m_reg = mn; l_reg *= alpha;
#pragma unroll
        for (int d = 0; d < 4; ++d)
#pragma unroll
            for (int r = 0; r < 16; ++r) o[d][r] *= alpha;
    }
    float ps = 0.f;
#pragma unroll
    for (int r = 0; r < 16; ++r) { p0[r] = __builtin_amdgcn_exp2f(p0[r] - m_reg); ps += p0[r]; }
    if (!META) {
#pragma unroll
        for (int r = 0; r < 16; ++r) { p1[r] = __builtin_amdgcn_exp2f(p1[r] - m_reg); ps += p1[r]; } }
    l_reg += pl_sum(ps);
    bf16x8 pb[4]; pb[0] = pack8(p0, 0);
    if (!META) { pb[1] = pack8(p0, 8); pb[2] = pack8(p1, 0); pb[3] = pack8(p1, 8); }
    LAS const unsigned char* vb = Vb + v_rd_base(lane);
#pragma unroll
    for (int d0 = 0; d0 < 4; ++d0)
#pragma unroll
        for (int ks = 0; ks < (META ? 1 : 4); ++ks) {
            const s16x4 lo = vtr(vb + d0 * 512 + ks * 4096), hh = vtr(vb + d0 * 512 + ks * 4096 + 2048);
            const bf16x8 a = (bf16x8){lo[0], lo[1], lo[2], lo[3], hh[0], hh[1], hh[2], hh[3]};
            o[d0] = __builtin_amdgcn_mfma_f32_32x32x16_bf16(a, pb[ks], o[d0], 0, 0, 0); }
}
__device__ __forceinline__ void unit(LAS unsigned char* lds, const bf16* P, const bf16* Pm, bf16* YA, const float* subln, float lam, int b, int h, int qb, int tid, int wave, int lane) {
    const int c = wave >> 2, jw = wave & 3, r32 = lane & 31, hi = lane >> 5, q0 = qb * 128, NT = 2 * qb + 2;
    bf16x8 qr[4];
    { const bf16* qp = P + (size_t)(b * SEQ + q0 + jw * 32 + r32) * NIN + C_Q + h * 128 + c * 64 + hi * 8;
#pragma unroll
      for (int d0 = 0; d0 < 4; ++d0) qr[d0] = *(const GAS bf16x8*)(qp + d0 * 16); }
    f32x16 o[4] = {}; float m_reg = -1e30f, l_reg = 0.f;
    const int sr = tid >> 4, sc = (tid & 15) * 8;
    { const int mr = sr & 15;
      if (tid < 256) { const v4u v = *(const GAS v4u*)(Pm + (size_t)mr * NIN + C_K + h * 128 + sc); *(LAS v4u*)(lds + K_OFF + KBUF + kswz(mr, sc * 2)) = v; }
      else           { const v4u v = *(const GAS v4u*)(Pm + (size_t)mr * NIN + C_V + h * 128 + sc); *(LAS v4u*)(lds + V_OFF + VBUF + v_st(mr, sc)) = v; } }
    const bf16* kg = P + (size_t)(b * SEQ + sr) * NIN + C_K + h * 128 + sc; const bf16* vg = P + (size_t)(b * SEQ + sr) * NIN + C_V + h * 128 + sc;
    v4u ks0 = *(const GAS v4u*)kg, ks1 = *(const GAS v4u*)(kg + (size_t)32 * NIN), vs0 = *(const GAS v4u*)vg, vs1 = *(const GAS v4u*)(vg + (size_t)32 * NIN);
    __syncthreads();
    tile<true>(lds + K_OFF + KBUF, lds + V_OFF + VBUF, qr, o, m_reg, l_reg, c, r32, hi, lane, false, 0);
#pragma unroll 1
    for (int kt = 0; kt < NT; ++kt) {
        const int buf = kt & 1;
        *(LAS v4u*)(lds + K_OFF + buf * KBUF + kswz(sr, sc * 2)) = ks0; *(LAS v4u*)(lds + K_OFF + buf * KBUF + kswz(32 + sr, sc * 2)) = ks1;
        *(LAS v4u*)(lds + V_OFF + buf * VBUF + v_st(sr, sc)) = vs0; *(LAS v4u*)(lds + V_OFF + buf * VBUF + v_st(32 + sr, sc)) = vs1;
        __syncthreads();
        if (kt + 1 < NT) { const size_t go = (size_t)(kt + 1) * 64 * NIN;
            ks0 = *(const GAS v4u*)(kg + go); ks1 = *(const GAS v4u*)(kg + go + (size_t)32 * NIN); vs0 = *(const GAS v4u*)(vg + go); vs1 = *(const GAS v4u*)(vg + go + (size_t)32 * NIN); }
        const int dt = kt - 2 * qb;
        const int rel = 32 * jw + r32 - 64 * dt;
        if (!(dt == 1 && jw < 2))
            tile<false>(lds + K_OFF + buf * KBUF, lds + V_OFF + buf * VBUF, qr, o, m_reg, l_reg, c, r32, hi, lane, dt >= 0, rel);
    }
    __syncthreads();
    LAS float* ex = (LAS float*)lds;
    if (c == 1) { const float s1 = -lam / l_reg;
#pragma unroll
        for (int d0 = 0; d0 < 4; ++d0)
#pragma unroll
            for (int r = 0; r < 16; ++r) ex[((jw * 4 + d0) * 16 + r) * 64 + lane] = o[d0][r] * s1; }
    __syncthreads();
    if (c == 0) { const float il = 1.f / l_reg; float ss = 0.f;
#pragma unroll
        for (int d0 = 0; d0 < 4; ++d0)
#pragma unroll
            for (int r = 0; r < 16; ++r) { const float v = o[d0][r] * il + ex[((jw * 4 + d0) * 16 + r) * 64 + lane]; o[d0][r] = v; ss += v * v; }
        ss = pl_sum(ss);
        const float rstd = (1.f - LAM_INIT) / sqrtf(ss * (1.f / 128.f) + EPS);
        bf16* yp = YA + (size_t)(b * SEQ + q0 + jw * 32 + r32) * WHD + h * 128;
#pragma unroll
        for (int d0 = 0; d0 < 4; ++d0)
#pragma unroll
            for (int g = 0; g < 4; ++g) { const int e = 32 * d0 + 8 * g + 4 * hi; const f32x4 sw = *(const GAS f32x4*)(subln + e);
                const unsigned w0 = pg8::cvt_pk_bf16(o[d0][4 * g + 0] * rstd * sw.x, o[d0][4 * g + 1] * rstd * sw.y), w1 = pg8::cvt_pk_bf16(o[d0][4 * g + 2] * rstd * sw.z, o[d0][4 * g + 3] * rstd * sw.w);
                *(GAS unsigned long long*)(yp + e) = (unsigned long long)w0 | ((unsigned long long)w1 << 32); }
    }
    __syncthreads();
}
}


namespace hg {
using da::f32x16; using da::s16x4; using da::crow; using da::vtr; using da::pl_sum; using da::pack8;
typedef float f32x2 __attribute__((ext_vector_type(2)));
__device__ __forceinline__ int ioff(int row, int ch) { return 2048 * (row >> 3) + 512 * (ch >> 2) + 64 * (row & 7) + 16 * ((ch & 3) ^ ((row >> 2) & 3)); }
constexpr int QD = 0, KI = 16384, VI = 32768, SI = 49152, PART = 81920, DEC = 86016, SSQ = 86528;
__device__ __forceinline__ bf16x8 cat(s16x4 lo, s16x4 hh) { return (bf16x8){lo[0], lo[1], lo[2], lo[3], hh[0], hh[1], hh[2], hh[3]}; }
__device__ __forceinline__ void unit(LAS unsigned char* lds, const bf16* P, const bf16* Pm, bf16* YB, const float* hg_lb, const float* onorm, int b, int h, int tid, int wave, int lane) {
    const int r32 = lane & 31, hi = lane >> 5, blk = (lane >> 4) & 1, q4 = (lane & 15) >> 2, p4 = lane & 3;
    const int eb = wave & 3, tb = wave >> 2;
    const int trc = 2 * blk + (p4 >> 1), trb = 8 * (p4 & 1);
    const int cc = h * 128 + 2 * lane;
    float lb0, lb1;
    { const float a0 = hg_lb[cc], a1 = hg_lb[cc + 1], c0 = hg_lb[WHD + cc], c1 = hg_lb[WHD + cc + 1]; lb0 = 1.f / (1.f + __expf(c0 - a0)); lb1 = 1.f / (1.f + __expf(c1 - a1)); }
#pragma unroll
    for (int i = 0; i < 4; ++i) *(LAS v4u*)(lds + SI + (tid * 4 + i) * 16) = (v4u){0u, 0u, 0u, 0u};
    f32x16 acc0 = {}, acc1 = {};
    const int sr = tid >> 4, sch = tid & 15;
    unsigned fr[8], qw[8]; v4u vr0, vr1;
#pragma unroll
    for (int i = 0; i < 8; ++i) { const int t = 8 * wave + i; fr[i] = 0u; qw[i] = 0u; if (t < NMETA) fr[i] = *(const GAS unsigned*)(Pm + (size_t)t * NIN + C_HF + cc); }
    vr0 = (v4u){0u, 0u, 0u, 0u}; vr1 = vr0; if (sr < NMETA) vr0 = *(const GAS v4u*)(Pm + (size_t)sr * NIN + C_HI + h * 128 + sch * 8);
    LAS float* part = (LAS float*)(lds + PART); LAS float* dec = (LAS float*)(lds + DEC); LAS float* ssq = (LAS float*)(lds + SSQ);
#pragma unroll 1
    for (int n = 0; n <= 32; ++n) {
        float c0[8], c1[8], k0[8], k1[8]; float run0 = 0.f, run1 = 0.f;
#pragma unroll
        for (int i = 0; i < 8; ++i) { const bool valid = (n > 0) || (8 * wave + i < NMETA);
            const float f0 = lb0 + (1.f - lb0) * sigmoidf_(bflo(fr[i])), f1 = lb1 + (1.f - lb1) * sigmoidf_(bfhi(fr[i]));
            run0 += valid ? __logf(f0) : 0.f; run1 += valid ? __logf(f1) : 0.f; c0[i] = run0; c1[i] = run1;
            k0[i] = valid ? 1.f - f0 : 0.f; k1[i] = valid ? 1.f - f1 : 0.f; }
        *(LAS f32x2*)(part + wave * 128 + 2 * lane) = (f32x2){run0, run1};
        *(LAS v4u*)(lds + VI + ioff(sr, sch)) = vr0; *(LAS v4u*)(lds + VI + ioff(32 + sr, sch)) = vr1;
        __syncthreads();
        float pre0 = 0.f, pre1 = 0.f, tot0 = 0.f, tot1 = 0.f;
#pragma unroll
        for (int w2 = 0; w2 < 8; ++w2) { const f32x2 t = *(const LAS f32x2*)(part + w2 * 128 + 2 * lane); tot0 += t.x; tot1 += t.y; if (w2 < wave) { pre0 += t.x; pre1 += t.y; } }
#pragma unroll
        for (int i = 0; i < 8; ++i) { const float b0 = pre0 + c0[i], b1 = pre1 + c1[i]; const int row = 8 * wave + i;
            const unsigned qd = pg8::cvt_pk_bf16(bflo(qw[i]) * __expf(b0), bfhi(qw[i]) * __expf(b1)), ki = pg8::cvt_pk_bf16(k0[i] * __expf(-b0), k1[i] * __expf(-b1));
            const int o4 = ioff(row, lane >> 2) + (lane & 3) * 4;
            *(LAS unsigned*)(lds + QD + o4) = qd; *(LAS unsigned*)(lds + KI + o4) = ki; }
        if (wave == 0) *(LAS f32x2*)(dec + 2 * lane) = (f32x2){__expf(tot0), __expf(tot1)};
        __syncthreads();
        if (n < 32) {
            const bf16* rp = P + (size_t)(b * SEQ + 64 * n + 8 * wave) * NIN + cc;
#pragma unroll
            for (int i = 0; i < 8; ++i) { fr[i] = *(const GAS unsigned*)(rp + (size_t)i * NIN + C_HF); qw[i] = *(const GAS unsigned*)(rp + (size_t)i * NIN + C_HQ); }
            const bf16* vp = P + (size_t)(b * SEQ + 64 * n + sr) * NIN + C_HI + h * 128 + sch * 8;
            vr0 = *(const GAS v4u*)vp; vr1 = *(const GAS v4u*)(vp + (size_t)32 * NIN);
        }
        bf16x8 vf[4];
#pragma unroll
        for (int ks = 0; ks < 4; ++ks) vf[ks] = cat(vtr(lds + VI + ioff(16 * ks + 4 * hi + q4, 4 * eb + trc) + trb), vtr(lds + VI + ioff(16 * ks + 8 + 4 * hi + q4, 4 * eb + trc) + trb));
        f32x16 o = {};
        if (n > 0) {
#pragma unroll
            for (int sb = 0; sb < 2; ++sb) if (sb <= tb) {
                f32x16 X = {};
#pragma unroll
                for (int ds = 0; ds < 8; ++ds) { const bf16x8 A = *(const LAS bf16x8*)(lds + KI + ioff(32 * sb + r32, 2 * ds + hi)), B = *(const LAS bf16x8*)(lds + QD + ioff(32 * tb + r32, 2 * ds + hi));
                    X = __builtin_amdgcn_mfma_f32_32x32x16_bf16(A, B, X, 0, 0, 0); }
                if (sb == tb) {
#pragma unroll
                    for (int r = 0; r < 16; ++r) if (crow(r, hi) > r32) X[r] = 0.f; }
                o = __builtin_amdgcn_mfma_f32_32x32x16_bf16(vf[2 * sb], pack8(X, 0), o, 0, 0, 0);
                o = __builtin_amdgcn_mfma_f32_32x32x16_bf16(vf[2 * sb + 1], pack8(X, 8), o, 0, 0, 0);
            }
#pragma unroll
            for (int ds = 0; ds < 8; ++ds) { const bf16x8 A = cat(vtr(lds + SI + ioff(16 * ds + 8 * hi + q4, 4 * eb + trc) + trb), vtr(lds + SI + ioff(16 * ds + 8 * hi + 4 + q4, 4 * eb + trc) + trb));
                const bf16x8 B = *(const LAS bf16x8*)(lds + QD + ioff(32 * tb + r32, 2 * ds + hi));
                o = __builtin_amdgcn_mfma_f32_32x32x16_bf16(A, B, o, 0, 0, 0); }
            float ss = 0.f;
#pragma unroll
            for (int r = 0; r < 16; ++r) ss += o[r] * o[r];
            ss = pl_sum(ss);
            if (hi == 0) ssq[eb * 64 + 32 * tb + r32] = ss;
        }
#pragma unroll
        for (int ks = 0; ks < 4; ++ks) {
            const bf16x8 B0 = cat(vtr(lds + KI + ioff(16 * ks + 4 * hi + q4, 4 * (2 * tb) + trc) + trb), vtr(lds + KI + ioff(16 * ks + 8 + 4 * hi + q4, 4 * (2 * tb) + trc) + trb));
            const bf16x8 B1 = cat(vtr(lds + KI + ioff(16 * ks + 4 * hi + q4, 4 * (2 * tb + 1) + trc) + trb), vtr(lds + KI + ioff(16 * ks + 8 + 4 * hi + q4, 4 * (2 * tb + 1) + trc) + trb));
            acc0 = __builtin_amdgcn_mfma_f32_32x32x16_bf16(vf[ks], B0, acc0, 0, 0, 0); acc1 = __builtin_amdgcn_mfma_f32_32x32x16_bf16(vf[ks], B1, acc1, 0, 0, 0); }
        { const float d0 = dec[32 * (2 * tb) + r32], d1 = dec[32 * (2 * tb + 1) + r32];
#pragma unroll
          for (int r = 0; r < 16; ++r) { acc0[r] *= d0; acc1[r] *= d1; } }
        __syncthreads();
#pragma unroll
        for (int g = 0; g < 4; ++g) {
            *(LAS unsigned long long*)(lds + SI + ioff(32 * (2 * tb) + r32, 4 * eb + g) + 8 * hi) = (unsigned long long)pg8::cvt_pk_bf16(acc0[4 * g], acc0[4 * g + 1]) | ((unsigned long long)pg8::cvt_pk_bf16(acc0[4 * g + 2], acc0[4 * g + 3]) << 32);
            *(LAS unsigned long long*)(lds + SI + ioff(32 * (2 * tb + 1) + r32, 4 * eb + g) + 8 * hi) = (unsigned long long)pg8::cvt_pk_bf16(acc1[4 * g], acc1[4 * g + 1]) | ((unsigned long long)pg8::cvt_pk_bf16(acc1[4 * g + 2], acc1[4 * g + 3]) << 32); }
        if (n > 0) {
            const int t = 32 * tb + r32; const float tot = (ssq[t] + ssq[64 + t]) + (ssq[128 + t] + ssq[192 + t]);
            const float rstd = 1.f / sqrtf(tot * (1.f / 128.f) + EPS);
            const size_t row = (size_t)(b * SEQ + 64 * (n - 1) + t);
#pragma unroll
            for (int g = 0; g < 4; ++g) { const int e = 32 * eb + 8 * g + 4 * hi;
                const unsigned long long gw = *(const GAS unsigned long long*)(P + row * NIN + C_HG + h * 128 + e); const unsigned g01 = (unsigned)gw, g23 = (unsigned)(gw >> 32);
                const f32x4 on = *(const GAS f32x4*)(onorm + e);
                const unsigned w0 = pg8::cvt_pk_bf16(o[4 * g] * rstd * on.x * sigmoidf_(bflo(g01)), o[4 * g + 1] * rstd * on.y * sigmoidf_(bfhi(g01)));
                const unsigned w1 = pg8::cvt_pk_bf16(o[4 * g + 2] * rstd * on.z * sigmoidf_(bflo(g23)), o[4 * g + 3] * rstd * on.w * sigmoidf_(bfhi(g23)));
                *(GAS unsigned long long*)(YB + row * WHD + h * 128 + e) = (unsigned long long)w0 | ((unsigned long long)w1 << 32); }
        }
    }
    __syncthreads();
}
}

__global__ void __launch_bounds__(NWAVES * 64, 2) mk_fwd(Ptrs args) {
    extern __shared__ __attribute__((aligned(16))) unsigned char lds_raw[];
    LAS unsigned char* lds = (LAS unsigned char*)lds_raw;
    volatile LAS unsigned* MISC = (volatile LAS unsigned*)(lds + LDSCTL_OFF);
    const int tid = threadIdx.x, lane = tid & 63, wave = __builtin_amdgcn_readfirstlane(tid >> 6);
    const int G = gridDim.x, bx = blockIdx.x;
    const int vcu = (G % 8 == 0) ? (bx % 8) * (G / 8) + bx / 8 : bx;
    unsigned char* ws = args.ws;
    gu32* ctl = (gu32*)(ws + WS_CTL);
    const float* x = args.in[0]; const float* meta = args.in[1]; const float* norm_mix = args.in[2]; const float* w_in = args.in[3];
    const float* q_norm = args.in[4]; const float* k_norm = args.in[5];
    const float* lq1 = args.in[6]; const float* lk1 = args.in[7]; const float* lq2 = args.in[8]; const float* lk2 = args.in[9];
    const float* subln = args.in[10]; const float* hg_lb = args.in[11]; const float* hg_onorm = args.in[12];
    const float* w_up_a = args.in[13]; const float* w_up_b = args.in[14]; const float* w_out = args.in[15]; const float* norm_mlp = args.in[16];
    const float* w_ff1 = args.in[17]; const float* w_ff2 = args.in[18];
    float* out = args.out;
    bf16* Wt_in = (bf16*)(ws + WS_WIN); bf16* Wt_upa = (bf16*)(ws + WS_WUPA); bf16* Wt_upb = (bf16*)(ws + WS_WUPB); bf16* Wt_out = (bf16*)(ws + WS_WOUT);
    bf16* Wt_ff1 = (bf16*)(ws + WS_WFF1); bf16* Wt_ff2 = (bf16*)(ws + WS_WFF2);
    bf16* U = (bf16*)(ws + WS_U); bf16* Umeta = (bf16*)(ws + WS_UMETA); bf16* Pm = (bf16*)(ws + WS_PM); float* ROPE = (float*)(ws + WS_ROPE);
    float* RSTD = (float*)(ws + WS_RSTD); float* SSQ = (float*)(ws + WS_SSQ); bf16* P = (bf16*)(ws + WS_P); bf16* HID = (bf16*)(ws + WS_P);
    bf16* YA = (bf16*)(ws + WS_YA); bf16* YB = (bf16*)(ws + WS_YB); bf16* MG = (bf16*)(ws + WS_MG);

    for (int u = tid; u < (LDS_BYTES - LDSCTL_OFF) / 4; u += NWAVES * 64) ((LAS unsigned*)(lds + LDSCTL_OFF))[u] = 0u;
    __syncthreads();
    XcdBarrier bar = xcd_barrier_post((unsigned*)(ctl + CW_BAR), MISC + 8);
    if (wave == 0) {
        const float s1 = wave_sum(lq1[lane] * lk1[lane]), s2 = wave_sum(lq2[lane] * lk2[lane]);
        if (lane == 0) ((LAS float*)(lds + LDSCTL_OFF))[16] = expf(s1) - expf(s2) + LAM_INIT;
    }
    __syncthreads();
    const float lam = ((LAS float*)(lds + LDSCTL_OFF))[16];

    {
        LAS float* scr = (LAS float*)(lds + wave * 16384);
        const int gw = vcu * NWAVES + wave, NGW = G * NWAVES;
        constexpr int I_IN = (DM / 64) * (NIN / 32), I_UP = (WHD / 64) * (DM / 32), I_OUT = (DM / 64) * (DM / 32), I_F1 = (DM / 64) * (DFF / 32), I_F2 = (DFF / 64) * (DM / 32);
        constexpr int NITEMS = I_IN + 2 * I_UP + I_OUT + I_F1 + I_F2;
        for (int it = gw; it < NITEMS; it += NGW) {
            int r = it;
            if (r < I_IN) { p0_transpose_item(w_in, DM, NIN, Wt_in, scr, r, lane); continue; } r -= I_IN;
            if (r < I_UP) { p0_transpose_item(w_up_a, WHD, DM, Wt_upa, scr, r, lane); continue; } r -= I_UP;
            if (r < I_UP) { p0_transpose_item(w_up_b, WHD, DM, Wt_upb, scr, r, lane); continue; } r -= I_UP;
            if (r < I_OUT) { p0_transpose_item(w_out, DM, DM, Wt_out, scr, r, lane); continue; } r -= I_OUT;
            if (r < I_F1) { p0_transpose_item(w_ff1, DM, DFF, Wt_ff1, scr, r, lane); continue; } r -= I_F1;
            p0_transpose_item(w_ff2, DFF, DM, Wt_ff2, scr, r, lane);
        }
        for (int m = gw; m < MR + NMETA; m += NGW) {
            if (m < MR) rms_row_to_bf16(x + (size_t)m * DM, norm_mix, U + (size_t)m * DM, lane);
            else rms_row_to_bf16(meta + (size_t)(m - MR) * DM, norm_mix, Umeta + (size_t)(m - MR) * DM, lane);
        }
        const int gt = bx * (NWAVES * 64) + tid;
        if (gt < TT * 8) {
            const int pos = gt >> 3, j = gt & 7;
            const float invf[8] = {1.0f, 0.1939227432012558f, 0.03760603070259094f, 0.007292664609849453f, 0.0014142135623842478f, 0.00027424818836152554f, 5.3182957344688475e-05f, 1.0313385246263351e-05f};
            float inv = invf[0];
#pragma unroll
            for (int q = 1; q < 8; ++q) inv = (j == q) ? invf[q] : inv;
            const float ang = (float)pos * inv; float sn, cs; sincos_d((double)ang, sn, cs);
            ROPE[pos * 16 + j] = cs; ROPE[pos * 16 + 8 + j] = sn;
        }
    }
    xcd_barrier(bar);

    {
        for (int i = tid; i < NMETA * DM * 2 / 16; i += NWAVES * 64) ((LAS v4u*)lds)[i] = ((const GAS v4u*)Umeta)[i];
        __syncthreads();
        const int gw = vcu * NWAVES + wave, NGW = G * NWAVES;
        for (int ci = gw; ci < 8192; ci += NGW) {
            const int c = (ci < 4096) ? (C_K + ci) : (C_HF + (ci - 4096));
            const bf16* wrow = Wt_in + (size_t)c * DM;
            float acc[16];
#pragma unroll
            for (int r = 0; r < 16; ++r) acc[r] = 0.f;
#pragma unroll 1
            for (int i = 0; i < 8; ++i) {
                const int k = i * 512 + lane * 8;
                const v4u w = *(const GAS v4u*)(wrow + k);
                const float w0 = bflo(w.x), w1 = bfhi(w.x), w2 = bflo(w.y), w3 = bfhi(w.y), w4 = bflo(w.z), w5 = bfhi(w.z), w6 = bflo(w.w), w7 = bfhi(w.w);
#pragma unroll
                for (int r = 0; r < 16; ++r) { const v4u a = *(const LAS v4u*)(lds + (size_t)(r * DM + k) * 2);
                    acc[r] += (bflo(a.x) * w0 + bfhi(a.x) * w1) + (bflo(a.y) * w2 + bfhi(a.y) * w3) + (bflo(a.z) * w4 + bfhi(a.z) * w5) + (bflo(a.w) * w6 + bfhi(a.w) * w7); }
            }
            float mine = 0.f;
#pragma unroll
            for (int r = 0; r < 16; ++r) { const float s = wave_sum(acc[r]); mine = (lane == r) ? s : mine; }
            if (lane < 16) Pm[(size_t)lane * NIN + c] = (bf16)f2bf(mine);
        }
        __syncthreads();
        pg8::Gemm g{U, Wt_in, MR, NIN, DM}; pg8::StaticOrder S; S.init(MR, NIN, G, bx);
        EpiProj E{P, NIN, C_GA / 256};
        pg8::gemm_phase<EpiProj, pg8::StaticOrder, true, true>(lds, g, S, E);
    }
    xcd_barrier(bar);

    {
        const int gw = vcu * NWAVES + wave, NGW = G * NWAVES;
        for (int it = gw; it < 2 * MR + NMETA; it += NGW) {
            bf16* base; int pos; bool isk;
            if (it < 2 * MR) { const int row = it >> 1; isk = it & 1; base = P + (size_t)row * NIN + (isk ? C_K : C_Q); pos = NMETA + (row & (SEQ - 1)); }
            else { const int r = it - 2 * MR; isk = true; base = Pm + (size_t)r * NIN + C_K; pos = r; }
            const float* wv = isk ? k_norm : q_norm;
            const int d0 = (lane & 7) * 8, sub = lane & 7;
            float wn[8], cs[8], sn[8];
#pragma unroll
            for (int j = 0; j < 8; ++j) { wn[j] = wv[d0 + j]; cs[j] = ROPE[pos * 16 + j]; sn[j] = ROPE[pos * 16 + 8 + j]; }
#pragma unroll 1
            for (int i = 0; i < 4; ++i) {
                bf16* p = base + i * 512 + lane * 8;
                const v4u raw = *(const GAS v4u*)p;
                float xv[8] = {bflo(raw.x), bfhi(raw.x), bflo(raw.y), bfhi(raw.y), bflo(raw.z), bfhi(raw.z), bflo(raw.w), bfhi(raw.w)};
                float ss = 0.f;
#pragma unroll
                for (int j = 0; j < 8; ++j) ss += xv[j] * xv[j];
                ss += __shfl_xor(ss, 1); ss += __shfl_xor(ss, 2); ss += __shfl_xor(ss, 4);
                const float rstd = 1.f / sqrtf(ss * (1.f / 64.f) + EPS);
                float o[8];
#pragma unroll
                for (int j = 0; j < 8; ++j) {
                    const float xn = xv[j] * rstd * wn[j];
                    const float pr = __shfl_xor(xn, 1);
                    float v = xn;
                    if (sub == 0) v = xn * cs[j] - pr * sn[j];
                    else if (sub == 1) v = xn * cs[j] + pr * sn[j];
                    o[j] = isk ? v : v * C2;
                }
                v4u w; w.x = pk2(o[0], o[1]); w.y = pk2(o[2], o[3]); w.z = pk2(o[4], o[5]); w.w = pk2(o[6], o[7]);
                *(GAS v4u*)p = w;
            }
        }
    }
    xcd_barrier(bar);

    if (bx < 64) {
        hg::unit(lds, P, Pm, YB, hg_lb, hg_onorm, bx >> 4, bx & 15, tid, wave, lane);
    } else {
        const int nwg = G - 64, wgi = bx - 64;
#pragma unroll 1
        for (int u = wgi; u < NB * NH * 16; u += nwg) {
            const int qb = 15 - (u >> 6), bh = u & 63, b = bh >> 4, h = bh & 15;
            da::unit(lds, P, Pm, YA, subln, lam, b, h, qb, tid, wave, lane);
        }
    }
    xcd_barrier(bar);

    {
        { pg8::Gemm g{YA, Wt_upa, MR, DM, WHD}; pg8::StaticOrder S; S.init(MR, DM, G, bx); EpiUpA E{out, P};
          pg8::gemm_phase<EpiUpA, pg8::StaticOrder, true, true>(lds, g, S, E); }
        __syncthreads();
        { pg8::Gemm g{YB, Wt_upb, MR, DM, WHD}; pg8::StaticOrder S; S.init(MR, DM, G, bx); EpiUpB E{out, P, MG};
          pg8::gemm_phase<EpiUpB, pg8::StaticOrder, true, true>(lds, g, S, E); }
    }
    xcd_barrier(bar);

    {
        pg8::Gemm g{MG, Wt_out, MR, DM, DM}; pg8::StaticOrder S; S.init(MR, DM, G, bx); EpiOut E{x, out, U, norm_mlp, SSQ};
        pg8::gemm_phase<EpiOut, pg8::StaticOrder, true, true>(lds, g, S, E);
    }
    xcd_barrier(bar);
    {
        const int gt = bx * (NWAVES * 64) + tid;
        for (int row = gt; row < MR; row += G * NWAVES * 64) { float s = 0.f;
#pragma unroll
            for (int i = 0; i < 16; ++i) { const f32x4 v = *(const GAS f32x4*)(SSQ + (size_t)row * 64 + i * 4); s += (v.x + v.y) + (v.z + v.w); }
            RSTD[row] = 1.f / sqrtf(s * (1.f / DM) + EPS); }
    }
    xcd_barrier(bar);

    {
        pg8::Gemm g{U, Wt_ff1, MR, DFF, DM}; pg8::StaticOrder S; S.init(MR, DFF, G, bx); EpiFf1 E{HID, RSTD};
        pg8::gemm_phase<EpiFf1, pg8::StaticOrder, true, true>(lds, g, S, E);
    }
    xcd_barrier(bar);

    {
        pg8::Gemm g{HID, Wt_ff2, MR, DM, DFF}; pg8::StaticOrder S; S.init(MR, DM, G, bx); EpiFf2 E{out};
        pg8::gemm_phase<EpiFf2, pg8::StaticOrder, true, true>(lds, g, S, E);
    }
}

extern "C" void kernel_launch(void* const* d_in, const int* in_sizes, int n_in, void* d_out, int out_size, void* d_ws, size_t ws_size, hipStream_t stream) {
    static int grid = 0;
    if (grid == 0) {
        if (n_in != 19 || out_size != MR * DM || ws_size < WS_END) { fprintf(stderr, "kernel_launch: unexpected shapes (n_in %d out %d ws %zu)\n", n_in, out_size, ws_size); grid = -1; return; }
        int dev = 0, cus = 0, per_cu = 0;
        if (hipGetDevice(&dev) != hipSuccess || hipDeviceGetAttribute(&cus, hipDeviceAttributeMultiprocessorCount, dev) != hipSuccess) { grid = -1; return; }
        if (hipFuncSetAttribute((const void*)mk_fwd, hipFuncAttributeMaxDynamicSharedMemorySize, LDS_BYTES) != hipSuccess) { fprintf(stderr, "kernel_launch: hipFuncSetAttribute failed\n"); grid = -1; return; }
        if (hipOccupancyMaxActiveBlocksPerMultiprocessor(&per_cu, (const void*)mk_fwd, NWAVES * 64, LDS_BYTES) != hipSuccess || per_cu < 1) { fprintf(stderr, "kernel_launch: occupancy query says %d\n", per_cu); }
        (void)hipGetLastError();
        grid = cus;
    }
    if (grid < 0) return;
    if (hipMemsetAsync((char*)d_ws + WS_CTL, 0, CTL_ZERO_BYTES, stream) != hipSuccess) return;
    Ptrs a{};
    for (int i = 0; i < 19; ++i) a.in[i] = (const float*)d_in[i];
    a.out = (float*)d_out; a.ws = (unsigned char*)d_ws;
    hipLaunchKernelGGL(mk_fwd, dim3(grid), dim3(NWAVES * 64), LDS_BYTES, stream, a);
}
```

```cpp
#include <hip/hip_runtime.h>
#include <cstdio>
#include <cstdint>
namespace pg8 {
#define PG8_LAS __attribute__((address_space(3)))
typedef unsigned short bf16_t;
typedef short bf16x8 __attribute__((ext_vector_type(8)));
typedef float f32x4 __attribute__((ext_vector_type(4)));
typedef unsigned u32x4 __attribute__((ext_vector_type(4)));
typedef int i32x4_ __attribute__((ext_vector_type(4)));
typedef int i32x8_ __attribute__((ext_vector_type(8)));
template <bool FP8> struct Frag;
template <> struct Frag<false> { bf16x8 v[2]; __device__ __forceinline__ void set(int k, bf16x8 x) { v[k] = x; } };
template <> struct Frag<true>  { i32x8_ w;    __device__ __forceinline__ void set(int k, bf16x8 x) { if (k == 0) w.lo = __builtin_bit_cast(i32x4_, x); else w.hi = __builtin_bit_cast(i32x4_, x); } };
constexpr int BM = 256, BK = 64, HALF = 128, HTB = HALF * BK * 2  , STAGE_BYTES = 8 * HTB, NXCD = 8, WGM = 8;

__host__ __device__ __forceinline__ int lds_byte(int r, int c) { const int st = (r >> 4) * 2 + (c >> 5), rr = r & 15, cc = c & 31, ob = rr * 64 + cc * 2; return st * 1024 + (ob ^ (((ob >> 9) & 1) << 5)); }
__host__ __device__ __forceinline__ void stage_rc(int b, int& R, int& C) { const int st = b / 1024, sb = b % 1024, swz = sb ^ (((sb >> 9) & 1) << 5); R = (st >> 1) * 16 + swz / 64; C = (st & 1) * 32 + (swz % 64) / 2; }
__host__ __device__ __forceinline__ int perm32(int rho) { const int n = rho >> 4, i = rho & 15; return 8 * (i >> 2) + 4 * n + (i & 3); }

struct Unit { int pm, pn; };
struct Gemm { const bf16_t* A; const bf16_t* Bt; int M, N, K; };

struct StaticOrder {
    int nM, nN, nwg, G, c;
    __host__ __device__ void init(int M, int N, int G_, int c_) { nM = M / BM; nN = N / BM; nwg = nM * nN; G = G_; c = c_; }
    __host__ __device__ bool next(int i, Unit& u) const {
        const long L = (long)i * G + c; if (L >= nwg) return false;
        int wgid = (int)L; { const int q = nwg / NXCD, r = nwg % NXCD, xcd = wgid % NXCD, off = wgid / NXCD; wgid = (xcd < r ? xcd * (q + 1) : r * (q + 1) + (xcd - r) * q) + off; }
        const int nig = WGM * nN, gid = wgid / nig, fm = gid * WGM, gsz = (nM - fm) < WGM ? (nM - fm) : WGM;
        u.pm = fm + ((wgid % nig) % gsz); u.pn = (wgid % nig) / gsz; return true;
    }
    __device__ __forceinline__ void a_ready(const Unit&) const {}
    __device__ __forceinline__ void done(const Unit&) const {}
    static constexpr int KLOOP = 0;
    __device__ __forceinline__ size_t kofs(const Unit&) const { return 0; }
    __device__ __forceinline__ bool zero_after(const Unit&) const { return true; }
};

__device__ __forceinline__ unsigned cvt_pk_bf16(float lo, float hi) { unsigned r; asm volatile("v_cvt_pk_bf16_f32 %0, %1, %2" : "=v"(r) : "v"(lo), "v"(hi)); return r; }
typedef float f32x2 __attribute__((ext_vector_type(2)));
__device__ __forceinline__ void mfma_f8(f32x4& acc, const i32x8_& a, const i32x8_& b, int sc) {
    asm volatile("v_mfma_scale_f32_16x16x128_f8f6f4 %0, %1, %2, %0, %3, %3 op_sel_hi:[0,0,0]" : "+v"(acc) : "v"(a), "v"(b), "v"(sc));
}
template <class Epi, class Sched, bool ALIGN_EPI = false, bool SP2 = false, bool FP8 = false, bool I8 = false>
__device__ __forceinline__ void gemm_phase(PG8_LAS unsigned char* lds, const Gemm g, const Sched& S, const Epi& E) {
    int tid_ = threadIdx.x; asm volatile("" : "+v"(tid_));
    const int tid = tid_, wid = __builtin_amdgcn_readfirstlane(tid >> 6), lane = tid & 63, wr = wid >> 2, wc = wid & 3, fr = lane & 15, fq = lane >> 4;
    int one_scale = 0x7f7f7f7f; asm volatile("" : "+v"(one_scale));      (void)one_scale;
    const int K = g.K, nt = (Sched::KLOOP ? Sched::KLOOP : K) / BK;
    unsigned voffA[2], voffB[2];
#pragma unroll
    for (int i = 0; i < 2; ++i) { int R, C; stage_rc(tid * 16 + i * 8192, R, C); const int Rb = Epi::PERM ? ((R & ~31) + perm32(R & 31)) : R;
        if (FP8) { const int q8 = C >> 3; C = (2 * (q8 & 3) + (q8 >> 2)) * 8; }
        voffA[i] = (unsigned)(R * K + C) * 2u; voffB[i] = (unsigned)(Rb * K + C) * 2u; }
    const size_t kstep = (size_t)(BK * 2);
    const size_t hstep = (size_t)HALF * K * 2;
    const size_t tstep = 2 * hstep;
    const unsigned ldsw = (unsigned)wid * 1024u;
    const int aoff = lds_byte(wr * 64 + fr, fq * 8), boff = lds_byte(wc * 32 + fr, fq * 8);
#define PG8_SA(b, h) (((b) * 2 + (h)) * HTB)
#define PG8_SB(b, h) ((4 + (b) * 2 + (h)) * HTB)
#define PG8_STAGE(bufoff, gbase, voff) do { _Pragma("unroll") for (int _i = 0; _i < 2; ++_i) \
        __builtin_amdgcn_global_load_lds((const unsigned*)((const char*)(gbase) + (voff)[_i]), (PG8_LAS unsigned*)(lds + (bufoff) + ldsw + _i * 8192), 16, 0, 0); } while (0)
#define PG8_LDA(dst, b, h) do { _Pragma("unroll") for (int m = 0; m < 4; ++m) _Pragma("unroll") for (int k = 0; k < 2; ++k) dst[m].set(k, *(const PG8_LAS bf16x8*)(lds + PG8_SA(b, h) + aoff + m * 2048 + k * 1024)); } while (0)
#define PG8_LDB(dst, b, h) do { _Pragma("unroll") for (int n = 0; n < 2; ++n) _Pragma("unroll") for (int k = 0; k < 2; ++k) dst[n].set(k, *(const PG8_LAS bf16x8*)(lds + PG8_SB(b, h) + boff + n * 2048 + k * 1024)); } while (0)
#define PG8_MMA(ai, bj, At, Bt) do { __builtin_amdgcn_s_setprio(1); _Pragma("unroll") for (int m = 0; m < 4; ++m) _Pragma("unroll") for (int n = 0; n < 2; ++n) { \
        if constexpr (FP8) mfma_f8(acc[ai][bj][m][n], Bt[n].w, At[m].w, one_scale); \
        else if constexpr (I8) { _Pragma("unroll") for (int k = 0; k < 2; ++k) acc[ai][bj][m][n] = __builtin_bit_cast(f32x4, __builtin_amdgcn_mfma_i32_16x16x64_i8(__builtin_bit_cast(i32x4_, Bt[n].v[k]), __builtin_bit_cast(i32x4_, At[m].v[k]), __builtin_bit_cast(i32x4_, acc[ai][bj][m][n]), 0, 0, 0)); } \
        else { _Pragma("unroll") for (int k = 0; k < 2; ++k) acc[ai][bj][m][n] = __builtin_amdgcn_mfma_f32_16x16x32_bf16(Bt[n].v[k], At[m].v[k], acc[ai][bj][m][n], 0, 0, 0); } } \
        if constexpr (FP8) asm volatile("s_nop 15" ::: "memory");     \
        __builtin_amdgcn_s_setprio(0); } while (0)
#define PG8_WAIT_V(n) asm volatile("s_waitcnt vmcnt(" #n ")" ::: "memory")
#define PG8_WAIT_L(n) asm volatile("s_waitcnt lgkmcnt(" #n ")" ::: "memory")
#define PG8_BAR __builtin_amdgcn_s_barrier()
#define PG8_SCHED __builtin_amdgcn_sched_barrier(0)
    Unit cur, nxt; int ui = 0;
    if (!S.next(0, cur)) return;
    f32x4 acc[2][2][4][2];
    if constexpr (Epi::INIT) E.init(acc, cur, wr, wc, fr, fq);
    else {
#pragma unroll
    for (int a = 0; a < 2; ++a)
#pragma unroll
        for (int b = 0; b < 2; ++b)
#pragma unroll
            for (int m = 0; m < 4; ++m)
#pragma unroll
                for (int n = 0; n < 2; ++n) acc[a][b][m][n] = (f32x4){0.f, 0.f, 0.f, 0.f};
    }
    Frag<FP8> At[4], B0[2], B1[2];
    const char* cA = (const char*)g.A + (size_t)cur.pm * tstep + S.kofs(cur); const char* cB = (const char*)g.Bt + (size_t)(cur.pn & 0xffff) * tstep + S.kofs(cur);
    S.a_ready(cur);
    if constexpr (SP2) {
        PG8_STAGE(PG8_SB(0, 0), cB, voffB); PG8_STAGE(PG8_SB(0, 1), cB + hstep, voffB); PG8_STAGE(PG8_SA(0, 0), cA, voffA); PG8_STAGE(PG8_SA(0, 1), cA + hstep, voffA);
        if (wr == 1) PG8_BAR;
        PG8_WAIT_V(2); PG8_BAR;
        PG8_STAGE(PG8_SB(1, 0), cB + kstep, voffB); PG8_STAGE(PG8_SA(1, 0), cA + kstep, voffA); PG8_STAGE(PG8_SB(1, 1), cB + hstep + kstep, voffB);
        PG8_WAIT_V(6); PG8_BAR;
    } else {
        PG8_STAGE(PG8_SB(0, 0), cB, voffB); PG8_STAGE(PG8_SA(0, 0), cA, voffA); PG8_STAGE(PG8_SB(0, 1), cB + hstep, voffB); PG8_STAGE(PG8_SA(0, 1), cA + hstep, voffA);
        if (wr == 1) PG8_BAR;
        PG8_WAIT_V(4); PG8_BAR;
        PG8_STAGE(PG8_SB(1, 0), cB + kstep, voffB); PG8_STAGE(PG8_SA(1, 0), cA + kstep, voffA); PG8_STAGE(PG8_SB(1, 1), cB + hstep + kstep, voffB);
        PG8_WAIT_V(6); PG8_BAR;
    }
    for (;;) {
        const bool has_next = S.next(ui + 1, nxt);
        const char* nA = has_next ? (const char*)g.A + (size_t)nxt.pm * tstep + S.kofs(nxt) : cA; const char* nB = has_next ? (const char*)g.Bt + (size_t)(nxt.pn & 0xffff) * tstep + S.kofs(nxt) : cB;
        for (int t = 0; t < nt; t += 2) {
            const bool last = (t == nt - 2);
            const char* a1 = cA + (size_t)(t + 1) * kstep;
            const char* a2 = last ? nA : cA + (size_t)(t + 2) * kstep; const char* b2 = last ? nB : cB + (size_t)(t + 2) * kstep;
            const char* a3 = a2 + kstep; const char* b3 = b2 + kstep;
            if (last && has_next) S.a_ready(nxt);
            if constexpr (SP2) {
            PG8_LDB(B0, 0, 0); PG8_LDB(B1, 0, 1); PG8_SCHED; PG8_LDA(At, 0, 0); PG8_STAGE(PG8_SA(1, 1), a1 + hstep, voffA);
            PG8_WAIT_V(8); PG8_WAIT_L(0); PG8_BAR; PG8_MMA(0, 0, At, B0); PG8_MMA(0, 1, At, B1); PG8_BAR; PG8_SCHED;
            PG8_LDA(At, 0, 1); PG8_STAGE(PG8_SB(0, 0), b2, voffB); PG8_STAGE(PG8_SB(0, 1), b2 + hstep, voffB); PG8_STAGE(PG8_SA(0, 0), a2, voffA);
            PG8_WAIT_V(8); PG8_WAIT_L(0); PG8_BAR; PG8_MMA(1, 0, At, B0); PG8_MMA(1, 1, At, B1); PG8_BAR; PG8_SCHED;
            PG8_LDB(B0, 1, 0); PG8_LDB(B1, 1, 1); PG8_SCHED; PG8_LDA(At, 1, 0); PG8_STAGE(PG8_SA(0, 1), a2 + hstep, voffA);
            PG8_WAIT_V(8); PG8_WAIT_L(0); PG8_BAR; PG8_MMA(0, 0, At, B0); PG8_MMA(0, 1, At, B1); PG8_BAR; PG8_SCHED;
            PG8_LDA(At, 1, 1); PG8_STAGE(PG8_SB(1, 0), b3, voffB); PG8_STAGE(PG8_SB(1, 1), b3 + hstep, voffB); PG8_STAGE(PG8_SA(1, 0), a3, voffA);
            PG8_WAIT_V(8); PG8_WAIT_L(0); PG8_BAR; PG8_MMA(1, 0, At, B0); PG8_MMA(1, 1, At, B1); PG8_BAR; PG8_SCHED;
            } else {
            PG8_LDB(B0, 0, 0); PG8_SCHED; PG8_LDA(At, 0, 0); PG8_STAGE(PG8_SA(1, 1), a1 + hstep, voffA);
            PG8_WAIT_L(8); PG8_BAR; PG8_WAIT_L(0); PG8_MMA(0, 0, At, B0); PG8_BAR; PG8_SCHED;
            PG8_LDB(B1, 0, 1); PG8_STAGE(PG8_SB(0, 0), b2, voffB);
            PG8_BAR; PG8_WAIT_L(0); PG8_MMA(0, 1, At, B1); PG8_BAR;
            PG8_LDA(At, 0, 1); PG8_STAGE(PG8_SA(0, 0), a2, voffA);
            PG8_BAR; PG8_WAIT_L(0); PG8_MMA(1, 0, At, B0); PG8_BAR; PG8_SCHED;
            PG8_STAGE(PG8_SB(0, 1), b2 + hstep, voffB);
            PG8_WAIT_V(6); PG8_BAR; PG8_MMA(1, 1, At, B1); PG8_BAR;
            PG8_LDB(B0, 1, 0); PG8_SCHED; PG8_LDA(At, 1, 0); PG8_STAGE(PG8_SA(0, 1), a2 + hstep, voffA);
            PG8_WAIT_L(8); PG8_BAR; PG8_WAIT_L(0); PG8_MMA(0, 0, At, B0); PG8_BAR; PG8_SCHED;
            PG8_LDB(B1, 1, 1); PG8_STAGE(PG8_SB(1, 0), b3, voffB);
            PG8_BAR; PG8_WAIT_L(0); PG8_MMA(0, 1, At, B1); PG8_BAR;
            PG8_LDA(At, 1, 1); PG8_STAGE(PG8_SA(1, 0), a3, voffA);
            PG8_BAR; PG8_WAIT_L(0); PG8_MMA(1, 0, At, B0); PG8_BAR; PG8_SCHED;
            PG8_STAGE(PG8_SB(1, 1), b3 + hstep, voffB);
            PG8_WAIT_V(6); PG8_BAR; PG8_MMA(1, 1, At, B1); PG8_BAR;
            }
        }
        if constexpr (ALIGN_EPI) { if (wr == 0) PG8_BAR; }
        if constexpr (FP8) asm volatile("s_nop 15\n\ts_nop 15" ::: "memory");
        if constexpr (!Epi::AFTER_DRAIN) { E(acc, cur, wr, wc, fr, fq); S.done(cur); }
        if (!has_next) break;
        if constexpr (Epi::INIT) E.init(acc, nxt, wr, wc, fr, fq);
        else if (S.zero_after(cur)) {
#pragma unroll
        for (int a = 0; a < 2; ++a)
#pragma unroll
            for (int b = 0; b < 2; ++b)
#pragma unroll
                for (int m = 0; m < 4; ++m)
#pragma unroll
                    for (int n = 0; n < 2; ++n) acc[a][b][m][n] = (f32x4){0.f, 0.f, 0.f, 0.f};
        }
        cur = nxt; cA = nA; cB = nB; ++ui;
        if constexpr (ALIGN_EPI) { if (wr == 1) PG8_BAR; }
    }
    PG8_WAIT_V(0);
    if constexpr (!ALIGN_EPI) { if (wr == 0) PG8_BAR; }
    PG8_BAR;
    if constexpr (Epi::AFTER_DRAIN) { E.fused(acc, cur, wr, wc, fr, fq, lds, wid, lane); S.done(cur); }
#undef PG8_SA
#undef PG8_SB
#undef PG8_STAGE
#undef PG8_LDA
#undef PG8_LDB
#undef PG8_MMA
#undef PG8_WAIT_V
#undef PG8_WAIT_L
#undef PG8_BAR
#undef PG8_SCHED
}
}
#define GAS __attribute__((address_space(1)))
#define LAS __attribute__((address_space(3)))
typedef unsigned short bf16;
typedef unsigned v4u __attribute__((ext_vector_type(4)));
typedef float f32x4 __attribute__((ext_vector_type(4)));
typedef short bf16x8 __attribute__((ext_vector_type(8)));
typedef GAS unsigned gu32;
typedef GAS unsigned long long gu64;
#define RLX_AGENT __ATOMIC_RELAXED, __HIP_MEMORY_SCOPE_AGENT
#define LDS_WAIT() asm volatile("s_waitcnt lgkmcnt(0)" ::: "memory")
#define VM_WAIT() asm volatile("s_waitcnt vmcnt(0)" ::: "memory")
__device__ __forceinline__ unsigned long long rt() { return __builtin_amdgcn_s_memrealtime(); }
__device__ __forceinline__ unsigned f2bf(float f) { unsigned u = __builtin_bit_cast(unsigned, f); return (u + 0x7fffu + ((u >> 16) & 1u)) >> 16; }
__device__ __forceinline__ unsigned pk2(float lo, float hi) { return f2bf(lo) | (f2bf(hi) << 16); }
#define XB_TMO      128
#define XB_XCNT(j)  (256  + 64 * (j))
#define XB_XSUB(j)  (1280 + 64 * (j))
#define XB_XGEN(j)  (2304 + 64 * (j))
#define XB_TOP      3328
#define XB_TOPGEN   3392
#define XCD_BAR_WORDS 3456
#define XB_SPIN_CAP (1u << 22)

__device__ __forceinline__ unsigned xb_ld(unsigned* p)              { return __hip_atomic_load(p, __ATOMIC_RELAXED, __HIP_MEMORY_SCOPE_AGENT); }
__device__ __forceinline__ unsigned xb_add(unsigned* p, unsigned v) { return __hip_atomic_fetch_add(p, v, __ATOMIC_RELAXED, __HIP_MEMORY_SCOPE_AGENT); }
__device__ __forceinline__ unsigned xb_xcc_id() { return (unsigned)__builtin_amdgcn_s_getreg((3 << 11) | 20) & 0xFu; }
#define XB_SPIN(cond, bar) do { unsigned _sp = 0; while (cond) { __builtin_amdgcn_s_sleep(1); \
    if ((++_sp & 255u) == 0u) { if (xb_ld(&(bar)[XB_TMO])) break; if (_sp > XB_SPIN_CAP) { atomicAdd(&(bar)[XB_TMO], 1u); break; } } } } while (0)

struct XcdBarrier {
    unsigned* bar; unsigned x;
    volatile LAS unsigned* st;
};

__device__ __forceinline__ XcdBarrier xcd_barrier_post(unsigned* bar, volatile LAS unsigned* st) {
    XcdBarrier b; b.bar = bar; b.x = xb_xcc_id(); b.st = st;
    if (threadIdx.x == 0) (void)xb_add(&bar[XB_XCNT(b.x)], 1u);
    return b;
}
__device__ __forceinline__ void xcd_barrier_complete(unsigned* bar, unsigned x, unsigned& nloc, unsigned& nx) {
    const unsigned G = gridDim.x * gridDim.y * gridDim.z;
    unsigned sum, cnt, mine, sp = 0u;
    for (;;) {
        sum = 0u; cnt = 0u; mine = 0u;
#pragma unroll
        for (unsigned j = 0; j < 16; ++j) { const unsigned c = xb_ld(&bar[XB_XCNT(j)]); sum += c; cnt += (c > 0u) ? 1u : 0u; mine = (j == x) ? c : mine; }
        if (sum == G) break;
        __builtin_amdgcn_s_sleep(1);
        if ((++sp & 255u) == 0u) { if (xb_ld(&bar[XB_TMO])) break; if (sp > XB_SPIN_CAP) { atomicAdd(&bar[XB_TMO], 1u); break; } }
    }
    nloc = mine > 0u ? mine : 1u; nx = cnt > 0u ? cnt : 1u;
}

__device__ __forceinline__ void xcd_barrier(const XcdBarrier& b) {
    asm volatile("s_waitcnt vmcnt(0)" ::: "memory");
    __syncthreads();
    if (threadIdx.x == 0) {
        unsigned* bar = b.bar;
        __builtin_amdgcn_s_waitcnt(0);
        unsigned nloc = b.st[0], nx = b.st[1];
        if (nloc == 0u) { xcd_barrier_complete(bar, b.x, nloc, nx); b.st[0] = nloc; b.st[1] = nx; }
        const unsigned old = xb_add(&bar[XB_XSUB(b.x)], 1u);
        const unsigned gen = old / nloc;
        if (old + 1u == (gen + 1u) * nloc) {
            __builtin_amdgcn_fence(__ATOMIC_RELEASE, "agent");
            asm volatile("s_waitcnt vmcnt(0)" ::: "memory");
            const unsigned og = xb_add(&bar[XB_TOP], 1u);
            const unsigned tg = og / nx;
            if (og + 1u == (tg + 1u) * nx) xb_add(&bar[XB_TOPGEN], 1u);
            else XB_SPIN(xb_ld(&bar[XB_TOPGEN]) == tg, bar);
            __builtin_amdgcn_fence(__ATOMIC_ACQUIRE, "agent");
            xb_add(&bar[XB_XGEN(b.x)], 1u);
            asm volatile("s_waitcnt vmcnt(0)" ::: "memory");
        } else {
            XB_SPIN(xb_ld(&bar[XB_XGEN(b.x)]) == gen, bar);
            __builtin_amdgcn_fence(__ATOMIC_ACQUIRE, "agent");
            asm volatile("s_waitcnt vmcnt(0)" ::: "memory");
        }
    }
    __syncthreads();
}
constexpr int NWAVES = 8;
constexpr int DM = 4096, NB = 4, SEQ = 2048, NMETA = 16, TT = SEQ + NMETA;
constexpr int MR = NB * SEQ;
constexpr int NIN = 22528, DFF = 16384, NH = 16, WHD = 2048;
constexpr int C_Q = 0, C_K = 2048, C_V = 4096, C_HQ = 6144, C_HF = 8192, C_HI = 10240, C_HG = 12288, C_GA = 14336, C_GB = 18432;
constexpr int YP = 2 * WHD;
constexpr float EPS = 1e-6f;
constexpr float C2 = 0.18033688011112042f;
constexpr float LAM_INIT = 0.2f;

constexpr size_t MiB = 1u << 20;
constexpr size_t WS_CTL = 0, CTL_ZERO_BYTES = 1 * MiB;
constexpr size_t WS_WIN = 2 * MiB, WS_WUPA = 178 * MiB, WS_WUPB = 194 * MiB, WS_WOUT = 210 * MiB, WS_WFF1 = 242 * MiB, WS_WFF2 = 370 * MiB;
constexpr size_t WS_U = 498 * MiB;
constexpr size_t WS_UMETA = 562 * MiB;
constexpr size_t WS_PM = 563 * MiB;
constexpr size_t WS_ROPE = 564 * MiB;
constexpr size_t WS_RSTD = 565 * MiB;
constexpr size_t WS_P = 568 * MiB;
constexpr size_t WS_YA = 920 * MiB, WS_YB = 952 * MiB, WS_MG = 984 * MiB;
constexpr size_t WS_SSQ = 1048 * MiB;
constexpr size_t WS_DEC = 1050 * MiB;
constexpr size_t WS_U8 = 1052 * MiB;
constexpr size_t WS_W8 = 1084 * MiB;
constexpr size_t WS_SU = 1172 * MiB;
constexpr size_t WS_SW = 1173 * MiB;
constexpr size_t WS_END = 1174 * MiB;
constexpr int NQK = C_V;
constexpr int CW_QHEAD = 2048;
constexpr int CW_SWMAX = 32768;
constexpr int CW_BAR = 4096;

constexpr int RING_BYTES = 131072, LDSCTL_OFF = 146432, LDS_BYTES = 147456;

__device__ __forceinline__ int opaque_v(int v) { asm volatile("" : "+v"(v)); return v; }
typedef __bf16 bf16v2_ __attribute__((ext_vector_type(2)));
__device__ __forceinline__ unsigned cvt2(float lo, float hi) { const pg8::f32x2 v = {lo, hi}; return __builtin_bit_cast(unsigned, __builtin_convertvector(v, bf16v2_)); }
#define PHASE_IDS const int tid = opaque_v((int)threadIdx.x), lane = tid & 63, wave = __builtin_amdgcn_readfirstlane(tid >> 6); (void)lane; (void)wave;
__device__ __forceinline__ float bf2f(bf16 v) { return __builtin_bit_cast(float, (unsigned)v << 16); }
__device__ __forceinline__ float bflo(unsigned w) { return __builtin_bit_cast(float, w << 16); }
__device__ __forceinline__ float bfhi(unsigned w) { return __builtin_bit_cast(float, w & 0xffff0000u); }
__device__ __forceinline__ float wave_sum(float v) {
#pragma unroll
    for (int o = 1; o < 64; o <<= 1) v += __shfl_xor(v, o);
    return v;
}
__device__ __forceinline__ float wave_max(float v) {
#pragma unroll
    for (int o = 1; o < 64; o <<= 1) v = fmaxf(v, __shfl_xor(v, o));
    return v;
}
__device__ __forceinline__ float sigmoidf_(float x) { return __builtin_amdgcn_rcpf(1.0f + __expf(-x)); }

__host__ __device__ __forceinline__ int wt_row(int s) {
    if (s < C_V) { const int base = s & ~2047, t = s & 2047, h = t >> 7, cm = (t >> 6) & 1, d = t & 63; return base + 256 * (h >> 1) + 128 * ((d >> 3) & 1) + 32 * (2 * (h & 1) + cm) + 8 * (d >> 4) + (d & 7); }
    if (s >= C_HQ && s < C_HI) { const int t = s - C_HQ, isf = t >> 11, h = (t & 2047) >> 7, d = t & 127; return C_HQ + 256 * h + 128 * isf + d; }
    return s;
}
__device__ __forceinline__ unsigned pk4_i8(float a, float b, float c, float d) {
    const int ia = (int)__builtin_rintf(a), ib = (int)__builtin_rintf(b), ic = (int)__builtin_rintf(c), id = (int)__builtin_rintf(d);
    return (unsigned)(ia & 0xff) | ((unsigned)(ib & 0xff) << 8) | ((unsigned)(ic & 0xff) << 16) | ((unsigned)id << 24);
}
__device__ __forceinline__ const void* ldp(LAS unsigned char* lds, int k) {
    volatile LAS unsigned* t = (volatile LAS unsigned*)(lds + LDSCTL_OFF) + 32 + 2 * k;
    const unsigned lo = t[0], hi = t[1];
    return (const void*)(const GAS void*)(((unsigned long long)(unsigned)__builtin_amdgcn_readfirstlane((int)hi) << 32) | (unsigned long long)(unsigned)__builtin_amdgcn_readfirstlane((int)lo));
}
struct TItem { const float* src; bf16* dst; int N, KP; const float* gain; };
constexpr int TI_UP = (WHD / 64) * (DM / 32), TI_OUT = (DM / 64) * (DM / 32), TI_F1 = (DM / 64) * (DFF / 32), TI_F2 = (DFF / 64) * (DM / 32), TI_ALL = 2 * TI_UP + TI_OUT + TI_F1 + TI_F2;
constexpr int TSCR_BYTES = 32 * 33 * 4;
__device__ __forceinline__ TItem t_item(const float* W, int N, bf16* WT, int item, int KP, int koff, const float* gain = nullptr) {
    const int nblk = N / 32, kb = item / nblk, nb = item % nblk;
    return TItem{W + (size_t)(64 * kb) * N + 32 * nb, WT + (size_t)(32 * nb) * KP + koff + 64 * kb, N, KP, gain ? gain + 64 * kb : nullptr};
}
__device__ __forceinline__ TItem t_decode(LAS unsigned char* lds, int it) {
    unsigned char* ws = (unsigned char*)ldp(lds, 20);
    int r = it;
    if (r < TI_UP) return t_item((const float*)ldp(lds, 13), DM, (bf16*)(ws + WS_WUPA), r, YP, 0);
    r -= TI_UP; if (r < TI_UP) return t_item((const float*)ldp(lds, 14), DM, (bf16*)(ws + WS_WUPA), r, YP, WHD);
    r -= TI_UP; if (r < TI_OUT) return t_item((const float*)ldp(lds, 15), DM, (bf16*)(ws + WS_WOUT), r, DM, 0);
    r -= TI_OUT; if (r < TI_F1) return t_item((const float*)ldp(lds, 17), DFF, (bf16*)(ws + WS_WFF1), r, DM, 0, (const float*)ldp(lds, 16));
    r -= TI_F1; return t_item((const float*)ldp(lds, 18), DM, (bf16*)(ws + WS_WFF2), r, DFF, 0);
}
__device__ __forceinline__ void t_convert(const TItem& t, LAS unsigned* scr, int lane) {
    const int r = lane >> 3, c4 = lane & 7;
    const unsigned off = (unsigned)(2 * r) * (unsigned)t.N + (unsigned)(4 * c4);
    f32x4 v[8];
#pragma unroll
    for (int i = 0; i < 8; ++i) v[i] = __builtin_nontemporal_load((const GAS f32x4*)((const GAS float*)t.src + (size_t)(16 * (i >> 1) + (i & 1)) * t.N + off));
    if (t.gain) {
#pragma unroll
        for (int i = 0; i < 8; ++i) v[i] = v[i] * t.gain[16 * (i >> 1) + (i & 1) + 2 * r];
    }
#pragma unroll
    for (int m = 0; m < 4; ++m)
#pragma unroll
        for (int e = 0; e < 4; ++e) scr[(8 * m + r) * 33 + 4 * c4 + e] = pg8::cvt_pk_bf16(v[2 * m][e], v[2 * m + 1][e]);
    LDS_WAIT(); asm volatile("" ::: "memory");
    const int c = lane & 7;
#pragma unroll
    for (int j = 0; j < 4; ++j) { const int n = (lane >> 3) + 8 * j; const LAS unsigned* w = scr + (4 * c) * 33 + n;
        v4u o; o.x = w[0]; o.y = w[33]; o.z = w[66]; o.w = w[99];
        *(GAS v4u*)(t.dst + (size_t)n * t.KP + 8 * c) = o; }
    LDS_WAIT(); asm volatile("" ::: "memory");
}
template <bool PERMW = false>
__device__ __forceinline__ void p0_transpose_item(const float* W, int K, int N, bf16* WT, LAS float* scr, int item, int lane, int KP = 0, int koff = 0, gu32* cmaxw = nullptr) {
    if (KP == 0) KP = K;
    const int nblk = N / 32, kb = item / nblk, nb = item % nblk, k0 = 64 * kb, n0 = 32 * nb;
    float cmx = 0.f;
#pragma unroll
    for (int i = 0; i < 32; ++i) { const int kk = 2 * i + (lane >> 5); const float wv = __builtin_nontemporal_load((const GAS float*)W + (size_t)(k0 + kk) * N + n0 + (lane & 31)); scr[kk * 33 + (lane & 31)] = wv; cmx = fmaxf(cmx, fabsf(wv)); }
    if (PERMW && cmaxw) { cmx = fmaxf(cmx, __shfl_xor(cmx, 32));
        if (lane < 32) __hip_atomic_fetch_max(cmaxw + wt_row(n0 + lane), __float_as_uint(cmx), RLX_AGENT); }
    LDS_WAIT(); asm volatile("" ::: "memory");
    const int c = lane & 7;
#pragma unroll
    for (int j = 0; j < 4; ++j) { const int n = (lane >> 3) + 8 * j; const LAS float* s = scr + (8 * c) * 33 + n;
        v4u o; o.x = pk2(s[0 * 33], s[1 * 33]); o.y = pk2(s[2 * 33], s[3 * 33]); o.z = pk2(s[4 * 33], s[5 * 33]); o.w = pk2(s[6 * 33], s[7 * 33]);
        *(GAS v4u*)(WT + (size_t)(PERMW ? wt_row(n0 + n) : (n0 + n)) * KP + koff + k0 + 8 * c) = o; }
    LDS_WAIT(); asm volatile("" ::: "memory");
}
__device__ __forceinline__ void rms_row_to_bf16(const float* xrow, const float* g, bf16* orow, int lane, unsigned char* o8row = nullptr, float* su = nullptr) {
    const GAS f32x4* xr = (const GAS f32x4*)xrow + lane; const GAS f32x4* gr = (const GAS f32x4*)g + lane;
    f32x4 v[16]; float s = 0.f, am = 0.f;
#pragma unroll
    for (int j = 0; j < 16; ++j) { v[j] = __builtin_nontemporal_load(xr + 64 * j); s += (v[j].x * v[j].x + v[j].y * v[j].y) + (v[j].z * v[j].z + v[j].w * v[j].w);
        const f32x4 gg = gr[64 * j]; v[j] = v[j] * gg; am = fmaxf(am, fmaxf(fmaxf(fabsf(v[j].x), fabsf(v[j].y)), fmaxf(fabsf(v[j].z), fabsf(v[j].w)))); }
    const float rstd = 1.f / sqrtf(wave_sum(s) * (1.f / DM) + EPS);
    if (orow) { GAS unsigned long long* o8 = (GAS unsigned long long*)orow + lane;
#pragma unroll
        for (int j = 0; j < 16; ++j) o8[64 * j] = (unsigned long long)pk2(v[j].x * rstd, v[j].y * rstd) | ((unsigned long long)pk2(v[j].z * rstd, v[j].w * rstd) << 32); }
    if (o8row) {
        am = wave_max(am); const float inv = am > 0.f ? 127.f / am : 0.f;
#pragma unroll
        for (int j = 0; j < 16; ++j) ((GAS unsigned*)o8row)[64 * j + lane] = pk4_i8(v[j].x * inv, v[j].y * inv, v[j].z * inv, v[j].w * inv);
        if (lane == 0) *su = am * rstd * (1.f / 127.f); }
}
__device__ __forceinline__ void sincos_d(double a, float& sn, float& cs) {
    const double PI = 3.14159265358979323846;
    const double k = rint(a / PI); const double r = a - k * PI; const double r2 = r * r;
    double s = 1.0, c = 1.0, ts = 1.0, tc = 1.0;
#pragma unroll
    for (int i = 1; i <= 11; ++i) { tc *= -r2 / (double)((2 * i - 1) * (2 * i)); ts *= -r2 / (double)((2 * i) * (2 * i + 1)); c += tc; s += ts; }
    s *= r;
    const bool odd = ((long long)k) & 1;
    sn = (float)(odd ? -s : s); cs = (float)(odd ? -c : c);
}

struct Ptrs {
    const float* in[19]; float* out; unsigned char* ws;
};

__device__ __forceinline__ const bf16* rowptr(const bf16* P, const bf16* Pm, int b, int t) {
    return t < NMETA ? Pm + (size_t)t * NIN : P + (size_t)(b * SEQ + t - NMETA) * NIN;
}

__device__ __forceinline__ float dpp_shr(float v, int n) {
    const int x = __float_as_int(v); int r;
    if (n == 1) r = __builtin_amdgcn_update_dpp(0, x, 0x111, 0xf, 0xf, true); else if (n == 2) r = __builtin_amdgcn_update_dpp(0, x, 0x112, 0xf, 0xf, true);
    else if (n == 4) r = __builtin_amdgcn_update_dpp(0, x, 0x114, 0xf, 0xf, true); else r = __builtin_amdgcn_update_dpp(0, x, 0x118, 0xf, 0xf, true);
    return __int_as_float(r);
}
template <bool QK_ONLY>
struct EpiProjT {
    static constexpr bool PERM = true, AFTER_DRAIN = false, INIT = false;
    bf16* O; const float* qn; const float* kn; const float* rope; const float* hlb; float* dec; int pn0; float oscale; const float* su; const float* sw;
    __device__ __forceinline__ float val(float a, float rs, float cs) const { return su ? (float)__float_as_int(a) * (rs * cs) : a * oscale; }
    __device__ __forceinline__ void operator()(const pg8::f32x4 (&acc)[2][2][4][2], const pg8::Unit& u, int wr, int wc, int fr_, int fq_) const {
        const int fr = opaque_v(fr_), fq = opaque_v(fq_);
        const int row0 = u.pm * 256 + wr * 64 + fr, pn = u.pn + pn0;
        if constexpr (QK_ONLY) {
            const bool isk = pn >= 8; const int h = 2 * (pn & 7) + (wc >> 1), cm = wc & 1; const float* wv = isk ? kn : qn;
            float w0[8], w1[8], cq0[8], cq1[8];
#pragma unroll
            for (int j = 0; j < 8; ++j) { w0[j] = wv[16 * fq + j]; w1[j] = wv[16 * fq + 8 + j]; cq0[j] = su ? sw[pn * 256 + 32 * wc + 8 * fq + j] : 1.f; cq1[j] = su ? sw[pn * 256 + 128 + 32 * wc + 8 * fq + j] : 1.f; }
            bf16* obase = O + (isk ? C_K : C_Q) + h * 128 + cm * 64 + 16 * fq;
#pragma unroll
            for (int ai = 0; ai < 2; ++ai)
#pragma unroll
                for (int m = 0; m < 4; ++m) { const int row = row0 + ai * 128 + m * 16;
                    float x0[8], x1[8]; float ss = 0.f;
                    const float rs_ = su ? su[row] : 1.f;
#pragma unroll
                    for (int j = 0; j < 8; ++j) { x0[j] = val(acc[ai][0][m][j >> 2][j & 3], rs_, cq0[j]); x1[j] = val(acc[ai][1][m][j >> 2][j & 3], rs_, cq1[j]); ss += x0[j] * x0[j] + x1[j] * x1[j]; }
                    ss += __shfl_xor(ss, 16); ss += __shfl_xor(ss, 32);
                    const float rstd = 1.f / sqrtf(ss * (1.f / 64.f) + EPS);
                    const float* rp = rope + (NMETA + (row & (SEQ - 1))) * 16;
                    const f32x4 c0 = *(const GAS f32x4*)rp, c1 = *(const GAS f32x4*)(rp + 4), s0 = *(const GAS f32x4*)(rp + 8), s1 = *(const GAS f32x4*)(rp + 12);
                    const float cs[8] = {c0.x, c0.y, c0.z, c0.w, c1.x, c1.y, c1.z, c1.w}, sn[8] = {s0.x, s0.y, s0.z, s0.w, s1.x, s1.y, s1.z, s1.w};
                    float o0[8], o1[8];
#pragma unroll
                    for (int j = 0; j < 8; ++j) { const float a = x0[j] * rstd * w0[j], bb = x1[j] * rstd * w1[j];
                        float r0 = a, r1 = bb; if (fq == 0) { r0 = a * cs[j] - bb * sn[j]; r1 = bb * cs[j] + a * sn[j]; }
                        o0[j] = isk ? r0 : r0 * C2; o1[j] = isk ? r1 : r1 * C2; }
                    v4u wa, wb; wa.x = pg8::cvt_pk_bf16(o0[0], o0[1]); wa.y = pg8::cvt_pk_bf16(o0[2], o0[3]); wa.z = pg8::cvt_pk_bf16(o0[4], o0[5]); wa.w = pg8::cvt_pk_bf16(o0[6], o0[7]);
                    wb.x = pg8::cvt_pk_bf16(o1[0], o1[1]); wb.y = pg8::cvt_pk_bf16(o1[2], o1[3]); wb.z = pg8::cvt_pk_bf16(o1[4], o1[5]); wb.w = pg8::cvt_pk_bf16(o1[6], o1[7]);
                    bf16* op = obase + (size_t)row * NIN; *(v4u*)op = wa; *(v4u*)(op + 8) = wb; }
        } else { if (pn >= 24 && pn < 40) {
            const int h = pn - 24, d0 = 32 * wc + 8 * fq, colg = h * 128 + d0; const int lane15 = (fq << 4) | 15;
            float lb[8], cq[8], cf[8];
#pragma unroll
            for (int j = 0; j < 8; ++j) { cq[j] = su ? sw[pn * 256 + d0 + j] : 1.f; cf[j] = su ? sw[pn * 256 + 128 + d0 + j] : 1.f; }
#pragma unroll
            for (int j = 0; j < 8; ++j) { const float a = hlb[colg + j], c = hlb[WHD + colg + j]; lb[j] = 1.f / (1.f + __expf(c - a)); }
#pragma unroll
            for (int ai = 0; ai < 2; ++ai) {
                const int rowc = u.pm * 256 + ai * 128 + wr * 64, cj = (rowc >> 11) * 32 + ((rowc & (SEQ - 1)) >> 6);
                unsigned qd[4][4], ki[4][4]; float tot[8]; float rsm[4];
#pragma unroll
                for (int m = 0; m < 4; ++m) rsm[m] = su ? su[row0 + ai * 128 + m * 16] : 1.f;
#pragma unroll
                for (int jp = 0; jp < 4; ++jp) {
                    float qv[2][4], kv[2][4];
#pragma unroll
                    for (int jj = 0; jj < 2; ++jj) { const int j = 2 * jp + jj;
                        float f[4], s[4];
#pragma unroll
                        for (int m = 0; m < 4; ++m) { f[m] = lb[j] + (1.f - lb[j]) * sigmoidf_(val(acc[ai][1][m][j >> 2][j & 3], rsm[m], cf[j])); float g = __logf(f[m]);
                            g += dpp_shr(g, 1); g += dpp_shr(g, 2); g += dpp_shr(g, 4); g += dpp_shr(g, 8); s[m] = g; }
                        float carry = 0.f;
#pragma unroll
                        for (int m = 0; m < 4; ++m) { const float bcur = s[m] + carry; carry += __shfl(s[m], lane15); s[m] = bcur; }
                        tot[j] = carry;
#pragma unroll
                        for (int m = 0; m < 4; ++m) { qv[jj][m] = val(acc[ai][0][m][j >> 2][j & 3], rsm[m], cq[j]) * __expf(s[m]); kv[jj][m] = (1.f - f[m]) * __expf(-s[m]); }
                    }
#pragma unroll
                    for (int m = 0; m < 4; ++m) { qd[m][jp] = pg8::cvt_pk_bf16(qv[0][m], qv[1][m]); ki[m][jp] = pg8::cvt_pk_bf16(kv[0][m], kv[1][m]); }
                }
#pragma unroll
                for (int m = 0; m < 4; ++m) { bf16* op = O + (size_t)(row0 + ai * 128 + m * 16) * NIN + colg;
                    *(v4u*)(op + C_HQ) = (v4u){qd[m][0], qd[m][1], qd[m][2], qd[m][3]}; *(v4u*)(op + C_HF) = (v4u){ki[m][0], ki[m][1], ki[m][2], ki[m][3]}; }
                if (fr == 15) { float* dp = dec + (size_t)cj * WHD + colg;
                    *(f32x4*)dp = (f32x4){__expf(tot[0]), __expf(tot[1]), __expf(tot[2]), __expf(tot[3])}; *(f32x4*)(dp + 4) = (f32x4){__expf(tot[4]), __expf(tot[5]), __expf(tot[6]), __expf(tot[7])}; }
            }
        } else {
            const int col0 = pn * 256 + wc * 32 + 8 * fq; const bool sg = pn >= 56;
            float cw[2][8];
#pragma unroll
            for (int bj = 0; bj < 2; ++bj)
#pragma unroll
                for (int j = 0; j < 8; ++j) cw[bj][j] = su ? sw[col0 + bj * 128 + j] : 1.f;
#pragma unroll
            for (int ai = 0; ai < 2; ++ai)
#pragma unroll
                for (int m = 0; m < 4; ++m) { bf16* rowp = O + (size_t)(row0 + ai * 128 + m * 16) * NIN + col0; const float rs_ = su ? su[row0 + ai * 128 + m * 16] : 1.f;
#pragma unroll
                    for (int bj = 0; bj < 2; ++bj) { pg8::f32x4 v0, v1;
#pragma unroll
                        for (int e = 0; e < 4; ++e) { v0[e] = val(acc[ai][bj][m][0][e], rs_, cw[bj][e]); v1[e] = val(acc[ai][bj][m][1][e], rs_, cw[bj][4 + e]); }
                        if (sg) { for (int e = 0; e < 4; ++e) { v0[e] = sigmoidf_(v0[e]); v1[e] = sigmoidf_(v1[e]); } }
                        v4u w; w.x = cvt2(v0[0], v0[1]); w.y = cvt2(v0[2], v0[3]); w.z = cvt2(v1[0], v1[1]); w.w = cvt2(v1[2], v1[3]);
                        *(v4u*)(rowp + bj * 128) = w; } }
        } }
    }
};
struct HalfOrder : pg8::StaticOrder {
    static constexpr int KLOOP = WHD;
    __device__ __forceinline__ bool next(int i, pg8::Unit& u) const { if (!pg8::StaticOrder::next(i >> 1, u)) return false; u.pn |= (i & 1) << 16; return true; }
    __device__ __forceinline__ size_t kofs(const pg8::Unit& u) const { return (size_t)(u.pn >> 16) * (size_t)(WHD * 2); }
    __device__ __forceinline__ bool zero_after(const pg8::Unit& u) const { return (u.pn >> 16) != 0; }
};
struct EpiUp {
    static constexpr bool PERM = true, AFTER_DRAIN = false, INIT = false;
    const bf16* P; bf16* MG;
    __device__ __forceinline__ void operator()(pg8::f32x4 (&acc)[2][2][4][2], const pg8::Unit& u, int wr, int wc, int fr, int fq) const {
        const int pn = u.pn & 0xffff; const bool second = (u.pn >> 16) != 0;
        const int row0 = u.pm * 256 + wr * 64 + fr, col0 = pn * 256 + wc * 32 + 8 * fq;
#pragma unroll
        for (int ai = 0; ai < 2; ++ai)
#pragma unroll
            for (int m = 0; m < 4; ++m) { const int row = row0 + ai * 128 + m * 16;
#pragma unroll
                for (int bj = 0; bj < 2; ++bj) { const int col = col0 + bj * 128;
                    const v4u gb = *(const GAS v4u*)(P + (size_t)row * NIN + C_GB + col);
                    pg8::f32x4& v0 = acc[ai][bj][m][0]; pg8::f32x4& v1 = acc[ai][bj][m][1];
                    if (!second) { const v4u ga = *(const GAS v4u*)(P + (size_t)row * NIN + C_GA + col);
                        v0[0] *= bflo(ga.x) * __builtin_amdgcn_rcpf(bflo(gb.x)); v0[1] *= bfhi(ga.x) * __builtin_amdgcn_rcpf(bfhi(gb.x)); v0[2] *= bflo(ga.y) * __builtin_amdgcn_rcpf(bflo(gb.y)); v0[3] *= bfhi(ga.y) * __builtin_amdgcn_rcpf(bfhi(gb.y));
                        v1[0] *= bflo(ga.z) * __builtin_amdgcn_rcpf(bflo(gb.z)); v1[1] *= bfhi(ga.z) * __builtin_amdgcn_rcpf(bfhi(gb.z)); v1[2] *= bflo(ga.w) * __builtin_amdgcn_rcpf(bflo(gb.w)); v1[3] *= bfhi(ga.w) * __builtin_amdgcn_rcpf(bfhi(gb.w));
                    } else {
                        v4u w; w.x = pg8::cvt_pk_bf16(v0[0] * bflo(gb.x), v0[1] * bfhi(gb.x)); w.y = pg8::cvt_pk_bf16(v0[2] * bflo(gb.y), v0[3] * bfhi(gb.y));
                        w.z = pg8::cvt_pk_bf16(v1[0] * bflo(gb.z), v1[1] * bfhi(gb.z)); w.w = pg8::cvt_pk_bf16(v1[2] * bflo(gb.w), v1[3] * bfhi(gb.w));
                        *(v4u*)(MG + (size_t)row * DM + col) = w; } } }
    }
};
struct EpiOut {
    static constexpr bool PERM = true, AFTER_DRAIN = false, INIT = true;
    const float* X; bf16* H1b; float* SSQ;
    __device__ __forceinline__ void init(pg8::f32x4 (&acc)[2][2][4][2], const pg8::Unit& u, int wr, int wc, int fr_, int fq_) const {
        const int fr = opaque_v(fr_), fq = opaque_v(fq_);
        const float* xp = X + (size_t)(u.pm * 256 + wr * 64 + fr) * DM + u.pn * 256 + wc * 32 + 8 * fq;
#pragma unroll
        for (int ai = 0; ai < 2; ++ai)
#pragma unroll
            for (int bj = 0; bj < 2; ++bj)
#pragma unroll
                for (int m = 0; m < 4; ++m) { const float* q = xp + (size_t)(ai * 128 + m * 16) * DM + bj * 128;
                    acc[ai][bj][m][0] = __builtin_nontemporal_load((const pg8::f32x4*)q); acc[ai][bj][m][1] = __builtin_nontemporal_load((const pg8::f32x4*)(q + 4)); }
    }
    __device__ __forceinline__ void operator()(const pg8::f32x4 (&acc)[2][2][4][2], const pg8::Unit& u, int wr, int wc, int fr, int fq) const {
        const int row0 = u.pm * 256 + wr * 64 + fr, col0 = u.pn * 256 + wc * 32 + 8 * fq;
#pragma unroll
        for (int ai = 0; ai < 2; ++ai)
#pragma unroll
            for (int m = 0; m < 4; ++m) { const int row = row0 + ai * 128 + m * 16; float ss = 0.f;
#pragma unroll
                for (int bj = 0; bj < 2; ++bj) { const int col = col0 + bj * 128; const size_t off = (size_t)row * DM + col;
                    const pg8::f32x4 h0 = acc[ai][bj][m][0], h1 = acc[ai][bj][m][1];
                    ss += (h0[0] * h0[0] + h0[1] * h0[1]) + (h0[2] * h0[2] + h0[3] * h0[3]) + (h1[0] * h1[0] + h1[1] * h1[1]) + (h1[2] * h1[2] + h1[3] * h1[3]);
                    v4u w; w.x = pg8::cvt_pk_bf16(h0[0], h0[1]); w.y = pg8::cvt_pk_bf16(h0[2], h0[3]); w.z = pg8::cvt_pk_bf16(h1[0], h1[1]); w.w = pg8::cvt_pk_bf16(h1[2], h1[3]);
                    *(v4u*)(H1b + off) = w; }
                ss += __shfl_xor(ss, 16); ss += __shfl_xor(ss, 32);
                if (fq == 0) SSQ[(size_t)row * 64 + u.pn * 4 + wc] = ss; }
    }
};
struct EpiFf1 {
    static constexpr bool PERM = true, AFTER_DRAIN = false, INIT = false;
    bf16* H;
    __device__ __forceinline__ void operator()(const pg8::f32x4 (&acc)[2][2][4][2], const pg8::Unit& u, int wr, int wc, int fr, int fq) const {
        const int row0 = u.pm * 256 + wr * 64 + fr, col0 = u.pn * 256 + wc * 32 + 8 * fq;
#pragma unroll
        for (int ai = 0; ai < 2; ++ai)
#pragma unroll
            for (int m = 0; m < 4; ++m) { const int row = row0 + ai * 128 + m * 16;
#pragma unroll
                for (int bj = 0; bj < 2; ++bj) { pg8::f32x4 v0 = acc[ai][bj][m][0], v1 = acc[ai][bj][m][1];
#pragma unroll
                    for (int e = 0; e < 4; ++e) { const float a = fmaxf(v0[e], 0.f), b = fmaxf(v1[e], 0.f); v0[e] = a * a; v1[e] = b * b; }
                    v4u w; w.x = pg8::cvt_pk_bf16(v0[0], v0[1]); w.y = pg8::cvt_pk_bf16(v0[2], v0[3]); w.z = pg8::cvt_pk_bf16(v1[0], v1[1]); w.w = pg8::cvt_pk_bf16(v1[2], v1[3]);
                    *(v4u*)(H + (size_t)row * DFF + col0 + bj * 128) = w; } }
    }
};
struct EpiFf2 {
    static constexpr bool PERM = false, AFTER_DRAIN = false, INIT = true;
    float* O; const float* RSTD; const bf16* H1b;
    __device__ __forceinline__ void init(pg8::f32x4 (&acc)[2][2][4][2], const pg8::Unit& u, int wr, int wc, int fr_, int fq_) const {
        const int fr = opaque_v(fr_), fq = opaque_v(fq_);
        const int row0 = u.pm * 256 + wr * 64 + fr, col0 = u.pn * 256 + wc * 32 + 4 * fq;
#pragma unroll
        for (int ai = 0; ai < 2; ++ai)
#pragma unroll
            for (int bj = 0; bj < 2; ++bj)
#pragma unroll
                for (int m = 0; m < 4; ++m) { const int row = row0 + ai * 128 + m * 16; const float rs = RSTD[row], ir2 = 1.f / (rs * rs); const bf16* rowp = H1b + (size_t)row * DM + col0 + bj * 128;
#pragma unroll
                    for (int n = 0; n < 2; ++n) { const unsigned long long w = *(const GAS unsigned long long*)(rowp + n * 16); const unsigned lo = (unsigned)w, hh = (unsigned)(w >> 32);
                        acc[ai][bj][m][n] = (pg8::f32x4){bflo(lo) * ir2, bfhi(lo) * ir2, bflo(hh) * ir2, bfhi(hh) * ir2}; } }
    }
    __device__ __forceinline__ void operator()(const pg8::f32x4 (&acc)[2][2][4][2], const pg8::Unit& u, int wr, int wc, int fr, int fq) const {
        const int row0 = u.pm * 256 + wr * 64 + fr, col0 = u.pn * 256 + wc * 32 + 4 * fq;
#pragma unroll
        for (int ai = 0; ai < 2; ++ai)
#pragma unroll
            for (int m = 0; m < 4; ++m) { const int row = row0 + ai * 128 + m * 16; const float rs = RSTD[row], r2 = rs * rs; float* rowp = O + (size_t)row * DM + col0;
#pragma unroll
                for (int bj = 0; bj < 2; ++bj)
#pragma unroll
                    for (int n = 0; n < 2; ++n) __builtin_nontemporal_store(acc[ai][bj][m][n] * r2, (pg8::f32x4*)(rowp + bj * 128 + n * 16)); }
    }
};

constexpr int NCONV = 96;
namespace da {
typedef float f32x16 __attribute__((ext_vector_type(16)));
typedef short s16x4 __attribute__((ext_vector_type(4)));
constexpr int KBUF = 16384, VBUF = 16384, K_OFF = 0, V_OFF = 32768;
__device__ __forceinline__ int crow(int r, int hi) { return (r & 3) + 8 * (r >> 2) + 4 * hi; }
__device__ __forceinline__ int kswz(int row, int colB) { return row * 256 + (colB ^ ((row & 7) << 4)); }
__device__ __forceinline__ int v_st(int k, int c) { return ((k >> 3) * 4 + (c >> 5)) * 512 + ((k & 7) * 32 + (c & 31)) * 2; }
__device__ __forceinline__ int v_rd_base(int lane) { return ((lane & 3) << 3) | (((lane >> 2) & 3) << 6) | (((lane >> 4) & 1) << 5) | (((lane >> 5) & 1) << 8); }
__device__ __forceinline__ s16x4 vtr(LAS const unsigned char* p) { return __builtin_bit_cast(s16x4, __builtin_amdgcn_ds_read_tr16_b64_v4i16((LAS s16x4*)p)); }
__device__ __forceinline__ float pl_max(float v) { auto rr = __builtin_amdgcn_permlane32_swap(__float_as_uint(v), __float_as_uint(v), false, false); return fmaxf(__uint_as_float(rr[0]), __uint_as_float(rr[1])); }
__device__ __forceinline__ float pl_sum(float v) { auto rr = __builtin_amdgcn_permlane32_swap(__float_as_uint(v), __float_as_uint(v), false, false); return __uint_as_float(rr[0]) + __uint_as_float(rr[1]); }
__device__ __forceinline__ bf16x8 pack8(const f32x16& p, int base) {
    v4u w; w.x = pg8::cvt_pk_bf16(p[base + 0], p[base + 1]); w.y = pg8::cvt_pk_bf16(p[base + 2], p[base + 3]); w.z = pg8::cvt_pk_bf16(p[base + 4], p[base + 5]); w.w = pg8::cvt_pk_bf16(p[base + 6], p[base + 7]);
    return __builtin_bit_cast(bf16x8, w);
}
__device__ __forceinline__ void qk(f32x16& p0, f32x16& p1, LAS const unsigned char* Kb, LAS const unsigned char* Qw, float negm, int c, int r32, int hi) {
#pragma unroll
    for (int r = 0; r < 16; ++r) { p0[r] = negm; p1[r] = negm; }
#pragma unroll
    for (int d0 = 0; d0 < 4; ++d0) { const int cb = (c * 64 + d0 * 16 + hi * 8) * 2;
        const bf16x8 b0 = *(LAS const bf16x8*)(Kb + kswz(r32, cb)), b1 = *(LAS const bf16x8*)(Kb + kswz(32 + r32, cb)), qf = *(LAS const bf16x8*)(Qw + d0 * 1024);
        p0 = __builtin_amdgcn_mfma_f32_32x32x16_bf16(b0, qf, p0, 0, 0, 0); p1 = __builtin_amdgcn_mfma_f32_32x32x16_bf16(b1, qf, p1, 0, 0, 0); }
}
__device__ __forceinline__ void mask_diag(f32x16& p0, f32x16& p1, int hi, int rel) {
#pragma unroll
    for (int r = 0; r < 16; ++r) { if (crow(r, hi) > rel) p0[r] = -1e30f; if (32 + crow(r, hi) > rel) p1[r] = -1e30f; }
}
__device__ __forceinline__ bf16x8 pack8e(const f32x16& p, int base) {
    v4u w; w.x = cvt2(p[base + 0], p[base + 1]); w.y = cvt2(p[base + 2], p[base + 3]); w.z = cvt2(p[base + 4], p[base + 5]); w.w = cvt2(p[base + 6], p[base + 7]);
    return __builtin_bit_cast(bf16x8, w);
}
__device__ __forceinline__ void partB(f32x16& p0, f32x16& p1, float& l_part, bf16x8 (&pb)[4]) {
    float ps = 0.f;
#pragma unroll
    for (int r = 0; r < 16; ++r) { p0[r] = __builtin_amdgcn_exp2f(p0[r]); p1[r] = __builtin_amdgcn_exp2f(p1[r]); ps += p0[r] + p1[r]; }
    l_part += ps;
    pb[0] = pack8e(p0, 0); pb[1] = pack8e(p0, 8); pb[2] = pack8e(p1, 0); pb[3] = pack8e(p1, 8);
}
__device__ __forceinline__ void pv(f32x16 (&o)[4], LAS const unsigned char* Vb, const bf16x8 (&pb)[4], int lane) {
    LAS const unsigned char* vb = Vb + v_rd_base(lane);
#pragma unroll
    for (int d0 = 0; d0 < 4; ++d0) {
        s16x4 lo[4], hh[4];
#pragma unroll
        for (int ks = 0; ks < 4; ++ks) { lo[ks] = vtr(vb + d0 * 512 + ks * 4096); hh[ks] = vtr(vb + d0 * 512 + ks * 4096 + 2048); }
#pragma unroll
        for (int ks = 0; ks < 4; ++ks) {
            const bf16x8 a = (bf16x8){lo[ks][0], lo[ks][1], lo[ks][2], lo[ks][3], hh[ks][0], hh[ks][1], hh[ks][2], hh[ks][3]};
            o[d0] = __builtin_amdgcn_mfma_f32_32x32x16_bf16(a, pb[ks], o[d0], 0, 0, 0); }
    }
}
__device__ __forceinline__ void meta_tile(LAS const unsigned char* Kb, LAS const unsigned char* Vb, LAS const unsigned char* Qw, f32x16 (&o)[4], float& l_part, float negm, int c, int r32, int hi, int lane) {
    f32x16 p0;
#pragma unroll
    for (int r = 0; r < 16; ++r) p0[r] = negm;
#pragma unroll
    for (int d0 = 0; d0 < 4; ++d0) { const int cb = (c * 64 + d0 * 16 + hi * 8) * 2;
        p0 = __builtin_amdgcn_mfma_f32_32x32x16_bf16(*(LAS const bf16x8*)(Kb + kswz(r32, cb)), *(LAS const bf16x8*)(Qw + d0 * 1024), p0, 0, 0, 0); }
    float ps = 0.f;
#pragma unroll
    for (int r = 0; r < 16; ++r) { p0[r] = (crow(r, hi) >= NMETA) ? 0.f : __builtin_amdgcn_exp2f(p0[r]); ps += p0[r]; }
    l_part += ps;
    const bf16x8 pb0 = pack8e(p0, 0);
    LAS const unsigned char* vb = Vb + v_rd_base(lane);
#pragma unroll
    for (int d0 = 0; d0 < 4; ++d0) { const s16x4 lo = vtr(vb + d0 * 512), hh = vtr(vb + d0 * 512 + 2048);
        o[d0] = __builtin_amdgcn_mfma_f32_32x32x16_bf16((bf16x8){lo[0], lo[1], lo[2], lo[3], hh[0], hh[1], hh[2], hh[3]}, pb0, o[d0], 0, 0, 0); }
}
constexpr int KB3 = 0, VB3 = 49152, QFR = 98304, MKB = 131072, MVB = 139264;
__device__ __forceinline__ void glds16(const void* g, unsigned lds_base) {
    unsigned sv; asm volatile("s_mov_b32 %0, m0\n\ts_mov_b32 m0, %2\n\ts_nop 0\n\tglobal_load_lds_dwordx4 %1, off\n\ts_mov_b32 m0, %0" : "=&s"(sv) : "v"(g), "s"(lds_base) : "memory"); }
__device__ __forceinline__ void dma_tile(LAS unsigned char* lds, int buf, const bf16* tile0, int wave, int lane_) {
    const int lane = opaque_v(lane_);
    LAS unsigned char* dst = lds + (wave < 4 ? KB3 + buf * KBUF + wave * 4096 : VB3 + buf * VBUF + (wave - 4) * 4096);
#pragma unroll
    for (int i = 0; i < 4; ++i) {
        unsigned off;
        if (wave < 4) { const int p = 4 * wave + i, row = 4 * p + (lane >> 4), colB = ((lane & 15) ^ (row & 7)) << 4; off = (unsigned)(row * NIN + C_K + (colB >> 1)); }
        else { const int p = 4 * (wave - 4) + i, st = 2 * p + (lane >> 5), key = (st >> 2) * 8 + ((lane & 31) >> 2), col = (st & 3) * 32 + (lane & 3) * 8; off = (unsigned)(key * NIN + C_V + col); }
        glds16(tile0 + off, (unsigned)__builtin_amdgcn_readfirstlane((int)(unsigned)(size_t)(dst + i * 1024))); }
}
#define ATT_SBAR() __builtin_amdgcn_sched_barrier(0)
#define ATT_PIN(x) asm volatile("" : "+v"(x))
__device__ __forceinline__ void fast_step(f32x16 (&o)[4], f32x16& s0, f32x16& s1, float& l_part, const f32x16& negm16, LAS const unsigned char* Vslot, LAS const unsigned char* Kb, LAS const unsigned char* Qw, int c, int r32, int hi, int lane) {
    LAS const unsigned char* vb = Vslot + v_rd_base(lane);
    float ps = 0.f; unsigned pk[4], pn[4];
#pragma unroll
    for (int i = 0; i < 4; ++i) { const float x = __builtin_amdgcn_exp2f(s0[2 * i]), y = __builtin_amdgcn_exp2f(s0[2 * i + 1]); ps += x; ps += y; pk[i] = cvt2(x, y); }
    s16x4 va[8], vn[8];
#pragma unroll
    for (int d0 = 0; d0 < 4; ++d0) { va[2 * d0] = vtr(vb + d0 * 512); va[2 * d0 + 1] = vtr(vb + d0 * 512 + 2048); }
    bf16x8 kb0[4], kb1[4], qf[4];
    ATT_SBAR();
#pragma unroll
    for (int ch = 0; ch < 4; ++ch) {
        const bf16x8 pbc = __builtin_bit_cast(bf16x8, ((v4u){pk[0], pk[1], pk[2], pk[3]}));
#pragma unroll
        for (int d0 = 0; d0 < 4; ++d0) {
            const bf16x8 a = (bf16x8){va[2 * d0][0], va[2 * d0][1], va[2 * d0][2], va[2 * d0][3], va[2 * d0 + 1][0], va[2 * d0 + 1][1], va[2 * d0 + 1][2], va[2 * d0 + 1][3]};
            o[d0] = __builtin_amdgcn_mfma_f32_32x32x16_bf16(a, pbc, o[d0], 0, 0, 0);
            if (ch < 3) {
                const int nb = ((ch + 1) & 1) * 8 + 2 * d0;
                const float x = __builtin_amdgcn_exp2f((ch + 1 < 2) ? s0[nb] : s1[nb]), y = __builtin_amdgcn_exp2f((ch + 1 < 2) ? s0[nb + 1] : s1[nb + 1]);
                ps += x; ps += y; pn[d0] = cvt2(x, y);
                vn[2 * d0] = vtr(vb + d0 * 512 + (ch + 1) * 4096); vn[2 * d0 + 1] = vtr(vb + d0 * 512 + (ch + 1) * 4096 + 2048);
                ATT_PIN(pn[d0]); ATT_PIN(ps);
            } else {
                const int cb = (c * 64 + d0 * 16 + hi * 8) * 2;
                kb0[d0] = *(LAS const bf16x8*)(Kb + kswz(r32, cb)); kb1[d0] = *(LAS const bf16x8*)(Kb + kswz(32 + r32, cb)); qf[d0] = *(LAS const bf16x8*)(Qw + d0 * 1024);
            }
            ATT_SBAR();
        }
        if (ch < 3) {
#pragma unroll
            for (int i = 0; i < 4; ++i) pk[i] = pn[i];
#pragma unroll
            for (int i = 0; i < 8; ++i) va[i] = vn[i];
        }
    }
    l_part += ps;
    s0 = __builtin_amdgcn_mfma_f32_32x32x16_bf16(kb0[0], qf[0], negm16, 0, 0, 0); s1 = __builtin_amdgcn_mfma_f32_32x32x16_bf16(kb1[0], qf[0], negm16, 0, 0, 0);
#pragma unroll
    for (int d0 = 1; d0 < 4; ++d0) { s0 = __builtin_amdgcn_mfma_f32_32x32x16_bf16(kb0[d0], qf[d0], s0, 0, 0, 0); s1 = __builtin_amdgcn_mfma_f32_32x32x16_bf16(kb1[d0], qf[d0], s1, 0, 0, 0); }
}
__device__ __forceinline__ void unit(LAS unsigned char* lds, const bf16* P, const bf16* Pm, bf16* YA, const float* subln, const float* kn, const float* rope, float lam, float mfix, int b, int h, int qb, int tid, int wave, int lane_in) {
    const int c = wave >> 2, jw = wave & 3, q0 = qb * 128, NT = 2 * qb + 2;
    const bf16* tb0 = P + (size_t)(b * SEQ) * NIN + h * 128;
    f32x16 o[4] = {}; float l_part = 0.f; const float negm = -mfix;
    { const int lane = lane_in, r32 = lane & 31, hi = lane >> 5;
    dma_tile(lds, 0, tb0, wave, lane); dma_tile(lds, 1, tb0 + (size_t)64 * NIN, wave, lane);
    if (c == 0 && NT > 2) dma_tile(lds, 2, tb0 + (size_t)128 * NIN, wave, lane);
    LAS unsigned char* Qw = lds + QFR + wave * 4096 + lane * 16;
    { const bf16* qp = P + (size_t)(b * SEQ + q0 + jw * 32 + r32) * NIN + C_Q + h * 128 + c * 64 + hi * 8;
#pragma unroll
      for (int d0 = 0; d0 < 4; ++d0) *(LAS bf16x8*)(Qw + d0 * 1024) = *(const GAS bf16x8*)(qp + d0 * 16); }
    { const int sr = tid >> 4, sc = (tid & 15) * 8, mr = sr & 15;
      if (tid < 256) {
          const v4u raw = *(const GAS v4u*)(Pm + (size_t)mr * NIN + C_K + h * 128 + sc); const int sub = tid & 7;
          float xv[8] = {bflo(raw.x), bfhi(raw.x), bflo(raw.y), bfhi(raw.y), bflo(raw.z), bfhi(raw.z), bflo(raw.w), bfhi(raw.w)};
          float ss = 0.f;
#pragma unroll
          for (int j = 0; j < 8; ++j) ss += xv[j] * xv[j];
          ss += __shfl_xor(ss, 1); ss += __shfl_xor(ss, 2); ss += __shfl_xor(ss, 4);
          const float rstd = 1.f / sqrtf(ss * (1.f / 64.f) + EPS); float ov[8];
#pragma unroll
          for (int j = 0; j < 8; ++j) { const float xn = xv[j] * rstd * kn[sub * 8 + j], pr = __shfl_xor(xn, 1), cs = rope[mr * 16 + j], sn = rope[mr * 16 + 8 + j];
              ov[j] = (sub == 0) ? xn * cs - pr * sn : (sub == 1) ? xn * cs + pr * sn : xn; }
          v4u v; v.x = pk2(ov[0], ov[1]); v.y = pk2(ov[2], ov[3]); v.z = pk2(ov[4], ov[5]); v.w = pk2(ov[6], ov[7]);
          *(LAS v4u*)(lds + MKB + kswz(mr, sc * 2)) = v; }
      else           { const v4u v = *(const GAS v4u*)(Pm + (size_t)mr * NIN + C_V + h * 128 + sc); *(LAS v4u*)(lds + MVB + v_st(mr, sc)) = v; } }
    asm volatile("s_waitcnt vmcnt(0)" ::: "memory"); __syncthreads();
    meta_tile(lds + MKB, lds + MVB, Qw, o, l_part, negm, c, r32, hi, lane);
    f32x16 s0, s1;
    qk(s0, s1, lds + KB3, Qw, negm, c, r32, hi);
    if (qb == 0) mask_diag(s0, s1, hi, 32 * jw + r32);
    int s_j = 0;
    int j = 0;
    { f32x16 negm16;
#pragma unroll
      for (int r = 0; r < 16; ++r) negm16[r] = negm;
      ATT_PIN(negm16);
#pragma unroll 1
      for (; j < NT - 3; ++j) {
        const int s_j1 = (s_j == 2) ? 0 : s_j + 1, s_j2 = (s_j1 == 2) ? 0 : s_j1 + 1;
        asm volatile("s_waitcnt vmcnt(4) lgkmcnt(0)" ::: "memory"); __builtin_amdgcn_s_barrier(); asm volatile("" ::: "memory");
        if (c == 0) dma_tile(lds, s_j, tb0 + (size_t)(j + 3) * 64 * NIN, wave, lane); else dma_tile(lds, s_j2, tb0 + (size_t)(j + 2) * 64 * NIN, wave, lane);
        fast_step(o, s0, s1, l_part, negm16, lds + VB3 + s_j * VBUF, lds + KB3 + s_j1 * KBUF, Qw, c, r32, hi, lane);
        s_j = s_j1;
      } }
#pragma unroll 1
    for (; j < NT; ++j) {
        const int s_j1 = (s_j == 2) ? 0 : s_j + 1, s_j2 = (s_j1 == 2) ? 0 : s_j1 + 1;
        { if ((c == 0) ? (j + 2 < NT) : (j + 1 < NT)) asm volatile("s_waitcnt vmcnt(4) lgkmcnt(0)" ::: "memory"); else asm volatile("s_waitcnt vmcnt(0) lgkmcnt(0)" ::: "memory");
            __builtin_amdgcn_s_barrier(); asm volatile("" ::: "memory"); }
        if (c == 0) { if (j + 3 < NT) dma_tile(lds, s_j, tb0 + (size_t)(j + 3) * 64 * NIN, wave, lane); }
        else        { if (j + 2 < NT) dma_tile(lds, s_j2, tb0 + (size_t)(j + 2) * 64 * NIN, wave, lane); }
        const int dt = j - 2 * qb, dn = dt + 1;
        const bool act = !(dt == 1 && jw < 2), actn = (j + 1 < NT) && !(dn == 1 && jw < 2);
        if (act) { bf16x8 pb[4]; partB(s0, s1, l_part, pb); pv(o, lds + VB3 + s_j * VBUF, pb, lane); }
        if (actn) { qk(s0, s1, lds + KB3 + s_j1 * KBUF, Qw, negm, c, r32, hi); if (dn >= 0) mask_diag(s0, s1, hi, 32 * jw + r32 - 64 * dn); }
        s_j = s_j1;
    }
    }
    __syncthreads();
    LAS float* ex = (LAS float*)lds;
    const int lane = opaque_v(lane_in), r32 = lane & 31, hi = lane >> 5;
    const float l_reg = pl_sum(l_part);
    if (c == 1) { const float s1x = -lam / l_reg;
#pragma unroll
        for (int d0 = 0; d0 < 4; ++d0)
#pragma unroll
            for (int r = 0; r < 16; ++r) ex[((jw * 4 + d0) * 16 + r) * 64 + lane] = o[d0][r] * s1x; }
    __syncthreads();
    if (c == 0) { const float il = 1.f / l_reg; float ss = 0.f;
#pragma unroll
        for (int d0 = 0; d0 < 4; ++d0)
#pragma unroll
            for (int r = 0; r < 16; ++r) { const float v = o[d0][r] * il + ex[((jw * 4 + d0) * 16 + r) * 64 + lane]; o[d0][r] = v; ss += v * v; }
        ss = pl_sum(ss);
        const float rstd = (1.f - LAM_INIT) / sqrtf(ss * (1.f / 128.f) + EPS);
        bf16* yp = YA + (size_t)(b * SEQ + q0 + jw * 32 + r32) * YP + h * 128;
#pragma unroll
        for (int d0 = 0; d0 < 4; ++d0)
#pragma unroll
            for (int g = 0; g < 4; ++g) { const int e = 32 * d0 + 8 * g + 4 * hi; const f32x4 sw = *(const GAS f32x4*)(subln + e);
                const unsigned w0 = pg8::cvt_pk_bf16(o[d0][4 * g + 0] * rstd * sw.x, o[d0][4 * g + 1] * rstd * sw.y), w1 = pg8::cvt_pk_bf16(o[d0][4 * g + 2] * rstd * sw.z, o[d0][4 * g + 3] * rstd * sw.w);
                *(GAS unsigned long long*)(yp + e) = (unsigned long long)w0 | ((unsigned long long)w1 << 32); }
    }
    __syncthreads();
}
}


namespace hg {
using da::f32x16; using da::s16x4; using da::crow; using da::vtr; using da::pl_sum; using da::pack8;
__device__ __forceinline__ int ioff(int row, int ch) { return 2048 * (row >> 3) + 512 * (ch >> 2) + 64 * (row & 7) + 16 * ((ch & 3) ^ ((row >> 2) & 3)); }
constexpr int QD = 0, KI = 16384, VI = 32768, SI = 49152, DECL = 81920, SSQ = 82432;
__device__ __forceinline__ bf16x8 cat(s16x4 lo, s16x4 hh) { return (bf16x8){lo[0], lo[1], lo[2], lo[3], hh[0], hh[1], hh[2], hh[3]}; }
__device__ __forceinline__ void unit(LAS unsigned char* lds, const bf16* P, const bf16* Pm, bf16* YB, const float* DEC, const float* onorm, const float* hlb, int b, int h, int tid, int wave, int lane) {
    const int r32 = lane & 31, hi = lane >> 5, blk = (lane >> 4) & 1, q4 = (lane & 15) >> 2, p4 = lane & 3;
    const int eb = wave & 3, tb = wave >> 2;
    const int trc = 2 * blk + (p4 >> 1), trb = 8 * (p4 & 1);
#pragma unroll
    for (int i = 0; i < 4; ++i) *(LAS v4u*)(lds + SI + (tid * 4 + i) * 16) = (v4u){0u, 0u, 0u, 0u};
    f32x16 acc0 = {}, acc1 = {};
    const int sr = tid >> 4, sch = tid & 15;
    const v4u z4 = (v4u){0u, 0u, 0u, 0u};
    v4u q0 = z4, q1 = z4, k0 = z4, k1 = z4, v0 = z4, v1 = z4; float dcv = 0.f;
    if (sr < NMETA) { const bf16* mp = Pm + (size_t)sr * NIN + h * 128 + sch * 8; v0 = *(const GAS v4u*)(mp + C_HI); }
    LAS float* dec = (LAS float*)(lds + DECL); LAS float* ssq = (LAS float*)(lds + SSQ);
    if (tid < 128) {
        const int col = h * 128 + tid; const float lb = 1.f / (1.f + __expf(hlb[WHD + col] - hlb[col]));
        float xr[NMETA];
#pragma unroll
        for (int r = 0; r < NMETA; ++r) xr[r] = bf2f(Pm[(size_t)r * NIN + C_HF + col]);
        float run = 0.f;
#pragma unroll
        for (int r = 0; r < NMETA; ++r) { const float f = lb + (1.f - lb) * sigmoidf_(xr[r]); run += __logf(f);
            *(LAS unsigned short*)(lds + KI + ioff(r, tid >> 3) + (tid & 7) * 2) = (unsigned short)f2bf((1.f - f) * __expf(-run)); }
        dec[tid] = __expf(run);
    }
#pragma unroll 1
    for (int n = 0; n <= 32; ++n) {
        { const int o0 = ioff(sr, sch), o1 = ioff(32 + sr, sch);
          *(LAS v4u*)(lds + QD + o0) = q0; *(LAS v4u*)(lds + QD + o1) = q1; if (n > 0 || sr >= NMETA) *(LAS v4u*)(lds + KI + o0) = k0; *(LAS v4u*)(lds + KI + o1) = k1; *(LAS v4u*)(lds + VI + o0) = v0; *(LAS v4u*)(lds + VI + o1) = v1; }
        if (tid < 128 && n > 0) dec[tid] = dcv;
        __syncthreads();
        if (n < 32) {
            const bf16* rp = P + (size_t)(b * SEQ + 64 * n + sr) * NIN + h * 128 + sch * 8; const size_t r32o = (size_t)32 * NIN;
            q0 = *(const GAS v4u*)(rp + C_HQ); q1 = *(const GAS v4u*)(rp + C_HQ + r32o); k0 = *(const GAS v4u*)(rp + C_HF); k1 = *(const GAS v4u*)(rp + C_HF + r32o);
            v0 = *(const GAS v4u*)(rp + C_HI); v1 = *(const GAS v4u*)(rp + C_HI + r32o);
            if (tid < 128) dcv = DEC[(size_t)(b * 32 + n) * WHD + h * 128 + tid];
        }
        unsigned long long gw[4] = {0ull, 0ull, 0ull, 0ull};
        if (n > 0) { const bf16* gp = P + (size_t)(b * SEQ + 64 * (n - 1) + 32 * tb + r32) * NIN + C_HG + h * 128 + 32 * eb + 4 * hi;
#pragma unroll
            for (int g = 0; g < 4; ++g) gw[g] = *(const GAS unsigned long long*)(gp + 8 * g); }
        bf16x8 vf[4];
#pragma unroll
        for (int ks = 0; ks < 4; ++ks) vf[ks] = cat(vtr(lds + VI + ioff(16 * ks + 4 * hi + q4, 4 * eb + trc) + trb), vtr(lds + VI + ioff(16 * ks + 8 + 4 * hi + q4, 4 * eb + trc) + trb));
        f32x16 o = {};
        if (n > 0) {
#pragma unroll
            for (int sb = 0; sb < 2; ++sb) if (sb <= tb) {
                f32x16 X = {};
#pragma unroll
                for (int ds = 0; ds < 8; ++ds) { const bf16x8 A = *(const LAS bf16x8*)(lds + KI + ioff(32 * sb + r32, 2 * ds + hi)), B = *(const LAS bf16x8*)(lds + QD + ioff(32 * tb + r32, 2 * ds + hi));
                    X = __builtin_amdgcn_mfma_f32_32x32x16_bf16(A, B, X, 0, 0, 0); }
                if (sb == tb) {
#pragma unroll
                    for (int r = 0; r < 16; ++r) if (crow(r, hi) > r32) X[r] = 0.f; }
                o = __builtin_amdgcn_mfma_f32_32x32x16_bf16(vf[2 * sb], pack8(X, 0), o, 0, 0, 0);
                o = __builtin_amdgcn_mfma_f32_32x32x16_bf16(vf[2 * sb + 1], pack8(X, 8), o, 0, 0, 0);
            }
#pragma unroll
            for (int ds = 0; ds < 8; ++ds) { const bf16x8 A = cat(vtr(lds + SI + ioff(16 * ds + 8 * hi + q4, 4 * eb + trc) + trb), vtr(lds + SI + ioff(16 * ds + 8 * hi + 4 + q4, 4 * eb + trc) + trb));
                const bf16x8 B = *(const LAS bf16x8*)(lds + QD + ioff(32 * tb + r32, 2 * ds + hi));
                o = __builtin_amdgcn_mfma_f32_32x32x16_bf16(A, B, o, 0, 0, 0); }
            float ss = 0.f;
#pragma unroll
            for (int r = 0; r < 16; ++r) ss += o[r] * o[r];
            ss = pl_sum(ss);
            if (hi == 0) ssq[eb * 64 + 32 * tb + r32] = ss;
        }
#pragma unroll
        for (int ks = 0; ks < 4; ++ks) {
            const bf16x8 B0 = cat(vtr(lds + KI + ioff(16 * ks + 4 * hi + q4, 4 * (2 * tb) + trc) + trb), vtr(lds + KI + ioff(16 * ks + 8 + 4 * hi + q4, 4 * (2 * tb) + trc) + trb));
            const bf16x8 B1 = cat(vtr(lds + KI + ioff(16 * ks + 4 * hi + q4, 4 * (2 * tb + 1) + trc) + trb), vtr(lds + KI + ioff(16 * ks + 8 + 4 * hi + q4, 4 * (2 * tb + 1) + trc) + trb));
            acc0 = __builtin_amdgcn_mfma_f32_32x32x16_bf16(vf[ks], B0, acc0, 0, 0, 0); acc1 = __builtin_amdgcn_mfma_f32_32x32x16_bf16(vf[ks], B1, acc1, 0, 0, 0); }
        { const float d0 = dec[32 * (2 * tb) + r32], d1 = dec[32 * (2 * tb + 1) + r32];
#pragma unroll
          for (int r = 0; r < 16; ++r) { acc0[r] *= d0; acc1[r] *= d1; } }
        __syncthreads();
#pragma unroll
        for (int g = 0; g < 4; ++g) {
            *(LAS unsigned long long*)(lds + SI + ioff(32 * (2 * tb) + r32, 4 * eb + g) + 8 * hi) = (unsigned long long)pg8::cvt_pk_bf16(acc0[4 * g], acc0[4 * g + 1]) | ((unsigned long long)pg8::cvt_pk_bf16(acc0[4 * g + 2], acc0[4 * g + 3]) << 32);
            *(LAS unsigned long long*)(lds + SI + ioff(32 * (2 * tb + 1) + r32, 4 * eb + g) + 8 * hi) = (unsigned long long)pg8::cvt_pk_bf16(acc1[4 * g], acc1[4 * g + 1]) | ((unsigned long long)pg8::cvt_pk_bf16(acc1[4 * g + 2], acc1[4 * g + 3]) << 32); }
        if (n > 0) {
            const int t = 32 * tb + r32; const float tot = (ssq[t] + ssq[64 + t]) + (ssq[128 + t] + ssq[192 + t]);
            const float rstd = 1.f / sqrtf(tot * (1.f / 128.f) + EPS);
            const size_t row = (size_t)(b * SEQ + 64 * (n - 1) + t);
#pragma unroll
            for (int g = 0; g < 4; ++g) { const int e = 32 * eb + 8 * g + 4 * hi;
                const unsigned g01 = (unsigned)gw[g], g23 = (unsigned)(gw[g] >> 32);
                const f32x4 on = *(const GAS f32x4*)(onorm + e);
                const float y0 = o[4 * g] * rstd * on.x * sigmoidf_(bflo(g01)), y1 = o[4 * g + 1] * rstd * on.y * sigmoidf_(bfhi(g01)), y2 = o[4 * g + 2] * rstd * on.z * sigmoidf_(bflo(g23)), y3 = o[4 * g + 3] * rstd * on.w * sigmoidf_(bfhi(g23));
                const unsigned w0 = pg8::cvt_pk_bf16(y0, y1);
                const unsigned w1 = pg8::cvt_pk_bf16(y2, y3);
                *(GAS unsigned long long*)(YB + row * YP + h * 128 + e) = (unsigned long long)w0 | ((unsigned long long)w1 << 32); }
        }
    }
    __syncthreads();
}
}

#define PHASE_PTRS unsigned char* ws = (unsigned char*)ldp(lds, 20); \
    gu32* ctl = (gu32*)(ws + WS_CTL); \
    const float* x = (const float*)ldp(lds, 0); const float* meta = (const float*)ldp(lds, 1); const float* norm_mix = (const float*)ldp(lds, 2); const float* w_in = (const float*)ldp(lds, 3); \
    const float* q_norm = (const float*)ldp(lds, 4); const float* k_norm = (const float*)ldp(lds, 5); \
    const float* lq1 = (const float*)ldp(lds, 6); const float* lk1 = (const float*)ldp(lds, 7); const float* lq2 = (const float*)ldp(lds, 8); const float* lk2 = (const float*)ldp(lds, 9); \
    const float* subln = (const float*)ldp(lds, 10); const float* hg_lb = (const float*)ldp(lds, 11); const float* hg_onorm = (const float*)ldp(lds, 12); \
    const float* w_up_a = (const float*)ldp(lds, 13); const float* w_up_b = (const float*)ldp(lds, 14); const float* w_out = (const float*)ldp(lds, 15); const float* norm_mlp = (const float*)ldp(lds, 16); \
    const float* w_ff1 = (const float*)ldp(lds, 17); const float* w_ff2 = (const float*)ldp(lds, 18); \
    float* out = (float*)ldp(lds, 19); \
    bf16* Wt_in = (bf16*)(ws + WS_WIN); bf16* Wt_upa = (bf16*)(ws + WS_WUPA); bf16* Wt_upb = (bf16*)(ws + WS_WUPB); bf16* Wt_out = (bf16*)(ws + WS_WOUT); \
    bf16* Wt_ff1 = (bf16*)(ws + WS_WFF1); bf16* Wt_ff2 = (bf16*)(ws + WS_WFF2); \
    bf16* U = (bf16*)(ws + WS_U); bf16* Umeta = (bf16*)(ws + WS_UMETA); bf16* Pm = (bf16*)(ws + WS_PM); float* ROPE = (float*)(ws + WS_ROPE); \
    float* RSTD = (float*)(ws + WS_RSTD); float* SSQ = (float*)(ws + WS_SSQ); float* DEC = (float*)(ws + WS_DEC); bf16* P = (bf16*)(ws + WS_P); bf16* HID = (bf16*)(ws + WS_P); \
    unsigned char* U8 = ws + WS_U8; unsigned char* W8 = ws + WS_W8; float* SU = (float*)(ws + WS_SU); float* SW = (float*)(ws + WS_SW); bf16* YA = (bf16*)(ws + WS_YA); bf16* YB = YA + WHD;      bf16* MG = (bf16*)(ws + WS_MG);
__global__ void __launch_bounds__(NWAVES * 64, 2) mk_fwd(Ptrs args) {
    extern __shared__ __attribute__((aligned(16))) unsigned char lds_raw[];
    LAS unsigned char* lds = (LAS unsigned char*)lds_raw;
    volatile LAS unsigned* MISC = (volatile LAS unsigned*)(lds + LDSCTL_OFF);
    const int G = gridDim.x, bx = blockIdx.x;
    const int vcu = (G % 8 == 0) ? (bx % 8) * (G / 8) + bx / 8 : bx;

    { PHASE_IDS
    for (int u = tid; u < (LDS_BYTES - LDSCTL_OFF) / 4; u += NWAVES * 64) ((LAS unsigned*)(lds + LDSCTL_OFF))[u] = 0u;
    __syncthreads();
    if (tid == 0) {
#pragma unroll
        for (int k = 0; k < 21; ++k) { const unsigned long long pv_ = (k < 19) ? (unsigned long long)args.in[k < 19 ? k : 0] : (k == 19 ? (unsigned long long)args.out : (unsigned long long)args.ws);
            MISC[32 + 2 * k] = (unsigned)pv_; MISC[33 + 2 * k] = (unsigned)(pv_ >> 32); } } }
    __syncthreads();
    XcdBarrier bar = xcd_barrier_post((unsigned*)((gu32*)args.ws + CW_BAR), MISC + 8);
    { PHASE_IDS PHASE_PTRS
    if (wave == 0) {
        const float s1 = wave_sum(lq1[lane] * lk1[lane]), s2 = wave_sum(lq2[lane] * lk2[lane]);
        if (lane == 0) ((LAS float*)(lds + LDSCTL_OFF))[16] = expf(s1) - expf(s2) + LAM_INIT;
        const float wqm = wave_max(fabsf(q_norm[lane])), wkm = wave_max(fabsf(k_norm[lane]));
        if (lane == 0) ((LAS float*)(lds + LDSCTL_OFF))[17] = fmaxf(0.f, 64.f * C2 * wqm * wkm - 64.f);
    } }
    __syncthreads();

    { PHASE_IDS PHASE_PTRS
        LAS float* scr = (LAS float*)(lds + wave * 16384);
        const int gw = vcu * NWAVES + wave, NGW = G * NWAVES;
        constexpr int I_QK = (DM / 64) * (NIN / 32);
        for (int it = gw; it < I_QK; it += NGW) p0_transpose_item<true>(w_in, DM, NIN, Wt_in, scr, it, lane, 0, 0, ctl + CW_SWMAX);
        for (int m = gw; m < MR + NMETA; m += NGW) {
            if (m < MR) rms_row_to_bf16(x + (size_t)m * DM, norm_mix, nullptr, lane, U8 + (size_t)m * DM, SU + m);
            else rms_row_to_bf16(meta + (size_t)(m - MR) * DM, norm_mix, Umeta + (size_t)(m - MR) * DM, lane);
        }
        const int gt = tid * G + bx;
        if (gt < TT * 8) {
            const int pos = gt >> 3, j = gt & 7;
            const float invf[8] = {1.0f, 0.1939227432012558f, 0.03760603070259094f, 0.007292664609849453f, 0.0014142135623842478f, 0.00027424818836152554f, 5.3182957344688475e-05f, 1.0313385246263351e-05f};
            float inv = invf[0];
#pragma unroll
            for (int q = 1; q < 8; ++q) inv = (j == q) ? invf[q] : inv;
            const float ang = (float)pos * inv; float sn, cs; sincos_d((double)ang, sn, cs);
            ROPE[pos * 16 + j] = cs; ROPE[pos * 16 + 8 + j] = sn;
        }
    }
    xcd_barrier(bar);

    { PHASE_IDS PHASE_PTRS
        const int gw = vcu * NWAVES + wave, NGW = G * NWAVES;
        for (int r = gw; r < NIN; r += NGW) {
            const float cmax = __uint_as_float(__hip_atomic_load(ctl + CW_SWMAX + r, RLX_AGENT)), inv = cmax > 0.f ? 127.f / cmax : 0.f;
            const GAS v4u* rp = (const GAS v4u*)(Wt_in + (size_t)r * DM) + lane; v4u q[8];
#pragma unroll
            for (int j = 0; j < 8; ++j) q[j] = __builtin_nontemporal_load(rp + 64 * j);
            GAS unsigned long long* op = (GAS unsigned long long*)(W8 + (size_t)r * DM) + lane;
#pragma unroll
            for (int j = 0; j < 8; ++j) op[64 * j] = (unsigned long long)pk4_i8(bflo(q[j].x) * inv, bfhi(q[j].x) * inv, bflo(q[j].y) * inv, bfhi(q[j].y) * inv) | ((unsigned long long)pk4_i8(bflo(q[j].z) * inv, bfhi(q[j].z) * inv, bflo(q[j].w) * inv, bfhi(q[j].w) * inv) << 32);
            if (lane == 0) SW[r] = cmax * (1.f / 127.f);
        }
    }
    xcd_barrier(bar);

    { PHASE_IDS PHASE_PTRS
        { constexpr int UPB = DM * 2 + 16, PART = 16 * UPB;
          for (int i = tid; i < NMETA * DM * 2 / 16; i += NWAVES * 64) { const int r = i >> 9, cch = i & 511; *(LAS v4u*)(lds + r * UPB + cch * 16) = ((const GAS v4u*)Umeta)[i]; }
          __syncthreads();
          const int tsel = wave >> 2, kq = wave & 3, fr = lane & 15, fq = lane >> 4;
#pragma unroll 1
          for (int cb = vcu * 32; cb < 8192; cb += G * 32) {
              const int ci = cb + tsel * 16 + fr; const int c = (ci < 4096) ? (C_K + ci) : (C_HF + (ci - 4096));
              const bf16* wrow = Wt_in + (size_t)wt_row(c) * DM + kq * 1024 + fq * 8;
              LAS const unsigned char* arow = lds + fr * UPB + (kq * 1024 + fq * 8) * 2;
              f32x4 acc = {0.f, 0.f, 0.f, 0.f};
#pragma unroll 1
              for (int kb = 0; kb < 32; kb += 8) {
                  bf16x8 bfr[8];
#pragma unroll
                  for (int i = 0; i < 8; ++i) bfr[i] = *(const GAS bf16x8*)(wrow + (kb + i) * 32);
#pragma unroll
                  for (int i = 0; i < 8; ++i) { const bf16x8 afr = *(LAS const bf16x8*)(arow + (kb + i) * 64); acc = __builtin_amdgcn_mfma_f32_16x16x32_bf16(afr, bfr[i], acc, 0, 0, 0); }
              }
              *(LAS f32x4*)(lds + PART + (wave * 64 + lane) * 16) = acc;
              __syncthreads();
              if (kq == 0) { f32x4 s = acc;
#pragma unroll
                  for (int q = 1; q < 4; ++q) { const f32x4 t = *(LAS const f32x4*)(lds + PART + ((wave + q) * 64 + lane) * 16); s = s + t; }
#pragma unroll
                  for (int reg = 0; reg < 4; ++reg) Pm[(size_t)(4 * fq + reg) * NIN + c] = (bf16)f2bf(s[reg]); }
              __syncthreads();
          }
        }
        { pg8::Gemm g{(const bf16*)U8, (const bf16*)W8, MR, NQK, DM / 2}; pg8::StaticOrder S; S.init(MR, NQK, G, bx);
          EpiProjT<true> E{P, q_norm, k_norm, ROPE, hg_lb, DEC, 0, 1.f, SU, SW};
          pg8::gemm_phase<EpiProjT<true>, pg8::StaticOrder, true, true, false, true>(lds, g, S, E); }
        __syncthreads();
        { pg8::Gemm g{(const bf16*)U8, (const bf16*)(W8 + (size_t)NQK * DM), MR, NIN - NQK, DM / 2}; pg8::StaticOrder S; S.init(MR, NIN - NQK, G, bx);
          EpiProjT<false> E{P, q_norm, k_norm, ROPE, hg_lb, DEC, NQK / 256, 1.f, SU, SW};
          pg8::gemm_phase<EpiProjT<false>, pg8::StaticOrder, true, true, false, true>(lds, g, S, E); }
    }
    xcd_barrier(bar);


    { PHASE_IDS PHASE_PTRS
        { const int nconv = (G > 2 * NCONV) ? NCONV : G, cv = bx - (G - nconv);
          if (cv >= 0) {
              LAS unsigned* scr = (LAS unsigned*)(lds + wave * TSCR_BYTES);
#pragma unroll 1
              for (int it = cv * NWAVES + wave; it < TI_ALL; it += nconv * NWAVES) { const TItem t = t_decode(lds, it); t_convert(t, scr, lane); }
              __syncthreads();
          } }
        gu32* qh_h = ctl + CW_QHEAD; gu32* qh_a = ctl + CW_QHEAD + 64; const float lam = ((volatile LAS float*)(lds + LDSCTL_OFF))[16], mfix = ((volatile LAS float*)(lds + LDSCTL_OFF))[17];
#pragma unroll 1
        for (;;) {
            if (tid == 0) MISC[20] = __hip_atomic_fetch_add(qh_h, 1u, RLX_AGENT);
            __syncthreads();
            const int it = (int)MISC[20];
            __syncthreads();
            if (it >= 64) break;
            hg::unit(lds, P, Pm, YB, DEC, hg_onorm, hg_lb, it >> 4, it & 15, tid, wave, lane);
        }
#pragma unroll 1
        for (;;) {
            if (tid == 0) MISC[20] = __hip_atomic_fetch_add(qh_a, 1u, RLX_AGENT);
            __syncthreads();
            const int u = (int)MISC[20];
            __syncthreads();
            if (u >= NB * NH * 16) break;
            const int qb = 15 - (u >> 6), bh = u & 63;
            da::unit(lds, P, Pm, YA, subln, k_norm, ROPE, lam, mfix, bh >> 4, bh & 15, qb, tid, wave, lane);
        }
    }
    xcd_barrier(bar);

    { PHASE_IDS PHASE_PTRS
        pg8::Gemm g{YA, Wt_upa, MR, DM, YP}; HalfOrder S; S.init(MR, DM, G, bx); EpiUp E{P, MG};
        pg8::gemm_phase<EpiUp, HalfOrder, true, true>(lds, g, S, E);
    }
    xcd_barrier(bar);

    { PHASE_IDS PHASE_PTRS
        pg8::Gemm g{MG, Wt_out, MR, DM, DM}; pg8::StaticOrder S; S.init(MR, DM, G, bx); EpiOut E{x, U, SSQ};
        pg8::gemm_phase<EpiOut, pg8::StaticOrder, true, true>(lds, g, S, E);
    }
    xcd_barrier(bar);

    { PHASE_IDS PHASE_PTRS
        { const int gt = bx * (NWAVES * 64) + tid;
          for (int row = gt; row < MR; row += G * NWAVES * 64) { float s = 0.f;
#pragma unroll
              for (int i = 0; i < 16; ++i) { const f32x4 v = *(const GAS f32x4*)(SSQ + (size_t)row * 64 + i * 4); s += (v.x + v.y) + (v.z + v.w); }
              RSTD[row] = 1.f / sqrtf(s * (1.f / DM) + EPS); } }
        pg8::Gemm g{U, Wt_ff1, MR, DFF, DM}; pg8::StaticOrder S; S.init(MR, DFF, G, bx); EpiFf1 E{HID};
        pg8::gemm_phase<EpiFf1, pg8::StaticOrder, true, true>(lds, g, S, E);
    }
    xcd_barrier(bar);

    { PHASE_IDS PHASE_PTRS
        pg8::Gemm g{HID, Wt_ff2, MR, DM, DFF}; pg8::StaticOrder S; S.init(MR, DM, G, bx); EpiFf2 E{out, RSTD, U};
        pg8::gemm_phase<EpiFf2, pg8::StaticOrder, true, true>(lds, g, S, E);
    }
}

extern "C" void kernel_launch(void* const* d_in, const int* in_sizes, int n_in, void* d_out, int out_size, void* d_ws, size_t ws_size, hipStream_t stream) {
    static int grid = 0;
    if (grid == 0) {
        if (n_in != 19 || out_size != MR * DM || ws_size < WS_END) { fprintf(stderr, "kernel_launch: unexpected shapes (n_in %d out %d ws %zu)\n", n_in, out_size, ws_size); grid = -1; return; }
        int dev = 0, cus = 0, per_cu = 0;
        if (hipGetDevice(&dev) != hipSuccess || hipDeviceGetAttribute(&cus, hipDeviceAttributeMultiprocessorCount, dev) != hipSuccess) { grid = -1; return; }
        if (hipFuncSetAttribute((const void*)mk_fwd, hipFuncAttributeMaxDynamicSharedMemorySize, LDS_BYTES) != hipSuccess) { fprintf(stderr, "kernel_launch: hipFuncSetAttribute failed\n"); grid = -1; return; }
        if (hipOccupancyMaxActiveBlocksPerMultiprocessor(&per_cu, (const void*)mk_fwd, NWAVES * 64, LDS_BYTES) != hipSuccess || per_cu < 1) { fprintf(stderr, "kernel_launch: occupancy query says %d\n", per_cu); }
        (void)hipGetLastError();
        grid = cus;
    }
    if (grid < 0) return;
    if (hipMemsetAsync((char*)d_ws + WS_CTL, 0, CTL_ZERO_BYTES, stream) != hipSuccess) return;
    Ptrs a{};
    for (int i = 0; i < 19; ++i) a.in[i] = (const float*)d_in[i];
    a.out = (float*)d_out; a.ws = (unsigned char*)d_ws;
    hipLaunchKernelGGL(mk_fwd, dim3(grid), dim3(NWAVES * 64), LDS_BYTES, stream, a);
}
```

```cpp
#include <hip/hip_runtime.h>
#include <cstdio>
#include <cstdint>
namespace pg8 {
#define PG8_LAS __attribute__((address_space(3)))
typedef unsigned short bf16_t;
typedef short bf16x8 __attribute__((ext_vector_type(8)));
typedef float f32x4 __attribute__((ext_vector_type(4)));
typedef unsigned u32x4 __attribute__((ext_vector_type(4)));
typedef int i32x4_ __attribute__((ext_vector_type(4)));
typedef int i32x8_ __attribute__((ext_vector_type(8)));
template <bool FP8> struct Frag;
template <> struct Frag<false> { bf16x8 v[2]; __device__ __forceinline__ void set(int k, bf16x8 x) { v[k] = x; } };
template <> struct Frag<true>  { i32x8_ w;    __device__ __forceinline__ void set(int k, bf16x8 x) { if (k == 0) w.lo = __builtin_bit_cast(i32x4_, x); else w.hi = __builtin_bit_cast(i32x4_, x); } };
constexpr int BM = 256, BK = 64, HALF = 128, HTB = HALF * BK * 2  , STAGE_BYTES = 8 * HTB, NXCD = 8, WGM = 8;

__host__ __device__ __forceinline__ int lds_byte(int r, int c) { const int st = (r >> 4) * 2 + (c >> 5), rr = r & 15, cc = c & 31, ob = rr * 64 + cc * 2; return st * 1024 + (ob ^ (((ob >> 9) & 1) << 5)); }
__host__ __device__ __forceinline__ void stage_rc(int b, int& R, int& C) { const int st = b / 1024, sb = b % 1024, swz = sb ^ (((sb >> 9) & 1) << 5); R = (st >> 1) * 16 + swz / 64; C = (st & 1) * 32 + (swz % 64) / 2; }
__host__ __device__ __forceinline__ int perm32(int rho) { const int n = rho >> 4, i = rho & 15; return 8 * (i >> 2) + 4 * n + (i & 3); }

struct Unit { int pm, pn; };
struct Gemm { const bf16_t* A; const bf16_t* Bt; int M, N, K; };

struct StaticOrder {
    int nM, nN, nwg, G, c;
    __host__ __device__ void init(int M, int N, int G_, int c_) { nM = M / BM; nN = N / BM; nwg = nM * nN; G = G_; c = c_; }
    __host__ __device__ bool next(int i, Unit& u) const {
        const long L = (long)i * G + c; if (L >= nwg) return false;
        int wgid = (int)L; { const int q = nwg / NXCD, r = nwg % NXCD, xcd = wgid % NXCD, off = wgid / NXCD; wgid = (xcd < r ? xcd * (q + 1) : r * (q + 1) + (xcd - r) * q) + off; }
        const int nig = WGM * nN, gid = wgid / nig, fm = gid * WGM, gsz = (nM - fm) < WGM ? (nM - fm) : WGM;
        u.pm = fm + ((wgid % nig) % gsz); u.pn = (wgid % nig) / gsz; return true;
    }
    __device__ __forceinline__ void a_ready(const Unit&) const {}
    __device__ __forceinline__ void done(const Unit&) const {}
    static constexpr int KLOOP = 0;
    __device__ __forceinline__ size_t kofs(const Unit&) const { return 0; }
    __device__ __forceinline__ bool zero_after(const Unit&) const { return true; }
};

__device__ __forceinline__ unsigned cvt_pk_bf16(float lo, float hi) { unsigned r; asm volatile("v_cvt_pk_bf16_f32 %0, %1, %2" : "=v"(r) : "v"(lo), "v"(hi)); return r; }
typedef float f32x2 __attribute__((ext_vector_type(2)));
__device__ __forceinline__ void mfma_f8(f32x4& acc, const i32x8_& a, const i32x8_& b, int sc) {
    asm volatile("v_mfma_scale_f32_16x16x128_f8f6f4 %0, %1, %2, %0, %3, %3 op_sel_hi:[0,0,0]" : "+v"(acc) : "v"(a), "v"(b), "v"(sc));
}
template <class Epi, class Sched, bool ALIGN_EPI = false, bool SP2 = false, bool FP8 = false, bool I8 = false>
__device__ __forceinline__ void gemm_phase(PG8_LAS unsigned char* lds, const Gemm g, const Sched& S, const Epi& E) {
    int tid_ = threadIdx.x; asm volatile("" : "+v"(tid_));
    const int tid = tid_, wid = __builtin_amdgcn_readfirstlane(tid >> 6), lane = tid & 63, wr = wid >> 2, wc = wid & 3, fr = lane & 15, fq = lane >> 4;
    int one_scale = 0x7f7f7f7f; asm volatile("" : "+v"(one_scale));      (void)one_scale;
    const int K = g.K, nt = (Sched::KLOOP ? Sched::KLOOP : K) / BK;
    unsigned voffA[2], voffB[2];
#pragma unroll
    for (int i = 0; i < 2; ++i) { int R, C; stage_rc(tid * 16 + i * 8192, R, C); const int Rb = Epi::PERM ? ((R & ~31) + perm32(R & 31)) : R;
        if (FP8) { const int q8 = C >> 3; C = (2 * (q8 & 3) + (q8 >> 2)) * 8; }
        voffA[i] = (unsigned)(R * K + C) * 2u; voffB[i] = (unsigned)(Rb * K + C) * 2u; }
    const size_t kstep = (size_t)(BK * 2);
    const size_t hstep = (size_t)HALF * K * 2;
    const size_t tstep = 2 * hstep;
    const unsigned ldsw = (unsigned)wid * 1024u;
    const int aoff = lds_byte(wr * 64 + fr, fq * 8), boff = lds_byte(wc * 32 + fr, fq * 8);
#define PG8_SA(b, h) (((b) * 2 + (h)) * HTB)
#define PG8_SB(b, h) ((4 + (b) * 2 + (h)) * HTB)
#define PG8_STAGE(bufoff, gbase, voff) do { _Pragma("unroll") for (int _i = 0; _i < 2; ++_i) \
        __builtin_amdgcn_global_load_lds((const unsigned*)((const char*)(gbase) + (voff)[_i]), (PG8_LAS unsigned*)(lds + (bufoff) + ldsw + _i * 8192), 16, 0, 0); } while (0)
#define PG8_LDA(dst, b, h) do { _Pragma("unroll") for (int m = 0; m < 4; ++m) _Pragma("unroll") for (int k = 0; k < 2; ++k) dst[m].set(k, *(const PG8_LAS bf16x8*)(lds + PG8_SA(b, h) + aoff + m * 2048 + k * 1024)); } while (0)
#define PG8_LDB(dst, b, h) do { _Pragma("unroll") for (int n = 0; n < 2; ++n) _Pragma("unroll") for (int k = 0; k < 2; ++k) dst[n].set(k, *(const PG8_LAS bf16x8*)(lds + PG8_SB(b, h) + boff + n * 2048 + k * 1024)); } while (0)
#define PG8_MMA(ai, bj, At, Bt) do { __builtin_amdgcn_s_setprio(1); _Pragma("unroll") for (int m = 0; m < 4; ++m) _Pragma("unroll") for (int n = 0; n < 2; ++n) { \
        if constexpr (FP8) mfma_f8(acc[ai][bj][m][n], Bt[n].w, At[m].w, one_scale); \
        else if constexpr (I8) { _Pragma("unroll") for (int k = 0; k < 2; ++k) acc[ai][bj][m][n] = __builtin_bit_cast(f32x4, __builtin_amdgcn_mfma_i32_16x16x64_i8(__builtin_bit_cast(i32x4_, Bt[n].v[k]), __builtin_bit_cast(i32x4_, At[m].v[k]), __builtin_bit_cast(i32x4_, acc[ai][bj][m][n]), 0, 0, 0)); } \
        else { _Pragma("unroll") for (int k = 0; k < 2; ++k) acc[ai][bj][m][n] = __builtin_amdgcn_mfma_f32_16x16x32_bf16(Bt[n].v[k], At[m].v[k], acc[ai][bj][m][n], 0, 0, 0); } } \
        if constexpr (FP8) asm volatile("s_nop 15" ::: "memory");     \
        __builtin_amdgcn_s_setprio(0); } while (0)
#define PG8_WAIT_V(n) asm volatile("s_waitcnt vmcnt(" #n ")" ::: "memory")
#define PG8_WAIT_L(n) asm volatile("s_waitcnt lgkmcnt(" #n ")" ::: "memory")
#define PG8_BAR __builtin_amdgcn_s_barrier()
#define PG8_SCHED __builtin_amdgcn_sched_barrier(0)
    Unit cur, nxt; int ui = 0;
    if (!S.next(0, cur)) return;
    f32x4 acc[2][2][4][2];
    if constexpr (Epi::INIT) E.init(acc, cur, wr, wc, fr, fq);
    else {
#pragma unroll
    for (int a = 0; a < 2; ++a)
#pragma unroll
        for (int b = 0; b < 2; ++b)
#pragma unroll
            for (int m = 0; m < 4; ++m)
#pragma unroll
                for (int n = 0; n < 2; ++n) acc[a][b][m][n] = (f32x4){0.f, 0.f, 0.f, 0.f};
    }
    Frag<FP8> At[4], B0[2], B1[2];
    const char* cA = (const char*)g.A + (size_t)cur.pm * tstep + S.kofs(cur); const char* cB = (const char*)g.Bt + (size_t)(cur.pn & 0xffff) * tstep + S.kofs(cur);
    S.a_ready(cur);
    if constexpr (SP2) {
        PG8_STAGE(PG8_SB(0, 0), cB, voffB); PG8_STAGE(PG8_SB(0, 1), cB + hstep, voffB); PG8_STAGE(PG8_SA(0, 0), cA, voffA); PG8_STAGE(PG8_SA(0, 1), cA + hstep, voffA);
        if (wr == 1) PG8_BAR;
        PG8_WAIT_V(2); PG8_BAR;
        PG8_STAGE(PG8_SB(1, 0), cB + kstep, voffB); PG8_STAGE(PG8_SA(1, 0), cA + kstep, voffA); PG8_STAGE(PG8_SB(1, 1), cB + hstep + kstep, voffB);
        PG8_WAIT_V(6); PG8_BAR;
    } else {
        PG8_STAGE(PG8_SB(0, 0), cB, voffB); PG8_STAGE(PG8_SA(0, 0), cA, voffA); PG8_STAGE(PG8_SB(0, 1), cB + hstep, voffB); PG8_STAGE(PG8_SA(0, 1), cA + hstep, voffA);
        if (wr == 1) PG8_BAR;
        PG8_WAIT_V(4); PG8_BAR;
        PG8_STAGE(PG8_SB(1, 0), cB + kstep, voffB); PG8_STAGE(PG8_SA(1, 0), cA + kstep, voffA); PG8_STAGE(PG8_SB(1, 1), cB + hstep + kstep, voffB);
        PG8_WAIT_V(6); PG8_BAR;
    }
    for (;;) {
        const bool has_next = S.next(ui + 1, nxt);
        const char* nA = has_next ? (const char*)g.A + (size_t)nxt.pm * tstep + S.kofs(nxt) : cA; const char* nB = has_next ? (const char*)g.Bt + (size_t)(nxt.pn & 0xffff) * tstep + S.kofs(nxt) : cB;
        for (int t = 0; t < nt; t += 2) {
            const bool last = (t == nt - 2);
            const char* a1 = cA + (size_t)(t + 1) * kstep;
            const char* a2 = last ? nA : cA + (size_t)(t + 2) * kstep; const char* b2 = last ? nB : cB + (size_t)(t + 2) * kstep;
            const char* a3 = a2 + kstep; const char* b3 = b2 + kstep;
            if (last && has_next) S.a_ready(nxt);
            if constexpr (SP2) {
            PG8_LDB(B0, 0, 0); PG8_LDB(B1, 0, 1); PG8_SCHED; PG8_LDA(At, 0, 0); PG8_STAGE(PG8_SA(1, 1), a1 + hstep, voffA);
            PG8_WAIT_V(8); PG8_WAIT_L(0); PG8_BAR; PG8_MMA(0, 0, At, B0); PG8_MMA(0, 1, At, B1); PG8_BAR; PG8_SCHED;
            PG8_LDA(At, 0, 1); PG8_STAGE(PG8_SB(0, 0), b2, voffB); PG8_STAGE(PG8_SB(0, 1), b2 + hstep, voffB); PG8_STAGE(PG8_SA(0, 0), a2, voffA);
            PG8_WAIT_V(8); PG8_WAIT_L(0); PG8_BAR; PG8_MMA(1, 0, At, B0); PG8_MMA(1, 1, At, B1); PG8_BAR; PG8_SCHED;
            PG8_LDB(B0, 1, 0); PG8_LDB(B1, 1, 1); PG8_SCHED; PG8_LDA(At, 1, 0); PG8_STAGE(PG8_SA(0, 1), a2 + hstep, voffA);
            PG8_WAIT_V(8); PG8_WAIT_L(0); PG8_BAR; PG8_MMA(0, 0, At, B0); PG8_MMA(0, 1, At, B1); PG8_BAR; PG8_SCHED;
            PG8_LDA(At, 1, 1); PG8_STAGE(PG8_SB(1, 0), b3, voffB); PG8_STAGE(PG8_SB(1, 1), b3 + hstep, voffB); PG8_STAGE(PG8_SA(1, 0), a3, voffA);
            PG8_WAIT_V(8); PG8_WAIT_L(0); PG8_BAR; PG8_MMA(1, 0, At, B0); PG8_MMA(1, 1, At, B1); PG8_BAR; PG8_SCHED;
            } else {
            PG8_LDB(B0, 0, 0); PG8_SCHED; PG8_LDA(At, 0, 0); PG8_STAGE(PG8_SA(1, 1), a1 + hstep, voffA);
            PG8_WAIT_L(8); PG8_BAR; PG8_WAIT_L(0); PG8_MMA(0, 0, At, B0); PG8_BAR; PG8_SCHED;
            PG8_LDB(B1, 0, 1); PG8_STAGE(PG8_SB(0, 0), b2, voffB);
            PG8_BAR; PG8_WAIT_L(0); PG8_MMA(0, 1, At, B1); PG8_BAR;
            PG8_LDA(At, 0, 1); PG8_STAGE(PG8_SA(0, 0), a2, voffA);
            PG8_BAR; PG8_WAIT_L(0); PG8_MMA(1, 0, At, B0); PG8_BAR; PG8_SCHED;
            PG8_STAGE(PG8_SB(0, 1), b2 + hstep, voffB);
            PG8_WAIT_V(6); PG8_BAR; PG8_MMA(1, 1, At, B1); PG8_BAR;
            PG8_LDB(B0, 1, 0); PG8_SCHED; PG8_LDA(At, 1, 0); PG8_STAGE(PG8_SA(0, 1), a2 + hstep, voffA);
            PG8_WAIT_L(8); PG8_BAR; PG8_WAIT_L(0); PG8_MMA(0, 0, At, B0); PG8_BAR; PG8_SCHED;
            PG8_LDB(B1, 1, 1); PG8_STAGE(PG8_SB(1, 0), b3, voffB);
            PG8_BAR; PG8_WAIT_L(0); PG8_MMA(0, 1, At, B1); PG8_BAR;
            PG8_LDA(At, 1, 1); PG8_STAGE(PG8_SA(1, 0), a3, voffA);
            PG8_BAR; PG8_WAIT_L(0); PG8_MMA(1, 0, At, B0); PG8_BAR; PG8_SCHED;
            PG8_STAGE(PG8_SB(1, 1), b3 + hstep, voffB);
            PG8_WAIT_V(6); PG8_BAR; PG8_MMA(1, 1, At, B1); PG8_BAR;
            }
        }
        if constexpr (ALIGN_EPI) { if (wr == 0) PG8_BAR; }
        if constexpr (FP8) asm volatile("s_nop 15\n\ts_nop 15" ::: "memory");
        if constexpr (!Epi::AFTER_DRAIN) { E(acc, cur, wr, wc, fr, fq); S.done(cur); }
        if (!has_next) break;
        if constexpr (Epi::INIT) E.init(acc, nxt, wr, wc, fr, fq);
        else if (S.zero_after(cur)) {
#pragma unroll
        for (int a = 0; a < 2; ++a)
#pragma unroll
            for (int b = 0; b < 2; ++b)
#pragma unroll
                for (int m = 0; m < 4; ++m)
#pragma unroll
                    for (int n = 0; n < 2; ++n) acc[a][b][m][n] = (f32x4){0.f, 0.f, 0.f, 0.f};
        }
        cur = nxt; cA = nA; cB = nB; ++ui;
        if constexpr (ALIGN_EPI) { if (wr == 1) PG8_BAR; }
    }
    PG8_WAIT_V(0);
    if constexpr (!ALIGN_EPI) { if (wr == 0) PG8_BAR; }
    PG8_BAR;
    if constexpr (Epi::AFTER_DRAIN) { E.fused(acc, cur, wr, wc, fr, fq, lds, wid, lane); S.done(cur); }
#undef PG8_SA
#undef PG8_SB
#undef PG8_STAGE
#undef PG8_LDA
#undef PG8_LDB
#undef PG8_MMA
#undef PG8_WAIT_V
#undef PG8_WAIT_L
#undef PG8_BAR
#undef PG8_SCHED
}
}
#define GAS __attribute__((address_space(1)))
#define LAS __attribute__((address_space(3)))
typedef unsigned short bf16;
typedef unsigned v4u __attribute__((ext_vector_type(4)));
typedef float f32x4 __attribute__((ext_vector_type(4)));
typedef short bf16x8 __attribute__((ext_vector_type(8)));
typedef GAS unsigned gu32;
typedef GAS unsigned long long gu64;
#define RLX_AGENT __ATOMIC_RELAXED, __HIP_MEMORY_SCOPE_AGENT
#define LDS_WAIT() asm volatile("s_waitcnt lgkmcnt(0)" ::: "memory")
#define VM_WAIT() asm volatile("s_waitcnt vmcnt(0)" ::: "memory")
__device__ __forceinline__ unsigned long long rt() { return __builtin_amdgcn_s_memrealtime(); }
__device__ __forceinline__ unsigned f2bf(float f) { unsigned u = __builtin_bit_cast(unsigned, f); return (u + 0x7fffu + ((u >> 16) & 1u)) >> 16; }
__device__ __forceinline__ unsigned pk2(float lo, float hi) { return f2bf(lo) | (f2bf(hi) << 16); }
#define XB_TMO      128
#define XB_XCNT(j)  (256  + 64 * (j))
#define XB_XSUB(j)  (1280 + 64 * (j))
#define XB_XGEN(j)  (2304 + 64 * (j))
#define XB_TOP      3328
#define XB_TOPGEN   3392
#define XCD_BAR_WORDS 3456
#define XB_SPIN_CAP (1u << 22)

__device__ __forceinline__ unsigned xb_ld(unsigned* p)              { return __hip_atomic_load(p, __ATOMIC_RELAXED, __HIP_MEMORY_SCOPE_AGENT); }
__device__ __forceinline__ unsigned xb_add(unsigned* p, unsigned v) { return __hip_atomic_fetch_add(p, v, __ATOMIC_RELAXED, __HIP_MEMORY_SCOPE_AGENT); }
__device__ __forceinline__ unsigned xb_xcc_id() { return (unsigned)__builtin_amdgcn_s_getreg((3 << 11) | 20) & 0xFu; }
#define XB_SPIN(cond, bar) do { unsigned _sp = 0; while (cond) { __builtin_amdgcn_s_sleep(1); \
    if ((++_sp & 255u) == 0u) { if (xb_ld(&(bar)[XB_TMO])) break; if (_sp > XB_SPIN_CAP) { atomicAdd(&(bar)[XB_TMO], 1u); break; } } } } while (0)

struct XcdBarrier {
    unsigned* bar; unsigned x;
    volatile LAS unsigned* st;
};

__device__ __forceinline__ XcdBarrier xcd_barrier_post(unsigned* bar, volatile LAS unsigned* st) {
    XcdBarrier b; b.bar = bar; b.x = xb_xcc_id(); b.st = st;
    if (threadIdx.x == 0) (void)xb_add(&bar[XB_XCNT(b.x)], 1u);
    return b;
}
__device__ __forceinline__ void xcd_barrier_complete(unsigned* bar, unsigned x, unsigned& nloc, unsigned& nx) {
    const unsigned G = gridDim.x * gridDim.y * gridDim.z;
    unsigned sum, cnt, mine, sp = 0u;
    for (;;) {
        sum = 0u; cnt = 0u; mine = 0u;
#pragma unroll
        for (unsigned j = 0; j < 16; ++j) { const unsigned c = xb_ld(&bar[XB_XCNT(j)]); sum += c; cnt += (c > 0u) ? 1u : 0u; mine = (j == x) ? c : mine; }
        if (sum == G) break;
        __builtin_amdgcn_s_sleep(1);
        if ((++sp & 255u) == 0u) { if (xb_ld(&bar[XB_TMO])) break; if (sp > XB_SPIN_CAP) { atomicAdd(&bar[XB_TMO], 1u); break; } }
    }
    nloc = mine > 0u ? mine : 1u; nx = cnt > 0u ? cnt : 1u;
}

__device__ __forceinline__ void xcd_barrier(const XcdBarrier& b) {
    asm volatile("s_waitcnt vmcnt(0)" ::: "memory");
    __syncthreads();
    if (threadIdx.x == 0) {
        unsigned* bar = b.bar;
        __builtin_amdgcn_s_waitcnt(0);
        unsigned nloc = b.st[0], nx = b.st[1];
        if (nloc == 0u) { xcd_barrier_complete(bar, b.x, nloc, nx); b.st[0] = nloc; b.st[1] = nx; }
        const unsigned old = xb_add(&bar[XB_XSUB(b.x)], 1u);
        const unsigned gen = old / nloc;
        if (old + 1u == (gen + 1u) * nloc) {
            __builtin_amdgcn_fence(__ATOMIC_RELEASE, "agent");
            asm volatile("s_waitcnt vmcnt(0)" ::: "memory");
            const unsigned og = xb_add(&bar[XB_TOP], 1u);
            const unsigned tg = og / nx;
            if (og + 1u == (tg + 1u) * nx) xb_add(&bar[XB_TOPGEN], 1u);
            else XB_SPIN(xb_ld(&bar[XB_TOPGEN]) == tg, bar);
            __builtin_amdgcn_fence(__ATOMIC_ACQUIRE, "agent");
            xb_add(&bar[XB_XGEN(b.x)], 1u);
            asm volatile("s_waitcnt vmcnt(0)" ::: "memory");
        } else {
            XB_SPIN(xb_ld(&bar[XB_XGEN(b.x)]) == gen, bar);
            __builtin_amdgcn_fence(__ATOMIC_ACQUIRE, "agent");
            asm volatile("s_waitcnt vmcnt(0)" ::: "memory");
        }
    }
    __syncthreads();
}
constexpr int NWAVES = 8;
constexpr int DM = 4096, NB = 4, SEQ = 2048, NMETA = 16, TT = SEQ + NMETA;
constexpr int MR = NB * SEQ;
constexpr int NIN = 22528, DFF = 16384, NH = 16, WHD = 2048;
constexpr int C_Q = 0, C_K = 2048, C_V = 4096, C_HQ = 6144, C_HF = 8192, C_HI = 10240, C_HG = 12288, C_GA = 14336, C_GB = 18432;
constexpr int YP = 2 * WHD;
constexpr float EPS = 1e-6f;
constexpr float C2 = 0.18033688011112042f;
constexpr float LAM_INIT = 0.2f;

constexpr size_t MiB = 1u << 20;
constexpr size_t WS_CTL = 0, CTL_ZERO_BYTES = 1 * MiB;
constexpr size_t WS_WIN = 2 * MiB, WS_WUPA = 178 * MiB, WS_WUPB = 194 * MiB, WS_WOUT = 210 * MiB, WS_WFF1 = 242 * MiB, WS_WFF2 = 370 * MiB;
constexpr size_t WS_U = 498 * MiB;
constexpr size_t WS_UMETA = 562 * MiB;
constexpr size_t WS_PM = 563 * MiB;
constexpr size_t WS_ROPE = 564 * MiB;
constexpr size_t WS_RSTD = 565 * MiB;
constexpr size_t WS_P = 568 * MiB;
constexpr size_t WS_YA = 920 * MiB, WS_YB = 952 * MiB, WS_MG = 984 * MiB;
constexpr size_t WS_SSQ = 1048 * MiB;
constexpr size_t WS_DEC = 1050 * MiB;
constexpr size_t WS_U8 = 1052 * MiB;
constexpr size_t WS_W8 = 1084 * MiB;
constexpr size_t WS_SU = 1172 * MiB;
constexpr size_t WS_SW = 1173 * MiB;
constexpr size_t WS_END = 1174 * MiB;
constexpr int NQK = C_V;
constexpr int CW_QHEAD = 2048;
constexpr int CW_SWMAX = 32768;
constexpr int CW_BAR = 4096;

constexpr int RING_BYTES = 131072, LDSCTL_OFF = 146432, LDS_BYTES = 147456;

__device__ __forceinline__ int opaque_v(int v) { asm volatile("" : "+v"(v)); return v; }
#define PHASE_IDS const int tid = opaque_v((int)threadIdx.x), lane = tid & 63, wave = __builtin_amdgcn_readfirstlane(tid >> 6); (void)lane; (void)wave;
__device__ __forceinline__ float bf2f(bf16 v) { return __builtin_bit_cast(float, (unsigned)v << 16); }
__device__ __forceinline__ float bflo(unsigned w) { return __builtin_bit_cast(float, w << 16); }
__device__ __forceinline__ float bfhi(unsigned w) { return __builtin_bit_cast(float, w & 0xffff0000u); }
__device__ __forceinline__ float wave_sum(float v) {
#pragma unroll
    for (int o = 1; o < 64; o <<= 1) v += __shfl_xor(v, o);
    return v;
}
__device__ __forceinline__ float wave_max(float v) {
#pragma unroll
    for (int o = 1; o < 64; o <<= 1) v = fmaxf(v, __shfl_xor(v, o));
    return v;
}
__device__ __forceinline__ float sigmoidf_(float x) { return __builtin_amdgcn_rcpf(1.0f + __expf(-x)); }

__host__ __device__ __forceinline__ int wt_row(int s) {
    if (s < C_V) { const int base = s & ~2047, t = s & 2047, h = t >> 7, cm = (t >> 6) & 1, d = t & 63; return base + 256 * (h >> 1) + 128 * ((d >> 3) & 1) + 32 * (2 * (h & 1) + cm) + 8 * (d >> 4) + (d & 7); }
    if (s >= C_HQ && s < C_HI) { const int t = s - C_HQ, isf = t >> 11, h = (t & 2047) >> 7, d = t & 127; return C_HQ + 256 * h + 128 * isf + d; }
    return s;
}
__device__ __forceinline__ unsigned pk4_i8(float a, float b, float c, float d) {
    const int ia = (int)__builtin_rintf(a), ib = (int)__builtin_rintf(b), ic = (int)__builtin_rintf(c), id = (int)__builtin_rintf(d);
    return (unsigned)(ia & 0xff) | ((unsigned)(ib & 0xff) << 8) | ((unsigned)(ic & 0xff) << 16) | ((unsigned)id << 24);
}
__device__ __forceinline__ const void* ldp(LAS unsigned char* lds, int k) {
    volatile LAS unsigned* t = (volatile LAS unsigned*)(lds + LDSCTL_OFF) + 32 + 2 * k;
    const unsigned lo = t[0], hi = t[1];
    return (const void*)(const GAS void*)(((unsigned long long)(unsigned)__builtin_amdgcn_readfirstlane((int)hi) << 32) | (unsigned long long)(unsigned)__builtin_amdgcn_readfirstlane((int)lo));
}
struct TItem { const float* src; bf16* dst; int N, KP; const float* gain; };
constexpr int TI_UP = (WHD / 64) * (DM / 32), TI_OUT = (DM / 64) * (DM / 32), TI_F1 = (DM / 64) * (DFF / 32), TI_F2 = (DFF / 64) * (DM / 32), TI_ALL = 2 * TI_UP + TI_OUT + TI_F1 + TI_F2;
constexpr int TSCR_BYTES = 32 * 33 * 4;
__device__ __forceinline__ TItem t_item(const float* W, int N, bf16* WT, int item, int KP, int koff, const float* gain = nullptr) {
    const int nblk = N / 32, kb = item / nblk, nb = item % nblk;
    return TItem{W + (size_t)(64 * kb) * N + 32 * nb, WT + (size_t)(32 * nb) * KP + koff + 64 * kb, N, KP, gain ? gain + 64 * kb : nullptr};
}
__device__ __forceinline__ TItem t_decode(LAS unsigned char* lds, int it) {
    unsigned char* ws = (unsigned char*)ldp(lds, 20);
    int r = it;
    if (r < TI_UP) return t_item((const float*)ldp(lds, 13), DM, (bf16*)(ws + WS_WUPA), r, YP, 0);
    r -= TI_UP; if (r < TI_UP) return t_item((const float*)ldp(lds, 14), DM, (bf16*)(ws + WS_WUPA), r, YP, WHD);
    r -= TI_UP; if (r < TI_OUT) return t_item((const float*)ldp(lds, 15), DM, (bf16*)(ws + WS_WOUT), r, DM, 0);
    r -= TI_OUT; if (r < TI_F1) return t_item((const float*)ldp(lds, 17), DFF, (bf16*)(ws + WS_WFF1), r, DM, 0, (const float*)ldp(lds, 16));
    r -= TI_F1; return t_item((const float*)ldp(lds, 18), DM, (bf16*)(ws + WS_WFF2), r, DFF, 0);
}
__device__ __forceinline__ void t_convert(const TItem& t, LAS unsigned* scr, int lane) {
    const int r = lane >> 3, c4 = lane & 7;
    const unsigned off = (unsigned)(2 * r) * (unsigned)t.N + (unsigned)(4 * c4);
    f32x4 v[8];
#pragma unroll
    for (int i = 0; i < 8; ++i) v[i] = __builtin_nontemporal_load((const GAS f32x4*)((const GAS float*)t.src + (size_t)(16 * (i >> 1) + (i & 1)) * t.N + off));
    if (t.gain) {
#pragma unroll
        for (int i = 0; i < 8; ++i) v[i] = v[i] * t.gain[16 * (i >> 1) + (i & 1) + 2 * r];
    }
#pragma unroll
    for (int m = 0; m < 4; ++m)
#pragma unroll
        for (int e = 0; e < 4; ++e) scr[(8 * m + r) * 33 + 4 * c4 + e] = pg8::cvt_pk_bf16(v[2 * m][e], v[2 * m + 1][e]);
    LDS_WAIT(); asm volatile("" ::: "memory");
    const int c = lane & 7;
#pragma unroll
    for (int j = 0; j < 4; ++j) { const int n = (lane >> 3) + 8 * j; const LAS unsigned* w = scr + (4 * c) * 33 + n;
        v4u o; o.x = w[0]; o.y = w[33]; o.z = w[66]; o.w = w[99];
        *(GAS v4u*)(t.dst + (size_t)n * t.KP + 8 * c) = o; }
    LDS_WAIT(); asm volatile("" ::: "memory");
}
template <bool PERMW = false>
__device__ __forceinline__ void p0_transpose_item(const float* W, int K, int N, bf16* WT, LAS float* scr, int item, int lane, int KP = 0, int koff = 0, gu32* cmaxw = nullptr) {
    if (KP == 0) KP = K;
    const int nblk = N / 32, kb = item / nblk, nb = item % nblk, k0 = 64 * kb, n0 = 32 * nb;
    float cmx = 0.f;
#pragma unroll
    for (int i = 0; i < 32; ++i) { const int kk = 2 * i + (lane >> 5); const float wv = __builtin_nontemporal_load((const GAS float*)W + (size_t)(k0 + kk) * N + n0 + (lane & 31)); scr[kk * 33 + (lane & 31)] = wv; cmx = fmaxf(cmx, fabsf(wv)); }
    if (PERMW && cmaxw) { cmx = fmaxf(cmx, __shfl_xor(cmx, 32));
        if (lane < 32) __hip_atomic_fetch_max(cmaxw + wt_row(n0 + lane), __float_as_uint(cmx), RLX_AGENT); }
    LDS_WAIT(); asm volatile("" ::: "memory");
    const int c = lane & 7;
#pragma unroll
    for (int j = 0; j < 4; ++j) { const int n = (lane >> 3) + 8 * j; const LAS float* s = scr + (8 * c) * 33 + n;
        v4u o; o.x = pk2(s[0 * 33], s[1 * 33]); o.y = pk2(s[2 * 33], s[3 * 33]); o.z = pk2(s[4 * 33], s[5 * 33]); o.w = pk2(s[6 * 33], s[7 * 33]);
        *(GAS v4u*)(WT + (size_t)(PERMW ? wt_row(n0 + n) : (n0 + n)) * KP + koff + k0 + 8 * c) = o; }
    LDS_WAIT(); asm volatile("" ::: "memory");
}
__device__ __forceinline__ void rms_row_to_bf16(const float* xrow, const float* g, bf16* orow, int lane, unsigned char* o8row = nullptr, float* su = nullptr) {
    const GAS f32x4* xr = (const GAS f32x4*)xrow + lane; const GAS f32x4* gr = (const GAS f32x4*)g + lane;
    f32x4 v[16]; float s = 0.f, am = 0.f;
#pragma unroll
    for (int j = 0; j < 16; ++j) { v[j] = __builtin_nontemporal_load(xr + 64 * j); s += (v[j].x * v[j].x + v[j].y * v[j].y) + (v[j].z * v[j].z + v[j].w * v[j].w);
        const f32x4 gg = gr[64 * j]; v[j] = v[j] * gg; am = fmaxf(am, fmaxf(fmaxf(fabsf(v[j].x), fabsf(v[j].y)), fmaxf(fabsf(v[j].z), fabsf(v[j].w)))); }
    const float rstd = 1.f / sqrtf(wave_sum(s) * (1.f / DM) + EPS);
    if (orow) { GAS unsigned long long* o8 = (GAS unsigned long long*)orow + lane;
#pragma unroll
        for (int j = 0; j < 16; ++j) o8[64 * j] = (unsigned long long)pk2(v[j].x * rstd, v[j].y * rstd) | ((unsigned long long)pk2(v[j].z * rstd, v[j].w * rstd) << 32); }
    if (o8row) {
        am = wave_max(am); const float inv = am > 0.f ? 127.f / am : 0.f;
#pragma unroll
        for (int j = 0; j < 16; ++j) ((GAS unsigned*)o8row)[64 * j + lane] = pk4_i8(v[j].x * inv, v[j].y * inv, v[j].z * inv, v[j].w * inv);
        if (lane == 0) *su = am * rstd * (1.f / 127.f); }
}
__device__ __forceinline__ void sincos_d(double a, float& sn, float& cs) {
    const double PI = 3.14159265358979323846;
    const double k = rint(a / PI); const double r = a - k * PI; const double r2 = r * r;
    double s = 1.0, c = 1.0, ts = 1.0, tc = 1.0;
#pragma unroll
    for (int i = 1; i <= 11; ++i) { tc *= -r2 / (double)((2 * i - 1) * (2 * i)); ts *= -r2 / (double)((2 * i) * (2 * i + 1)); c += tc; s += ts; }
    s *= r;
    const bool odd = ((long long)k) & 1;
    sn = (float)(odd ? -s : s); cs = (float)(odd ? -c : c);
}

struct Ptrs {
    const float* in[19]; float* out; unsigned char* ws;
};

__device__ __forceinline__ const bf16* rowptr(const bf16* P, const bf16* Pm, int b, int t) {
    return t < NMETA ? Pm + (size_t)t * NIN : P + (size_t)(b * SEQ + t - NMETA) * NIN;
}

__device__ __forceinline__ float dpp_shr(float v, int n) {
    const int x = __float_as_int(v); int r;
    if (n == 1) r = __builtin_amdgcn_update_dpp(0, x, 0x111, 0xf, 0xf, true); else if (n == 2) r = __builtin_amdgcn_update_dpp(0, x, 0x112, 0xf, 0xf, true);
    else if (n == 4) r = __builtin_amdgcn_update_dpp(0, x, 0x114, 0xf, 0xf, true); else r = __builtin_amdgcn_update_dpp(0, x, 0x118, 0xf, 0xf, true);
    return __int_as_float(r);
}
template <bool QK_ONLY>
struct EpiProjT {
    static constexpr bool PERM = true, AFTER_DRAIN = false, INIT = false;
    bf16* O; const float* qn; const float* kn; const float* rope; const float* hlb; float* dec; int pn0; float oscale; const float* su; const float* sw;
    __device__ __forceinline__ float val(float a, float rs, float cs) const { return su ? (float)__float_as_int(a) * (rs * cs) : a * oscale; }
    __device__ __forceinline__ void operator()(const pg8::f32x4 (&acc)[2][2][4][2], const pg8::Unit& u, int wr, int wc, int fr_, int fq_) const {
        const int fr = opaque_v(fr_), fq = opaque_v(fq_);
        const int row0 = u.pm * 256 + wr * 64 + fr, pn = u.pn + pn0;
        if constexpr (QK_ONLY) {
            const bool isk = pn >= 8; const int h = 2 * (pn & 7) + (wc >> 1), cm = wc & 1; const float* wv = isk ? kn : qn;
            float w0[8], w1[8], cq0[8], cq1[8];
#pragma unroll
            for (int j = 0; j < 8; ++j) { w0[j] = wv[16 * fq + j]; w1[j] = wv[16 * fq + 8 + j]; cq0[j] = su ? sw[pn * 256 + 32 * wc + 8 * fq + j] : 1.f; cq1[j] = su ? sw[pn * 256 + 128 + 32 * wc + 8 * fq + j] : 1.f; }
            bf16* obase = O + (isk ? C_K : C_Q) + h * 128 + cm * 64 + 16 * fq;
#pragma unroll
            for (int ai = 0; ai < 2; ++ai)
#pragma unroll
                for (int m = 0; m < 4; ++m) { const int row = row0 + ai * 128 + m * 16;
                    float x0[8], x1[8]; float ss = 0.f;
                    const float rs_ = su ? su[row] : 1.f;
#pragma unroll
                    for (int j = 0; j < 8; ++j) { x0[j] = val(acc[ai][0][m][j >> 2][j & 3], rs_, cq0[j]); x1[j] = val(acc[ai][1][m][j >> 2][j & 3], rs_, cq1[j]); ss += x0[j] * x0[j] + x1[j] * x1[j]; }
                    ss += __shfl_xor(ss, 16); ss += __shfl_xor(ss, 32);
                    const float rstd = 1.f / sqrtf(ss * (1.f / 64.f) + EPS);
                    const float* rp = rope + (NMETA + (row & (SEQ - 1))) * 16;
                    const f32x4 c0 = *(const GAS f32x4*)rp, c1 = *(const GAS f32x4*)(rp + 4), s0 = *(const GAS f32x4*)(rp + 8), s1 = *(const GAS f32x4*)(rp + 12);
                    const float cs[8] = {c0.x, c0.y, c0.z, c0.w, c1.x, c1.y, c1.z, c1.w}, sn[8] = {s0.x, s0.y, s0.z, s0.w, s1.x, s1.y, s1.z, s1.w};
                    float o0[8], o1[8];
#pragma unroll
                    for (int j = 0; j < 8; ++j) { const float a = x0[j] * rstd * w0[j], bb = x1[j] * rstd * w1[j];
                        float r0 = a, r1 = bb; if (fq == 0) { r0 = a * cs[j] - bb * sn[j]; r1 = bb * cs[j] + a * sn[j]; }
                        o0[j] = isk ? r0 : r0 * C2; o1[j] = isk ? r1 : r1 * C2; }
                    v4u wa, wb; wa.x = pg8::cvt_pk_bf16(o0[0], o0[1]); wa.y = pg8::cvt_pk_bf16(o0[2], o0[3]); wa.z = pg8::cvt_pk_bf16(o0[4], o0[5]); wa.w = pg8::cvt_pk_bf16(o0[6], o0[7]);
                    wb.x = pg8::cvt_pk_bf16(o1[0], o1[1]); wb.y = pg8::cvt_pk_bf16(o1[2], o1[3]); wb.z = pg8::cvt_pk_bf16(o1[4], o1[5]); wb.w = pg8::cvt_pk_bf16(o1[6], o1[7]);
                    bf16* op = obase + (size_t)row * NIN; *(v4u*)op = wa; *(v4u*)(op + 8) = wb; }
        } else { if (pn >= 24 && pn < 40) {
            const int h = pn - 24, d0 = 32 * wc + 8 * fq, colg = h * 128 + d0; const int lane15 = (fq << 4) | 15;
            float lb[8], cq[8], cf[8];
#pragma unroll
            for (int j = 0; j < 8; ++j) { cq[j] = su ? sw[pn * 256 + d0 + j] : 1.f; cf[j] = su ? sw[pn * 256 + 128 + d0 + j] : 1.f; }
#pragma unroll
            for (int j = 0; j < 8; ++j) { const float a = hlb[colg + j], c = hlb[WHD + colg + j]; lb[j] = 1.f / (1.f + __expf(c - a)); }
#pragma unroll
            for (int ai = 0; ai < 2; ++ai) {
                const int rowc = u.pm * 256 + ai * 128 + wr * 64, cj = (rowc >> 11) * 32 + ((rowc & (SEQ - 1)) >> 6);
                unsigned qd[4][4], ki[4][4]; float tot[8]; float rsm[4];
#pragma unroll
                for (int m = 0; m < 4; ++m) rsm[m] = su ? su[row0 + ai * 128 + m * 16] : 1.f;
#pragma unroll
                for (int jp = 0; jp < 4; ++jp) {
                    float qv[2][4], kv[2][4];
#pragma unroll
                    for (int jj = 0; jj < 2; ++jj) { const int j = 2 * jp + jj;
                        float f[4], s[4];
#pragma unroll
                        for (int m = 0; m < 4; ++m) { f[m] = lb[j] + (1.f - lb[j]) * sigmoidf_(val(acc[ai][1][m][j >> 2][j & 3], rsm[m], cf[j])); float g = __logf(f[m]);
                            g += dpp_shr(g, 1); g += dpp_shr(g, 2); g += dpp_shr(g, 4); g += dpp_shr(g, 8); s[m] = g; }
                        float carry = 0.f;
#pragma unroll
                        for (int m = 0; m < 4; ++m) { const float bcur = s[m] + carry; carry += __shfl(s[m], lane15); s[m] = bcur; }
                        tot[j] = carry;
#pragma unroll
                        for (int m = 0; m < 4; ++m) { qv[jj][m] = val(acc[ai][0][m][j >> 2][j & 3], rsm[m], cq[j]) * __expf(s[m]); kv[jj][m] = (1.f - f[m]) * __expf(-s[m]); }
                    }
#pragma unroll
                    for (int m = 0; m < 4; ++m) { qd[m][jp] = pg8::cvt_pk_bf16(qv[0][m], qv[1][m]); ki[m][jp] = pg8::cvt_pk_bf16(kv[0][m], kv[1][m]); }
                }
#pragma unroll
                for (int m = 0; m < 4; ++m) { bf16* op = O + (size_t)(row0 + ai * 128 + m * 16) * NIN + colg;
                    *(v4u*)(op + C_HQ) = (v4u){qd[m][0], qd[m][1], qd[m][2], qd[m][3]}; *(v4u*)(op + C_HF) = (v4u){ki[m][0], ki[m][1], ki[m][2], ki[m][3]}; }
                if (fr == 15) { float* dp = dec + (size_t)cj * WHD + colg;
                    *(f32x4*)dp = (f32x4){__expf(tot[0]), __expf(tot[1]), __expf(tot[2]), __expf(tot[3])}; *(f32x4*)(dp + 4) = (f32x4){__expf(tot[4]), __expf(tot[5]), __expf(tot[6]), __expf(tot[7])}; }
            }
        } else {
            const int col0 = pn * 256 + wc * 32 + 8 * fq; const bool sg = pn >= 56;
            float cw[2][8];
#pragma unroll
            for (int bj = 0; bj < 2; ++bj)
#pragma unroll
                for (int j = 0; j < 8; ++j) cw[bj][j] = su ? sw[col0 + bj * 128 + j] : 1.f;
#pragma unroll
            for (int ai = 0; ai < 2; ++ai)
#pragma unroll
                for (int m = 0; m < 4; ++m) { bf16* rowp = O + (size_t)(row0 + ai * 128 + m * 16) * NIN + col0; const float rs_ = su ? su[row0 + ai * 128 + m * 16] : 1.f;
#pragma unroll
                    for (int bj = 0; bj < 2; ++bj) { pg8::f32x4 v0, v1;
#pragma unroll
                        for (int e = 0; e < 4; ++e) { v0[e] = val(acc[ai][bj][m][0][e], rs_, cw[bj][e]); v1[e] = val(acc[ai][bj][m][1][e], rs_, cw[bj][4 + e]); }
                        if (sg) { for (int e = 0; e < 4; ++e) { v0[e] = sigmoidf_(v0[e]); v1[e] = sigmoidf_(v1[e]); } }
                        v4u w; w.x = pg8::cvt_pk_bf16(v0[0], v0[1]); w.y = pg8::cvt_pk_bf16(v0[2], v0[3]); w.z = pg8::cvt_pk_bf16(v1[0], v1[1]); w.w = pg8::cvt_pk_bf16(v1[2], v1[3]);
                        *(v4u*)(rowp + bj * 128) = w; } }
        } }
    }
};
struct HalfOrder : pg8::StaticOrder {
    static constexpr int KLOOP = WHD;
    __device__ __forceinline__ bool next(int i, pg8::Unit& u) const { if (!pg8::StaticOrder::next(i >> 1, u)) return false; u.pn |= (i & 1) << 16; return true; }
    __device__ __forceinline__ size_t kofs(const pg8::Unit& u) const { return (size_t)(u.pn >> 16) * (size_t)(WHD * 2); }
    __device__ __forceinline__ bool zero_after(const pg8::Unit& u) const { return (u.pn >> 16) != 0; }
};
struct EpiUp {
    static constexpr bool PERM = true, AFTER_DRAIN = false, INIT = false;
    const bf16* P; bf16* MG;
    __device__ __forceinline__ void operator()(pg8::f32x4 (&acc)[2][2][4][2], const pg8::Unit& u, int wr, int wc, int fr, int fq) const {
        const int pn = u.pn & 0xffff; const bool second = (u.pn >> 16) != 0;
        const int row0 = u.pm * 256 + wr * 64 + fr, col0 = pn * 256 + wc * 32 + 8 * fq;
#pragma unroll
        for (int ai = 0; ai < 2; ++ai)
#pragma unroll
            for (int m = 0; m < 4; ++m) { const int row = row0 + ai * 128 + m * 16;
#pragma unroll
                for (int bj = 0; bj < 2; ++bj) { const int col = col0 + bj * 128;
                    const v4u gb = *(const GAS v4u*)(P + (size_t)row * NIN + C_GB + col);
                    pg8::f32x4& v0 = acc[ai][bj][m][0]; pg8::f32x4& v1 = acc[ai][bj][m][1];
                    if (!second) { const v4u ga = *(const GAS v4u*)(P + (size_t)row * NIN + C_GA + col);
                        v0[0] *= bflo(ga.x) * __builtin_amdgcn_rcpf(bflo(gb.x)); v0[1] *= bfhi(ga.x) * __builtin_amdgcn_rcpf(bfhi(gb.x)); v0[2] *= bflo(ga.y) * __builtin_amdgcn_rcpf(bflo(gb.y)); v0[3] *= bfhi(ga.y) * __builtin_amdgcn_rcpf(bfhi(gb.y));
                        v1[0] *= bflo(ga.z) * __builtin_amdgcn_rcpf(bflo(gb.z)); v1[1] *= bfhi(ga.z) * __builtin_amdgcn_rcpf(bfhi(gb.z)); v1[2] *= bflo(ga.w) * __builtin_amdgcn_rcpf(bflo(gb.w)); v1[3] *= bfhi(ga.w) * __builtin_amdgcn_rcpf(bfhi(gb.w));
                    } else {
                        v4u w; w.x = pg8::cvt_pk_bf16(v0[0] * bflo(gb.x), v0[1] * bfhi(gb.x)); w.y = pg8::cvt_pk_bf16(v0[2] * bflo(gb.y), v0[3] * bfhi(gb.y));
                        w.z = pg8::cvt_pk_bf16(v1[0] * bflo(gb.z), v1[1] * bfhi(gb.z)); w.w = pg8::cvt_pk_bf16(v1[2] * bflo(gb.w), v1[3] * bfhi(gb.w));
                        *(v4u*)(MG + (size_t)row * DM + col) = w; } } }
    }
};
struct EpiOut {
    static constexpr bool PERM = true, AFTER_DRAIN = false, INIT = true;
    const float* X; bf16* H1b; float* SSQ;
    __device__ __forceinline__ void init(pg8::f32x4 (&acc)[2][2][4][2], const pg8::Unit& u, int wr, int wc, int fr_, int fq_) const {
        const int fr = opaque_v(fr_), fq = opaque_v(fq_);
        const float* xp = X + (size_t)(u.pm * 256 + wr * 64 + fr) * DM + u.pn * 256 + wc * 32 + 8 * fq;
#pragma unroll
        for (int ai = 0; ai < 2; ++ai)
#pragma unroll
            for (int bj = 0; bj < 2; ++bj)
#pragma unroll
                for (int m = 0; m < 4; ++m) { const float* q = xp + (size_t)(ai * 128 + m * 16) * DM + bj * 128;
                    acc[ai][bj][m][0] = __builtin_nontemporal_load((const pg8::f32x4*)q); acc[ai][bj][m][1] = __builtin_nontemporal_load((const pg8::f32x4*)(q + 4)); }
    }
    __device__ __forceinline__ void operator()(const pg8::f32x4 (&acc)[2][2][4][2], const pg8::Unit& u, int wr, int wc, int fr, int fq) const {
        const int row0 = u.pm * 256 + wr * 64 + fr, col0 = u.pn * 256 + wc * 32 + 8 * fq;
#pragma unroll
        for (int ai = 0; ai < 2; ++ai)
#pragma unroll
            for (int m = 0; m < 4; ++m) { const int row = row0 + ai * 128 + m * 16; float ss = 0.f;
#pragma unroll
                for (int bj = 0; bj < 2; ++bj) { const int col = col0 + bj * 128; const size_t off = (size_t)row * DM + col;
                    const pg8::f32x4 h0 = acc[ai][bj][m][0], h1 = acc[ai][bj][m][1];
                    ss += (h0[0] * h0[0] + h0[1] * h0[1]) + (h0[2] * h0[2] + h0[3] * h0[3]) + (h1[0] * h1[0] + h1[1] * h1[1]) + (h1[2] * h1[2] + h1[3] * h1[3]);
                    v4u w; w.x = pg8::cvt_pk_bf16(h0[0], h0[1]); w.y = pg8::cvt_pk_bf16(h0[2], h0[3]); w.z = pg8::cvt_pk_bf16(h1[0], h1[1]); w.w = pg8::cvt_pk_bf16(h1[2], h1[3]);
                    *(v4u*)(H1b + off) = w; }
                ss += __shfl_xor(ss, 16); ss += __shfl_xor(ss, 32);
                if (fq == 0) SSQ[(size_t)row * 64 + u.pn * 4 + wc] = ss; }
    }
};
struct EpiFf1 {
    static constexpr bool PERM = true, AFTER_DRAIN = false, INIT = false;
    bf16* H;
    __device__ __forceinline__ void operator()(const pg8::f32x4 (&acc)[2][2][4][2], const pg8::Unit& u, int wr, int wc, int fr, int fq) const {
        const int row0 = u.pm * 256 + wr * 64 + fr, col0 = u.pn * 256 + wc * 32 + 8 * fq;
#pragma unroll
        for (int ai = 0; ai < 2; ++ai)
#pragma unroll
            for (int m = 0; m < 4; ++m) { const int row = row0 + ai * 128 + m * 16;
#pragma unroll
                for (int bj = 0; bj < 2; ++bj) { pg8::f32x4 v0 = acc[ai][bj][m][0], v1 = acc[ai][bj][m][1];
#pragma unroll
                    for (int e = 0; e < 4; ++e) { const float a = fmaxf(v0[e], 0.f), b = fmaxf(v1[e], 0.f); v0[e] = a * a; v1[e] = b * b; }
                    v4u w; w.x = pg8::cvt_pk_bf16(v0[0], v0[1]); w.y = pg8::cvt_pk_bf16(v0[2], v0[3]); w.z = pg8::cvt_pk_bf16(v1[0], v1[1]); w.w = pg8::cvt_pk_bf16(v1[2], v1[3]);
                    *(v4u*)(H + (size_t)row * DFF + col0 + bj * 128) = w; } }
    }
};
struct EpiFf2 {
    static constexpr bool PERM = false, AFTER_DRAIN = false, INIT = true;
    float* O; const float* RSTD; const bf16* H1b;
    __device__ __forceinline__ void init(pg8::f32x4 (&acc)[2][2][4][2], const pg8::Unit& u, int wr, int wc, int fr_, int fq_) const {
        const int fr = opaque_v(fr_), fq = opaque_v(fq_);
        const int row0 = u.pm * 256 + wr * 64 + fr, col0 = u.pn * 256 + wc * 32 + 4 * fq;
#pragma unroll
        for (int ai = 0; ai < 2; ++ai)
#pragma unroll
            for (int bj = 0; bj < 2; ++bj)
#pragma unroll
                for (int m = 0; m < 4; ++m) { const int row = row0 + ai * 128 + m * 16; const float rs = RSTD[row], ir2 = 1.f / (rs * rs); const bf16* rowp = H1b + (size_t)row * DM + col0 + bj * 128;
#pragma unroll
                    for (int n = 0; n < 2; ++n) { const unsigned long long w = *(const GAS unsigned long long*)(rowp + n * 16); const unsigned lo = (unsigned)w, hh = (unsigned)(w >> 32);
                        acc[ai][bj][m][n] = (pg8::f32x4){bflo(lo) * ir2, bfhi(lo) * ir2, bflo(hh) * ir2, bfhi(hh) * ir2}; } }
    }
    __device__ __forceinline__ void operator()(const pg8::f32x4 (&acc)[2][2][4][2], const pg8::Unit& u, int wr, int wc, int fr, int fq) const {
        const int row0 = u.pm * 256 + wr * 64 + fr, col0 = u.pn * 256 + wc * 32 + 4 * fq;
#pragma unroll
        for (int ai = 0; ai < 2; ++ai)
#pragma unroll
            for (int m = 0; m < 4; ++m) { const int row = row0 + ai * 128 + m * 16; const float rs = RSTD[row], r2 = rs * rs; float* rowp = O + (size_t)row * DM + col0;
#pragma unroll
                for (int bj = 0; bj < 2; ++bj)
#pragma unroll
                    for (int n = 0; n < 2; ++n) __builtin_nontemporal_store(acc[ai][bj][m][n] * r2, (pg8::f32x4*)(rowp + bj * 128 + n * 16)); }
    }
};

constexpr int NCONV = 96;
namespace da {
typedef float f32x16 __attribute__((ext_vector_type(16)));
typedef short s16x4 __attribute__((ext_vector_type(4)));
constexpr int KBUF = 16384, VBUF = 16384, K_OFF = 0, V_OFF = 32768;
__device__ __forceinline__ int crow(int r, int hi) { return (r & 3) + 8 * (r >> 2) + 4 * hi; }
__device__ __forceinline__ int kswz(int row, int colB) { return row * 256 + (colB ^ ((row & 7) << 4)); }
__device__ __forceinline__ int v_st(int k, int c) { return ((k >> 3) * 4 + (c >> 5)) * 512 + ((k & 7) * 32 + (c & 31)) * 2; }
__device__ __forceinline__ int v_rd_base(int lane) { return ((lane & 3) << 3) | (((lane >> 2) & 3) << 6) | (((lane >> 4) & 1) << 5) | (((lane >> 5) & 1) << 8); }
__device__ __forceinline__ s16x4 vtr(LAS const unsigned char* p) { return __builtin_bit_cast(s16x4, __builtin_amdgcn_ds_read_tr16_b64_v4i16((LAS s16x4*)p)); }
__device__ __forceinline__ float pl_max(float v) { auto rr = __builtin_amdgcn_permlane32_swap(__float_as_uint(v), __float_as_uint(v), false, false); return fmaxf(__uint_as_float(rr[0]), __uint_as_float(rr[1])); }
__device__ __forceinline__ float pl_sum(float v) { auto rr = __builtin_amdgcn_permlane32_swap(__float_as_uint(v), __float_as_uint(v), false, false); return __uint_as_float(rr[0]) + __uint_as_float(rr[1]); }
__device__ __forceinline__ bf16x8 pack8(const f32x16& p, int base) {
    v4u w; w.x = pg8::cvt_pk_bf16(p[base + 0], p[base + 1]); w.y = pg8::cvt_pk_bf16(p[base + 2], p[base + 3]); w.z = pg8::cvt_pk_bf16(p[base + 4], p[base + 5]); w.w = pg8::cvt_pk_bf16(p[base + 6], p[base + 7]);
    return __builtin_bit_cast(bf16x8, w);
}
__device__ __forceinline__ void qk(f32x16& p0, f32x16& p1, LAS const unsigned char* Kb, LAS const unsigned char* Qw, float negm, int c, int r32, int hi) {
#pragma unroll
    for (int r = 0; r < 16; ++r) { p0[r] = negm; p1[r] = negm; }
#pragma unroll
    for (int d0 = 0; d0 < 4; ++d0) { const int cb = (c * 64 + d0 * 16 + hi * 8) * 2;
        const bf16x8 b0 = *(LAS const bf16x8*)(Kb + kswz(r32, cb)), b1 = *(LAS const bf16x8*)(Kb + kswz(32 + r32, cb)), qf = *(LAS const bf16x8*)(Qw + d0 * 1024);
        p0 = __builtin_amdgcn_mfma_f32_32x32x16_bf16(b0, qf, p0, 0, 0, 0); p1 = __builtin_amdgcn_mfma_f32_32x32x16_bf16(b1, qf, p1, 0, 0, 0); }
}
__device__ __forceinline__ void mask_diag(f32x16& p0, f32x16& p1, int hi, int rel) {
#pragma unroll
    for (int r = 0; r < 16; ++r) { if (crow(r, hi) > rel) p0[r] = -1e30f; if (32 + crow(r, hi) > rel) p1[r] = -1e30f; }
}
__device__ __forceinline__ void partB(f32x16& p0, f32x16& p1, float& l_part, bf16x8 (&pb)[4]) {
    float ps = 0.f;
#pragma unroll
    for (int r = 0; r < 16; ++r) { p0[r] = __builtin_amdgcn_exp2f(p0[r]); p1[r] = __builtin_amdgcn_exp2f(p1[r]); ps += p0[r] + p1[r]; }
    l_part += ps;
    pb[0] = pack8(p0, 0); pb[1] = pack8(p0, 8); pb[2] = pack8(p1, 0); pb[3] = pack8(p1, 8);
}
__device__ __forceinline__ void pv(f32x16 (&o)[4], LAS const unsigned char* Vb, const bf16x8 (&pb)[4], int lane) {
    LAS const unsigned char* vb = Vb + v_rd_base(lane);
#pragma unroll
    for (int d0 = 0; d0 < 4; ++d0) {
        s16x4 lo[4], hh[4];
#pragma unroll
        for (int ks = 0; ks < 4; ++ks) { lo[ks] = vtr(vb + d0 * 512 + ks * 4096); hh[ks] = vtr(vb + d0 * 512 + ks * 4096 + 2048); }
#pragma unroll
        for (int ks = 0; ks < 4; ++ks) {
            const bf16x8 a = (bf16x8){lo[ks][0], lo[ks][1], lo[ks][2], lo[ks][3], hh[ks][0], hh[ks][1], hh[ks][2], hh[ks][3]};
            o[d0] = __builtin_amdgcn_mfma_f32_32x32x16_bf16(a, pb[ks], o[d0], 0, 0, 0); }
    }
}
__device__ __forceinline__ void meta_tile(LAS const unsigned char* Kb, LAS const unsigned char* Vb, LAS const unsigned char* Qw, f32x16 (&o)[4], float& l_part, float negm, int c, int r32, int hi, int lane) {
    f32x16 p0;
#pragma unroll
    for (int r = 0; r < 16; ++r) p0[r] = negm;
#pragma unroll
    for (int d0 = 0; d0 < 4; ++d0) { const int cb = (c * 64 + d0 * 16 + hi * 8) * 2;
        p0 = __builtin_amdgcn_mfma_f32_32x32x16_bf16(*(LAS const bf16x8*)(Kb + kswz(r32, cb)), *(LAS const bf16x8*)(Qw + d0 * 1024), p0, 0, 0, 0); }
    float ps = 0.f;
#pragma unroll
    for (int r = 0; r < 16; ++r) { p0[r] = (crow(r, hi) >= NMETA) ? 0.f : __builtin_amdgcn_exp2f(p0[r]); ps += p0[r]; }
    l_part += ps;
    const bf16x8 pb0 = pack8(p0, 0);
    LAS const unsigned char* vb = Vb + v_rd_base(lane);
#pragma unroll
    for (int d0 = 0; d0 < 4; ++d0) { const s16x4 lo = vtr(vb + d0 * 512), hh = vtr(vb + d0 * 512 + 2048);
        o[d0] = __builtin_amdgcn_mfma_f32_32x32x16_bf16((bf16x8){lo[0], lo[1], lo[2], lo[3], hh[0], hh[1], hh[2], hh[3]}, pb0, o[d0], 0, 0, 0); }
}
constexpr int KB3 = 0, VB3 = 49152, QFR = 98304, MKB = 131072, MVB = 139264;
__device__ __forceinline__ void glds16(const void* g, unsigned lds_base) {
    unsigned sv; asm volatile("s_mov_b32 %0, m0\n\ts_mov_b32 m0, %2\n\ts_nop 0\n\tglobal_load_lds_dwordx4 %1, off\n\ts_mov_b32 m0, %0" : "=&s"(sv) : "v"(g), "s"(lds_base) : "memory"); }
__device__ __forceinline__ void dma_tile(LAS unsigned char* lds, int buf, const bf16* tile0, int wave, int lane_) {
    const int lane = opaque_v(lane_);
    LAS unsigned char* dst = lds + (wave < 4 ? KB3 + buf * KBUF + wave * 4096 : VB3 + buf * VBUF + (wave - 4) * 4096);
#pragma unroll
    for (int i = 0; i < 4; ++i) {
        unsigned off;
        if (wave < 4) { const int p = 4 * wave + i, row = 4 * p + (lane >> 4), colB = ((lane & 15) ^ (row & 7)) << 4; off = (unsigned)(row * NIN + C_K + (colB >> 1)); }
        else { const int p = 4 * (wave - 4) + i, st = 2 * p + (lane >> 5), key = (st >> 2) * 8 + ((lane & 31) >> 2), col = (st & 3) * 32 + (lane & 3) * 8; off = (unsigned)(key * NIN + C_V + col); }
        glds16(tile0 + off, (unsigned)__builtin_amdgcn_readfirstlane((int)(unsigned)(size_t)(dst + i * 1024))); }
}
typedef __bf16 bf16v2_ __attribute__((ext_vector_type(2)));
__device__ __forceinline__ unsigned cvt2(float lo, float hi) { const pg8::f32x2 v = {lo, hi}; return __builtin_bit_cast(unsigned, __builtin_convertvector(v, bf16v2_)); }
#define ATT_SBAR() __builtin_amdgcn_sched_barrier(0)
#define ATT_PIN(x) asm volatile("" : "+v"(x))
__device__ __forceinline__ void fast_step(f32x16 (&o)[4], f32x16& s0, f32x16& s1, float& l_part, const f32x16& negm16, LAS const unsigned char* Vslot, LAS const unsigned char* Kb, LAS const unsigned char* Qw, int c, int r32, int hi, int lane) {
    LAS const unsigned char* vb = Vslot + v_rd_base(lane);
    float ps = 0.f; unsigned pk[4], pn[4];
#pragma unroll
    for (int i = 0; i < 4; ++i) { const float x = __builtin_amdgcn_exp2f(s0[2 * i]), y = __builtin_amdgcn_exp2f(s0[2 * i + 1]); ps += x; ps += y; pk[i] = cvt2(x, y); }
    s16x4 va[8], vn[8];
#pragma unroll
    for (int d0 = 0; d0 < 4; ++d0) { va[2 * d0] = vtr(vb + d0 * 512); va[2 * d0 + 1] = vtr(vb + d0 * 512 + 2048); }
    bf16x8 kb0[4], kb1[4], qf[4];
    ATT_SBAR();
#pragma unroll
    for (int ch = 0; ch < 4; ++ch) {
        const bf16x8 pbc = __builtin_bit_cast(bf16x8, ((v4u){pk[0], pk[1], pk[2], pk[3]}));
#pragma unroll
        for (int d0 = 0; d0 < 4; ++d0) {
            const bf16x8 a = (bf16x8){va[2 * d0][0], va[2 * d0][1], va[2 * d0][2], va[2 * d0][3], va[2 * d0 + 1][0], va[2 * d0 + 1][1], va[2 * d0 + 1][2], va[2 * d0 + 1][3]};
            o[d0] = __builtin_amdgcn_mfma_f32_32x32x16_bf16(a, pbc, o[d0], 0, 0, 0);
            if (ch < 3) {
                const int nb = ((ch + 1) & 1) * 8 + 2 * d0;
                const float x = __builtin_amdgcn_exp2f((ch + 1 < 2) ? s0[nb] : s1[nb]), y = __builtin_amdgcn_exp2f((ch + 1 < 2) ? s0[nb + 1] : s1[nb + 1]);
                ps += x; ps += y; pn[d0] = cvt2(x, y);
                vn[2 * d0] = vtr(vb + d0 * 512 + (ch + 1) * 4096); vn[2 * d0 + 1] = vtr(vb + d0 * 512 + (ch + 1) * 4096 + 2048);
                ATT_PIN(pn[d0]); ATT_PIN(ps);
            } else {
                const int cb = (c * 64 + d0 * 16 + hi * 8) * 2;
                kb0[d0] = *(LAS const bf16x8*)(Kb + kswz(r32, cb)); kb1[d0] = *(LAS const bf16x8*)(Kb + kswz(32 + r32, cb)); qf[d0] = *(LAS const bf16x8*)(Qw + d0 * 1024);
            }
            ATT_SBAR();
        }
        if (ch < 3) {
#pragma unroll
            for (int i = 0; i < 4; ++i) pk[i] = pn[i];
#pragma unroll
            for (int i = 0; i < 8; ++i) va[i] = vn[i];
        }
    }
    l_part += ps;
    s0 = __builtin_amdgcn_mfma_f32_32x32x16_bf16(kb0[0], qf[0], negm16, 0, 0, 0); s1 = __builtin_amdgcn_mfma_f32_32x32x16_bf16(kb1[0], qf[0], negm16, 0, 0, 0);
#pragma unroll
    for (int d0 = 1; d0 < 4; ++d0) { s0 = __builtin_amdgcn_mfma_f32_32x32x16_bf16(kb0[d0], qf[d0], s0, 0, 0, 0); s1 = __builtin_amdgcn_mfma_f32_32x32x16_bf16(kb1[d0], qf[d0], s1, 0, 0, 0); }
}
__device__ __forceinline__ void unit(LAS unsigned char* lds, const bf16* P, const bf16* Pm, bf16* YA, const float* subln, const float* kn, const float* rope, float lam, float mfix, int b, int h, int qb, int tid, int wave, int lane_in) {
    const int c = wave >> 2, jw = wave & 3, q0 = qb * 128, NT = 2 * qb + 2;
    const bf16* tb0 = P + (size_t)(b * SEQ) * NIN + h * 128;
    f32x16 o[4] = {}; float l_part = 0.f; const float negm = -mfix;
    { const int lane = lane_in, r32 = lane & 31, hi = lane >> 5;
    dma_tile(lds, 0, tb0, wave, lane); dma_tile(lds, 1, tb0 + (size_t)64 * NIN, wave, lane);
    if (c == 0 && NT > 2) dma_tile(lds, 2, tb0 + (size_t)128 * NIN, wave, lane);
    LAS unsigned char* Qw = lds + QFR + wave * 4096 + lane * 16;
    { const bf16* qp = P + (size_t)(b * SEQ + q0 + jw * 32 + r32) * NIN + C_Q + h * 128 + c * 64 + hi * 8;
#pragma unroll
      for (int d0 = 0; d0 < 4; ++d0) *(LAS bf16x8*)(Qw + d0 * 1024) = *(const GAS bf16x8*)(qp + d0 * 16); }
    { const int sr = tid >> 4, sc = (tid & 15) * 8, mr = sr & 15;
      if (tid < 256) {
          const v4u raw = *(const GAS v4u*)(Pm + (size_t)mr * NIN + C_K + h * 128 + sc); const int sub = tid & 7;
          float xv[8] = {bflo(raw.x), bfhi(raw.x), bflo(raw.y), bfhi(raw.y), bflo(raw.z), bfhi(raw.z), bflo(raw.w), bfhi(raw.w)};
          float ss = 0.f;
#pragma unroll
          for (int j = 0; j < 8; ++j) ss += xv[j] * xv[j];
          ss += __shfl_xor(ss, 1); ss += __shfl_xor(ss, 2); ss += __shfl_xor(ss, 4);
          const float rstd = 1.f / sqrtf(ss * (1.f / 64.f) + EPS); float ov[8];
#pragma unroll
          for (int j = 0; j < 8; ++j) { const float xn = xv[j] * rstd * kn[sub * 8 + j], pr = __shfl_xor(xn, 1), cs = rope[mr * 16 + j], sn = rope[mr * 16 + 8 + j];
              ov[j] = (sub == 0) ? xn * cs - pr * sn : (sub == 1) ? xn * cs + pr * sn : xn; }
          v4u v; v.x = pk2(ov[0], ov[1]); v.y = pk2(ov[2], ov[3]); v.z = pk2(ov[4], ov[5]); v.w = pk2(ov[6], ov[7]);
          *(LAS v4u*)(lds + MKB + kswz(mr, sc * 2)) = v; }
      else           { const v4u v = *(const GAS v4u*)(Pm + (size_t)mr * NIN + C_V + h * 128 + sc); *(LAS v4u*)(lds + MVB + v_st(mr, sc)) = v; } }
    asm volatile("s_waitcnt vmcnt(0)" ::: "memory"); __syncthreads();
    meta_tile(lds + MKB, lds + MVB, Qw, o, l_part, negm, c, r32, hi, lane);
    f32x16 s0, s1;
    qk(s0, s1, lds + KB3, Qw, negm, c, r32, hi);
    if (qb == 0) mask_diag(s0, s1, hi, 32 * jw + r32);
    int s_j = 0;
    int j = 0;
    { f32x16 negm16;
#pragma unroll
      for (int r = 0; r < 16; ++r) negm16[r] = negm;
      ATT_PIN(negm16);
#pragma unroll 1
      for (; j < NT - 3; ++j) {
        const int s_j1 = (s_j == 2) ? 0 : s_j + 1, s_j2 = (s_j1 == 2) ? 0 : s_j1 + 1;
        asm volatile("s_waitcnt vmcnt(4) lgkmcnt(0)" ::: "memory"); __builtin_amdgcn_s_barrier(); asm volatile("" ::: "memory");
        if (c == 0) dma_tile(lds, s_j, tb0 + (size_t)(j + 3) * 64 * NIN, wave, lane); else dma_tile(lds, s_j2, tb0 + (size_t)(j + 2) * 64 * NIN, wave, lane);
        fast_step(o, s0, s1, l_part, negm16, lds + VB3 + s_j * VBUF, lds + KB3 + s_j1 * KBUF, Qw, c, r32, hi, lane);
        s_j = s_j1;
      } }
#pragma unroll 1
    for (; j < NT; ++j) {
        const int s_j1 = (s_j == 2) ? 0 : s_j + 1, s_j2 = (s_j1 == 2) ? 0 : s_j1 + 1;
        { if ((c == 0) ? (j + 2 < NT) : (j + 1 < NT)) asm volatile("s_waitcnt vmcnt(4) lgkmcnt(0)" ::: "memory"); else asm volatile("s_waitcnt vmcnt(0) lgkmcnt(0)" ::: "memory");
            __builtin_amdgcn_s_barrier(); asm volatile("" ::: "memory"); }
        if (c == 0) { if (j + 3 < NT) dma_tile(lds, s_j, tb0 + (size_t)(j + 3) * 64 * NIN, wave, lane); }
        else        { if (j + 2 < NT) dma_tile(lds, s_j2, tb0 + (size_t)(j + 2) * 64 * NIN, wave, lane); }
        const int dt = j - 2 * qb, dn = dt + 1;
        const bool act = !(dt == 1 && jw < 2), actn = (j + 1 < NT) && !(dn == 1 && jw < 2);
        if (act) { bf16x8 pb[4]; partB(s0, s1, l_part, pb); pv(o, lds + VB3 + s_j * VBUF, pb, lane); }
        if (actn) { qk(s0, s1, lds + KB3 + s_j1 * KBUF, Qw, negm, c, r32, hi); if (dn >= 0) mask_diag(s0, s1, hi, 32 * jw + r32 - 64 * dn); }
        s_j = s_j1;
    }
    }
    __syncthreads();
    LAS float* ex = (LAS float*)lds;
    const int lane = opaque_v(lane_in), r32 = lane & 31, hi = lane >> 5;
    const float l_reg = pl_sum(l_part);
    if (c == 1) { const float s1x = -lam / l_reg;
#pragma unroll
        for (int d0 = 0; d0 < 4; ++d0)
#pragma unroll
            for (int r = 0; r < 16; ++r) ex[((jw * 4 + d0) * 16 + r) * 64 + lane] = o[d0][r] * s1x; }
    __syncthreads();
    if (c == 0) { const float il = 1.f / l_reg; float ss = 0.f;
#pragma unroll
        for (int d0 = 0; d0 < 4; ++d0)
#pragma unroll
            for (int r = 0; r < 16; ++r) { const float v = o[d0][r] * il + ex[((jw * 4 + d0) * 16 + r) * 64 + lane]; o[d0][r] = v; ss += v * v; }
        ss = pl_sum(ss);
        const float rstd = (1.f - LAM_INIT) / sqrtf(ss * (1.f / 128.f) + EPS);
        bf16* yp = YA + (size_t)(b * SEQ + q0 + jw * 32 + r32) * YP + h * 128;
#pragma unroll
        for (int d0 = 0; d0 < 4; ++d0)
#pragma unroll
            for (int g = 0; g < 4; ++g) { const int e = 32 * d0 + 8 * g + 4 * hi; const f32x4 sw = *(const GAS f32x4*)(subln + e);
                const unsigned w0 = pg8::cvt_pk_bf16(o[d0][4 * g + 0] * rstd * sw.x, o[d0][4 * g + 1] * rstd * sw.y), w1 = pg8::cvt_pk_bf16(o[d0][4 * g + 2] * rstd * sw.z, o[d0][4 * g + 3] * rstd * sw.w);
                *(GAS unsigned long long*)(yp + e) = (unsigned long long)w0 | ((unsigned long long)w1 << 32); }
    }
    __syncthreads();
}
}


namespace hg {
using da::f32x16; using da::s16x4; using da::crow; using da::vtr; using da::pl_sum; using da::pack8;
__device__ __forceinline__ int ioff(int row, int ch) { return 2048 * (row >> 3) + 512 * (ch >> 2) + 64 * (row & 7) + 16 * ((ch & 3) ^ ((row >> 2) & 3)); }
constexpr int QD = 0, KI = 16384, VI = 32768, SI = 49152, DECL = 81920, SSQ = 82432;
__device__ __forceinline__ bf16x8 cat(s16x4 lo, s16x4 hh) { return (bf16x8){lo[0], lo[1], lo[2], lo[3], hh[0], hh[1], hh[2], hh[3]}; }
__device__ __forceinline__ void unit(LAS unsigned char* lds, const bf16* P, const bf16* Pm, bf16* YB, const float* DEC, const float* onorm, const float* hlb, int b, int h, int tid, int wave, int lane) {
    const int r32 = lane & 31, hi = lane >> 5, blk = (lane >> 4) & 1, q4 = (lane & 15) >> 2, p4 = lane & 3;
    const int eb = wave & 3, tb = wave >> 2;
    const int trc = 2 * blk + (p4 >> 1), trb = 8 * (p4 & 1);
#pragma unroll
    for (int i = 0; i < 4; ++i) *(LAS v4u*)(lds + SI + (tid * 4 + i) * 16) = (v4u){0u, 0u, 0u, 0u};
    f32x16 acc0 = {}, acc1 = {};
    const int sr = tid >> 4, sch = tid & 15;
    const v4u z4 = (v4u){0u, 0u, 0u, 0u};
    v4u q0 = z4, q1 = z4, k0 = z4, k1 = z4, v0 = z4, v1 = z4; float dcv = 0.f;
    if (sr < NMETA) { const bf16* mp = Pm + (size_t)sr * NIN + h * 128 + sch * 8; v0 = *(const GAS v4u*)(mp + C_HI); }
    LAS float* dec = (LAS float*)(lds + DECL); LAS float* ssq = (LAS float*)(lds + SSQ);
    if (tid < 128) {
        const int col = h * 128 + tid; const float lb = 1.f / (1.f + __expf(hlb[WHD + col] - hlb[col]));
        float xr[NMETA];
#pragma unroll
        for (int r = 0; r < NMETA; ++r) xr[r] = bf2f(Pm[(size_t)r * NIN + C_HF + col]);
        float run = 0.f;
#pragma unroll
        for (int r = 0; r < NMETA; ++r) { const float f = lb + (1.f - lb) * sigmoidf_(xr[r]); run += __logf(f);
            *(LAS unsigned short*)(lds + KI + ioff(r, tid >> 3) + (tid & 7) * 2) = (unsigned short)f2bf((1.f - f) * __expf(-run)); }
        dec[tid] = __expf(run);
    }
#pragma unroll 1
    for (int n = 0; n <= 32; ++n) {
        { const int o0 = ioff(sr, sch), o1 = ioff(32 + sr, sch);
          *(LAS v4u*)(lds + QD + o0) = q0; *(LAS v4u*)(lds + QD + o1) = q1; if (n > 0 || sr >= NMETA) *(LAS v4u*)(lds + KI + o0) = k0; *(LAS v4u*)(lds + KI + o1) = k1; *(LAS v4u*)(lds + VI + o0) = v0; *(LAS v4u*)(lds + VI + o1) = v1; }
        if (tid < 128 && n > 0) dec[tid] = dcv;
        __syncthreads();
        if (n < 32) {
            const bf16* rp = P + (size_t)(b * SEQ + 64 * n + sr) * NIN + h * 128 + sch * 8; const size_t r32o = (size_t)32 * NIN;
            q0 = *(const GAS v4u*)(rp + C_HQ); q1 = *(const GAS v4u*)(rp + C_HQ + r32o); k0 = *(const GAS v4u*)(rp + C_HF); k1 = *(const GAS v4u*)(rp + C_HF + r32o);
            v0 = *(const GAS v4u*)(rp + C_HI); v1 = *(const GAS v4u*)(rp + C_HI + r32o);
            if (tid < 128) dcv = DEC[(size_t)(b * 32 + n) * WHD + h * 128 + tid];
        }
        unsigned long long gw[4] = {0ull, 0ull, 0ull, 0ull};
        if (n > 0) { const bf16* gp = P + (size_t)(b * SEQ + 64 * (n - 1) + 32 * tb + r32) * NIN + C_HG + h * 128 + 32 * eb + 4 * hi;
#pragma unroll
            for (int g = 0; g < 4; ++g) gw[g] = *(const GAS unsigned long long*)(gp + 8 * g); }
        bf16x8 vf[4];
#pragma unroll
        for (int ks = 0; ks < 4; ++ks) vf[ks] = cat(vtr(lds + VI + ioff(16 * ks + 4 * hi + q4, 4 * eb + trc) + trb), vtr(lds + VI + ioff(16 * ks + 8 + 4 * hi + q4, 4 * eb + trc) + trb));
        f32x16 o = {};
        if (n > 0) {
#pragma unroll
            for (int sb = 0; sb < 2; ++sb) if (sb <= tb) {
                f32x16 X = {};
#pragma unroll
                for (int ds = 0; ds < 8; ++ds) { const bf16x8 A = *(const LAS bf16x8*)(lds + KI + ioff(32 * sb + r32, 2 * ds + hi)), B = *(const LAS bf16x8*)(lds + QD + ioff(32 * tb + r32, 2 * ds + hi));
                    X = __builtin_amdgcn_mfma_f32_32x32x16_bf16(A, B, X, 0, 0, 0); }
                if (sb == tb) {
#pragma unroll
                    for (int r = 0; r < 16; ++r) if (crow(r, hi) > r32) X[r] = 0.f; }
                o = __builtin_amdgcn_mfma_f32_32x32x16_bf16(vf[2 * sb], pack8(X, 0), o, 0, 0, 0);
                o = __builtin_amdgcn_mfma_f32_32x32x16_bf16(vf[2 * sb + 1], pack8(X, 8), o, 0, 0, 0);
            }
#pragma unroll
            for (int ds = 0; ds < 8; ++ds) { const bf16x8 A = cat(vtr(lds + SI + ioff(16 * ds + 8 * hi + q4, 4 * eb + trc) + trb), vtr(lds + SI + ioff(16 * ds + 8 * hi + 4 + q4, 4 * eb + trc) + trb));
                const bf16x8 B = *(const LAS bf16x8*)(lds + QD + ioff(32 * tb + r32, 2 * ds + hi));
                o = __builtin_amdgcn_mfma_f32_32x32x16_bf16(A, B, o, 0, 0, 0); }
            float ss = 0.f;
#pragma unroll
            for (int r = 0; r < 16; ++r) ss += o[r] * o[r];
            ss = pl_sum(ss);
            if (hi == 0) ssq[eb * 64 + 32 * tb + r32] = ss;
        }
#pragma unroll
        for (int ks = 0; ks < 4; ++ks) {
            const bf16x8 B0 = cat(vtr(lds + KI + ioff(16 * ks + 4 * hi + q4, 4 * (2 * tb) + trc) + trb), vtr(lds + KI + ioff(16 * ks + 8 + 4 * hi + q4, 4 * (2 * tb) + trc) + trb));
            const bf16x8 B1 = cat(vtr(lds + KI + ioff(16 * ks + 4 * hi + q4, 4 * (2 * tb + 1) + trc) + trb), vtr(lds + KI + ioff(16 * ks + 8 + 4 * hi + q4, 4 * (2 * tb + 1) + trc) + trb));
            acc0 = __builtin_amdgcn_mfma_f32_32x32x16_bf16(vf[ks], B0, acc0, 0, 0, 0); acc1 = __builtin_amdgcn_mfma_f32_32x32x16_bf16(vf[ks], B1, acc1, 0, 0, 0); }
        { const float d0 = dec[32 * (2 * tb) + r32], d1 = dec[32 * (2 * tb + 1) + r32];
#pragma unroll
          for (int r = 0; r < 16; ++r) { acc0[r] *= d0; acc1[r] *= d1; } }
        __syncthreads();
#pragma unroll
        for (int g = 0; g < 4; ++g) {
            *(LAS unsigned long long*)(lds + SI + ioff(32 * (2 * tb) + r32, 4 * eb + g) + 8 * hi) = (unsigned long long)pg8::cvt_pk_bf16(acc0[4 * g], acc0[4 * g + 1]) | ((unsigned long long)pg8::cvt_pk_bf16(acc0[4 * g + 2], acc0[4 * g + 3]) << 32);
            *(LAS unsigned long long*)(lds + SI + ioff(32 * (2 * tb + 1) + r32, 4 * eb + g) + 8 * hi) = (unsigned long long)pg8::cvt_pk_bf16(acc1[4 * g], acc1[4 * g + 1]) | ((unsigned long long)pg8::cvt_pk_bf16(acc1[4 * g + 2], acc1[4 * g + 3]) << 32); }
        if (n > 0) {
            const int t = 32 * tb + r32; const float tot = (ssq[t] + ssq[64 + t]) + (ssq[128 + t] + ssq[192 + t]);
            const float rstd = 1.f / sqrtf(tot * (1.f / 128.f) + EPS);
            const size_t row = (size_t)(b * SEQ + 64 * (n - 1) + t);
#pragma unroll
            for (int g = 0; g < 4; ++g) { const int e = 32 * eb + 8 * g + 4 * hi;
                const unsigned g01 = (unsigned)gw[g], g23 = (unsigned)(gw[g] >> 32);
                const f32x4 on = *(const GAS f32x4*)(onorm + e);
                const float y0 = o[4 * g] * rstd * on.x * sigmoidf_(bflo(g01)), y1 = o[4 * g + 1] * rstd * on.y * sigmoidf_(bfhi(g01)), y2 = o[4 * g + 2] * rstd * on.z * sigmoidf_(bflo(g23)), y3 = o[4 * g + 3] * rstd * on.w * sigmoidf_(bfhi(g23));
                const unsigned w0 = pg8::cvt_pk_bf16(y0, y1);
                const unsigned w1 = pg8::cvt_pk_bf16(y2, y3);
                *(GAS unsigned long long*)(YB + row * YP + h * 128 + e) = (unsigned long long)w0 | ((unsigned long long)w1 << 32); }
        }
    }
    __syncthreads();
}
}

#define PHASE_PTRS unsigned char* ws = (unsigned char*)ldp(lds, 20); \
    gu32* ctl = (gu32*)(ws + WS_CTL); \
    const float* x = (const float*)ldp(lds, 0); const float* meta = (const float*)ldp(lds, 1); const float* norm_mix = (const float*)ldp(lds, 2); const float* w_in = (const float*)ldp(lds, 3); \
    const float* q_norm = (const float*)ldp(lds, 4); const float* k_norm = (const float*)ldp(lds, 5); \
    const float* lq1 = (const float*)ldp(lds, 6); const float* lk1 = (const float*)ldp(lds, 7); const float* lq2 = (const float*)ldp(lds, 8); const float* lk2 = (const float*)ldp(lds, 9); \
    const float* subln = (const float*)ldp(lds, 10); const float* hg_lb = (const float*)ldp(lds, 11); const float* hg_onorm = (const float*)ldp(lds, 12); \
    const float* w_up_a = (const float*)ldp(lds, 13); const float* w_up_b = (const float*)ldp(lds, 14); const float* w_out = (const float*)ldp(lds, 15); const float* norm_mlp = (const float*)ldp(lds, 16); \
    const float* w_ff1 = (const float*)ldp(lds, 17); const float* w_ff2 = (const float*)ldp(lds, 18); \
    float* out = (float*)ldp(lds, 19); \
    bf16* Wt_in = (bf16*)(ws + WS_WIN); bf16* Wt_upa = (bf16*)(ws + WS_WUPA); bf16* Wt_upb = (bf16*)(ws + WS_WUPB); bf16* Wt_out = (bf16*)(ws + WS_WOUT); \
    bf16* Wt_ff1 = (bf16*)(ws + WS_WFF1); bf16* Wt_ff2 = (bf16*)(ws + WS_WFF2); \
    bf16* U = (bf16*)(ws + WS_U); bf16* Umeta = (bf16*)(ws + WS_UMETA); bf16* Pm = (bf16*)(ws + WS_PM); float* ROPE = (float*)(ws + WS_ROPE); \
    float* RSTD = (float*)(ws + WS_RSTD); float* SSQ = (float*)(ws + WS_SSQ); float* DEC = (float*)(ws + WS_DEC); bf16* P = (bf16*)(ws + WS_P); bf16* HID = (bf16*)(ws + WS_P); \
    unsigned char* U8 = ws + WS_U8; unsigned char* W8 = ws + WS_W8; float* SU = (float*)(ws + WS_SU); float* SW = (float*)(ws + WS_SW); bf16* YA = (bf16*)(ws + WS_YA); bf16* YB = YA + WHD;      bf16* MG = (bf16*)(ws + WS_MG);
__global__ void __launch_bounds__(NWAVES * 64, 2) mk_fwd(Ptrs args) {
    extern __shared__ __attribute__((aligned(16))) unsigned char lds_raw[];
    LAS unsigned char* lds = (LAS unsigned char*)lds_raw;
    volatile LAS unsigned* MISC = (volatile LAS unsigned*)(lds + LDSCTL_OFF);
    const int G = gridDim.x, bx = blockIdx.x;
    const int vcu = (G % 8 == 0) ? (bx % 8) * (G / 8) + bx / 8 : bx;

    { PHASE_IDS
    for (int u = tid; u < (LDS_BYTES - LDSCTL_OFF) / 4; u += NWAVES * 64) ((LAS unsigned*)(lds + LDSCTL_OFF))[u] = 0u;
    __syncthreads();
    if (tid == 0) {
#pragma unroll
        for (int k = 0; k < 21; ++k) { const unsigned long long pv_ = (k < 19) ? (unsigned long long)args.in[k < 19 ? k : 0] : (k == 19 ? (unsigned long long)args.out : (unsigned long long)args.ws);
            MISC[32 + 2 * k] = (unsigned)pv_; MISC[33 + 2 * k] = (unsigned)(pv_ >> 32); } } }
    __syncthreads();
    XcdBarrier bar = xcd_barrier_post((unsigned*)((gu32*)args.ws + CW_BAR), MISC + 8);
    { PHASE_IDS PHASE_PTRS
    if (wave == 0) {
        const float s1 = wave_sum(lq1[lane] * lk1[lane]), s2 = wave_sum(lq2[lane] * lk2[lane]);
        if (lane == 0) ((LAS float*)(lds + LDSCTL_OFF))[16] = expf(s1) - expf(s2) + LAM_INIT;
        const float wqm = wave_max(fabsf(q_norm[lane])), wkm = wave_max(fabsf(k_norm[lane]));
        if (lane == 0) ((LAS float*)(lds + LDSCTL_OFF))[17] = fmaxf(0.f, 64.f * C2 * wqm * wkm - 64.f);
    } }
    __syncthreads();

    { PHASE_IDS PHASE_PTRS
        LAS float* scr = (LAS float*)(lds + wave * 16384);
        const int gw = vcu * NWAVES + wave, NGW = G * NWAVES;
        constexpr int I_QK = (DM / 64) * (NIN / 32);
        for (int it = gw; it < I_QK; it += NGW) p0_transpose_item<true>(w_in, DM, NIN, Wt_in, scr, it, lane);
        for (int m = gw; m < MR + NMETA; m += NGW) {
            if (m < MR) rms_row_to_bf16(x + (size_t)m * DM, norm_mix, nullptr, lane, U8 + (size_t)m * DM, SU + m);
            else rms_row_to_bf16(meta + (size_t)(m - MR) * DM, norm_mix, Umeta + (size_t)(m - MR) * DM, lane);
        }
        const int gt = tid * G + bx;
        if (gt < TT * 8) {
            const int pos = gt >> 3, j = gt & 7;
            const float invf[8] = {1.0f, 0.1939227432012558f, 0.03760603070259094f, 0.007292664609849453f, 0.0014142135623842478f, 0.00027424818836152554f, 5.3182957344688475e-05f, 1.0313385246263351e-05f};
            float inv = invf[0];
#pragma unroll
            for (int q = 1; q < 8; ++q) inv = (j == q) ? invf[q] : inv;
            const float ang = (float)pos * inv; float sn, cs; sincos_d((double)ang, sn, cs);
            ROPE[pos * 16 + j] = cs; ROPE[pos * 16 + 8 + j] = sn;
        }
    }
    xcd_barrier(bar);

    { PHASE_IDS PHASE_PTRS
        const int gw = vcu * NWAVES + wave, NGW = G * NWAVES;
        for (int r = gw; r < NIN; r += NGW) {
            const GAS v4u* rp = (const GAS v4u*)(Wt_in + (size_t)r * DM) + lane; v4u q[8];
#pragma unroll
            for (int j = 0; j < 8; ++j) q[j] = __builtin_nontemporal_load(rp + 64 * j);
            unsigned mb = 0u;
#pragma unroll
            for (int j = 0; j < 8; ++j)
#pragma unroll
                for (int e = 0; e < 4; ++e) { const unsigned w = q[j][e]; const unsigned hi_ = w & 0x7fff0000u, lo_ = (w << 16) & 0x7fff0000u; mb = mb > hi_ ? mb : hi_; mb = mb > lo_ ? mb : lo_; }
            const float cmax = wave_max(__uint_as_float(mb)), inv = cmax > 0.f ? 127.f / cmax : 0.f;
            GAS unsigned long long* op = (GAS unsigned long long*)(W8 + (size_t)r * DM) + lane;
#pragma unroll
            for (int j = 0; j < 8; ++j) op[64 * j] = (unsigned long long)pk4_i8(bflo(q[j].x) * inv, bfhi(q[j].x) * inv, bflo(q[j].y) * inv, bfhi(q[j].y) * inv) | ((unsigned long long)pk4_i8(bflo(q[j].z) * inv, bfhi(q[j].z) * inv, bflo(q[j].w) * inv, bfhi(q[j].w) * inv) << 32);
            if (lane == 0) SW[r] = cmax * (1.f / 127.f);
        }
    }
    xcd_barrier(bar);

    { PHASE_IDS PHASE_PTRS
        { constexpr int UPB = DM * 2 + 16, PART = 16 * UPB;
          for (int i = tid; i < NMETA * DM * 2 / 16; i += NWAVES * 64) { const int r = i >> 9, cch = i & 511; *(LAS v4u*)(lds + r * UPB + cch * 16) = ((const GAS v4u*)Umeta)[i]; }
          __syncthreads();
          const int tsel = wave >> 2, kq = wave & 3, fr = lane & 15, fq = lane >> 4;
#pragma unroll 1
          for (int cb = vcu * 32; cb < 8192; cb += G * 32) {
              const int ci = cb + tsel * 16 + fr; const int c = (ci < 4096) ? (C_K + ci) : (C_HF + (ci - 4096));
              const bf16* wrow = Wt_in + (size_t)wt_row(c) * DM + kq * 1024 + fq * 8;
              LAS const unsigned char* arow = lds + fr * UPB + (kq * 1024 + fq * 8) * 2;
              f32x4 acc = {0.f, 0.f, 0.f, 0.f};
#pragma unroll 1
              for (int kb = 0; kb < 32; kb += 8) {
                  bf16x8 bfr[8];
#pragma unroll
                  for (int i = 0; i < 8; ++i) bfr[i] = *(const GAS bf16x8*)(wrow + (kb + i) * 32);
#pragma unroll
                  for (int i = 0; i < 8; ++i) { const bf16x8 afr = *(LAS const bf16x8*)(arow + (kb + i) * 64); acc = __builtin_amdgcn_mfma_f32_16x16x32_bf16(afr, bfr[i], acc, 0, 0, 0); }
              }
              *(LAS f32x4*)(lds + PART + (wave * 64 + lane) * 16) = acc;
              __syncthreads();
              if (kq == 0) { f32x4 s = acc;
#pragma unroll
                  for (int q = 1; q < 4; ++q) { const f32x4 t = *(LAS const f32x4*)(lds + PART + ((wave + q) * 64 + lane) * 16); s = s + t; }
#pragma unroll
                  for (int reg = 0; reg < 4; ++reg) Pm[(size_t)(4 * fq + reg) * NIN + c] = (bf16)f2bf(s[reg]); }
              __syncthreads();
          }
        }
        { pg8::Gemm g{(const bf16*)U8, (const bf16*)W8, MR, NQK, DM / 2}; pg8::StaticOrder S; S.init(MR, NQK, G, bx);
          EpiProjT<true> E{P, q_norm, k_norm, ROPE, hg_lb, DEC, 0, 1.f, SU, SW};
          pg8::gemm_phase<EpiProjT<true>, pg8::StaticOrder, true, true, false, true>(lds, g, S, E); }
        __syncthreads();
        { pg8::Gemm g{(const bf16*)U8, (const bf16*)(W8 + (size_t)NQK * DM), MR, NIN - NQK, DM / 2}; pg8::StaticOrder S; S.init(MR, NIN - NQK, G, bx);
          EpiProjT<false> E{P, q_norm, k_norm, ROPE, hg_lb, DEC, NQK / 256, 1.f, SU, SW};
          pg8::gemm_phase<EpiProjT<false>, pg8::StaticOrder, true, true, false, true>(lds, g, S, E); }
    }
    xcd_barrier(bar);


    { PHASE_IDS PHASE_PTRS
        { const int nconv = (G > 2 * NCONV) ? NCONV : G, cv = bx - (G - nconv);
          if (cv >= 0) {
              LAS unsigned* scr = (LAS unsigned*)(lds + wave * TSCR_BYTES);
#pragma unroll 1
              for (int it = cv * NWAVES + wave; it < TI_ALL; it += nconv * NWAVES) { const TItem t = t_decode(lds, it); t_convert(t, scr, lane); }
              __syncthreads();
          } }
        gu32* qh_h = ctl + CW_QHEAD; gu32* qh_a = ctl + CW_QHEAD + 64; const float lam = ((volatile LAS float*)(lds + LDSCTL_OFF))[16], mfix = ((volatile LAS float*)(lds + LDSCTL_OFF))[17];
#pragma unroll 1
        for (;;) {
            if (tid == 0) MISC[20] = __hip_atomic_fetch_add(qh_h, 1u, RLX_AGENT);
            __syncthreads();
            const int it = (int)MISC[20];
            __syncthreads();
            if (it >= 64) break;
            hg::unit(lds, P, Pm, YB, DEC, hg_onorm, hg_lb, it >> 4, it & 15, tid, wave, lane);
        }
#pragma unroll 1
        for (;;) {
            if (tid == 0) MISC[20] = __hip_atomic_fetch_add(qh_a, 1u, RLX_AGENT);
            __syncthreads();
            const int u = (int)MISC[20];
            __syncthreads();
            if (u >= NB * NH * 16) break;
            const int qb = 15 - (u >> 6), bh = u & 63;
            da::unit(lds, P, Pm, YA, subln, k_norm, ROPE, lam, mfix, bh >> 4, bh & 15, qb, tid, wave, lane);
        }
    }
    xcd_barrier(bar);

    { PHASE_IDS PHASE_PTRS
        pg8::Gemm g{YA, Wt_upa, MR, DM, YP}; HalfOrder S; S.init(MR, DM, G, bx); EpiUp E{P, MG};
        pg8::gemm_phase<EpiUp, HalfOrder, true, true>(lds, g, S, E);
    }
    xcd_barrier(bar);

    { PHASE_IDS PHASE_PTRS
        pg8::Gemm g{MG, Wt_out, MR, DM, DM}; pg8::StaticOrder S; S.init(MR, DM, G, bx); EpiOut E{x, U, SSQ};
        pg8::gemm_phase<EpiOut, pg8::StaticOrder, true, true>(lds, g, S, E);
    }
    xcd_barrier(bar);

    { PHASE_IDS PHASE_PTRS
        { const int gt = bx * (NWAVES * 64) + tid;
          for (int row = gt; row < MR; row += G * NWAVES * 64) { float s = 0.f;
#pragma unroll
              for (int i = 0; i < 16; ++i) { const f32x4 v = *(const GAS f32x4*)(SSQ + (size_t)row * 64 + i * 4); s += (v.x + v.y) + (v.z + v.w); }
              RSTD[row] = 1.f / sqrtf(s * (1.f / DM) + EPS); } }
        pg8::Gemm g{U, Wt_ff1, MR, DFF, DM}; pg8::StaticOrder S; S.init(MR, DFF, G, bx); EpiFf1 E{HID};
        pg8::gemm_phase<EpiFf1, pg8::StaticOrder, true, true>(lds, g, S, E);
    }
    xcd_barrier(bar);

    { PHASE_IDS PHASE_PTRS
        pg8::Gemm g{HID, Wt_ff2, MR, DM, DFF}; pg8::StaticOrder S; S.init(MR, DM, G, bx); EpiFf2 E{out, RSTD, U};
        pg8::gemm_phase<EpiFf2, pg8::StaticOrder, true, true>(lds, g, S, E);
    }
}

extern "C" void kernel_launch(void* const* d_in, const int* in_sizes, int n_in, void* d_out, int out_size, void* d_ws, size_t ws_size, hipStream_t stream) {
    static int grid = 0;
    if (grid == 0) {
        if (n_in != 19 || out_size != MR * DM || ws_size < WS_END) { fprintf(stderr, "kernel_launch: unexpected shapes (n_in %d out %d ws %zu)\n", n_in, out_size, ws_size); grid = -1; return; }
        int dev = 0, cus = 0, per_cu = 0;
        if (hipGetDevice(&dev) != hipSuccess || hipDeviceGetAttribute(&cus, hipDeviceAttributeMultiprocessorCount, dev) != hipSuccess) { grid = -1; return; }
        if (hipFuncSetAttribute((const void*)mk_fwd, hipFuncAttributeMaxDynamicSharedMemorySize, LDS_BYTES) != hipSuccess) { fprintf(stderr, "kernel_launch: hipFuncSetAttribute failed\n"); grid = -1; return; }
        if (hipOccupancyMaxActiveBlocksPerMultiprocessor(&per_cu, (const void*)mk_fwd, NWAVES * 64, LDS_BYTES) != hipSuccess || per_cu < 1) { fprintf(stderr, "kernel_launch: occupancy query says %d\n", per_cu); }
        (void)hipGetLastError();
        grid = cus;
    }
    if (grid < 0) return;
    if (hipMemsetAsync((char*)d_ws + WS_CTL, 0, CTL_ZERO_BYTES, stream) != hipSuccess) return;
    Ptrs a{};
    for (int i = 0; i < 19; ++i) a.in[i] = (const float*)d_in[i];
    a.out = (float*)d_out; a.ws = (unsigned char*)d_ws;
    hipLaunchKernelGGL(mk_fwd, dim3(grid), dim3(NWAVES * 64), LDS_BYTES, stream, a);
}
```

```cpp
#include <hip/hip_runtime.h>
#include <cstdio>
#include <cstdint>
namespace pg8 {
#define PG8_LAS __attribute__((address_space(3)))
typedef unsigned short bf16_t;
typedef short bf16x8 __attribute__((ext_vector_type(8)));
typedef float f32x4 __attribute__((ext_vector_type(4)));
typedef unsigned u32x4 __attribute__((ext_vector_type(4)));
typedef int i32x4_ __attribute__((ext_vector_type(4)));
typedef int i32x8_ __attribute__((ext_vector_type(8)));
template <bool FP8> struct Frag;
template <> struct Frag<false> { bf16x8 v[2]; __device__ __forceinline__ void set(int k, bf16x8 x) { v[k] = x; } };
template <> struct Frag<true>  { i32x8_ w;    __device__ __forceinline__ void set(int k, bf16x8 x) { if (k == 0) w.lo = __builtin_bit_cast(i32x4_, x); else w.hi = __builtin_bit_cast(i32x4_, x); } };
constexpr int BM = 256, BK = 64, HALF = 128, HTB = HALF * BK * 2  , STAGE_BYTES = 8 * HTB, NXCD = 8, WGM = 8;

__host__ __device__ __forceinline__ int lds_byte(int r, int c) { const int st = (r >> 4) * 2 + (c >> 5), rr = r & 15, cc = c & 31, ob = rr * 64 + cc * 2; return st * 1024 + (ob ^ (((ob >> 9) & 1) << 5)); }
__host__ __device__ __forceinline__ void stage_rc(int b, int& R, int& C) { const int st = b / 1024, sb = b % 1024, swz = sb ^ (((sb >> 9) & 1) << 5); R = (st >> 1) * 16 + swz / 64; C = (st & 1) * 32 + (swz % 64) / 2; }
__host__ __device__ __forceinline__ int perm32(int rho) { const int n = rho >> 4, i = rho & 15; return 8 * (i >> 2) + 4 * n + (i & 3); }

struct Unit { int pm, pn; };
struct Gemm { const bf16_t* A; const bf16_t* Bt; int M, N, K; };

struct StaticOrder {
    int nM, nN, nwg, G, c;
    __host__ __device__ void init(int M, int N, int G_, int c_) { nM = M / BM; nN = N / BM; nwg = nM * nN; G = G_; c = c_; }
    __host__ __device__ bool next(int i, Unit& u) const {
        const long L = (long)i * G + c; if (L >= nwg) return false;
        int wgid = (int)L; { const int q = nwg / NXCD, r = nwg % NXCD, xcd = wgid % NXCD, off = wgid / NXCD; wgid = (xcd < r ? xcd * (q + 1) : r * (q + 1) + (xcd - r) * q) + off; }
        const int nig = WGM * nN, gid = wgid / nig, fm = gid * WGM, gsz = (nM - fm) < WGM ? (nM - fm) : WGM;
        u.pm = fm + ((wgid % nig) % gsz); u.pn = (wgid % nig) / gsz; return true;
    }
    __device__ __forceinline__ void a_ready(const Unit&) const {}
    __device__ __forceinline__ void done(const Unit&) const {}
    static constexpr int KLOOP = 0;
    __device__ __forceinline__ size_t kofs(const Unit&) const { return 0; }
    __device__ __forceinline__ bool zero_after(const Unit&) const { return true; }
};

__device__ __forceinline__ unsigned cvt_pk_bf16(float lo, float hi) { unsigned r; asm volatile("v_cvt_pk_bf16_f32 %0, %1, %2" : "=v"(r) : "v"(lo), "v"(hi)); return r; }
typedef float f32x2 __attribute__((ext_vector_type(2)));
__device__ __forceinline__ void mfma_f8(f32x4& acc, const i32x8_& a, const i32x8_& b, int sc) {
    asm volatile("v_mfma_scale_f32_16x16x128_f8f6f4 %0, %1, %2, %0, %3, %3 op_sel_hi:[0,0,0]" : "+v"(acc) : "v"(a), "v"(b), "v"(sc));
}
template <class Epi, class Sched, bool ALIGN_EPI = false, bool SP2 = false, bool FP8 = false, bool I8 = false>
__device__ __forceinline__ void gemm_phase(PG8_LAS unsigned char* lds, const Gemm g, const Sched& S, const Epi& E) {
    int tid_ = threadIdx.x; asm volatile("" : "+v"(tid_));
    const int tid = tid_, wid = __builtin_amdgcn_readfirstlane(tid >> 6), lane = tid & 63, wr = wid >> 2, wc = wid & 3, fr = lane & 15, fq = lane >> 4;
    int one_scale = 0x7f7f7f7f; asm volatile("" : "+v"(one_scale));      (void)one_scale;
    const int K = g.K, nt = (Sched::KLOOP ? Sched::KLOOP : K) / BK;
    unsigned voffA[2], voffB[2];
#pragma unroll
    for (int i = 0; i < 2; ++i) { int R, C; stage_rc(tid * 16 + i * 8192, R, C); const int Rb = Epi::PERM ? ((R & ~31) + perm32(R & 31)) : R;
        if (FP8) { const int q8 = C >> 3; C = (2 * (q8 & 3) + (q8 >> 2)) * 8; }
        voffA[i] = (unsigned)(R * K + C) * 2u; voffB[i] = (unsigned)(Rb * K + C) * 2u; }
    const size_t kstep = (size_t)(BK * 2);
    const size_t hstep = (size_t)HALF * K * 2;
    const size_t tstep = 2 * hstep;
    const unsigned ldsw = (unsigned)wid * 1024u;
    const int aoff = lds_byte(wr * 64 + fr, fq * 8), boff = lds_byte(wc * 32 + fr, fq * 8);
#define PG8_SA(b, h) (((b) * 2 + (h)) * HTB)
#define PG8_SB(b, h) ((4 + (b) * 2 + (h)) * HTB)
#define PG8_STAGE(bufoff, gbase, voff) do { _Pragma("unroll") for (int _i = 0; _i < 2; ++_i) \
        __builtin_amdgcn_global_load_lds((const unsigned*)((const char*)(gbase) + (voff)[_i]), (PG8_LAS unsigned*)(lds + (bufoff) + ldsw + _i * 8192), 16, 0, 0); } while (0)
#define PG8_LDA(dst, b, h) do { _Pragma("unroll") for (int m = 0; m < 4; ++m) _Pragma("unroll") for (int k = 0; k < 2; ++k) dst[m].set(k, *(const PG8_LAS bf16x8*)(lds + PG8_SA(b, h) + aoff + m * 2048 + k * 1024)); } while (0)
#define PG8_LDB(dst, b, h) do { _Pragma("unroll") for (int n = 0; n < 2; ++n) _Pragma("unroll") for (int k = 0; k < 2; ++k) dst[n].set(k, *(const PG8_LAS bf16x8*)(lds + PG8_SB(b, h) + boff + n * 2048 + k * 1024)); } while (0)
#define PG8_MMA(ai, bj, At, Bt) do { __builtin_amdgcn_s_setprio(1); _Pragma("unroll") for (int m = 0; m < 4; ++m) _Pragma("unroll") for (int n = 0; n < 2; ++n) { \
        if constexpr (FP8) mfma_f8(acc[ai][bj][m][n], Bt[n].w, At[m].w, one_scale); \
        else if constexpr (I8) { _Pragma("unroll") for (int k = 0; k < 2; ++k) acc[ai][bj][m][n] = __builtin_bit_cast(f32x4, __builtin_amdgcn_mfma_i32_16x16x64_i8(__builtin_bit_cast(i32x4_, Bt[n].v[k]), __builtin_bit_cast(i32x4_, At[m].v[k]), __builtin_bit_cast(i32x4_, acc[ai][bj][m][n]), 0, 0, 0)); } \
        else { _Pragma("unroll") for (int k = 0; k < 2; ++k) acc[ai][bj][m][n] = __builtin_amdgcn_mfma_f32_16x16x32_bf16(Bt[n].v[k], At[m].v[k], acc[ai][bj][m][n], 0, 0, 0); } } \
        if constexpr (FP8) asm volatile("s_nop 15" ::: "memory");     \
        __builtin_amdgcn_s_setprio(0); } while (0)
#define PG8_WAIT_V(n) asm volatile("s_waitcnt vmcnt(" #n ")" ::: "memory")
#define PG8_WAIT_L(n) asm volatile("s_waitcnt lgkmcnt(" #n ")" ::: "memory")
#define PG8_BAR __builtin_amdgcn_s_barrier()
#define PG8_SCHED __builtin_amdgcn_sched_barrier(0)
    Unit cur, nxt; int ui = 0;
    if (!S.next(0, cur)) return;
    f32x4 acc[2][2][4][2];
    if constexpr (Epi::INIT) E.init(acc, cur, wr, wc, fr, fq);
    else {
#pragma unroll
    for (int a = 0; a < 2; ++a)
#pragma unroll
        for (int b = 0; b < 2; ++b)
#pragma unroll
            for (int m = 0; m < 4; ++m)
#pragma unroll
                for (int n = 0; n < 2; ++n) acc[a][b][m][n] = (f32x4){0.f, 0.f, 0.f, 0.f};
    }
    Frag<FP8> At[4], B0[2], B1[2];
    const char* cA = (const char*)g.A + (size_t)cur.pm * tstep + S.kofs(cur); const char* cB = (const char*)g.Bt + (size_t)(cur.pn & 0xffff) * tstep + S.kofs(cur);
    S.a_ready(cur);
    if constexpr (SP2) {
        PG8_STAGE(PG8_SB(0, 0), cB, voffB); PG8_STAGE(PG8_SB(0, 1), cB + hstep, voffB); PG8_STAGE(PG8_SA(0, 0), cA, voffA); PG8_STAGE(PG8_SA(0, 1), cA + hstep, voffA);
        if (wr == 1) PG8_BAR;
        PG8_WAIT_V(2); PG8_BAR;
        PG8_STAGE(PG8_SB(1, 0), cB + kstep, voffB); PG8_STAGE(PG8_SA(1, 0), cA + kstep, voffA); PG8_STAGE(PG8_SB(1, 1), cB + hstep + kstep, voffB);
        PG8_WAIT_V(6); PG8_BAR;
    } else {
        PG8_STAGE(PG8_SB(0, 0), cB, voffB); PG8_STAGE(PG8_SA(0, 0), cA, voffA); PG8_STAGE(PG8_SB(0, 1), cB + hstep, voffB); PG8_STAGE(PG8_SA(0, 1), cA + hstep, voffA);
        if (wr == 1) PG8_BAR;
        PG8_WAIT_V(4); PG8_BAR;
        PG8_STAGE(PG8_SB(1, 0), cB + kstep, voffB); PG8_STAGE(PG8_SA(1, 0), cA + kstep, voffA); PG8_STAGE(PG8_SB(1, 1), cB + hstep + kstep, voffB);
        PG8_WAIT_V(6); PG8_BAR;
    }
    for (;;) {
        const bool has_next = S.next(ui + 1, nxt);
        const char* nA = has_next ? (const char*)g.A + (size_t)nxt.pm * tstep + S.kofs(nxt) : cA; const char* nB = has_next ? (const char*)g.Bt + (size_t)(nxt.pn & 0xffff) * tstep + S.kofs(nxt) : cB;
        for (int t = 0; t < nt; t += 2) {
            const bool last = (t == nt - 2);
            const char* a1 = cA + (size_t)(t + 1) * kstep;
            const char* a2 = last ? nA : cA + (size_t)(t + 2) * kstep; const char* b2 = last ? nB : cB + (size_t)(t + 2) * kstep;
            const char* a3 = a2 + kstep; const char* b3 = b2 + kstep;
            if (last && has_next) S.a_ready(nxt);
            if constexpr (SP2) {
            PG8_LDB(B0, 0, 0); PG8_LDB(B1, 0, 1); PG8_SCHED; PG8_LDA(At, 0, 0); PG8_STAGE(PG8_SA(1, 1), a1 + hstep, voffA);
            PG8_WAIT_V(8); PG8_WAIT_L(0); PG8_BAR; PG8_MMA(0, 0, At, B0); PG8_MMA(0, 1, At, B1); PG8_BAR; PG8_SCHED;
            PG8_LDA(At, 0, 1); PG8_STAGE(PG8_SB(0, 0), b2, voffB); PG8_STAGE(PG8_SB(0, 1), b2 + hstep, voffB); PG8_STAGE(PG8_SA(0, 0), a2, voffA);
            PG8_WAIT_V(8); PG8_WAIT_L(0); PG8_BAR; PG8_MMA(1, 0, At, B0); PG8_MMA(1, 1, At, B1); PG8_BAR; PG8_SCHED;
            PG8_LDB(B0, 1, 0); PG8_LDB(B1, 1, 1); PG8_SCHED; PG8_LDA(At, 1, 0); PG8_STAGE(PG8_SA(0, 1), a2 + hstep, voffA);
            PG8_WAIT_V(8); PG8_WAIT_L(0); PG8_BAR; PG8_MMA(0, 0, At, B0); PG8_MMA(0, 1, At, B1); PG8_BAR; PG8_SCHED;
            PG8_LDA(At, 1, 1); PG8_STAGE(PG8_SB(1, 0), b3, voffB); PG8_STAGE(PG8_SB(1, 1), b3 + hstep, voffB); PG8_STAGE(PG8_SA(1, 0), a3, voffA);
            PG8_WAIT_V(8); PG8_WAIT_L(0); PG8_BAR; PG8_MMA(1, 0, At, B0); PG8_MMA(1, 1, At, B1); PG8_BAR; PG8_SCHED;
            } else {
            PG8_LDB(B0, 0, 0); PG8_SCHED; PG8_LDA(At, 0, 0); PG8_STAGE(PG8_SA(1, 1), a1 + hstep, voffA);
            PG8_WAIT_L(8); PG8_BAR; PG8_WAIT_L(0); PG8_MMA(0, 0, At, B0); PG8_BAR; PG8_SCHED;
            PG8_LDB(B1, 0, 1); PG8_STAGE(PG8_SB(0, 0), b2, voffB);
            PG8_BAR; PG8_WAIT_L(0); PG8_MMA(0, 1, At, B1); PG8_BAR;
            PG8_LDA(At, 0, 1); PG8_STAGE(PG8_SA(0, 0), a2, voffA);
            PG8_BAR; PG8_WAIT_L(0); PG8_MMA(1, 0, At, B0); PG8_BAR; PG8_SCHED;
            PG8_STAGE(PG8_SB(0, 1), b2 + hstep, voffB);
            PG8_WAIT_V(6); PG8_BAR; PG8_MMA(1, 1, At, B1); PG8_BAR;
            PG8_LDB(B0, 1, 0); PG8_SCHED; PG8_LDA(At, 1, 0); PG8_STAGE(PG8_SA(0, 1), a2 + hstep, voffA);
            PG8_WAIT_L(8); PG8_BAR; PG8_WAIT_L(0); PG8_MMA(0, 0, At, B0); PG8_BAR; PG8_SCHED;
            PG8_LDB(B1, 1, 1); PG8_STAGE(PG8_SB(1, 0), b3, voffB);
            PG8_BAR; PG8_WAIT_L(0); PG8_MMA(0, 1, At, B1); PG8_BAR;
            PG8_LDA(At, 1, 1); PG8_STAGE(PG8_SA(1, 0), a3, voffA);
            PG8_BAR; PG8_WAIT_L(0); PG8_MMA(1, 0, At, B0); PG8_BAR; PG8_SCHED;
            PG8_STAGE(PG8_SB(1, 1), b3 + hstep, voffB);
            PG8_WAIT_V(6); PG8_BAR; PG8_MMA(1, 1, At, B1); PG8_BAR;
            }
        }
        if constexpr (ALIGN_EPI) { if (wr == 0) PG8_BAR; }
        if constexpr (FP8) asm volatile("s_nop 15\n\ts_nop 15" ::: "memory");
        if constexpr (!Epi::AFTER_DRAIN) { E(acc, cur, wr, wc, fr, fq); S.done(cur); }
        if (!has_next) break;
        if constexpr (Epi::INIT) E.init(acc, nxt, wr, wc, fr, fq);
        else if (S.zero_after(cur)) {
#pragma unroll
        for (int a = 0; a < 2; ++a)
#pragma unroll
            for (int b = 0; b < 2; ++b)
#pragma unroll
                for (int m = 0; m < 4; ++m)
#pragma unroll
                    for (int n = 0; n < 2; ++n) acc[a][b][m][n] = (f32x4){0.f, 0.f, 0.f, 0.f};
        }
        cur = nxt; cA = nA; cB = nB; ++ui;
        if constexpr (ALIGN_EPI) { if (wr == 1) PG8_BAR; }
    }
    PG8_WAIT_V(0);
    if constexpr (!ALIGN_EPI) { if (wr == 0) PG8_BAR; }
    PG8_BAR;
    if constexpr (Epi::AFTER_DRAIN) { E.fused(acc, cur, wr, wc, fr, fq, lds, wid, lane); S.done(cur); }
#undef PG8_SA
#undef PG8_SB
#undef PG8_STAGE
#undef PG8_LDA
#undef PG8_LDB
#undef PG8_MMA
#undef PG8_WAIT_V
#undef PG8_WAIT_L
#undef PG8_BAR
#undef PG8_SCHED
}
}
#define GAS __attribute__((address_space(1)))
#define LAS __attribute__((address_space(3)))
typedef unsigned short bf16;
typedef unsigned v4u __attribute__((ext_vector_type(4)));
typedef float f32x4 __attribute__((ext_vector_type(4)));
typedef short bf16x8 __attribute__((ext_vector_type(8)));
typedef GAS unsigned gu32;
typedef GAS unsigned long long gu64;
#define RLX_AGENT __ATOMIC_RELAXED, __HIP_MEMORY_SCOPE_AGENT
#define LDS_WAIT() asm volatile("s_waitcnt lgkmcnt(0)" ::: "memory")
#define VM_WAIT() asm volatile("s_waitcnt vmcnt(0)" ::: "memory")
__device__ __forceinline__ unsigned long long rt() { return __builtin_amdgcn_s_memrealtime(); }
__device__ __forceinline__ unsigned f2bf(float f) { unsigned u = __builtin_bit_cast(unsigned, f); return (u + 0x7fffu + ((u >> 16) & 1u)) >> 16; }
__device__ __forceinline__ unsigned pk2(float lo, float hi) { return f2bf(lo) | (f2bf(hi) << 16); }
#define XB_TMO      128
#define XB_XCNT(j)  (256  + 64 * (j))
#define XB_XSUB(j)  (1280 + 64 * (j))
#define XB_XGEN(j)  (2304 + 64 * (j))
#define XB_TOP      3328
#define XB_TOPGEN   3392
#define XCD_BAR_WORDS 3456
#define XB_SPIN_CAP (1u << 22)

__device__ __forceinline__ unsigned xb_ld(unsigned* p)              { return __hip_atomic_load(p, __ATOMIC_RELAXED, __HIP_MEMORY_SCOPE_AGENT); }
__device__ __forceinline__ unsigned xb_add(unsigned* p, unsigned v) { return __hip_atomic_fetch_add(p, v, __ATOMIC_RELAXED, __HIP_MEMORY_SCOPE_AGENT); }
__device__ __forceinline__ unsigned xb_xcc_id() { return (unsigned)__builtin_amdgcn_s_getreg((3 << 11) | 20) & 0xFu; }
#define XB_SPIN(cond, bar) do { unsigned _sp = 0; while (cond) { __builtin_amdgcn_s_sleep(1); \
    if ((++_sp & 255u) == 0u) { if (xb_ld(&(bar)[XB_TMO])) break; if (_sp > XB_SPIN_CAP) { atomicAdd(&(bar)[XB_TMO], 1u); break; } } } } while (0)

struct XcdBarrier {
    unsigned* bar; unsigned x;
    volatile LAS unsigned* st;
};

__device__ __forceinline__ XcdBarrier xcd_barrier_post(unsigned* bar, volatile LAS unsigned* st) {
    XcdBarrier b; b.bar = bar; b.x = xb_xcc_id(); b.st = st;
    if (threadIdx.x == 0) (void)xb_add(&bar[XB_XCNT(b.x)], 1u);
    return b;
}
__device__ __forceinline__ void xcd_barrier_complete(unsigned* bar, unsigned x, unsigned& nloc, unsigned& nx) {
    const unsigned G = gridDim.x * gridDim.y * gridDim.z;
    unsigned sum, cnt, mine, sp = 0u;
    for (;;) {
        sum = 0u; cnt = 0u; mine = 0u;
#pragma unroll
        for (unsigned j = 0; j < 16; ++j) { const unsigned c = xb_ld(&bar[XB_XCNT(j)]); sum += c; cnt += (c > 0u) ? 1u : 0u; mine = (j == x) ? c : mine; }
        if (sum == G) break;
        __builtin_amdgcn_s_sleep(1);
        if ((++sp & 255u) == 0u) { if (xb_ld(&bar[XB_TMO])) break; if (sp > XB_SPIN_CAP) { atomicAdd(&bar[XB_TMO], 1u); break; } }
    }
    nloc = mine > 0u ? mine : 1u; nx = cnt > 0u ? cnt : 1u;
}

__device__ __forceinline__ void xcd_barrier(const XcdBarrier& b) {
    asm volatile("s_waitcnt vmcnt(0)" ::: "memory");
    __syncthreads();
    if (threadIdx.x == 0) {
        unsigned* bar = b.bar;
        __builtin_amdgcn_s_waitcnt(0);
        unsigned nloc = b.st[0], nx = b.st[1];
        if (nloc == 0u) { xcd_barrier_complete(bar, b.x, nloc, nx); b.st[0] = nloc; b.st[1] = nx; }
        const unsigned old = xb_add(&bar[XB_XSUB(b.x)], 1u);
        const unsigned gen = old / nloc;
        if (old + 1u == (gen + 1u) * nloc) {
            __builtin_amdgcn_fence(__ATOMIC_RELEASE, "agent");
            asm volatile("s_waitcnt vmcnt(0)" ::: "memory");
            const unsigned og = xb_add(&bar[XB_TOP], 1u);
            const unsigned tg = og / nx;
            if (og + 1u == (tg + 1u) * nx) xb_add(&bar[XB_TOPGEN], 1u);
            else XB_SPIN(xb_ld(&bar[XB_TOPGEN]) == tg, bar);
            __builtin_amdgcn_fence(__ATOMIC_ACQUIRE, "agent");
            xb_add(&bar[XB_XGEN(b.x)], 1u);
            asm volatile("s_waitcnt vmcnt(0)" ::: "memory");
        } else {
            XB_SPIN(xb_ld(&bar[XB_XGEN(b.x)]) == gen, bar);
            __builtin_amdgcn_fence(__ATOMIC_ACQUIRE, "agent");
            asm volatile("s_waitcnt vmcnt(0)" ::: "memory");
        }
    }
    __syncthreads();
}
constexpr int NWAVES = 8;
constexpr int DM = 4096, NB = 4, SEQ = 2048, NMETA = 16, TT = SEQ + NMETA;
constexpr int MR = NB * SEQ;
constexpr int NIN = 22528, DFF = 16384, NH = 16, WHD = 2048;
constexpr int C_Q = 0, C_K = 2048, C_V = 4096, C_HQ = 6144, C_HF = 8192, C_HI = 10240, C_HG = 12288, C_GA = 14336, C_GB = 18432;
constexpr int YP = 2 * WHD;
constexpr float EPS = 1e-6f;
constexpr float C2 = 0.18033688011112042f;
constexpr float LAM_INIT = 0.2f;

constexpr size_t MiB = 1u << 20;
constexpr size_t WS_CTL = 0, CTL_ZERO_BYTES = 1 * MiB;
constexpr size_t WS_WIN = 2 * MiB, WS_WUPA = 178 * MiB, WS_WUPB = 194 * MiB, WS_WOUT = 210 * MiB, WS_WFF1 = 242 * MiB, WS_WFF2 = 370 * MiB;
constexpr size_t WS_U = 498 * MiB;
constexpr size_t WS_UMETA = 562 * MiB;
constexpr size_t WS_PM = 563 * MiB;
constexpr size_t WS_ROPE = 564 * MiB;
constexpr size_t WS_RSTD = 565 * MiB;
constexpr size_t WS_P = 568 * MiB;
constexpr size_t WS_YA = 920 * MiB, WS_YB = 952 * MiB, WS_MG = 984 * MiB;
constexpr size_t WS_SSQ = 1048 * MiB;
constexpr size_t WS_DEC = 1050 * MiB;
constexpr size_t WS_U8 = 1052 * MiB;
constexpr size_t WS_W8 = 1084 * MiB;
constexpr size_t WS_SU = 1172 * MiB;
constexpr size_t WS_SW = 1173 * MiB;
constexpr size_t WS_END = 1174 * MiB;
constexpr int NQK = C_V;
constexpr int CW_QHEAD = 2048;
constexpr int CW_SWMAX = 32768;
constexpr int CW_BAR = 4096;

constexpr int RING_BYTES = 131072, LDSCTL_OFF = 146432, LDS_BYTES = 147456;

__device__ __forceinline__ int opaque_v(int v) { asm volatile("" : "+v"(v)); return v; }
#define PHASE_IDS const int tid = opaque_v((int)threadIdx.x), lane = tid & 63, wave = __builtin_amdgcn_readfirstlane(tid >> 6); (void)lane; (void)wave;
__device__ __forceinline__ float bf2f(bf16 v) { return __builtin_bit_cast(float, (unsigned)v << 16); }
__device__ __forceinline__ float bflo(unsigned w) { return __builtin_bit_cast(float, w << 16); }
__device__ __forceinline__ float bfhi(unsigned w) { return __builtin_bit_cast(float, w & 0xffff0000u); }
__device__ __forceinline__ float wave_sum(float v) {
#pragma unroll
    for (int o = 1; o < 64; o <<= 1) v += __shfl_xor(v, o);
    return v;
}
__device__ __forceinline__ float wave_max(float v) {
#pragma unroll
    for (int o = 1; o < 64; o <<= 1) v = fmaxf(v, __shfl_xor(v, o));
    return v;
}
__device__ __forceinline__ float sigmoidf_(float x) { return __builtin_amdgcn_rcpf(1.0f + __expf(-x)); }

__host__ __device__ __forceinline__ int wt_row(int s) {
    if (s < C_V) { const int base = s & ~2047, t = s & 2047, h = t >> 7, cm = (t >> 6) & 1, d = t & 63; return base + 256 * (h >> 1) + 128 * ((d >> 3) & 1) + 32 * (2 * (h & 1) + cm) + 8 * (d >> 4) + (d & 7); }
    if (s >= C_HQ && s < C_HI) { const int t = s - C_HQ, isf = t >> 11, h = (t & 2047) >> 7, d = t & 127; return C_HQ + 256 * h + 128 * isf + d; }
    return s;
}
__device__ __forceinline__ unsigned pk4_i8(float a, float b, float c, float d) {
    const int ia = (int)__builtin_rintf(a), ib = (int)__builtin_rintf(b), ic = (int)__builtin_rintf(c), id = (int)__builtin_rintf(d);
    return (unsigned)(ia & 0xff) | ((unsigned)(ib & 0xff) << 8) | ((unsigned)(ic & 0xff) << 16) | ((unsigned)id << 24);
}
__device__ __forceinline__ const void* ldp(LAS unsigned char* lds, int k) {
    volatile LAS unsigned* t = (volatile LAS unsigned*)(lds + LDSCTL_OFF) + 32 + 2 * k;
    const unsigned lo = t[0], hi = t[1];
    return (const void*)(const GAS void*)(((unsigned long long)(unsigned)__builtin_amdgcn_readfirstlane((int)hi) << 32) | (unsigned long long)(unsigned)__builtin_amdgcn_readfirstlane((int)lo));
}
struct TItem { const float* src; bf16* dst; int N, KP; const float* gain; };
constexpr int TI_UP = (WHD / 64) * (DM / 32), TI_OUT = (DM / 64) * (DM / 32), TI_F1 = (DM / 64) * (DFF / 32), TI_F2 = (DFF / 64) * (DM / 32), TI_ALL = 2 * TI_UP + TI_OUT + TI_F1 + TI_F2;
constexpr int TSCR_BYTES = 32 * 33 * 4;
__device__ __forceinline__ TItem t_item(const float* W, int N, bf16* WT, int item, int KP, int koff, const float* gain = nullptr) {
    const int nblk = N / 32, kb = item / nblk, nb = item % nblk;
    return TItem{W + (size_t)(64 * kb) * N + 32 * nb, WT + (size_t)(32 * nb) * KP + koff + 64 * kb, N, KP, gain ? gain + 64 * kb : nullptr};
}
__device__ __forceinline__ TItem t_decode(LAS unsigned char* lds, int it) {
    unsigned char* ws = (unsigned char*)ldp(lds, 20);
    int r = it;
    if (r < TI_UP) return t_item((const float*)ldp(lds, 13), DM, (bf16*)(ws + WS_WUPA), r, YP, 0);
    r -= TI_UP; if (r < TI_UP) return t_item((const float*)ldp(lds, 14), DM, (bf16*)(ws + WS_WUPA), r, YP, WHD);
    r -= TI_UP; if (r < TI_OUT) return t_item((const float*)ldp(lds, 15), DM, (bf16*)(ws + WS_WOUT), r, DM, 0);
    r -= TI_OUT; if (r < TI_F1) return t_item((const float*)ldp(lds, 17), DFF, (bf16*)(ws + WS_WFF1), r, DM, 0, (const float*)ldp(lds, 16));
    r -= TI_F1; return t_item((const float*)ldp(lds, 18), DM, (bf16*)(ws + WS_WFF2), r, DFF, 0);
}
__device__ __forceinline__ void t_convert(const TItem& t, LAS unsigned* scr, int lane) {
    const int r = lane >> 3, c4 = lane & 7;
    const unsigned off = (unsigned)(2 * r) * (unsigned)t.N + (unsigned)(4 * c4);
    f32x4 v[8];
#pragma unroll
    for (int i = 0; i < 8; ++i) v[i] = __builtin_nontemporal_load((const GAS f32x4*)((const GAS float*)t.src + (size_t)(16 * (i >> 1) + (i & 1)) * t.N + off));
    if (t.gain) {
#pragma unroll
        for (int i = 0; i < 8; ++i) v[i] = v[i] * t.gain[16 * (i >> 1) + (i & 1) + 2 * r];
    }
#pragma unroll
    for (int m = 0; m < 4; ++m)
#pragma unroll
        for (int e = 0; e < 4; ++e) scr[(8 * m + r) * 33 + 4 * c4 + e] = pg8::cvt_pk_bf16(v[2 * m][e], v[2 * m + 1][e]);
    LDS_WAIT(); asm volatile("" ::: "memory");
    const int c = lane & 7;
#pragma unroll
    for (int j = 0; j < 4; ++j) { const int n = (lane >> 3) + 8 * j; const LAS unsigned* w = scr + (4 * c) * 33 + n;
        v4u o; o.x = w[0]; o.y = w[33]; o.z = w[66]; o.w = w[99];
        *(GAS v4u*)(t.dst + (size_t)n * t.KP + 8 * c) = o; }
    LDS_WAIT(); asm volatile("" ::: "memory");
}
template <bool PERMW = false>
__device__ __forceinline__ void p0_transpose_item(const float* W, int K, int N, bf16* WT, LAS float* scr, int item, int lane, int KP = 0, int koff = 0, gu32* cmaxw = nullptr) {
    if (KP == 0) KP = K;
    const int nblk = N / 32, kb = item / nblk, nb = item % nblk, k0 = 64 * kb, n0 = 32 * nb;
    float cmx = 0.f;
#pragma unroll
    for (int i = 0; i < 32; ++i) { const int kk = 2 * i + (lane >> 5); const float wv = __builtin_nontemporal_load((const GAS float*)W + (size_t)(k0 + kk) * N + n0 + (lane & 31)); scr[kk * 33 + (lane & 31)] = wv; cmx = fmaxf(cmx, fabsf(wv)); }
    if (PERMW && cmaxw) { cmx = fmaxf(cmx, __shfl_xor(cmx, 32));
        if (lane < 32) __hip_atomic_fetch_max(cmaxw + wt_row(n0 + lane), __float_as_uint(cmx), RLX_AGENT); }
    LDS_WAIT(); asm volatile("" ::: "memory");
    const int c = lane & 7;
#pragma unroll
    for (int j = 0; j < 4; ++j) { const int n = (lane >> 3) + 8 * j; const LAS float* s = scr + (8 * c) * 33 + n;
        v4u o; o.x = pk2(s[0 * 33], s[1 * 33]); o.y = pk2(s[2 * 33], s[3 * 33]); o.z = pk2(s[4 * 33], s[5 * 33]); o.w = pk2(s[6 * 33], s[7 * 33]);
        *(GAS v4u*)(WT + (size_t)(PERMW ? wt_row(n0 + n) : (n0 + n)) * KP + koff + k0 + 8 * c) = o; }
    LDS_WAIT(); asm volatile("" ::: "memory");
}
__device__ __forceinline__ void rms_row_to_bf16(const float* xrow, const float* g, bf16* orow, int lane, unsigned char* o8row = nullptr, float* su = nullptr) {
    const GAS f32x4* xr = (const GAS f32x4*)xrow + lane; const GAS f32x4* gr = (const GAS f32x4*)g + lane;
    f32x4 v[16]; float s = 0.f, am = 0.f;
#pragma unroll
    for (int j = 0; j < 16; ++j) { v[j] = __builtin_nontemporal_load(xr + 64 * j); s += (v[j].x * v[j].x + v[j].y * v[j].y) + (v[j].z * v[j].z + v[j].w * v[j].w);
        const f32x4 gg = gr[64 * j]; v[j] = v[j] * gg; am = fmaxf(am, fmaxf(fmaxf(fabsf(v[j].x), fabsf(v[j].y)), fmaxf(fabsf(v[j].z), fabsf(v[j].w)))); }
    const float rstd = 1.f / sqrtf(wave_sum(s) * (1.f / DM) + EPS);
    if (orow) { GAS unsigned long long* o8 = (GAS unsigned long long*)orow + lane;
#pragma unroll
        for (int j = 0; j < 16; ++j) o8[64 * j] = (unsigned long long)pk2(v[j].x * rstd, v[j].y * rstd) | ((unsigned long long)pk2(v[j].z * rstd, v[j].w * rstd) << 32); }
    if (o8row) {
        am = wave_max(am); const float inv = am > 0.f ? 127.f / am : 0.f;
#pragma unroll
        for (int j = 0; j < 16; ++j) ((GAS unsigned*)o8row)[64 * j + lane] = pk4_i8(v[j].x * inv, v[j].y * inv, v[j].z * inv, v[j].w * inv);
        if (lane == 0) *su = am * rstd * (1.f / 127.f); }
}
__device__ __forceinline__ void sincos_d(double a, float& sn, float& cs) {
    const double PI = 3.14159265358979323846;
    const double k = rint(a / PI); const double r = a - k * PI; const double r2 = r * r;
    double s = 1.0, c = 1.0, ts = 1.0, tc = 1.0;
#pragma unroll
    for (int i = 1; i <= 11; ++i) { tc *= -r2 / (double)((2 * i - 1) * (2 * i)); ts *= -r2 / (double)((2 * i) * (2 * i + 1)); c += tc; s += ts; }
    s *= r;
    const bool odd = ((long long)k) & 1;
    sn = (float)(odd ? -s : s); cs = (float)(odd ? -c : c);
}

struct Ptrs {
    const float* in[19]; float* out; unsigned char* ws;
};

__device__ __forceinline__ const bf16* rowptr(const bf16* P, const bf16* Pm, int b, int t) {
    return t < NMETA ? Pm + (size_t)t * NIN : P + (size_t)(b * SEQ + t - NMETA) * NIN;
}

__device__ __forceinline__ float dpp_shr(float v, int n) {
    const int x = __float_as_int(v); int r;
    if (n == 1) r = __builtin_amdgcn_update_dpp(0, x, 0x111, 0xf, 0xf, true); else if (n == 2) r = __builtin_amdgcn_update_dpp(0, x, 0x112, 0xf, 0xf, true);
    else if (n == 4) r = __builtin_amdgcn_update_dpp(0, x, 0x114, 0xf, 0xf, true); else r = __builtin_amdgcn_update_dpp(0, x, 0x118, 0xf, 0xf, true);
    return __int_as_float(r);
}
template <bool QK_ONLY>
struct EpiProjT {
    static constexpr bool PERM = true, AFTER_DRAIN = false, INIT = false;
    bf16* O; const float* qn; const float* kn; const float* rope; const float* hlb; float* dec; int pn0; float oscale; const float* su; const float* sw;
    __device__ __forceinline__ float val(float a, float rs, float cs) const { return su ? (float)__float_as_int(a) * (rs * cs) : a * oscale; }
    __device__ __forceinline__ void operator()(const pg8::f32x4 (&acc)[2][2][4][2], const pg8::Unit& u, int wr, int wc, int fr_, int fq_) const {
        const int fr = opaque_v(fr_), fq = opaque_v(fq_);
        const int row0 = u.pm * 256 + wr * 64 + fr, pn = u.pn + pn0;
        if constexpr (QK_ONLY) {
            const bool isk = pn >= 8; const int h = 2 * (pn & 7) + (wc >> 1), cm = wc & 1; const float* wv = isk ? kn : qn;
            float w0[8], w1[8], cq0[8], cq1[8];
#pragma unroll
            for (int j = 0; j < 8; ++j) { w0[j] = wv[16 * fq + j]; w1[j] = wv[16 * fq + 8 + j]; cq0[j] = su ? sw[pn * 256 + 32 * wc + 8 * fq + j] : 1.f; cq1[j] = su ? sw[pn * 256 + 128 + 32 * wc + 8 * fq + j] : 1.f; }
            bf16* obase = O + (isk ? C_K : C_Q) + h * 128 + cm * 64 + 16 * fq;
#pragma unroll
            for (int ai = 0; ai < 2; ++ai)
#pragma unroll
                for (int m = 0; m < 4; ++m) { const int row = row0 + ai * 128 + m * 16;
                    float x0[8], x1[8]; float ss = 0.f;
                    const float rs_ = su ? su[row] : 1.f;
#pragma unroll
                    for (int j = 0; j < 8; ++j) { x0[j] = val(acc[ai][0][m][j >> 2][j & 3], rs_, cq0[j]); x1[j] = val(acc[ai][1][m][j >> 2][j & 3], rs_, cq1[j]); ss += x0[j] * x0[j] + x1[j] * x1[j]; }
                    ss += __shfl_xor(ss, 16); ss += __shfl_xor(ss, 32);
                    const float rstd = 1.f / sqrtf(ss * (1.f / 64.f) + EPS);
                    const float* rp = rope + (NMETA + (row & (SEQ - 1))) * 16;
                    const f32x4 c0 = *(const GAS f32x4*)rp, c1 = *(const GAS f32x4*)(rp + 4), s0 = *(const GAS f32x4*)(rp + 8), s1 = *(const GAS f32x4*)(rp + 12);
                    const float cs[8] = {c0.x, c0.y, c0.z, c0.w, c1.x, c1.y, c1.z, c1.w}, sn[8] = {s0.x, s0.y, s0.z, s0.w, s1.x, s1.y, s1.z, s1.w};
                    float o0[8], o1[8];
#pragma unroll
                    for (int j = 0; j < 8; ++j) { const float a = x0[j] * rstd * w0[j], bb = x1[j] * rstd * w1[j];
                        float r0 = a, r1 = bb; if (fq == 0) { r0 = a * cs[j] - bb * sn[j]; r1 = bb * cs[j] + a * sn[j]; }
                        o0[j] = isk ? r0 : r0 * C2; o1[j] = isk ? r1 : r1 * C2; }
                    v4u wa, wb; wa.x = pg8::cvt_pk_bf16(o0[0], o0[1]); wa.y = pg8::cvt_pk_bf16(o0[2], o0[3]); wa.z = pg8::cvt_pk_bf16(o0[4], o0[5]); wa.w = pg8::cvt_pk_bf16(o0[6], o0[7]);
                    wb.x = pg8::cvt_pk_bf16(o1[0], o1[1]); wb.y = pg8::cvt_pk_bf16(o1[2], o1[3]); wb.z = pg8::cvt_pk_bf16(o1[4], o1[5]); wb.w = pg8::cvt_pk_bf16(o1[6], o1[7]);
                    bf16* op = obase + (size_t)row * NIN; *(v4u*)op = wa; *(v4u*)(op + 8) = wb; }
        } else { if (pn >= 24 && pn < 40) {
            const int h = pn - 24, d0 = 32 * wc + 8 * fq, colg = h * 128 + d0; const int lane15 = (fq << 4) | 15;
            float lb[8], cq[8], cf[8];
#pragma unroll
            for (int j = 0; j < 8; ++j) { cq[j] = su ? sw[pn * 256 + d0 + j] : 1.f; cf[j] = su ? sw[pn * 256 + 128 + d0 + j] : 1.f; }
#pragma unroll
            for (int j = 0; j < 8; ++j) { const float a = hlb[colg + j], c = hlb[WHD + colg + j]; lb[j] = 1.f / (1.f + __expf(c - a)); }
#pragma unroll
            for (int ai = 0; ai < 2; ++ai) {
                const int rowc = u.pm * 256 + ai * 128 + wr * 64, cj = (rowc >> 11) * 32 + ((rowc & (SEQ - 1)) >> 6);
                unsigned qd[4][4], ki[4][4]; float tot[8]; float rsm[4];
#pragma unroll
                for (int m = 0; m < 4; ++m) rsm[m] = su ? su[row0 + ai * 128 + m * 16] : 1.f;
#pragma unroll
                for (int jp = 0; jp < 4; ++jp) {
                    float qv[2][4], kv[2][4];
#pragma unroll
                    for (int jj = 0; jj < 2; ++jj) { const int j = 2 * jp + jj;
                        float f[4], s[4];
#pragma unroll
                        for (int m = 0; m < 4; ++m) { f[m] = lb[j] + (1.f - lb[j]) * sigmoidf_(val(acc[ai][1][m][j >> 2][j & 3], rsm[m], cf[j])); float g = __logf(f[m]);
                            g += dpp_shr(g, 1); g += dpp_shr(g, 2); g += dpp_shr(g, 4); g += dpp_shr(g, 8); s[m] = g; }
                        float carry = 0.f;
#pragma unroll
                        for (int m = 0; m < 4; ++m) { const float bcur = s[m] + carry; carry += __shfl(s[m], lane15); s[m] = bcur; }
                        tot[j] = carry;
#pragma unroll
                        for (int m = 0; m < 4; ++m) { qv[jj][m] = val(acc[ai][0][m][j >> 2][j & 3], rsm[m], cq[j]) * __expf(s[m]); kv[jj][m] = (1.f - f[m]) * __expf(-s[m]); }
                    }
#pragma unroll
                    for (int m = 0; m < 4; ++m) { qd[m][jp] = pg8::cvt_pk_bf16(qv[0][m], qv[1][m]); ki[m][jp] = pg8::cvt_pk_bf16(kv[0][m], kv[1][m]); }
                }
#pragma unroll
                for (int m = 0; m < 4; ++m) { bf16* op = O + (size_t)(row0 + ai * 128 + m * 16) * NIN + colg;
                    *(v4u*)(op + C_HQ) = (v4u){qd[m][0], qd[m][1], qd[m][2], qd[m][3]}; *(v4u*)(op + C_HF) = (v4u){ki[m][0], ki[m][1], ki[m][2], ki[m][3]}; }
                if (fr == 15) { float* dp = dec + (size_t)cj * WHD + colg;
                    *(f32x4*)dp = (f32x4){__expf(tot[0]), __expf(tot[1]), __expf(tot[2]), __expf(tot[3])}; *(f32x4*)(dp + 4) = (f32x4){__expf(tot[4]), __expf(tot[5]), __expf(tot[6]), __expf(tot[7])}; }
            }
        } else {
            const int col0 = pn * 256 + wc * 32 + 8 * fq; const bool sg = pn >= 56;
            float cw[2][8];
#pragma unroll
            for (int bj = 0; bj < 2; ++bj)
#pragma unroll
                for (int j = 0; j < 8; ++j) cw[bj][j] = su ? sw[col0 + bj * 128 + j] : 1.f;
#pragma unroll
            for (int ai = 0; ai < 2; ++ai)
#pragma unroll
                for (int m = 0; m < 4; ++m) { bf16* rowp = O + (size_t)(row0 + ai * 128 + m * 16) * NIN + col0; const float rs_ = su ? su[row0 + ai * 128 + m * 16] : 1.f;
#pragma unroll
                    for (int bj = 0; bj < 2; ++bj) { pg8::f32x4 v0, v1;
#pragma unroll
                        for (int e = 0; e < 4; ++e) { v0[e] = val(acc[ai][bj][m][0][e], rs_, cw[bj][e]); v1[e] = val(acc[ai][bj][m][1][e], rs_, cw[bj][4 + e]); }
                        if (sg) { for (int e = 0; e < 4; ++e) { v0[e] = sigmoidf_(v0[e]); v1[e] = sigmoidf_(v1[e]); } }
                        v4u w; w.x = pg8::cvt_pk_bf16(v0[0], v0[1]); w.y = pg8::cvt_pk_bf16(v0[2], v0[3]); w.z = pg8::cvt_pk_bf16(v1[0], v1[1]); w.w = pg8::cvt_pk_bf16(v1[2], v1[3]);
                        *(v4u*)(rowp + bj * 128) = w; } }
        } }
    }
};
struct HalfOrder : pg8::StaticOrder {
    static constexpr int KLOOP = WHD;
    __device__ __forceinline__ bool next(int i, pg8::Unit& u) const { if (!pg8::StaticOrder::next(i >> 1, u)) return false; u.pn |= (i & 1) << 16; return true; }
    __device__ __forceinline__ size_t kofs(const pg8::Unit& u) const { return (size_t)(u.pn >> 16) * (size_t)(WHD * 2); }
    __device__ __forceinline__ bool zero_after(const pg8::Unit& u) const { return (u.pn >> 16) != 0; }
};
struct EpiUp {
    static constexpr bool PERM = true, AFTER_DRAIN = false, INIT = false;
    const bf16* P; bf16* MG;
    __device__ __forceinline__ void operator()(pg8::f32x4 (&acc)[2][2][4][2], const pg8::Unit& u, int wr, int wc, int fr, int fq) const {
        const int pn = u.pn & 0xffff; const bool second = (u.pn >> 16) != 0;
        const int row0 = u.pm * 256 + wr * 64 + fr, col0 = pn * 256 + wc * 32 + 8 * fq;
#pragma unroll
        for (int ai = 0; ai < 2; ++ai)
#pragma unroll
            for (int m = 0; m < 4; ++m) { const int row = row0 + ai * 128 + m * 16;
#pragma unroll
                for (int bj = 0; bj < 2; ++bj) { const int col = col0 + bj * 128;
                    const v4u gb = *(const GAS v4u*)(P + (size_t)row * NIN + C_GB + col);
                    pg8::f32x4& v0 = acc[ai][bj][m][0]; pg8::f32x4& v1 = acc[ai][bj][m][1];
                    if (!second) { const v4u ga = *(const GAS v4u*)(P + (size_t)row * NIN + C_GA + col);
                        v0[0] *= bflo(ga.x) * __builtin_amdgcn_rcpf(bflo(gb.x)); v0[1] *= bfhi(ga.x) * __builtin_amdgcn_rcpf(bfhi(gb.x)); v0[2] *= bflo(ga.y) * __builtin_amdgcn_rcpf(bflo(gb.y)); v0[3] *= bfhi(ga.y) * __builtin_amdgcn_rcpf(bfhi(gb.y));
                        v1[0] *= bflo(ga.z) * __builtin_amdgcn_rcpf(bflo(gb.z)); v1[1] *= bfhi(ga.z) * __builtin_amdgcn_rcpf(bfhi(gb.z)); v1[2] *= bflo(ga.w) * __builtin_amdgcn_rcpf(bflo(gb.w)); v1[3] *= bfhi(ga.w) * __builtin_amdgcn_rcpf(bfhi(gb.w));
                    } else {
                        v4u w; w.x = pg8::cvt_pk_bf16(v0[0] * bflo(gb.x), v0[1] * bfhi(gb.x)); w.y = pg8::cvt_pk_bf16(v0[2] * bflo(gb.y), v0[3] * bfhi(gb.y));
                        w.z = pg8::cvt_pk_bf16(v1[0] * bflo(gb.z), v1[1] * bfhi(gb.z)); w.w = pg8::cvt_pk_bf16(v1[2] * bflo(gb.w), v1[3] * bfhi(gb.w));
                        *(v4u*)(MG + (size_t)row * DM + col) = w; } } }
    }
};
struct EpiOut {
    static constexpr bool PERM = true, AFTER_DRAIN = false, INIT = true;
    const float* X; bf16* H1b; float* SSQ;
    __device__ __forceinline__ void init(pg8::f32x4 (&acc)[2][2][4][2], const pg8::Unit& u, int wr, int wc, int fr_, int fq_) const {
        const int fr = opaque_v(fr_), fq = opaque_v(fq_);
        const float* xp = X + (size_t)(u.pm * 256 + wr * 64 + fr) * DM + u.pn * 256 + wc * 32 + 8 * fq;
#pragma unroll
        for (int ai = 0; ai < 2; ++ai)
#pragma unroll
            for (int bj = 0; bj < 2; ++bj)
#pragma unroll
                for (int m = 0; m < 4; ++m) { const float* q = xp + (size_t)(ai * 128 + m * 16) * DM + bj * 128;
                    acc[ai][bj][m][0] = __builtin_nontemporal_load((const pg8::f32x4*)q); acc[ai][bj][m][1] = __builtin_nontemporal_load((const pg8::f32x4*)(q + 4)); }
    }
    __device__ __forceinline__ void operator()(const pg8::f32x4 (&acc)[2][2][4][2], const pg8::Unit& u, int wr, int wc, int fr, int fq) const {
        const int row0 = u.pm * 256 + wr * 64 + fr, col0 = u.pn * 256 + wc * 32 + 8 * fq;
#pragma unroll
        for (int ai = 0; ai < 2; ++ai)
#pragma unroll
            for (int m = 0; m < 4; ++m) { const int row = row0 + ai * 128 + m * 16; float ss = 0.f;
#pragma unroll
                for (int bj = 0; bj < 2; ++bj) { const int col = col0 + bj * 128; const size_t off = (size_t)row * DM + col;
                    const pg8::f32x4 h0 = acc[ai][bj][m][0], h1 = acc[ai][bj][m][1];
                    ss += (h0[0] * h0[0] + h0[1] * h0[1]) + (h0[2] * h0[2] + h0[3] * h0[3]) + (h1[0] * h1[0] + h1[1] * h1[1]) + (h1[2] * h1[2] + h1[3] * h1[3]);
                    v4u w; w.x = pg8::cvt_pk_bf16(h0[0], h0[1]); w.y = pg8::cvt_pk_bf16(h0[2], h0[3]); w.z = pg8::cvt_pk_bf16(h1[0], h1[1]); w.w = pg8::cvt_pk_bf16(h1[2], h1[3]);
                    *(v4u*)(H1b + off) = w; }
                ss += __shfl_xor(ss, 16); ss += __shfl_xor(ss, 32);
                if (fq == 0) SSQ[(size_t)row * 64 + u.pn * 4 + wc] = ss; }
    }
};
struct EpiFf1 {
    static constexpr bool PERM = true, AFTER_DRAIN = false, INIT = false;
    bf16* H;
    __device__ __forceinline__ void operator()(const pg8::f32x4 (&acc)[2][2][4][2], const pg8::Unit& u, int wr, int wc, int fr, int fq) const {
        const int row0 = u.pm * 256 + wr * 64 + fr, col0 = u.pn * 256 + wc * 32 + 8 * fq;
#pragma unroll
        for (int ai = 0; ai < 2; ++ai)
#pragma unroll
            for (int m = 0; m < 4; ++m) { const int row = row0 + ai * 128 + m * 16;
#pragma unroll
                for (int bj = 0; bj < 2; ++bj) { pg8::f32x4 v0 = acc[ai][bj][m][0], v1 = acc[ai][bj][m][1];
#pragma unroll
                    for (int e = 0; e < 4; ++e) { const float a = fmaxf(v0[e], 0.f), b = fmaxf(v1[e], 0.f); v0[e] = a * a; v1[e] = b * b; }
                    v4u w; w.x = pg8::cvt_pk_bf16(v0[0], v0[1]); w.y = pg8::cvt_pk_bf16(v0[2], v0[3]); w.z = pg8::cvt_pk_bf16(v1[0], v1[1]); w.w = pg8::cvt_pk_bf16(v1[2], v1[3]);
                    *(v4u*)(H + (size_t)row * DFF + col0 + bj * 128) = w; } }
    }
};
struct EpiFf2 {
    static constexpr bool PERM = false, AFTER_DRAIN = false, INIT = true;
    float* O; const float* RSTD; const bf16* H1b;
    __device__ __forceinline__ void init(pg8::f32x4 (&acc)[2][2][4][2], const pg8::Unit& u, int wr, int wc, int fr_, int fq_) const {
        const int fr = opaque_v(fr_), fq = opaque_v(fq_);
        const int row0 = u.pm * 256 + wr * 64 + fr, col0 = u.pn * 256 + wc * 32 + 4 * fq;
#pragma unroll
        for (int ai = 0; ai < 2; ++ai)
#pragma unroll
            for (int bj = 0; bj < 2; ++bj)
#pragma unroll
                for (int m = 0; m < 4; ++m) { const int row = row0 + ai * 128 + m * 16; const float rs = RSTD[row], ir2 = 1.f / (rs * rs); const bf16* rowp = H1b + (size_t)row * DM + col0 + bj * 128;
#pragma unroll
                    for (int n = 0; n < 2; ++n) { const unsigned long long w = *(const GAS unsigned long long*)(rowp + n * 16); const unsigned lo = (unsigned)w, hh = (unsigned)(w >> 32);
                        acc[ai][bj][m][n] = (pg8::f32x4){bflo(lo) * ir2, bfhi(lo) * ir2, bflo(hh) * ir2, bfhi(hh) * ir2}; } }
    }
    __device__ __forceinline__ void operator()(const pg8::f32x4 (&acc)[2][2][4][2], const pg8::Unit& u, int wr, int wc, int fr, int fq) const {
        const int row0 = u.pm * 256 + wr * 64 + fr, col0 = u.pn * 256 + wc * 32 + 4 * fq;
#pragma unroll
        for (int ai = 0; ai < 2; ++ai)
#pragma unroll
            for (int m = 0; m < 4; ++m) { const int row = row0 + ai * 128 + m * 16; const float rs = RSTD[row], r2 = rs * rs; float* rowp = O + (size_t)row * DM + col0;
#pragma unroll
                for (int bj = 0; bj < 2; ++bj)
#pragma unroll
                    for (int n = 0; n < 2; ++n) __builtin_nontemporal_store(acc[ai][bj][m][n] * r2, (pg8::f32x4*)(rowp + bj * 128 + n * 16)); }
    }
};

constexpr int NCONV = 96;
namespace da {
typedef float f32x16 __attribute__((ext_vector_type(16)));
typedef short s16x4 __attribute__((ext_vector_type(4)));
constexpr int KBUF = 16384, VBUF = 16384, K_OFF = 0, V_OFF = 32768;
__device__ __forceinline__ int crow(int r, int hi) { return (r & 3) + 8 * (r >> 2) + 4 * hi; }
__device__ __forceinline__ int kswz(int row, int colB) { return row * 256 + (colB ^ ((row & 7) << 4)); }
__device__ __forceinline__ int v_st(int k, int c) { return ((k >> 3) * 4 + (c >> 5)) * 512 + ((k & 7) * 32 + (c & 31)) * 2; }
__device__ __forceinline__ int v_rd_base(int lane) { return ((lane & 3) << 3) | (((lane >> 2) & 3) << 6) | (((lane >> 4) & 1) << 5) | (((lane >> 5) & 1) << 8); }
__device__ __forceinline__ s16x4 vtr(LAS const unsigned char* p) { return __builtin_bit_cast(s16x4, __builtin_amdgcn_ds_read_tr16_b64_v4i16((LAS s16x4*)p)); }
__device__ __forceinline__ float pl_max(float v) { auto rr = __builtin_amdgcn_permlane32_swap(__float_as_uint(v), __float_as_uint(v), false, false); return fmaxf(__uint_as_float(rr[0]), __uint_as_float(rr[1])); }
__device__ __forceinline__ float pl_sum(float v) { auto rr = __builtin_amdgcn_permlane32_swap(__float_as_uint(v), __float_as_uint(v), false, false); return __uint_as_float(rr[0]) + __uint_as_float(rr[1]); }
__device__ __forceinline__ bf16x8 pack8(const f32x16& p, int base) {
    v4u w; w.x = pg8::cvt_pk_bf16(p[base + 0], p[base + 1]); w.y = pg8::cvt_pk_bf16(p[base + 2], p[base + 3]); w.z = pg8::cvt_pk_bf16(p[base + 4], p[base + 5]); w.w = pg8::cvt_pk_bf16(p[base + 6], p[base + 7]);
    return __builtin_bit_cast(bf16x8, w);
}
__device__ __forceinline__ void qk(f32x16& p0, f32x16& p1, LAS const unsigned char* Kb, LAS const unsigned char* Qw, float negm, int c, int r32, int hi) {
#pragma unroll
    for (int r = 0; r < 16; ++r) { p0[r] = negm; p1[r] = negm; }
#pragma unroll
    for (int d0 = 0; d0 < 4; ++d0) { const int cb = (c * 64 + d0 * 16 + hi * 8) * 2;
        const bf16x8 b0 = *(LAS const bf16x8*)(Kb + kswz(r32, cb)), b1 = *(LAS const bf16x8*)(Kb + kswz(32 + r32, cb)), qf = *(LAS const bf16x8*)(Qw + d0 * 1024);
        p0 = __builtin_amdgcn_mfma_f32_32x32x16_bf16(b0, qf, p0, 0, 0, 0); p1 = __builtin_amdgcn_mfma_f32_32x32x16_bf16(b1, qf, p1, 0, 0, 0); }
}
__device__ __forceinline__ void mask_diag(f32x16& p0, f32x16& p1, int hi, int rel) {
#pragma unroll
    for (int r = 0; r < 16; ++r) { if (crow(r, hi) > rel) p0[r] = -1e30f; if (32 + crow(r, hi) > rel) p1[r] = -1e30f; }
}
__device__ __forceinline__ void partB(f32x16& p0, f32x16& p1, float& l_part, bf16x8 (&pb)[4]) {
    float ps = 0.f;
#pragma unroll
    for (int r = 0; r < 16; ++r) { p0[r] = __builtin_amdgcn_exp2f(p0[r]); p1[r] = __builtin_amdgcn_exp2f(p1[r]); ps += p0[r] + p1[r]; }
    l_part += ps;
    pb[0] = pack8(p0, 0); pb[1] = pack8(p0, 8); pb[2] = pack8(p1, 0); pb[3] = pack8(p1, 8);
}
__device__ __forceinline__ void pv(f32x16 (&o)[4], LAS const unsigned char* Vb, const bf16x8 (&pb)[4], int lane) {
    LAS const unsigned char* vb = Vb + v_rd_base(lane);
#pragma unroll
    for (int d0 = 0; d0 < 4; ++d0) {
        s16x4 lo[4], hh[4];
#pragma unroll
        for (int ks = 0; ks < 4; ++ks) { lo[ks] = vtr(vb + d0 * 512 + ks * 4096); hh[ks] = vtr(vb + d0 * 512 + ks * 4096 + 2048); }
#pragma unroll
        for (int ks = 0; ks < 4; ++ks) {
            const bf16x8 a = (bf16x8){lo[ks][0], lo[ks][1], lo[ks][2], lo[ks][3], hh[ks][0], hh[ks][1], hh[ks][2], hh[ks][3]};
            o[d0] = __builtin_amdgcn_mfma_f32_32x32x16_bf16(a, pb[ks], o[d0], 0, 0, 0); }
    }
}
__device__ __forceinline__ void meta_tile(LAS const unsigned char* Kb, LAS const unsigned char* Vb, LAS const unsigned char* Qw, f32x16 (&o)[4], float& l_part, float negm, int c, int r32, int hi, int lane) {
    f32x16 p0;
#pragma unroll
    for (int r = 0; r < 16; ++r) p0[r] = negm;
#pragma unroll
    for (int d0 = 0; d0 < 4; ++d0) { const int cb = (c * 64 + d0 * 16 + hi * 8) * 2;
        p0 = __builtin_amdgcn_mfma_f32_32x32x16_bf16(*(LAS const bf16x8*)(Kb + kswz(r32, cb)), *(LAS const bf16x8*)(Qw + d0 * 1024), p0, 0, 0, 0); }
    float ps = 0.f;
#pragma unroll
    for (int r = 0; r < 16; ++r) { p0[r] = (crow(r, hi) >= NMETA) ? 0.f : __builtin_amdgcn_exp2f(p0[r]); ps += p0[r]; }
    l_part += ps;
    const bf16x8 pb0 = pack8(p0, 0);
    LAS const unsigned char* vb = Vb + v_rd_base(lane);
#pragma unroll
    for (int d0 = 0; d0 < 4; ++d0) { const s16x4 lo = vtr(vb + d0 * 512), hh = vtr(vb + d0 * 512 + 2048);
        o[d0] = __builtin_amdgcn_mfma_f32_32x32x16_bf16((bf16x8){lo[0], lo[1], lo[2], lo[3], hh[0], hh[1], hh[2], hh[3]}, pb0, o[d0], 0, 0, 0); }
}
constexpr int KB3 = 0, VB3 = 49152, QFR = 98304, MKB = 131072, MVB = 139264;
__device__ __forceinline__ void glds16(const void* g, unsigned lds_base) {
    unsigned sv; asm volatile("s_mov_b32 %0, m0\n\ts_mov_b32 m0, %2\n\ts_nop 0\n\tglobal_load_lds_dwordx4 %1, off\n\ts_mov_b32 m0, %0" : "=&s"(sv) : "v"(g), "s"(lds_base) : "memory"); }
__device__ __forceinline__ void dma_tile(LAS unsigned char* lds, int buf, const bf16* tile0, int wave, int lane_) {
    const int lane = opaque_v(lane_);
    LAS unsigned char* dst = lds + (wave < 4 ? KB3 + buf * KBUF + wave * 4096 : VB3 + buf * VBUF + (wave - 4) * 4096);
#pragma unroll
    for (int i = 0; i < 4; ++i) {
        unsigned off;
        if (wave < 4) { const int p = 4 * wave + i, row = 4 * p + (lane >> 4), colB = ((lane & 15) ^ (row & 7)) << 4; off = (unsigned)(row * NIN + C_K + (colB >> 1)); }
        else { const int p = 4 * (wave - 4) + i, st = 2 * p + (lane >> 5), key = (st >> 2) * 8 + ((lane & 31) >> 2), col = (st & 3) * 32 + (lane & 3) * 8; off = (unsigned)(key * NIN + C_V + col); }
        glds16(tile0 + off, (unsigned)__builtin_amdgcn_readfirstlane((int)(unsigned)(size_t)(dst + i * 1024))); }
}
typedef __bf16 bf16v2_ __attribute__((ext_vector_type(2)));
__device__ __forceinline__ unsigned cvt2(float lo, float hi) { const pg8::f32x2 v = {lo, hi}; return __builtin_bit_cast(unsigned, __builtin_convertvector(v, bf16v2_)); }
#define ATT_SBAR() __builtin_amdgcn_sched_barrier(0)
#define ATT_PIN(x) asm volatile("" : "+v"(x))
__device__ __forceinline__ void fast_step(f32x16 (&o)[4], f32x16& s0, f32x16& s1, float& l_part, const f32x16& negm16, LAS const unsigned char* Vslot, LAS const unsigned char* Kb, LAS const unsigned char* Qw, int c, int r32, int hi, int lane) {
    LAS const unsigned char* vb = Vslot + v_rd_base(lane);
    float ps = 0.f; unsigned pk[4], pn[4];
#pragma unroll
    for (int i = 0; i < 4; ++i) { const float x = __builtin_amdgcn_exp2f(s0[2 * i]), y = __builtin_amdgcn_exp2f(s0[2 * i + 1]); ps += x; ps += y; pk[i] = cvt2(x, y); }
    s16x4 va[8], vn[8];
#pragma unroll
    for (int d0 = 0; d0 < 4; ++d0) { va[2 * d0] = vtr(vb + d0 * 512); va[2 * d0 + 1] = vtr(vb + d0 * 512 + 2048); }
    bf16x8 kb0[4], kb1[4], qf[4];
    ATT_SBAR();
#pragma unroll
    for (int ch = 0; ch < 4; ++ch) {
        const bf16x8 pbc = __builtin_bit_cast(bf16x8, ((v4u){pk[0], pk[1], pk[2], pk[3]}));
#pragma unroll
        for (int d0 = 0; d0 < 4; ++d0) {
            const bf16x8 a = (bf16x8){va[2 * d0][0], va[2 * d0][1], va[2 * d0][2], va[2 * d0][3], va[2 * d0 + 1][0], va[2 * d0 + 1][1], va[2 * d0 + 1][2], va[2 * d0 + 1][3]};
            o[d0] = __builtin_amdgcn_mfma_f32_32x32x16_bf16(a, pbc, o[d0], 0, 0, 0);
            if (ch < 3) {
                const int nb = ((ch + 1) & 1) * 8 + 2 * d0;
                const float x = __builtin_amdgcn_exp2f((ch + 1 < 2) ? s0[nb] : s1[nb]), y = __builtin_amdgcn_exp2f((ch + 1 < 2) ? s0[nb + 1] : s1[nb + 1]);
                ps += x; ps += y; pn[d0] = cvt2(x, y);
                vn[2 * d0] = vtr(vb + d0 * 512 + (ch + 1) * 4096); vn[2 * d0 + 1] = vtr(vb + d0 * 512 + (ch + 1) * 4096 + 2048);
                ATT_PIN(pn[d0]); ATT_PIN(ps);
            } else {
                const int cb = (c * 64 + d0 * 16 + hi * 8) * 2;
                kb0[d0] = *(LAS const bf16x8*)(Kb + kswz(r32, cb)); kb1[d0] = *(LAS const bf16x8*)(Kb + kswz(32 + r32, cb)); qf[d0] = *(LAS const bf16x8*)(Qw + d0 * 1024);
            }
            ATT_SBAR();
        }
        if (ch < 3) {
#pragma unroll
            for (int i = 0; i < 4; ++i) pk[i] = pn[i];
#pragma unroll
            for (int i = 0; i < 8; ++i) va[i] = vn[i];
        }
    }
    l_part += ps;
    s0 = __builtin_amdgcn_mfma_f32_32x32x16_bf16(kb0[0], qf[0], negm16, 0, 0, 0); s1 = __builtin_amdgcn_mfma_f32_32x32x16_bf16(kb1[0], qf[0], negm16, 0, 0, 0);
#pragma unroll
    for (int d0 = 1; d0 < 4; ++d0) { s0 = __builtin_amdgcn_mfma_f32_32x32x16_bf16(kb0[d0], qf[d0], s0, 0, 0, 0); s1 = __builtin_amdgcn_mfma_f32_32x32x16_bf16(kb1[d0], qf[d0], s1, 0, 0, 0); }
}
__device__ __forceinline__ void unit(LAS unsigned char* lds, const bf16* P, const bf16* Pm, bf16* YA, const float* subln, const float* kn, const float* rope, float lam, float mfix, int b, int h, int qb, int tid, int wave, int lane_in) {
    const int c = wave >> 2, jw = wave & 3, q0 = qb * 128, NT = 2 * qb + 2;
    const bf16* tb0 = P + (size_t)(b * SEQ) * NIN + h * 128;
    f32x16 o[4] = {}; float l_part = 0.f; const float negm = -mfix;
    { const int lane = lane_in, r32 = lane & 31, hi = lane >> 5;
    dma_tile(lds, 0, tb0, wave, lane); dma_tile(lds, 1, tb0 + (size_t)64 * NIN, wave, lane);
    if (c == 0 && NT > 2) dma_tile(lds, 2, tb0 + (size_t)128 * NIN, wave, lane);
    LAS unsigned char* Qw = lds + QFR + wave * 4096 + lane * 16;
    { const bf16* qp = P + (size_t)(b * SEQ + q0 + jw * 32 + r32) * NIN + C_Q + h * 128 + c * 64 + hi * 8;
#pragma unroll
      for (int d0 = 0; d0 < 4; ++d0) *(LAS bf16x8*)(Qw + d0 * 1024) = *(const GAS bf16x8*)(qp + d0 * 16); }
    { const int sr = tid >> 4, sc = (tid & 15) * 8, mr = sr & 15;
      if (tid < 256) {
          const v4u raw = *(const GAS v4u*)(Pm + (size_t)mr * NIN + C_K + h * 128 + sc); const int sub = tid & 7;
          float xv[8] = {bflo(raw.x), bfhi(raw.x), bflo(raw.y), bfhi(raw.y), bflo(raw.z), bfhi(raw.z), bflo(raw.w), bfhi(raw.w)};
          float ss = 0.f;
#pragma unroll
          for (int j = 0; j < 8; ++j) ss += xv[j] * xv[j];
          ss += __shfl_xor(ss, 1); ss += __shfl_xor(ss, 2); ss += __shfl_xor(ss, 4);
          const float rstd = 1.f / sqrtf(ss * (1.f / 64.f) + EPS); float ov[8];
#pragma unroll
          for (int j = 0; j < 8; ++j) { const float xn = xv[j] * rstd * kn[sub * 8 + j], pr = __shfl_xor(xn, 1), cs = rope[mr * 16 + j], sn = rope[mr * 16 + 8 + j];
              ov[j] = (sub == 0) ? xn * cs - pr * sn : (sub == 1) ? xn * cs + pr * sn : xn; }
          v4u v; v.x = pk2(ov[0], ov[1]); v.y = pk2(ov[2], ov[3]); v.z = pk2(ov[4], ov[5]); v.w = pk2(ov[6], ov[7]);
          *(LAS v4u*)(lds + MKB + kswz(mr, sc * 2)) = v; }
      else           { const v4u v = *(const GAS v4u*)(Pm + (size_t)mr * NIN + C_V + h * 128 + sc); *(LAS v4u*)(lds + MVB + v_st(mr, sc)) = v; } }
    asm volatile("s_waitcnt vmcnt(0)" ::: "memory"); __syncthreads();
    meta_tile(lds + MKB, lds + MVB, Qw, o, l_part, negm, c, r32, hi, lane);
    f32x16 s0, s1;
    qk(s0, s1, lds + KB3, Qw, negm, c, r32, hi);
    if (qb == 0) mask_diag(s0, s1, hi, 32 * jw + r32);
    int s_j = 0;
    int j = 0;
    { f32x16 negm16;
#pragma unroll
      for (int r = 0; r < 16; ++r) negm16[r] = negm;
      ATT_PIN(negm16);
#pragma unroll 1
      for (; j < NT - 3; ++j) {
        const int s_j1 = (s_j == 2) ? 0 : s_j + 1, s_j2 = (s_j1 == 2) ? 0 : s_j1 + 1;
        asm volatile("s_waitcnt vmcnt(4) lgkmcnt(0)" ::: "memory"); __builtin_amdgcn_s_barrier(); asm volatile("" ::: "memory");
        if (c == 0) dma_tile(lds, s_j, tb0 + (size_t)(j + 3) * 64 * NIN, wave, lane); else dma_tile(lds, s_j2, tb0 + (size_t)(j + 2) * 64 * NIN, wave, lane);
        fast_step(o, s0, s1, l_part, negm16, lds + VB3 + s_j * VBUF, lds + KB3 + s_j1 * KBUF, Qw, c, r32, hi, lane);
        s_j = s_j1;
      } }
#pragma unroll 1
    for (; j < NT; ++j) {
        const int s_j1 = (s_j == 2) ? 0 : s_j + 1, s_j2 = (s_j1 == 2) ? 0 : s_j1 + 1;
        { if ((c == 0) ? (j + 2 < NT) : (j + 1 < NT)) asm volatile("s_waitcnt vmcnt(4) lgkmcnt(0)" ::: "memory"); else asm volatile("s_waitcnt vmcnt(0) lgkmcnt(0)" ::: "memory");
            __builtin_amdgcn_s_barrier(); asm volatile("" ::: "memory"); }
        if (c == 0) { if (j + 3 < NT) dma_tile(lds, s_j, tb0 + (size_t)(j + 3) * 64 * NIN, wave, lane); }
        else        { if (j + 2 < NT) dma_tile(lds, s_j2, tb0 + (size_t)(j + 2) * 64 * NIN, wave, lane); }
        const int dt = j - 2 * qb, dn = dt + 1;
        const bool act = !(dt == 1 && jw < 2), actn = (j + 1 < NT) && !(dn == 1 && jw < 2);
        if (act) { bf16x8 pb[4]; partB(s0, s1, l_part, pb); pv(o, lds + VB3 + s_j * VBUF, pb, lane); }
        if (actn) { qk(s0, s1, lds + KB3 + s_j1 * KBUF, Qw, negm, c, r32, hi); if (dn >= 0) mask_diag(s0, s1, hi, 32 * jw + r32 - 64 * dn); }
        s_j = s_j1;
    }
    }
    __syncthreads();
    LAS float* ex = (LAS float*)lds;
    const int lane = opaque_v(lane_in), r32 = lane & 31, hi = lane >> 5;
    const float l_reg = pl_sum(l_part);
    if (c == 1) { const float s1x = -lam / l_reg;
#pragma unroll
        for (int d0 = 0; d0 < 4; ++d0)
#pragma unroll
            for (int r = 0; r < 16; ++r) ex[((jw * 4 + d0) * 16 + r) * 64 + lane] = o[d0][r] * s1x; }
    __syncthreads();
    if (c == 0) { const float il = 1.f / l_reg; float ss = 0.f;
#pragma unroll
        for (int d0 = 0; d0 < 4; ++d0)
#pragma unroll
            for (int r = 0; r < 16; ++r) { const float v = o[d0][r] * il + ex[((jw * 4 + d0) * 16 + r) * 64 + lane]; o[d0][r] = v; ss += v * v; }
        ss = pl_sum(ss);
        const float rstd = (1.f - LAM_INIT) / sqrtf(ss * (1.f / 128.f) + EPS);
        bf16* yp = YA + (size_t)(b * SEQ + q0 + jw * 32 + r32) * YP + h * 128;
#pragma unroll
        for (int d0 = 0; d0 < 4; ++d0)
#pragma unroll
            for (int g = 0; g < 4; ++g) { const int e = 32 * d0 + 8 * g + 4 * hi; const f32x4 sw = *(const GAS f32x4*)(subln + e);
                const unsigned w0 = pg8::cvt_pk_bf16(o[d0][4 * g + 0] * rstd * sw.x, o[d0][4 * g + 1] * rstd * sw.y), w1 = pg8::cvt_pk_bf16(o[d0][4 * g + 2] * rstd * sw.z, o[d0][4 * g + 3] * rstd * sw.w);
                *(GAS unsigned long long*)(yp + e) = (unsigned long long)w0 | ((unsigned long long)w1 << 32); }
    }
    __syncthreads();
}
}


namespace hg {
using da::f32x16; using da::s16x4; using da::crow; using da::vtr; using da::pl_sum; using da::pack8;
__device__ __forceinline__ int ioff(int row, int ch) { return 2048 * (row >> 3) + 512 * (ch >> 2) + 64 * (row & 7) + 16 * ((ch & 3) ^ ((row >> 2) & 3)); }
constexpr int QD = 0, KI = 16384, VI = 32768, SI = 49152, DECL = 81920, SSQ = 82432;
__device__ __forceinline__ bf16x8 cat(s16x4 lo, s16x4 hh) { return (bf16x8){lo[0], lo[1], lo[2], lo[3], hh[0], hh[1], hh[2], hh[3]}; }
__device__ __forceinline__ void unit(LAS unsigned char* lds, const bf16* P, const bf16* Pm, bf16* YB, const float* DEC, const float* onorm, const float* hlb, int b, int h, int tid, int wave, int lane) {
    const int r32 = lane & 31, hi = lane >> 5, blk = (lane >> 4) & 1, q4 = (lane & 15) >> 2, p4 = lane & 3;
    const int eb = wave & 3, tb = wave >> 2;
    const int trc = 2 * blk + (p4 >> 1), trb = 8 * (p4 & 1);
#pragma unroll
    for (int i = 0; i < 4; ++i) *(LAS v4u*)(lds + SI + (tid * 4 + i) * 16) = (v4u){0u, 0u, 0u, 0u};
    f32x16 acc0 = {}, acc1 = {};
    const int sr = tid >> 4, sch = tid & 15;
    const v4u z4 = (v4u){0u, 0u, 0u, 0u};
    v4u q0 = z4, q1 = z4, k0 = z4, k1 = z4, v0 = z4, v1 = z4; float dcv = 0.f;
    if (sr < NMETA) { const bf16* mp = Pm + (size_t)sr * NIN + h * 128 + sch * 8; v0 = *(const GAS v4u*)(mp + C_HI); }
    LAS float* dec = (LAS float*)(lds + DECL); LAS float* ssq = (LAS float*)(lds + SSQ);
    if (tid < 128) {
        const int col = h * 128 + tid; const float lb = 1.f / (1.f + __expf(hlb[WHD + col] - hlb[col]));
        float xr[NMETA];
#pragma unroll
        for (int r = 0; r < NMETA; ++r) xr[r] = bf2f(Pm[(size_t)r * NIN + C_HF + col]);
        float run = 0.f;
#pragma unroll
        for (int r = 0; r < NMETA; ++r) { const float f = lb + (1.f - lb) * sigmoidf_(xr[r]); run += __logf(f);
            *(LAS unsigned short*)(lds + KI + ioff(r, tid >> 3) + (tid & 7) * 2) = (unsigned short)f2bf((1.f - f) * __expf(-run)); }
        dec[tid] = __expf(run);
    }
#pragma unroll 1
    for (int n = 0; n <= 32; ++n) {
        { const int o0 = ioff(sr, sch), o1 = ioff(32 + sr, sch);
          *(LAS v4u*)(lds + QD + o0) = q0; *(LAS v4u*)(lds + QD + o1) = q1; if (n > 0 || sr >= NMETA) *(LAS v4u*)(lds + KI + o0) = k0; *(LAS v4u*)(lds + KI + o1) = k1; *(LAS v4u*)(lds + VI + o0) = v0; *(LAS v4u*)(lds + VI + o1) = v1; }
        if (tid < 128 && n > 0) dec[tid] = dcv;
        __syncthreads();
        if (n < 32) {
            const bf16* rp = P + (size_t)(b * SEQ + 64 * n + sr) * NIN + h * 128 + sch * 8; const size_t r32o = (size_t)32 * NIN;
            q0 = *(const GAS v4u*)(rp + C_HQ); q1 = *(const GAS v4u*)(rp + C_HQ + r32o); k0 = *(const GAS v4u*)(rp + C_HF); k1 = *(const GAS v4u*)(rp + C_HF + r32o);
            v0 = *(const GAS v4u*)(rp + C_HI); v1 = *(const GAS v4u*)(rp + C_HI + r32o);
            if (tid < 128) dcv = DEC[(size_t)(b * 32 + n) * WHD + h * 128 + tid];
        }
        unsigned long long gw[4] = {0ull, 0ull, 0ull, 0ull};
        if (n > 0) { const bf16* gp = P + (size_t)(b * SEQ + 64 * (n - 1) + 32 * tb + r32) * NIN + C_HG + h * 128 + 32 * eb + 4 * hi;
#pragma unroll
            for (int g = 0; g < 4; ++g) gw[g] = *(const GAS unsigned long long*)(gp + 8 * g); }
        bf16x8 vf[4];
#pragma unroll
        for (int ks = 0; ks < 4; ++ks) vf[ks] = cat(vtr(lds + VI + ioff(16 * ks + 4 * hi + q4, 4 * eb + trc) + trb), vtr(lds + VI + ioff(16 * ks + 8 + 4 * hi + q4, 4 * eb + trc) + trb));
        f32x16 o = {};
        if (n > 0) {
#pragma unroll
            for (int sb = 0; sb < 2; ++sb) if (sb <= tb) {
                f32x16 X = {};
#pragma unroll
                for (int ds = 0; ds < 8; ++ds) { const bf16x8 A = *(const LAS bf16x8*)(lds + KI + ioff(32 * sb + r32, 2 * ds + hi)), B = *(const LAS bf16x8*)(lds + QD + ioff(32 * tb + r32, 2 * ds + hi));
                    X = __builtin_amdgcn_mfma_f32_32x32x16_bf16(A, B, X, 0, 0, 0); }
                if (sb == tb) {
#pragma unroll
                    for (int r = 0; r < 16; ++r) if (crow(r, hi) > r32) X[r] = 0.f; }
                o = __builtin_amdgcn_mfma_f32_32x32x16_bf16(vf[2 * sb], pack8(X, 0), o, 0, 0, 0);
                o = __builtin_amdgcn_mfma_f32_32x32x16_bf16(vf[2 * sb + 1], pack8(X, 8), o, 0, 0, 0);
            }
#pragma unroll
            for (int ds = 0; ds < 8; ++ds) { const bf16x8 A = cat(vtr(lds + SI + ioff(16 * ds + 8 * hi + q4, 4 * eb + trc) + trb), vtr(lds + SI + ioff(16 * ds + 8 * hi + 4 + q4, 4 * eb + trc) + trb));
                const bf16x8 B = *(const LAS bf16x8*)(lds + QD + ioff(32 * tb + r32, 2 * ds + hi));
                o = __builtin_amdgcn_mfma_f32_32x32x16_bf16(A, B, o, 0, 0, 0); }
            float ss = 0.f;
#pragma unroll
            for (int r = 0; r < 16; ++r) ss += o[r] * o[r];
            ss = pl_sum(ss);
            if (hi == 0) ssq[eb * 64 + 32 * tb + r32] = ss;
        }
#pragma unroll
        for (int ks = 0; ks < 4; ++ks) {
            const bf16x8 B0 = cat(vtr(lds + KI + ioff(16 * ks + 4 * hi + q4, 4 * (2 * tb) + trc) + trb), vtr(lds + KI + ioff(16 * ks + 8 + 4 * hi + q4, 4 * (2 * tb) + trc) + trb));
            const bf16x8 B1 = cat(vtr(lds + KI + ioff(16 * ks + 4 * hi + q4, 4 * (2 * tb + 1) + trc) + trb), vtr(lds + KI + ioff(16 * ks + 8 + 4 * hi + q4, 4 * (2 * tb + 1) + trc) + trb));
            acc0 = __builtin_amdgcn_mfma_f32_32x32x16_bf16(vf[ks], B0, acc0, 0, 0, 0); acc1 = __builtin_amdgcn_mfma_f32_32x32x16_bf16(vf[ks], B1, acc1, 0, 0, 0); }
        { const float d0 = dec[32 * (2 * tb) + r32], d1 = dec[32 * (2 * tb + 1) + r32];
#pragma unroll
          for (int r = 0; r < 16; ++r) { acc0[r] *= d0; acc1[r] *= d1; } }
        __syncthreads();
#pragma unroll
        for (int g = 0; g < 4; ++g) {
            *(LAS unsigned long long*)(lds + SI + ioff(32 * (2 * tb) + r32, 4 * eb + g) + 8 * hi) = (unsigned long long)pg8::cvt_pk_bf16(acc0[4 * g], acc0[4 * g + 1]) | ((unsigned long long)pg8::cvt_pk_bf16(acc0[4 * g + 2], acc0[4 * g + 3]) << 32);
            *(LAS unsigned long long*)(lds + SI + ioff(32 * (2 * tb + 1) + r32, 4 * eb + g) + 8 * hi) = (unsigned long long)pg8::cvt_pk_bf16(acc1[4 * g], acc1[4 * g + 1]) | ((unsigned long long)pg8::cvt_pk_bf16(acc1[4 * g + 2], acc1[4 * g + 3]) << 32); }
        if (n > 0) {
            const int t = 32 * tb + r32; const float tot = (ssq[t] + ssq[64 + t]) + (ssq[128 + t] + ssq[192 + t]);
            const float rstd = 1.f / sqrtf(tot * (1.f / 128.f) + EPS);
            const size_t row = (size_t)(b * SEQ + 64 * (n - 1) + t);
#pragma unroll
            for (int g = 0; g < 4; ++g) { const int e = 32 * eb + 8 * g + 4 * hi;
                const unsigned g01 = (unsigned)gw[g], g23 = (unsigned)(gw[g] >> 32);
                const f32x4 on = *(const GAS f32x4*)(onorm + e);
                const float y0 = o[4 * g] * rstd * on.x * sigmoidf_(bflo(g01)), y1 = o[4 * g + 1] * rstd * on.y * sigmoidf_(bfhi(g01)), y2 = o[4 * g + 2] * rstd * on.z * sigmoidf_(bflo(g23)), y3 = o[4 * g + 3] * rstd * on.w * sigmoidf_(bfhi(g23));
                const unsigned w0 = pg8::cvt_pk_bf16(y0, y1);
                const unsigned w1 = pg8::cvt_pk_bf16(y2, y3);
                *(GAS unsigned long long*)(YB + row * YP + h * 128 + e) = (unsigned long long)w0 | ((unsigned long long)w1 << 32); }
        }
    }
    __syncthreads();
}
}

#define PHASE_PTRS unsigned char* ws = (unsigned char*)ldp(lds, 20); \
    gu32* ctl = (gu32*)(ws + WS_CTL); \
    const float* x = (const float*)ldp(lds, 0); const float* meta = (const float*)ldp(lds, 1); const float* norm_mix = (const float*)ldp(lds, 2); const float* w_in = (const float*)ldp(lds, 3); \
    const float* q_norm = (const float*)ldp(lds, 4); const float* k_norm = (const float*)ldp(lds, 5); \
    const float* lq1 = (const float*)ldp(lds, 6); const float* lk1 = (const float*)ldp(lds, 7); const float* lq2 = (const float*)ldp(lds, 8); const float* lk2 = (const float*)ldp(lds, 9); \
    const float* subln = (const float*)ldp(lds, 10); const float* hg_lb = (const float*)ldp(lds, 11); const float* hg_onorm = (const float*)ldp(lds, 12); \
    const float* w_up_a = (const float*)ldp(lds, 13); const float* w_up_b = (const float*)ldp(lds, 14); const float* w_out = (const float*)ldp(lds, 15); const float* norm_mlp = (const float*)ldp(lds, 16); \
    const float* w_ff1 = (const float*)ldp(lds, 17); const float* w_ff2 = (const float*)ldp(lds, 18); \
    float* out = (float*)ldp(lds, 19); \
    bf16* Wt_in = (bf16*)(ws + WS_WIN); bf16* Wt_upa = (bf16*)(ws + WS_WUPA); bf16* Wt_upb = (bf16*)(ws + WS_WUPB); bf16* Wt_out = (bf16*)(ws + WS_WOUT); \
    bf16* Wt_ff1 = (bf16*)(ws + WS_WFF1); bf16* Wt_ff2 = (bf16*)(ws + WS_WFF2); \
    bf16* U = (bf16*)(ws + WS_U); bf16* Umeta = (bf16*)(ws + WS_UMETA); bf16* Pm = (bf16*)(ws + WS_PM); float* ROPE = (float*)(ws + WS_ROPE); \
    float* RSTD = (float*)(ws + WS_RSTD); float* SSQ = (float*)(ws + WS_SSQ); float* DEC = (float*)(ws + WS_DEC); bf16* P = (bf16*)(ws + WS_P); bf16* HID = (bf16*)(ws + WS_P); \
    unsigned char* U8 = ws + WS_U8; unsigned char* W8 = ws + WS_W8; float* SU = (float*)(ws + WS_SU); float* SW = (float*)(ws + WS_SW); bf16* YA = (bf16*)(ws + WS_YA); bf16* YB = YA + WHD;      bf16* MG = (bf16*)(ws + WS_MG);
__global__ void __launch_bounds__(NWAVES * 64, 2) mk_fwd(Ptrs args) {
    extern __shared__ __attribute__((aligned(16))) unsigned char lds_raw[];
    LAS unsigned char* lds = (LAS unsigned char*)lds_raw;
    volatile LAS unsigned* MISC = (volatile LAS unsigned*)(lds + LDSCTL_OFF);
    const int G = gridDim.x, bx = blockIdx.x;
    const int vcu = (G % 8 == 0) ? (bx % 8) * (G / 8) + bx / 8 : bx;

    { PHASE_IDS
    for (int u = tid; u < (LDS_BYTES - LDSCTL_OFF) / 4; u += NWAVES * 64) ((LAS unsigned*)(lds + LDSCTL_OFF))[u] = 0u;
    __syncthreads();
    if (tid == 0) {
#pragma unroll
        for (int k = 0; k < 21; ++k) { const unsigned long long pv_ = (k < 19) ? (unsigned long long)args.in[k < 19 ? k : 0] : (k == 19 ? (unsigned long long)args.out : (unsigned long long)args.ws);
            MISC[32 + 2 * k] = (unsigned)pv_; MISC[33 + 2 * k] = (unsigned)(pv_ >> 32); } } }
    __syncthreads();
    XcdBarrier bar = xcd_barrier_post((unsigned*)((gu32*)args.ws + CW_BAR), MISC + 8);
    { PHASE_IDS PHASE_PTRS
    if (wave == 0) {
        const float s1 = wave_sum(lq1[lane] * lk1[lane]), s2 = wave_sum(lq2[lane] * lk2[lane]);
        if (lane == 0) ((LAS float*)(lds + LDSCTL_OFF))[16] = expf(s1) - expf(s2) + LAM_INIT;
        const float wqm = wave_max(fabsf(q_norm[lane])), wkm = wave_max(fabsf(k_norm[lane]));
        if (lane == 0) ((LAS float*)(lds + LDSCTL_OFF))[17] = fmaxf(0.f, 64.f * C2 * wqm * wkm - 64.f);
    } }
    __syncthreads();

    { PHASE_IDS PHASE_PTRS
        LAS float* scr = (LAS float*)(lds + wave * 16384);
        const int gw = vcu * NWAVES + wave, NGW = G * NWAVES;
        constexpr int I_QK = (DM / 64) * (NIN / 32);
        for (int it = gw; it < I_QK; it += NGW) p0_transpose_item<true>(w_in, DM, NIN, Wt_in, scr, it, lane);
        for (int m = gw; m < MR + NMETA; m += NGW) {
            if (m < MR) rms_row_to_bf16(x + (size_t)m * DM, norm_mix, nullptr, lane, U8 + (size_t)m * DM, SU + m);
            else rms_row_to_bf16(meta + (size_t)(m - MR) * DM, norm_mix, Umeta + (size_t)(m - MR) * DM, lane);
        }
        const int gt = tid * G + bx;
        if (gt < TT * 8) {
            const int pos = gt >> 3, j = gt & 7;
            const float invf[8] = {1.0f, 0.1939227432012558f, 0.03760603070259094f, 0.007292664609849453f, 0.0014142135623842478f, 0.00027424818836152554f, 5.3182957344688475e-05f, 1.0313385246263351e-05f};
            float inv = invf[0];
#pragma unroll
            for (int q = 1; q < 8; ++q) inv = (j == q) ? invf[q] : inv;
            const float ang = (float)pos * inv; float sn, cs; sincos_d((double)ang, sn, cs);
            ROPE[pos * 16 + j] = cs; ROPE[pos * 16 + 8 + j] = sn;
        }
    }
    xcd_barrier(bar);

    { PHASE_IDS PHASE_PTRS
        const int gw = vcu * NWAVES + wave, NGW = G * NWAVES;
        auto ldrow = [&](v4u (&q)[8], int r) {
            const GAS v4u* rp = (const GAS v4u*)(Wt_in + (size_t)r * DM) + lane;
#pragma unroll
            for (int j = 0; j < 8; ++j) q[j] = __builtin_nontemporal_load(rp + 64 * j); };
        auto dorow = [&](const v4u (&q)[8], int r) {
            unsigned mb = 0u;
#pragma unroll
            for (int j = 0; j < 8; ++j)
#pragma unroll
                for (int e = 0; e < 4; ++e) { const unsigned w = q[j][e]; const unsigned hi_ = w & 0x7fff0000u, lo_ = (w << 16) & 0x7fff0000u; mb = mb > hi_ ? mb : hi_; mb = mb > lo_ ? mb : lo_; }
            const float cmax = wave_max(__uint_as_float(mb)), inv = cmax > 0.f ? 127.f / cmax : 0.f;
            GAS unsigned long long* op = (GAS unsigned long long*)(W8 + (size_t)r * DM) + lane;
#pragma unroll
            for (int j = 0; j < 8; ++j) op[64 * j] = (unsigned long long)pk4_i8(bflo(q[j].x) * inv, bfhi(q[j].x) * inv, bflo(q[j].y) * inv, bfhi(q[j].y) * inv) | ((unsigned long long)pk4_i8(bflo(q[j].z) * inv, bfhi(q[j].z) * inv, bflo(q[j].w) * inv, bfhi(q[j].w) * inv) << 32);
            if (lane == 0) SW[r] = cmax * (1.f / 127.f); };
        int r = gw;
        if (r < NIN) {
            v4u qa[8], qb[8]; ldrow(qa, r);
#pragma unroll 1
            for (;;) {
                const int r1 = r + NGW; ldrow(qb, r1 < NIN ? r1 : r);
                dorow(qa, r);
                if (r1 >= NIN) break;
                const int r2 = r1 + NGW; ldrow(qa, r2 < NIN ? r2 : r1);
                dorow(qb, r1);
                if (r2 >= NIN) break;
                r = r2;
            }
        }
    }
    xcd_barrier(bar);

    { PHASE_IDS PHASE_PTRS
        { constexpr int UPB = DM * 2 + 16, PART = 16 * UPB;
          for (int i = tid; i < NMETA * DM * 2 / 16; i += NWAVES * 64) { const int r = i >> 9, cch = i & 511; *(LAS v4u*)(lds + r * UPB + cch * 16) = ((const GAS v4u*)Umeta)[i]; }
          __syncthreads();
          const int tsel = wave >> 2, kq = wave & 3, fr = lane & 15, fq = lane >> 4;
#pragma unroll 1
          for (int cb = vcu * 32; cb < 8192; cb += G * 32) {
              const int ci = cb + tsel * 16 + fr; const int c = (ci < 4096) ? (C_K + ci) : (C_HF + (ci - 4096));
              const bf16* wrow = Wt_in + (size_t)wt_row(c) * DM + kq * 1024 + fq * 8;
              LAS const unsigned char* arow = lds + fr * UPB + (kq * 1024 + fq * 8) * 2;
              f32x4 acc = {0.f, 0.f, 0.f, 0.f};
#pragma unroll 1
              for (int kb = 0; kb < 32; kb += 8) {
                  bf16x8 bfr[8];
#pragma unroll
                  for (int i = 0; i < 8; ++i) bfr[i] = *(const GAS bf16x8*)(wrow + (kb + i) * 32);
#pragma unroll
                  for (int i = 0; i < 8; ++i) { const bf16x8 afr = *(LAS const bf16x8*)(arow + (kb + i) * 64); acc = __builtin_amdgcn_mfma_f32_16x16x32_bf16(afr, bfr[i], acc, 0, 0, 0); }
              }
              *(LAS f32x4*)(lds + PART + (wave * 64 + lane) * 16) = acc;
              __syncthreads();
              if (kq == 0) { f32x4 s = acc;
#pragma unroll
                  for (int q = 1; q < 4; ++q) { const f32x4 t = *(LAS const f32x4*)(lds + PART + ((wave + q) * 64 + lane) * 16); s = s + t; }
#pragma unroll
                  for (int reg = 0; reg < 4; ++reg) Pm[(size_t)(4 * fq + reg) * NIN + c] = (bf16)f2bf(s[reg]); }
              __syncthreads();
          }
        }
        { pg8::Gemm g{(const bf16*)U8, (const bf16*)W8, MR, NQK, DM / 2}; pg8::StaticOrder S; S.init(MR, NQK, G, bx);
          EpiProjT<true> E{P, q_norm, k_norm, ROPE, hg_lb, DEC, 0, 1.f, SU, SW};
          pg8::gemm_phase<EpiProjT<true>, pg8::StaticOrder, true, true, false, true>(lds, g, S, E); }
        __syncthreads();
        { pg8::Gemm g{(const bf16*)U8, (const bf16*)(W8 + (size_t)NQK * DM), MR, NIN - NQK, DM / 2}; pg8::StaticOrder S; S.init(MR, NIN - NQK, G, bx);
          EpiProjT<false> E{P, q_norm, k_norm, ROPE, hg_lb, DEC, NQK / 256, 1.f, SU, SW};
          pg8::gemm_phase<EpiProjT<false>, pg8::StaticOrder, true, true, false, true>(lds, g, S, E); }
    }
    xcd_barrier(bar);


    { PHASE_IDS PHASE_PTRS
        { const int nconv = (G > 2 * NCONV) ? NCONV : G, cv = bx - (G - nconv);
          if (cv >= 0) {
              LAS unsigned* scr = (LAS unsigned*)(lds + wave * TSCR_BYTES);
#pragma unroll 1
              for (int it = cv * NWAVES + wave; it < TI_ALL; it += nconv * NWAVES) { const TItem t = t_decode(lds, it); t_convert(t, scr, lane); }
              __syncthreads();
          } }
        gu32* qh_h = ctl + CW_QHEAD; gu32* qh_a = ctl + CW_QHEAD + 64; const float lam = ((volatile LAS float*)(lds + LDSCTL_OFF))[16], mfix = ((volatile LAS float*)(lds + LDSCTL_OFF))[17];
#pragma unroll 1
        for (;;) {
            if (tid == 0) MISC[20] = __hip_atomic_fetch_add(qh_h, 1u, RLX_AGENT);
            __syncthreads();
            const int it = (int)MISC[20];
            __syncthreads();
            if (it >= 64) break;
            hg::unit(lds, P, Pm, YB, DEC, hg_onorm, hg_lb, it >> 4, it & 15, tid, wave, lane);
        }
#pragma unroll 1
        for (;;) {
            if (tid == 0) MISC[20] = __hip_atomic_fetch_add(qh_a, 1u, RLX_AGENT);
            __syncthreads();
            const int u = (int)MISC[20];
            __syncthreads();
            if (u >= NB * NH * 16) break;
            const int qb = 15 - (u >> 6), bh = u & 63;
            da::unit(lds, P, Pm, YA, subln, k_norm, ROPE, lam, mfix, bh >> 4, bh & 15, qb, tid, wave, lane);
        }
    }
    xcd_barrier(bar);

    { PHASE_IDS PHASE_PTRS
        pg8::Gemm g{YA, Wt_upa, MR, DM, YP}; HalfOrder S; S.init(MR, DM, G, bx); EpiUp E{P, MG};
        pg8::gemm_phase<EpiUp, HalfOrder, true, true>(lds, g, S, E);
    }
    xcd_barrier(bar);

    { PHASE_IDS PHASE_PTRS
        pg8::Gemm g{MG, Wt_out, MR, DM, DM}; pg8::StaticOrder S; S.init(MR, DM, G, bx); EpiOut E{x, U, SSQ};
        pg8::gemm_phase<EpiOut, pg8::StaticOrder, true, true>(lds, g, S, E);
    }
    xcd_barrier(bar);

    { PHASE_IDS PHASE_PTRS
        { const int gt = bx * (NWAVES * 64) + tid;
          for (int row = gt; row < MR; row += G * NWAVES * 64) { float s = 0.f;
#pragma unroll
              for (int i = 0; i < 16; ++i) { const f32x4 v = *(const GAS f32x4*)(SSQ + (size_t)row * 64 + i * 4); s += (v.x + v.y) + (v.z + v.w); }
              RSTD[row] = 1.f / sqrtf(s * (1.f / DM) + EPS); } }
        pg8::Gemm g{U, Wt_ff1, MR, DFF, DM}; pg8::StaticOrder S; S.init(MR, DFF, G, bx); EpiFf1 E{HID};
        pg8::gemm_phase<EpiFf1, pg8::StaticOrder, true, true>(lds, g, S, E);
    }
    xcd_barrier(bar);

    { PHASE_IDS PHASE_PTRS
        pg8::Gemm g{HID, Wt_ff2, MR, DM, DFF}; pg8::StaticOrder S; S.init(MR, DM, G, bx); EpiFf2 E{out, RSTD, U};
        pg8::gemm_phase<EpiFf2, pg8::StaticOrder, true, true>(lds, g, S, E);
    }
}

extern "C" void kernel_launch(void* const* d_in, const int* in_sizes, int n_in, void* d_out, int out_size, void* d_ws, size_t ws_size, hipStream_t stream) {
    static int grid = 0;
    if (grid == 0) {
        if (n_in != 19 || out_size != MR * DM || ws_size < WS_END) { fprintf(stderr, "kernel_launch: unexpected shapes (n_in %d out %d ws %zu)\n", n_in, out_size, ws_size); grid = -1; return; }
        int dev = 0, cus = 0, per_cu = 0;
        if (hipGetDevice(&dev) != hipSuccess || hipDeviceGetAttribute(&cus, hipDeviceAttributeMultiprocessorCount, dev) != hipSuccess) { grid = -1; return; }
        if (hipFuncSetAttribute((const void*)mk_fwd, hipFuncAttributeMaxDynamicSharedMemorySize, LDS_BYTES) != hipSuccess) { fprintf(stderr, "kernel_launch: hipFuncSetAttribute failed\n"); grid = -1; return; }
        if (hipOccupancyMaxActiveBlocksPerMultiprocessor(&per_cu, (const void*)mk_fwd, NWAVES * 64, LDS_BYTES) != hipSuccess || per_cu < 1) { fprintf(stderr, "kernel_launch: occupancy query says %d\n", per_cu); }
        (void)hipGetLastError();
        grid = cus;
    }
    if (grid < 0) return;
    if (hipMemsetAsync((char*)d_ws + WS_CTL, 0, CTL_ZERO_BYTES, stream) != hipSuccess) return;
    Ptrs a{};
    for (int i = 0; i < 19; ++i) a.in[i] = (const float*)d_in[i];
    a.out = (float*)d_out; a.ws = (unsigned char*)d_ws;
    hipLaunchKernelGGL(mk_fwd, dim3(grid), dim3(NWAVES * 64), LDS_BYTES, stream, a);
}
```

```cpp
#include <hip/hip_runtime.h>
#include <cstdio>
#include <cstdint>
namespace pg8 {
#define PG8_LAS __attribute__((address_space(3)))
typedef unsigned short bf16_t;
typedef short bf16x8 __attribute__((ext_vector_type(8)));
typedef float f32x4 __attribute__((ext_vector_type(4)));
typedef unsigned u32x4 __attribute__((ext_vector_type(4)));
typedef int i32x4_ __attribute__((ext_vector_type(4)));
typedef int i32x8_ __attribute__((ext_vector_type(8)));
template <bool FP8> struct Frag;
template <> struct Frag<false> { bf16x8 v[2]; __device__ __forceinline__ void set(int k, bf16x8 x) { v[k] = x; } };
template <> struct Frag<true>  { i32x8_ w;    __device__ __forceinline__ void set(int k, bf16x8 x) { if (k == 0) w.lo = __builtin_bit_cast(i32x4_, x); else w.hi = __builtin_bit_cast(i32x4_, x); } };
constexpr int BM = 256, BK = 64, HALF = 128, HTB = HALF * BK * 2  , STAGE_BYTES = 8 * HTB, NXCD = 8, WGM = 8;

__host__ __device__ __forceinline__ int lds_byte(int r, int c) { const int st = (r >> 4) * 2 + (c >> 5), rr = r & 15, cc = c & 31, ob = rr * 64 + cc * 2; return st * 1024 + (ob ^ (((ob >> 9) & 1) << 5)); }
__host__ __device__ __forceinline__ void stage_rc(int b, int& R, int& C) { const int st = b / 1024, sb = b % 1024, swz = sb ^ (((sb >> 9) & 1) << 5); R = (st >> 1) * 16 + swz / 64; C = (st & 1) * 32 + (swz % 64) / 2; }
__host__ __device__ __forceinline__ int perm32(int rho) { const int n = rho >> 4, i = rho & 15; return 8 * (i >> 2) + 4 * n + (i & 3); }

struct Unit { int pm, pn; };
struct Gemm { const bf16_t* A; const bf16_t* Bt; int M, N, K; };

struct StaticOrder {
    int nM, nN, nwg, G, c;
    __host__ __device__ void init(int M, int N, int G_, int c_) { nM = M / BM; nN = N / BM; nwg = nM * nN; G = G_; c = c_; }
    __host__ __device__ bool next(int i, Unit& u) const {
        const long L = (long)i * G + c; if (L >= nwg) return false;
        int wgid = (int)L; { const int q = nwg / NXCD, r = nwg % NXCD, xcd = wgid % NXCD, off = wgid / NXCD; wgid = (xcd < r ? xcd * (q + 1) : r * (q + 1) + (xcd - r) * q) + off; }
        const int nig = WGM * nN, gid = wgid / nig, fm = gid * WGM, gsz = (nM - fm) < WGM ? (nM - fm) : WGM;
        u.pm = fm + ((wgid % nig) % gsz); u.pn = (wgid % nig) / gsz; return true;
    }
    __device__ __forceinline__ void a_ready(const Unit&) const {}
    __device__ __forceinline__ void done(const Unit&) const {}
    static constexpr int KLOOP = 0;
    __device__ __forceinline__ size_t kofs(const Unit&) const { return 0; }
    __device__ __forceinline__ bool zero_after(const Unit&) const { return true; }
};

__device__ __forceinline__ unsigned cvt_pk_bf16(float lo, float hi) { unsigned r; asm volatile("v_cvt_pk_bf16_f32 %0, %1, %2" : "=v"(r) : "v"(lo), "v"(hi)); return r; }
typedef float f32x2 __attribute__((ext_vector_type(2)));
__device__ __forceinline__ void mfma_f8(f32x4& acc, const i32x8_& a, const i32x8_& b, int sc) {
    asm volatile("v_mfma_scale_f32_16x16x128_f8f6f4 %0, %1, %2, %0, %3, %3 op_sel_hi:[0,0,0]" : "+v"(acc) : "v"(a), "v"(b), "v"(sc));
}
template <class Epi, class Sched, bool ALIGN_EPI = false, bool SP2 = false, bool FP8 = false, bool I8 = false>
__device__ __forceinline__ void gemm_phase(PG8_LAS unsigned char* lds, const Gemm g, const Sched& S, const Epi& E) {
    int tid_ = threadIdx.x; asm volatile("" : "+v"(tid_));
    const int tid = tid_, wid = __builtin_amdgcn_readfirstlane(tid >> 6), lane = tid & 63, wr = wid >> 2, wc = wid & 3, fr = lane & 15, fq = lane >> 4;
    int one_scale = 0x7f7f7f7f; asm volatile("" : "+v"(one_scale));      (void)one_scale;
    const int K = g.K, nt = (Sched::KLOOP ? Sched::KLOOP : K) / BK;
    unsigned voffA[2], voffB[2];
#pragma unroll
    for (int i = 0; i < 2; ++i) { int R, C; stage_rc(tid * 16 + i * 8192, R, C); const int Rb = Epi::PERM ? ((R & ~31) + perm32(R & 31)) : R;
        if (FP8) { const int q8 = C >> 3; C = (2 * (q8 & 3) + (q8 >> 2)) * 8; }
        voffA[i] = (unsigned)(R * K + C) * 2u; voffB[i] = (unsigned)(Rb * K + C) * 2u; }
    const size_t kstep = (size_t)(BK * 2);
    const size_t hstep = (size_t)HALF * K * 2;
    const size_t tstep = 2 * hstep;
    const unsigned ldsw = (unsigned)wid * 1024u;
    const int aoff = lds_byte(wr * 64 + fr, fq * 8), boff = lds_byte(wc * 32 + fr, fq * 8);
#define PG8_SA(b, h) (((b) * 2 + (h)) * HTB)
#define PG8_SB(b, h) ((4 + (b) * 2 + (h)) * HTB)
#define PG8_STAGE(bufoff, gbase, voff) do { _Pragma("unroll") for (int _i = 0; _i < 2; ++_i) \
        __builtin_amdgcn_global_load_lds((const unsigned*)((const char*)(gbase) + (voff)[_i]), (PG8_LAS unsigned*)(lds + (bufoff) + ldsw + _i * 8192), 16, 0, 0); } while (0)
#define PG8_LDA(dst, b, h) do { _Pragma("unroll") for (int m = 0; m < 4; ++m) _Pragma("unroll") for (int k = 0; k < 2; ++k) dst[m].set(k, *(const PG8_LAS bf16x8*)(lds + PG8_SA(b, h) + aoff + m * 2048 + k * 1024)); } while (0)
#define PG8_LDB(dst, b, h) do { _Pragma("unroll") for (int n = 0; n < 2; ++n) _Pragma("unroll") for (int k = 0; k < 2; ++k) dst[n].set(k, *(const PG8_LAS bf16x8*)(lds + PG8_SB(b, h) + boff + n * 2048 + k * 1024)); } while (0)
#define PG8_MMA(ai, bj, At, Bt) do { __builtin_amdgcn_s_setprio(1); _Pragma("unroll") for (int m = 0; m < 4; ++m) _Pragma("unroll") for (int n = 0; n < 2; ++n) { \
        if constexpr (FP8) mfma_f8(acc[ai][bj][m][n], Bt[n].w, At[m].w, one_scale); \
        else if constexpr (I8) { _Pragma("unroll") for (int k = 0; k < 2; ++k) acc[ai][bj][m][n] = __builtin_bit_cast(f32x4, __builtin_amdgcn_mfma_i32_16x16x64_i8(__builtin_bit_cast(i32x4_, Bt[n].v[k]), __builtin_bit_cast(i32x4_, At[m].v[k]), __builtin_bit_cast(i32x4_, acc[ai][bj][m][n]), 0, 0, 0)); } \
        else { _Pragma("unroll") for (int k = 0; k < 2; ++k) acc[ai][bj][m][n] = __builtin_amdgcn_mfma_f32_16x16x32_bf16(Bt[n].v[k], At[m].v[k], acc[ai][bj][m][n], 0, 0, 0); } } \
        if constexpr (FP8) asm volatile("s_nop 15" ::: "memory");     \
        __builtin_amdgcn_s_setprio(0); } while (0)
#define PG8_WAIT_V(n) asm volatile("s_waitcnt vmcnt(" #n ")" ::: "memory")
#define PG8_WAIT_L(n) asm volatile("s_waitcnt lgkmcnt(" #n ")" ::: "memory")
#define PG8_BAR __builtin_amdgcn_s_barrier()
#define PG8_SCHED __builtin_amdgcn_sched_barrier(0)
    Unit cur, nxt; int ui = 0;
    if (!S.next(0, cur)) return;
    f32x4 acc[2][2][4][2];
    if constexpr (Epi::INIT) E.init(acc, cur, wr, wc, fr, fq);
    else {
#pragma unroll
    for (int a = 0; a < 2; ++a)
#pragma unroll
        for (int b = 0; b < 2; ++b)
#pragma unroll
            for (int m = 0; m < 4; ++m)
#pragma unroll
                for (int n = 0; n < 2; ++n) acc[a][b][m][n] = (f32x4){0.f, 0.f, 0.f, 0.f};
    }
    Frag<FP8> At[4], B0[2], B1[2];
    const char* cA = (const char*)g.A + (size_t)cur.pm * tstep + S.kofs(cur); const char* cB = (const char*)g.Bt + (size_t)(cur.pn & 0xffff) * tstep + S.kofs(cur);
    S.a_ready(cur);
    if constexpr (SP2) {
        PG8_STAGE(PG8_SB(0, 0), cB, voffB); PG8_STAGE(PG8_SB(0, 1), cB + hstep, voffB); PG8_STAGE(PG8_SA(0, 0), cA, voffA); PG8_STAGE(PG8_SA(0, 1), cA + hstep, voffA);
        if (wr == 1) PG8_BAR;
        PG8_WAIT_V(2); PG8_BAR;
        PG8_STAGE(PG8_SB(1, 0), cB + kstep, voffB); PG8_STAGE(PG8_SA(1, 0), cA + kstep, voffA); PG8_STAGE(PG8_SB(1, 1), cB + hstep + kstep, voffB);
        PG8_WAIT_V(6); PG8_BAR;
    } else {
        PG8_STAGE(PG8_SB(0, 0), cB, voffB); PG8_STAGE(PG8_SA(0, 0), cA, voffA); PG8_STAGE(PG8_SB(0, 1), cB + hstep, voffB); PG8_STAGE(PG8_SA(0, 1), cA + hstep, voffA);
        if (wr == 1) PG8_BAR;
        PG8_WAIT_V(4); PG8_BAR;
        PG8_STAGE(PG8_SB(1, 0), cB + kstep, voffB); PG8_STAGE(PG8_SA(1, 0), cA + kstep, voffA); PG8_STAGE(PG8_SB(1, 1), cB + hstep + kstep, voffB);
        PG8_WAIT_V(6); PG8_BAR;
    }
    for (;;) {
        const bool has_next = S.next(ui + 1, nxt);
        const char* nA = has_next ? (const char*)g.A + (size_t)nxt.pm * tstep + S.kofs(nxt) : cA; const char* nB = has_next ? (const char*)g.Bt + (size_t)(nxt.pn & 0xffff) * tstep + S.kofs(nxt) : cB;
        for (int t = 0; t < nt; t += 2) {
            const bool last = (t == nt - 2);
            const char* a1 = cA + (size_t)(t + 1) * kstep;
            const char* a2 = last ? nA : cA + (size_t)(t + 2) * kstep; const char* b2 = last ? nB : cB + (size_t)(t + 2) * kstep;
            const char* a3 = a2 + kstep; const char* b3 = b2 + kstep;
            if (last && has_next) S.a_ready(nxt);
            if constexpr (SP2) {
            PG8_LDB(B0, 0, 0); PG8_LDB(B1, 0, 1); PG8_SCHED; PG8_LDA(At, 0, 0); PG8_STAGE(PG8_SA(1, 1), a1 + hstep, voffA);
            PG8_WAIT_V(8); PG8_WAIT_L(0); PG8_BAR; PG8_MMA(0, 0, At, B0); PG8_MMA(0, 1, At, B1); PG8_BAR; PG8_SCHED;
            PG8_LDA(At, 0, 1); PG8_STAGE(PG8_SB(0, 0), b2, voffB); PG8_STAGE(PG8_SB(0, 1), b2 + hstep, voffB); PG8_STAGE(PG8_SA(0, 0), a2, voffA);
            PG8_WAIT_V(8); PG8_WAIT_L(0); PG8_BAR; PG8_MMA(1, 0, At, B0); PG8_MMA(1, 1, At, B1); PG8_BAR; PG8_SCHED;
            PG8_LDB(B0, 1, 0); PG8_LDB(B1, 1, 1); PG8_SCHED; PG8_LDA(At, 1, 0); PG8_STAGE(PG8_SA(0, 1), a2 + hstep, voffA);
            PG8_WAIT_V(8); PG8_WAIT_L(0); PG8_BAR; PG8_MMA(0, 0, At, B0); PG8_MMA(0, 1, At, B1); PG8_BAR; PG8_SCHED;
            PG8_LDA(At, 1, 1); PG8_STAGE(PG8_SB(1, 0), b3, voffB); PG8_STAGE(PG8_SB(1, 1), b3 + hstep, voffB); PG8_STAGE(PG8_SA(1, 0), a3, voffA);
            PG8_WAIT_V(8); PG8_WAIT_L(0); PG8_BAR; PG8_MMA(1, 0, At, B0); PG8_MMA(1, 1, At, B1); PG8_BAR; PG8_SCHED;
            } else {
            PG8_LDB(B0, 0, 0); PG8_SCHED; PG8_LDA(At, 0, 0); PG8_STAGE(PG8_SA(1, 1), a1 + hstep, voffA);
            PG8_WAIT_L(8); PG8_BAR; PG8_WAIT_L(0); PG8_MMA(0, 0, At, B0); PG8_BAR; PG8_SCHED;
            PG8_LDB(B1, 0, 1); PG8_STAGE(PG8_SB(0, 0), b2, voffB);
            PG8_BAR; PG8_WAIT_L(0); PG8_MMA(0, 1, At, B1); PG8_BAR;
            PG8_LDA(At, 0, 1); PG8_STAGE(PG8_SA(0, 0), a2, voffA);
            PG8_BAR; PG8_WAIT_L(0); PG8_MMA(1, 0, At, B0); PG8_BAR; PG8_SCHED;
            PG8_STAGE(PG8_SB(0, 1), b2 + hstep, voffB);
            PG8_WAIT_V(6); PG8_BAR; PG8_MMA(1, 1, At, B1); PG8_BAR;
            PG8_LDB(B0, 1, 0); PG8_SCHED; PG8_LDA(At, 1, 0); PG8_STAGE(PG8_SA(0, 1), a2 + hstep, voffA);
            PG8_WAIT_L(8); PG8_BAR; PG8_WAIT_L(0); PG8_MMA(0, 0, At, B0); PG8_BAR; PG8_SCHED;
            PG8_LDB(B1, 1, 1); PG8_STAGE(PG8_SB(1, 0), b3, voffB);
            PG8_BAR; PG8_WAIT_L(0); PG8_MMA(0, 1, At, B1); PG8_BAR;
            PG8_LDA(At, 1, 1); PG8_STAGE(PG8_SA(1, 0), a3, voffA);
            PG8_BAR; PG8_WAIT_L(0); PG8_MMA(1, 0, At, B0); PG8_BAR; PG8_SCHED;
            PG8_STAGE(PG8_SB(1, 1), b3 + hstep, voffB);
            PG8_WAIT_V(6); PG8_BAR; PG8_MMA(1, 1, At, B1); PG8_BAR;
            }
        }
        if constexpr (ALIGN_EPI) { if (wr == 0) PG8_BAR; }
        if constexpr (FP8) asm volatile("s_nop 15\n\ts_nop 15" ::: "memory");
        if constexpr (!Epi::AFTER_DRAIN) { E(acc, cur, wr, wc, fr, fq); S.done(cur); }
        if (!has_next) break;
        if constexpr (Epi::INIT) E.init(acc, nxt, wr, wc, fr, fq);
        else if (S.zero_after(cur)) {
#pragma unroll
        for (int a = 0; a < 2; ++a)
#pragma unroll
            for (int b = 0; b < 2; ++b)
#pragma unroll
                for (int m = 0; m < 4; ++m)
#pragma unroll
                    for (int n = 0; n < 2; ++n) acc[a][b][m][n] = (f32x4){0.f, 0.f, 0.f, 0.f};
        }
        cur = nxt; cA = nA; cB = nB; ++ui;
        if constexpr (ALIGN_EPI) { if (wr == 1) PG8_BAR; }
    }
    PG8_WAIT_V(0);
    if constexpr (!ALIGN_EPI) { if (wr == 0) PG8_BAR; }
    PG8_BAR;
    if constexpr (Epi::AFTER_DRAIN) { E.fused(acc, cur, wr, wc, fr, fq, lds, wid, lane); S.done(cur); }
#undef PG8_SA
#undef PG8_SB
#undef PG8_STAGE
#undef PG8_LDA
#undef PG8_LDB
#undef PG8_MMA
#undef PG8_WAIT_V
#undef PG8_WAIT_L
#undef PG8_BAR
#undef PG8_SCHED
}
}
#define GAS __attribute__((address_space(1)))
#define LAS __attribute__((address_space(3)))
typedef unsigned short bf16;
typedef unsigned v4u __attribute__((ext_vector_type(4)));
typedef float f32x4 __attribute__((ext_vector_type(4)));
typedef short bf16x8 __attribute__((ext_vector_type(8)));
typedef GAS unsigned gu32;
typedef GAS unsigned long long gu64;
#define RLX_AGENT __ATOMIC_RELAXED, __HIP_MEMORY_SCOPE_AGENT
#define LDS_WAIT() asm volatile("s_waitcnt lgkmcnt(0)" ::: "memory")
#define VM_WAIT() asm volatile("s_waitcnt vmcnt(0)" ::: "memory")
__device__ __forceinline__ unsigned long long rt() { return __builtin_amdgcn_s_memrealtime(); }
__device__ __forceinline__ unsigned f2bf(float f) { unsigned u = __builtin_bit_cast(unsigned, f); return (u + 0x7fffu + ((u >> 16) & 1u)) >> 16; }
__device__ __forceinline__ unsigned pk2(float lo, float hi) { return f2bf(lo) | (f2bf(hi) << 16); }
#define XB_TMO      128
#define XB_XCNT(j)  (256  + 64 * (j))
#define XB_XSUB(j)  (1280 + 64 * (j))
#define XB_XGEN(j)  (2304 + 64 * (j))
#define XB_TOP      3328
#define XB_TOPGEN   3392
#define XCD_BAR_WORDS 3456
#define XB_SPIN_CAP (1u << 22)

__device__ __forceinline__ unsigned xb_ld(unsigned* p)              { return __hip_atomic_load(p, __ATOMIC_RELAXED, __HIP_MEMORY_SCOPE_AGENT); }
__device__ __forceinline__ unsigned xb_add(unsigned* p, unsigned v) { return __hip_atomic_fetch_add(p, v, __ATOMIC_RELAXED, __HIP_MEMORY_SCOPE_AGENT); }
__device__ __forceinline__ unsigned xb_xcc_id() { return (unsigned)__builtin_amdgcn_s_getreg((3 << 11) | 20) & 0xFu; }
#define XB_SPIN(cond, bar) do { unsigned _sp = 0; while (cond) { __builtin_amdgcn_s_sleep(1); \
    if ((++_sp & 255u) == 0u) { if (xb_ld(&(bar)[XB_TMO])) break; if (_sp > XB_SPIN_CAP) { atomicAdd(&(bar)[XB_TMO], 1u); break; } } } } while (0)

struct XcdBarrier {
    unsigned* bar; unsigned x;
    volatile LAS unsigned* st;
};

__device__ __forceinline__ XcdBarrier xcd_barrier_post(unsigned* bar, volatile LAS unsigned* st) {
    XcdBarrier b; b.bar = bar; b.x = xb_xcc_id(); b.st = st;
    if (threadIdx.x == 0) (void)xb_add(&bar[XB_XCNT(b.x)], 1u);
    return b;
}
__device__ __forceinline__ void xcd_barrier_complete(unsigned* bar, unsigned x, unsigned& nloc, unsigned& nx) {
    const unsigned G = gridDim.x * gridDim.y * gridDim.z;
    unsigned sum, cnt, mine, sp = 0u;
    for (;;) {
        sum = 0u; cnt = 0u; mine = 0u;
#pragma unroll
        for (unsigned j = 0; j < 16; ++j) { const unsigned c = xb_ld(&bar[XB_XCNT(j)]); sum += c; cnt += (c > 0u) ? 1u : 0u; mine = (j == x) ? c : mine; }
        if (sum == G) break;
        __builtin_amdgcn_s_sleep(1);
        if ((++sp & 255u) == 0u) { if (xb_ld(&bar[XB_TMO])) break; if (sp > XB_SPIN_CAP) { atomicAdd(&bar[XB_TMO], 1u); break; } }
    }
    nloc = mine > 0u ? mine : 1u; nx = cnt > 0u ? cnt : 1u;
}

__device__ __forceinline__ void xcd_barrier(const XcdBarrier& b) {
    asm volatile("s_waitcnt vmcnt(0)" ::: "memory");
    __syncthreads();
    if (threadIdx.x == 0) {
        unsigned* bar = b.bar;
        __builtin_amdgcn_s_waitcnt(0);
        unsigned nloc = b.st[0], nx = b.st[1];
        if (nloc == 0u) { xcd_barrier_complete(bar, b.x, nloc, nx); b.st[0] = nloc; b.st[1] = nx; }
        const unsigned old = xb_add(&bar[XB_XSUB(b.x)], 1u);
        const unsigned gen = old / nloc;
        if (old + 1u == (gen + 1u) * nloc) {
            __builtin_amdgcn_fence(__ATOMIC_RELEASE, "agent");
            asm volatile("s_waitcnt vmcnt(0)" ::: "memory");
            const unsigned og = xb_add(&bar[XB_TOP], 1u);
            const unsigned tg = og / nx;
            if (og + 1u == (tg + 1u) * nx) xb_add(&bar[XB_TOPGEN], 1u);
            else XB_SPIN(xb_ld(&bar[XB_TOPGEN]) == tg, bar);
            __builtin_amdgcn_fence(__ATOMIC_ACQUIRE, "agent");
            xb_add(&bar[XB_XGEN(b.x)], 1u);
            asm volatile("s_waitcnt vmcnt(0)" ::: "memory");
        } else {
            XB_SPIN(xb_ld(&bar[XB_XGEN(b.x)]) == gen, bar);
            __builtin_amdgcn_fence(__ATOMIC_ACQUIRE, "agent");
            asm volatile("s_waitcnt vmcnt(0)" ::: "memory");
        }
    }
    __syncthreads();
}
constexpr int NWAVES = 8;
constexpr int DM = 4096, NB = 4, SEQ = 2048, NMETA = 16, TT = SEQ + NMETA;
constexpr int MR = NB * SEQ;
constexpr int NIN = 22528, DFF = 16384, NH = 16, WHD = 2048;
constexpr int C_Q = 0, C_K = 2048, C_V = 4096, C_HQ = 6144, C_HF = 8192, C_HI = 10240, C_HG = 12288, C_GA = 14336, C_GB = 18432;
constexpr int YP = 2 * WHD;
constexpr float EPS = 1e-6f;
constexpr float C2 = 0.18033688011112042f;
constexpr float LAM_INIT = 0.2f;

constexpr size_t MiB = 1u << 20;
constexpr size_t WS_CTL = 0, CTL_ZERO_BYTES = 1 * MiB;
constexpr size_t WS_WIN = 2 * MiB, WS_WUPA = 178 * MiB, WS_WUPB = 194 * MiB, WS_WOUT = 210 * MiB, WS_WFF1 = 242 * MiB, WS_WFF2 = 370 * MiB;
constexpr size_t WS_U = 498 * MiB;
constexpr size_t WS_UMETA = 562 * MiB;
constexpr size_t WS_PM = 563 * MiB;
constexpr size_t WS_ROPE = 564 * MiB;
constexpr size_t WS_RSTD = 565 * MiB;
constexpr size_t WS_P = 568 * MiB;
constexpr size_t WS_YA = 920 * MiB, WS_YB = 952 * MiB, WS_MG = 984 * MiB;
constexpr size_t WS_SSQ = 1048 * MiB;
constexpr size_t WS_DEC = 1050 * MiB;
constexpr size_t WS_U8 = 1052 * MiB;
constexpr size_t WS_W8 = 1084 * MiB;
constexpr size_t WS_SU = 1172 * MiB;
constexpr size_t WS_SW = 1173 * MiB;
constexpr size_t WS_Y8 = 1176 * MiB;
constexpr size_t WS_WUP8 = 1208 * MiB;
constexpr size_t WS_SY = 1224 * MiB;
constexpr size_t WS_END = 1225 * MiB;
constexpr int NQK = C_V;
constexpr int CW_QHEAD = 2048;
constexpr int CW_SWMAX = 32768;
constexpr int CW_BAR = 4096;

constexpr int RING_BYTES = 131072, LDSCTL_OFF = 146432, LDS_BYTES = 147456;

__device__ __forceinline__ int opaque_v(int v) { asm volatile("" : "+v"(v)); return v; }
#define PHASE_IDS const int tid = opaque_v((int)threadIdx.x), lane = tid & 63, wave = __builtin_amdgcn_readfirstlane(tid >> 6); (void)lane; (void)wave;
__device__ __forceinline__ float bf2f(bf16 v) { return __builtin_bit_cast(float, (unsigned)v << 16); }
__device__ __forceinline__ float bflo(unsigned w) { return __builtin_bit_cast(float, w << 16); }
__device__ __forceinline__ float bfhi(unsigned w) { return __builtin_bit_cast(float, w & 0xffff0000u); }
__device__ __forceinline__ float wave_sum(float v) {
#pragma unroll
    for (int o = 1; o < 64; o <<= 1) v += __shfl_xor(v, o);
    return v;
}
__device__ __forceinline__ float wave_max(float v) {
#pragma unroll
    for (int o = 1; o < 64; o <<= 1) v = fmaxf(v, __shfl_xor(v, o));
    return v;
}
__device__ __forceinline__ float sigmoidf_(float x) { return __builtin_amdgcn_rcpf(1.0f + __expf(-x)); }

__host__ __device__ __forceinline__ int wt_row(int s) {
    if (s < C_V) { const int base = s & ~2047, t = s & 2047, h = t >> 7, cm = (t >> 6) & 1, d = t & 63; return base + 256 * (h >> 1) + 128 * ((d >> 3) & 1) + 32 * (2 * (h & 1) + cm) + 8 * (d >> 4) + (d & 7); }
    if (s >= C_HQ && s < C_HI) { const int t = s - C_HQ, isf = t >> 11, h = (t & 2047) >> 7, d = t & 127; return C_HQ + 256 * h + 128 * isf + d; }
    return s;
}
__device__ __forceinline__ unsigned pk4_i8(float a, float b, float c, float d) {
    const int ia = (int)__builtin_rintf(a), ib = (int)__builtin_rintf(b), ic = (int)__builtin_rintf(c), id = (int)__builtin_rintf(d);
    return (unsigned)(ia & 0xff) | ((unsigned)(ib & 0xff) << 8) | ((unsigned)(ic & 0xff) << 16) | ((unsigned)id << 24);
}
__device__ __forceinline__ const void* ldp(LAS unsigned char* lds, int k) {
    volatile LAS unsigned* t = (volatile LAS unsigned*)(lds + LDSCTL_OFF) + 32 + 2 * k;
    const unsigned lo = t[0], hi = t[1];
    return (const void*)(const GAS void*)(((unsigned long long)(unsigned)__builtin_amdgcn_readfirstlane((int)hi) << 32) | (unsigned long long)(unsigned)__builtin_amdgcn_readfirstlane((int)lo));
}
struct TItem { const float* src; bf16* dst; int N, KP; const float* gain; };
constexpr int TI_UP = (WHD / 64) * (DM / 32), TI_OUT = (DM / 64) * (DM / 32), TI_F1 = (DM / 64) * (DFF / 32), TI_F2 = (DFF / 64) * (DM / 32), TI_ALL = 2 * TI_UP + TI_OUT + TI_F1 + TI_F2;
constexpr int TSCR_BYTES = 32 * 33 * 4;
__device__ __forceinline__ TItem t_item(const float* W, int N, bf16* WT, int item, int KP, int koff, const float* gain = nullptr) {
    const int nblk = N / 32, kb = item / nblk, nb = item % nblk;
    return TItem{W + (size_t)(64 * kb) * N + 32 * nb, WT + (size_t)(32 * nb) * KP + koff + 64 * kb, N, KP, gain ? gain + 64 * kb : nullptr};
}
__device__ __forceinline__ TItem t_decode(LAS unsigned char* lds, int it) {
    unsigned char* ws = (unsigned char*)ldp(lds, 20);
    int r = it;
    if (r < TI_UP) return t_item((const float*)ldp(lds, 13), DM, (bf16*)(ws + WS_WUPA), r, YP, 0);
    r -= TI_UP; if (r < TI_UP) return t_item((const float*)ldp(lds, 14), DM, (bf16*)(ws + WS_WUPA), r, YP, WHD);
    r -= TI_UP; if (r < TI_OUT) return t_item((const float*)ldp(lds, 15), DM, (bf16*)(ws + WS_WOUT), r, DM, 0);
    r -= TI_OUT; if (r < TI_F1) return t_item((const float*)ldp(lds, 17), DFF, (bf16*)(ws + WS_WFF1), r, DM, 0, (const float*)ldp(lds, 16));
    r -= TI_F1; return t_item((const float*)ldp(lds, 18), DM, (bf16*)(ws + WS_WFF2), r, DFF, 0);
}
__device__ __forceinline__ void t_convert(const TItem& t, LAS unsigned* scr, int lane) {
    const int r = lane >> 3, c4 = lane & 7;
    const unsigned off = (unsigned)(2 * r) * (unsigned)t.N + (unsigned)(4 * c4);
    f32x4 v[8];
#pragma unroll
    for (int i = 0; i < 8; ++i) v[i] = __builtin_nontemporal_load((const GAS f32x4*)((const GAS float*)t.src + (size_t)(16 * (i >> 1) + (i & 1)) * t.N + off));
    if (t.gain) {
#pragma unroll
        for (int i = 0; i < 8; ++i) v[i] = v[i] * t.gain[16 * (i >> 1) + (i & 1) + 2 * r];
    }
#pragma unroll
    for (int m = 0; m < 4; ++m)
#pragma unroll
        for (int e = 0; e < 4; ++e) scr[(8 * m + r) * 33 + 4 * c4 + e] = pg8::cvt_pk_bf16(v[2 * m][e], v[2 * m + 1][e]);
    LDS_WAIT(); asm volatile("" ::: "memory");
    const int c = lane & 7;
#pragma unroll
    for (int j = 0; j < 4; ++j) { const int n = (lane >> 3) + 8 * j; const LAS unsigned* w = scr + (4 * c) * 33 + n;
        v4u o; o.x = w[0]; o.y = w[33]; o.z = w[66]; o.w = w[99];
        *(GAS v4u*)(t.dst + (size_t)n * t.KP + 8 * c) = o; }
    LDS_WAIT(); asm volatile("" ::: "memory");
}
template <bool PERMW = false>
__device__ __forceinline__ void p0_transpose_item(const float* W, int K, int N, bf16* WT, LAS float* scr, int item, int lane, int KP = 0, int koff = 0, gu32* cmaxw = nullptr) {
    if (KP == 0) KP = K;
    const int nblk = N / 32, kb = item / nblk, nb = item % nblk, k0 = 64 * kb, n0 = 32 * nb;
    float cmx = 0.f;
#pragma unroll
    for (int i = 0; i < 32; ++i) { const int kk = 2 * i + (lane >> 5); const float wv = __builtin_nontemporal_load((const GAS float*)W + (size_t)(k0 + kk) * N + n0 + (lane & 31)); scr[kk * 33 + (lane & 31)] = wv; cmx = fmaxf(cmx, fabsf(wv)); }
    if (PERMW && cmaxw) { cmx = fmaxf(cmx, __shfl_xor(cmx, 32));
        if (lane < 32) __hip_atomic_fetch_max(cmaxw + wt_row(n0 + lane), __float_as_uint(cmx), RLX_AGENT); }
    LDS_WAIT(); asm volatile("" ::: "memory");
    const int c = lane & 7;
#pragma unroll
    for (int j = 0; j < 4; ++j) { const int n = (lane >> 3) + 8 * j; const LAS float* s = scr + (8 * c) * 33 + n;
        v4u o; o.x = pk2(s[0 * 33], s[1 * 33]); o.y = pk2(s[2 * 33], s[3 * 33]); o.z = pk2(s[4 * 33], s[5 * 33]); o.w = pk2(s[6 * 33], s[7 * 33]);
        *(GAS v4u*)(WT + (size_t)(PERMW ? wt_row(n0 + n) : (n0 + n)) * KP + koff + k0 + 8 * c) = o; }
    LDS_WAIT(); asm volatile("" ::: "memory");
}
__device__ __forceinline__ void rms_row_to_bf16(const float* xrow, const float* g, bf16* orow, int lane, unsigned char* o8row = nullptr, float* su = nullptr) {
    const GAS f32x4* xr = (const GAS f32x4*)xrow + lane; const GAS f32x4* gr = (const GAS f32x4*)g + lane;
    f32x4 v[16]; float s = 0.f, am = 0.f;
#pragma unroll
    for (int j = 0; j < 16; ++j) { v[j] = __builtin_nontemporal_load(xr + 64 * j); s += (v[j].x * v[j].x + v[j].y * v[j].y) + (v[j].z * v[j].z + v[j].w * v[j].w);
        const f32x4 gg = gr[64 * j]; v[j] = v[j] * gg; am = fmaxf(am, fmaxf(fmaxf(fabsf(v[j].x), fabsf(v[j].y)), fmaxf(fabsf(v[j].z), fabsf(v[j].w)))); }
    const float rstd = 1.f / sqrtf(wave_sum(s) * (1.f / DM) + EPS);
    if (orow) { GAS unsigned long long* o8 = (GAS unsigned long long*)orow + lane;
#pragma unroll
        for (int j = 0; j < 16; ++j) o8[64 * j] = (unsigned long long)pk2(v[j].x * rstd, v[j].y * rstd) | ((unsigned long long)pk2(v[j].z * rstd, v[j].w * rstd) << 32); }
    if (o8row) {
        am = wave_max(am); const float inv = am > 0.f ? 127.f / am : 0.f;
#pragma unroll
        for (int j = 0; j < 16; ++j) ((GAS unsigned*)o8row)[64 * j + lane] = pk4_i8(v[j].x * inv, v[j].y * inv, v[j].z * inv, v[j].w * inv);
        if (lane == 0) *su = am * rstd * (1.f / 127.f); }
}
__device__ __forceinline__ void sincos_d(double a, float& sn, float& cs) {
    const double PI = 3.14159265358979323846;
    const double k = rint(a / PI); const double r = a - k * PI; const double r2 = r * r;
    double s = 1.0, c = 1.0, ts = 1.0, tc = 1.0;
#pragma unroll
    for (int i = 1; i <= 11; ++i) { tc *= -r2 / (double)((2 * i - 1) * (2 * i)); ts *= -r2 / (double)((2 * i) * (2 * i + 1)); c += tc; s += ts; }
    s *= r;
    const bool odd = ((long long)k) & 1;
    sn = (float)(odd ? -s : s); cs = (float)(odd ? -c : c);
}

struct Ptrs {
    const float* in[19]; float* out; unsigned char* ws;
};

__device__ __forceinline__ const bf16* rowptr(const bf16* P, const bf16* Pm, int b, int t) {
    return t < NMETA ? Pm + (size_t)t * NIN : P + (size_t)(b * SEQ + t - NMETA) * NIN;
}

__device__ __forceinline__ float dpp_shr(float v, int n) {
    const int x = __float_as_int(v); int r;
    if (n == 1) r = __builtin_amdgcn_update_dpp(0, x, 0x111, 0xf, 0xf, true); else if (n == 2) r = __builtin_amdgcn_update_dpp(0, x, 0x112, 0xf, 0xf, true);
    else if (n == 4) r = __builtin_amdgcn_update_dpp(0, x, 0x114, 0xf, 0xf, true); else r = __builtin_amdgcn_update_dpp(0, x, 0x118, 0xf, 0xf, true);
    return __int_as_float(r);
}
template <bool QK_ONLY>
struct EpiProjT {
    static constexpr bool PERM = true, AFTER_DRAIN = false, INIT = false;
    bf16* O; const float* qn; const float* kn; const float* rope; const float* hlb; float* dec; int pn0; float oscale; const float* su; const float* sw;
    __device__ __forceinline__ float val(float a, float rs, float cs) const { return su ? (float)__float_as_int(a) * (rs * cs) : a * oscale; }
    __device__ __forceinline__ void operator()(const pg8::f32x4 (&acc)[2][2][4][2], const pg8::Unit& u, int wr, int wc, int fr_, int fq_) const {
        const int fr = opaque_v(fr_), fq = opaque_v(fq_);
        const int row0 = u.pm * 256 + wr * 64 + fr, pn = u.pn + pn0;
        if constexpr (QK_ONLY) {
            const bool isk = pn >= 8; const int h = 2 * (pn & 7) + (wc >> 1), cm = wc & 1; const float* wv = isk ? kn : qn;
            float w0[8], w1[8], cq0[8], cq1[8];
#pragma unroll
            for (int j = 0; j < 8; ++j) { w0[j] = wv[16 * fq + j]; w1[j] = wv[16 * fq + 8 + j]; cq0[j] = su ? sw[pn * 256 + 32 * wc + 8 * fq + j] : 1.f; cq1[j] = su ? sw[pn * 256 + 128 + 32 * wc + 8 * fq + j] : 1.f; }
            bf16* obase = O + (isk ? C_K : C_Q) + h * 128 + cm * 64 + 16 * fq;
#pragma unroll
            for (int ai = 0; ai < 2; ++ai)
#pragma unroll
                for (int m = 0; m < 4; ++m) { const int row = row0 + ai * 128 + m * 16;
                    float x0[8], x1[8]; float ss = 0.f;
                    const float rs_ = su ? su[row] : 1.f;
#pragma unroll
                    for (int j = 0; j < 8; ++j) { x0[j] = val(acc[ai][0][m][j >> 2][j & 3], rs_, cq0[j]); x1[j] = val(acc[ai][1][m][j >> 2][j & 3], rs_, cq1[j]); ss += x0[j] * x0[j] + x1[j] * x1[j]; }
                    ss += __shfl_xor(ss, 16); ss += __shfl_xor(ss, 32);
                    const float rstd = 1.f / sqrtf(ss * (1.f / 64.f) + EPS);
                    const float* rp = rope + (NMETA + (row & (SEQ - 1))) * 16;
                    const f32x4 c0 = *(const GAS f32x4*)rp, c1 = *(const GAS f32x4*)(rp + 4), s0 = *(const GAS f32x4*)(rp + 8), s1 = *(const GAS f32x4*)(rp + 12);
                    const float cs[8] = {c0.x, c0.y, c0.z, c0.w, c1.x, c1.y, c1.z, c1.w}, sn[8] = {s0.x, s0.y, s0.z, s0.w, s1.x, s1.y, s1.z, s1.w};
                    float o0[8], o1[8];
#pragma unroll
                    for (int j = 0; j < 8; ++j) { const float a = x0[j] * rstd * w0[j], bb = x1[j] * rstd * w1[j];
                        float r0 = a, r1 = bb; if (fq == 0) { r0 = a * cs[j] - bb * sn[j]; r1 = bb * cs[j] + a * sn[j]; }
                        o0[j] = isk ? r0 : r0 * C2; o1[j] = isk ? r1 : r1 * C2; }
                    v4u wa, wb; wa.x = pg8::cvt_pk_bf16(o0[0], o0[1]); wa.y = pg8::cvt_pk_bf16(o0[2], o0[3]); wa.z = pg8::cvt_pk_bf16(o0[4], o0[5]); wa.w = pg8::cvt_pk_bf16(o0[6], o0[7]);
                    wb.x = pg8::cvt_pk_bf16(o1[0], o1[1]); wb.y = pg8::cvt_pk_bf16(o1[2], o1[3]); wb.z = pg8::cvt_pk_bf16(o1[4], o1[5]); wb.w = pg8::cvt_pk_bf16(o1[6], o1[7]);
                    bf16* op = obase + (size_t)row * NIN; *(v4u*)op = wa; *(v4u*)(op + 8) = wb; }
        } else { if (pn >= 24 && pn < 40) {
            const int h = pn - 24, d0 = 32 * wc + 8 * fq, colg = h * 128 + d0; const int lane15 = (fq << 4) | 15;
            float lb[8], cq[8], cf[8];
#pragma unroll
            for (int j = 0; j < 8; ++j) { cq[j] = su ? sw[pn * 256 + d0 + j] : 1.f; cf[j] = su ? sw[pn * 256 + 128 + d0 + j] : 1.f; }
#pragma unroll
            for (int j = 0; j < 8; ++j) { const float a = hlb[colg + j], c = hlb[WHD + colg + j]; lb[j] = 1.f / (1.f + __expf(c - a)); }
#pragma unroll
            for (int ai = 0; ai < 2; ++ai) {
                const int rowc = u.pm * 256 + ai * 128 + wr * 64, cj = (rowc >> 11) * 32 + ((rowc & (SEQ - 1)) >> 6);
                unsigned qd[4][4], ki[4][4]; float tot[8]; float rsm[4];
#pragma unroll
                for (int m = 0; m < 4; ++m) rsm[m] = su ? su[row0 + ai * 128 + m * 16] : 1.f;
#pragma unroll
                for (int jp = 0; jp < 4; ++jp) {
                    float qv[2][4], kv[2][4];
#pragma unroll
                    for (int jj = 0; jj < 2; ++jj) { const int j = 2 * jp + jj;
                        float f[4], s[4];
#pragma unroll
                        for (int m = 0; m < 4; ++m) { f[m] = lb[j] + (1.f - lb[j]) * sigmoidf_(val(acc[ai][1][m][j >> 2][j & 3], rsm[m], cf[j])); float g = __logf(f[m]);
                            g += dpp_shr(g, 1); g += dpp_shr(g, 2); g += dpp_shr(g, 4); g += dpp_shr(g, 8); s[m] = g; }
                        float carry = 0.f;
#pragma unroll
                        for (int m = 0; m < 4; ++m) { const float bcur = s[m] + carry; carry += __shfl(s[m], lane15); s[m] = bcur; }
                        tot[j] = carry;
#pragma unroll
                        for (int m = 0; m < 4; ++m) { qv[jj][m] = val(acc[ai][0][m][j >> 2][j & 3], rsm[m], cq[j]) * __expf(s[m]); kv[jj][m] = (1.f - f[m]) * __expf(-s[m]); }
                    }
#pragma unroll
                    for (int m = 0; m < 4; ++m) { qd[m][jp] = pg8::cvt_pk_bf16(qv[0][m], qv[1][m]); ki[m][jp] = pg8::cvt_pk_bf16(kv[0][m], kv[1][m]); }
                }
#pragma unroll
                for (int m = 0; m < 4; ++m) { bf16* op = O + (size_t)(row0 + ai * 128 + m * 16) * NIN + colg;
                    *(v4u*)(op + C_HQ) = (v4u){qd[m][0], qd[m][1], qd[m][2], qd[m][3]}; *(v4u*)(op + C_HF) = (v4u){ki[m][0], ki[m][1], ki[m][2], ki[m][3]}; }
                if (fr == 15) { float* dp = dec + (size_t)cj * WHD + colg;
                    *(f32x4*)dp = (f32x4){__expf(tot[0]), __expf(tot[1]), __expf(tot[2]), __expf(tot[3])}; *(f32x4*)(dp + 4) = (f32x4){__expf(tot[4]), __expf(tot[5]), __expf(tot[6]), __expf(tot[7])}; }
            }
        } else {
            const int col0 = pn * 256 + wc * 32 + 8 * fq; const bool sg = pn >= 56;
            float cw[2][8];
#pragma unroll
            for (int bj = 0; bj < 2; ++bj)
#pragma unroll
                for (int j = 0; j < 8; ++j) cw[bj][j] = su ? sw[col0 + bj * 128 + j] : 1.f;
#pragma unroll
            for (int ai = 0; ai < 2; ++ai)
#pragma unroll
                for (int m = 0; m < 4; ++m) { bf16* rowp = O + (size_t)(row0 + ai * 128 + m * 16) * NIN + col0; const float rs_ = su ? su[row0 + ai * 128 + m * 16] : 1.f;
#pragma unroll
                    for (int bj = 0; bj < 2; ++bj) { pg8::f32x4 v0, v1;
#pragma unroll
                        for (int e = 0; e < 4; ++e) { v0[e] = val(acc[ai][bj][m][0][e], rs_, cw[bj][e]); v1[e] = val(acc[ai][bj][m][1][e], rs_, cw[bj][4 + e]); }
                        if (sg) { for (int e = 0; e < 4; ++e) { v0[e] = sigmoidf_(v0[e]); v1[e] = sigmoidf_(v1[e]); } }
                        v4u w; w.x = pg8::cvt_pk_bf16(v0[0], v0[1]); w.y = pg8::cvt_pk_bf16(v0[2], v0[3]); w.z = pg8::cvt_pk_bf16(v1[0], v1[1]); w.w = pg8::cvt_pk_bf16(v1[2], v1[3]);
                        *(v4u*)(rowp + bj * 128) = w; } }
        } }
    }
};
struct HalfOrder : pg8::StaticOrder {
    static constexpr int KLOOP = WHD;
    __device__ __forceinline__ bool next(int i, pg8::Unit& u) const { if (!pg8::StaticOrder::next(i >> 1, u)) return false; u.pn |= (i & 1) << 16; return true; }
    __device__ __forceinline__ size_t kofs(const pg8::Unit& u) const { return (size_t)(u.pn >> 16) * (size_t)(WHD * 2); }
    __device__ __forceinline__ bool zero_after(const pg8::Unit& u) const { return (u.pn >> 16) != 0; }
};
struct EpiUp {
    static constexpr bool PERM = true, AFTER_DRAIN = false, INIT = false;
    const bf16* P; bf16* MG;
    __device__ __forceinline__ void operator()(pg8::f32x4 (&acc)[2][2][4][2], const pg8::Unit& u, int wr, int wc, int fr, int fq) const {
        const int pn = u.pn & 0xffff; const bool second = (u.pn >> 16) != 0;
        const int row0 = u.pm * 256 + wr * 64 + fr, col0 = pn * 256 + wc * 32 + 8 * fq;
#pragma unroll
        for (int ai = 0; ai < 2; ++ai)
#pragma unroll
            for (int m = 0; m < 4; ++m) { const int row = row0 + ai * 128 + m * 16;
#pragma unroll
                for (int bj = 0; bj < 2; ++bj) { const int col = col0 + bj * 128;
                    const v4u gb = *(const GAS v4u*)(P + (size_t)row * NIN + C_GB + col);
                    pg8::f32x4& v0 = acc[ai][bj][m][0]; pg8::f32x4& v1 = acc[ai][bj][m][1];
                    if (!second) { const v4u ga = *(const GAS v4u*)(P + (size_t)row * NIN + C_GA + col);
                        v0[0] *= bflo(ga.x) * __builtin_amdgcn_rcpf(bflo(gb.x)); v0[1] *= bfhi(ga.x) * __builtin_amdgcn_rcpf(bfhi(gb.x)); v0[2] *= bflo(ga.y) * __builtin_amdgcn_rcpf(bflo(gb.y)); v0[3] *= bfhi(ga.y) * __builtin_amdgcn_rcpf(bfhi(gb.y));
                        v1[0] *= bflo(ga.z) * __builtin_amdgcn_rcpf(bflo(gb.z)); v1[1] *= bfhi(ga.z) * __builtin_amdgcn_rcpf(bfhi(gb.z)); v1[2] *= bflo(ga.w) * __builtin_amdgcn_rcpf(bflo(gb.w)); v1[3] *= bfhi(ga.w) * __builtin_amdgcn_rcpf(bfhi(gb.w));
                    } else {
                        v4u w; w.x = pg8::cvt_pk_bf16(v0[0] * bflo(gb.x), v0[1] * bfhi(gb.x)); w.y = pg8::cvt_pk_bf16(v0[2] * bflo(gb.y), v0[3] * bfhi(gb.y));
                        w.z = pg8::cvt_pk_bf16(v1[0] * bflo(gb.z), v1[1] * bfhi(gb.z)); w.w = pg8::cvt_pk_bf16(v1[2] * bflo(gb.w), v1[3] * bfhi(gb.w));
                        *(v4u*)(MG + (size_t)row * DM + col) = w; } } }
    }
};
struct HalfOrder8 : pg8::StaticOrder {
    static constexpr int KLOOP = WHD / 2;
    __device__ __forceinline__ bool next(int i, pg8::Unit& u) const { if (!pg8::StaticOrder::next(i >> 1, u)) return false; u.pn |= (i & 1) << 16; return true; }
    __device__ __forceinline__ size_t kofs(const pg8::Unit& u) const { return (size_t)(u.pn >> 16) * (size_t)WHD; }
    __device__ __forceinline__ bool zero_after(const pg8::Unit& u) const { return (u.pn >> 16) != 0; }
};
struct EpiUp8 {
    static constexpr bool PERM = true, AFTER_DRAIN = false, INIT = false;
    const bf16* P; bf16* MG; const float* SYR; const float* SYB; const float* SWR; const float* SWB;
    __device__ __forceinline__ void operator()(pg8::f32x4 (&acc)[2][2][4][2], const pg8::Unit& u, int wr, int wc, int fr_, int fq_) const {
        const int fr = opaque_v(fr_), fq = opaque_v(fq_);
        const int pn = u.pn & 0xffff; const bool second = (u.pn >> 16) != 0;
        const int row0 = u.pm * 256 + wr * 64 + fr, col0 = pn * 256 + wc * 32 + 8 * fq;
        const float* CS = second ? SWB : SWR; const float* RS = second ? SYB : SYR;
        float cs[2][8];
#pragma unroll
        for (int bj = 0; bj < 2; ++bj) { const f32x4 c0 = *(const GAS f32x4*)(CS + col0 + bj * 128), c1 = *(const GAS f32x4*)(CS + col0 + bj * 128 + 4);
            cs[bj][0] = c0.x; cs[bj][1] = c0.y; cs[bj][2] = c0.z; cs[bj][3] = c0.w; cs[bj][4] = c1.x; cs[bj][5] = c1.y; cs[bj][6] = c1.z; cs[bj][7] = c1.w; }
#pragma unroll
        for (int ai = 0; ai < 2; ++ai)
#pragma unroll
            for (int m = 0; m < 4; ++m) { const int row = row0 + ai * 128 + m * 16; const float rs = RS[row];
#pragma unroll
                for (int bj = 0; bj < 2; ++bj) { const int col = col0 + bj * 128;
                    const v4u gb = *(const GAS v4u*)(P + (size_t)row * NIN + C_GB + col);
                    const float b_[8] = {bflo(gb.x), bfhi(gb.x), bflo(gb.y), bfhi(gb.y), bflo(gb.z), bfhi(gb.z), bflo(gb.w), bfhi(gb.w)};
                    if (!second) { const v4u ga = *(const GAS v4u*)(P + (size_t)row * NIN + C_GA + col);
                        const float a_[8] = {bflo(ga.x), bfhi(ga.x), bflo(ga.y), bfhi(ga.y), bflo(ga.z), bfhi(ga.z), bflo(ga.w), bfhi(ga.w)};
#pragma unroll
                        for (int e = 0; e < 8; ++e) { float f = (float)__float_as_int(acc[ai][bj][m][e >> 2][e & 3]) * (a_[e] * __builtin_amdgcn_rcpf(b_[e])) * (rs * cs[bj][e]);
                            f = fminf(fmaxf(f, -2.0e9f), 2.0e9f);
                            acc[ai][bj][m][e >> 2][e & 3] = __int_as_float((int)__builtin_rintf(f)); }
                    } else { float o_[8];
#pragma unroll
                        for (int e = 0; e < 8; ++e) o_[e] = (float)__float_as_int(acc[ai][bj][m][e >> 2][e & 3]) * (b_[e] * (rs * cs[bj][e]));
                        v4u w; w.x = pg8::cvt_pk_bf16(o_[0], o_[1]); w.y = pg8::cvt_pk_bf16(o_[2], o_[3]); w.z = pg8::cvt_pk_bf16(o_[4], o_[5]); w.w = pg8::cvt_pk_bf16(o_[6], o_[7]);
                        *(v4u*)(MG + (size_t)row * DM + col) = w; } } }
    }
};
struct EpiOut {
    static constexpr bool PERM = true, AFTER_DRAIN = false, INIT = true;
    const float* X; bf16* H1b; float* SSQ;
    __device__ __forceinline__ void init(pg8::f32x4 (&acc)[2][2][4][2], const pg8::Unit& u, int wr, int wc, int fr_, int fq_) const {
        const int fr = opaque_v(fr_), fq = opaque_v(fq_);
        const float* xp = X + (size_t)(u.pm * 256 + wr * 64 + fr) * DM + u.pn * 256 + wc * 32 + 8 * fq;
#pragma unroll
        for (int ai = 0; ai < 2; ++ai)
#pragma unroll
            for (int bj = 0; bj < 2; ++bj)
#pragma unroll
                for (int m = 0; m < 4; ++m) { const float* q = xp + (size_t)(ai * 128 + m * 16) * DM + bj * 128;
                    acc[ai][bj][m][0] = __builtin_nontemporal_load((const pg8::f32x4*)q); acc[ai][bj][m][1] = __builtin_nontemporal_load((const pg8::f32x4*)(q + 4)); }
    }
    __device__ __forceinline__ void operator()(const pg8::f32x4 (&acc)[2][2][4][2], const pg8::Unit& u, int wr, int wc, int fr, int fq) const {
        const int row0 = u.pm * 256 + wr * 64 + fr, col0 = u.pn * 256 + wc * 32 + 8 * fq;
#pragma unroll
        for (int ai = 0; ai < 2; ++ai)
#pragma unroll
            for (int m = 0; m < 4; ++m) { const int row = row0 + ai * 128 + m * 16; float ss = 0.f;
#pragma unroll
                for (int bj = 0; bj < 2; ++bj) { const int col = col0 + bj * 128; const size_t off = (size_t)row * DM + col;
                    const pg8::f32x4 h0 = acc[ai][bj][m][0], h1 = acc[ai][bj][m][1];
                    ss += (h0[0] * h0[0] + h0[1] * h0[1]) + (h0[2] * h0[2] + h0[3] * h0[3]) + (h1[0] * h1[0] + h1[1] * h1[1]) + (h1[2] * h1[2] + h1[3] * h1[3]);
                    v4u w; w.x = pg8::cvt_pk_bf16(h0[0], h0[1]); w.y = pg8::cvt_pk_bf16(h0[2], h0[3]); w.z = pg8::cvt_pk_bf16(h1[0], h1[1]); w.w = pg8::cvt_pk_bf16(h1[2], h1[3]);
                    *(v4u*)(H1b + off) = w; }
                ss += __shfl_xor(ss, 16); ss += __shfl_xor(ss, 32);
                if (fq == 0) SSQ[(size_t)row * 64 + u.pn * 4 + wc] = ss; }
    }
};
struct EpiFf1 {
    static constexpr bool PERM = true, AFTER_DRAIN = false, INIT = false;
    bf16* H;
    __device__ __forceinline__ void operator()(const pg8::f32x4 (&acc)[2][2][4][2], const pg8::Unit& u, int wr, int wc, int fr, int fq) const {
        const int row0 = u.pm * 256 + wr * 64 + fr, col0 = u.pn * 256 + wc * 32 + 8 * fq;
#pragma unroll
        for (int ai = 0; ai < 2; ++ai)
#pragma unroll
            for (int m = 0; m < 4; ++m) { const int row = row0 + ai * 128 + m * 16;
#pragma unroll
                for (int bj = 0; bj < 2; ++bj) { pg8::f32x4 v0 = acc[ai][bj][m][0], v1 = acc[ai][bj][m][1];
#pragma unroll
                    for (int e = 0; e < 4; ++e) { const float a = fmaxf(v0[e], 0.f), b = fmaxf(v1[e], 0.f); v0[e] = a * a; v1[e] = b * b; }
                    v4u w; w.x = pg8::cvt_pk_bf16(v0[0], v0[1]); w.y = pg8::cvt_pk_bf16(v0[2], v0[3]); w.z = pg8::cvt_pk_bf16(v1[0], v1[1]); w.w = pg8::cvt_pk_bf16(v1[2], v1[3]);
                    *(v4u*)(H + (size_t)row * DFF + col0 + bj * 128) = w; } }
    }
};
struct EpiFf2 {
    static constexpr bool PERM = false, AFTER_DRAIN = false, INIT = true;
    float* O; const float* RSTD; const bf16* H1b;
    __device__ __forceinline__ void init(pg8::f32x4 (&acc)[2][2][4][2], const pg8::Unit& u, int wr, int wc, int fr_, int fq_) const {
        const int fr = opaque_v(fr_), fq = opaque_v(fq_);
        const int row0 = u.pm * 256 + wr * 64 + fr, col0 = u.pn * 256 + wc * 32 + 4 * fq;
#pragma unroll
        for (int ai = 0; ai < 2; ++ai)
#pragma unroll
            for (int bj = 0; bj < 2; ++bj)
#pragma unroll
                for (int m = 0; m < 4; ++m) { const int row = row0 + ai * 128 + m * 16; const float rs = RSTD[row], ir2 = 1.f / (rs * rs); const bf16* rowp = H1b + (size_t)row * DM + col0 + bj * 128;
#pragma unroll
                    for (int n = 0; n < 2; ++n) { const unsigned long long w = *(const GAS unsigned long long*)(rowp + n * 16); const unsigned lo = (unsigned)w, hh = (unsigned)(w >> 32);
                        acc[ai][bj][m][n] = (pg8::f32x4){bflo(lo) * ir2, bfhi(lo) * ir2, bflo(hh) * ir2, bfhi(hh) * ir2}; } }
    }
    __device__ __forceinline__ void operator()(const pg8::f32x4 (&acc)[2][2][4][2], const pg8::Unit& u, int wr, int wc, int fr, int fq) const {
        const int row0 = u.pm * 256 + wr * 64 + fr, col0 = u.pn * 256 + wc * 32 + 4 * fq;
#pragma unroll
        for (int ai = 0; ai < 2; ++ai)
#pragma unroll
            for (int m = 0; m < 4; ++m) { const int row = row0 + ai * 128 + m * 16; const float rs = RSTD[row], r2 = rs * rs; float* rowp = O + (size_t)row * DM + col0;
#pragma unroll
                for (int bj = 0; bj < 2; ++bj)
#pragma unroll
                    for (int n = 0; n < 2; ++n) __builtin_nontemporal_store(acc[ai][bj][m][n] * r2, (pg8::f32x4*)(rowp + bj * 128 + n * 16)); }
    }
};

constexpr int NCONV = 96;
namespace da {
typedef float f32x16 __attribute__((ext_vector_type(16)));
typedef short s16x4 __attribute__((ext_vector_type(4)));
constexpr int KBUF = 16384, VBUF = 16384, K_OFF = 0, V_OFF = 32768;
__device__ __forceinline__ int crow(int r, int hi) { return (r & 3) + 8 * (r >> 2) + 4 * hi; }
__device__ __forceinline__ int kswz(int row, int colB) { return row * 256 + (colB ^ ((row & 7) << 4)); }
__device__ __forceinline__ int v_st(int k, int c) { return ((k >> 3) * 4 + (c >> 5)) * 512 + ((k & 7) * 32 + (c & 31)) * 2; }
__device__ __forceinline__ int v_rd_base(int lane) { return ((lane & 3) << 3) | (((lane >> 2) & 3) << 6) | (((lane >> 4) & 1) << 5) | (((lane >> 5) & 1) << 8); }
__device__ __forceinline__ s16x4 vtr(LAS const unsigned char* p) { return __builtin_bit_cast(s16x4, __builtin_amdgcn_ds_read_tr16_b64_v4i16((LAS s16x4*)p)); }
__device__ __forceinline__ float pl_max(float v) { auto rr = __builtin_amdgcn_permlane32_swap(__float_as_uint(v), __float_as_uint(v), false, false); return fmaxf(__uint_as_float(rr[0]), __uint_as_float(rr[1])); }
__device__ __forceinline__ float pl_sum(float v) { auto rr = __builtin_amdgcn_permlane32_swap(__float_as_uint(v), __float_as_uint(v), false, false); return __uint_as_float(rr[0]) + __uint_as_float(rr[1]); }
__device__ __forceinline__ bf16x8 pack8(const f32x16& p, int base) {
    v4u w; w.x = pg8::cvt_pk_bf16(p[base + 0], p[base + 1]); w.y = pg8::cvt_pk_bf16(p[base + 2], p[base + 3]); w.z = pg8::cvt_pk_bf16(p[base + 4], p[base + 5]); w.w = pg8::cvt_pk_bf16(p[base + 6], p[base + 7]);
    return __builtin_bit_cast(bf16x8, w);
}
__device__ __forceinline__ void qk(f32x16& p0, f32x16& p1, LAS const unsigned char* Kb, LAS const unsigned char* Qw, float negm, int c, int r32, int hi) {
#pragma unroll
    for (int r = 0; r < 16; ++r) { p0[r] = negm; p1[r] = negm; }
#pragma unroll
    for (int d0 = 0; d0 < 4; ++d0) { const int cb = (c * 64 + d0 * 16 + hi * 8) * 2;
        const bf16x8 b0 = *(LAS const bf16x8*)(Kb + kswz(r32, cb)), b1 = *(LAS const bf16x8*)(Kb + kswz(32 + r32, cb)), qf = *(LAS const bf16x8*)(Qw + d0 * 1024);
        p0 = __builtin_amdgcn_mfma_f32_32x32x16_bf16(b0, qf, p0, 0, 0, 0); p1 = __builtin_amdgcn_mfma_f32_32x32x16_bf16(b1, qf, p1, 0, 0, 0); }
}
__device__ __forceinline__ void mask_diag(f32x16& p0, f32x16& p1, int hi, int rel) {
#pragma unroll
    for (int r = 0; r < 16; ++r) { if (crow(r, hi) > rel) p0[r] = -1e30f; if (32 + crow(r, hi) > rel) p1[r] = -1e30f; }
}
__device__ __forceinline__ void partB(f32x16& p0, f32x16& p1, float& l_part, bf16x8 (&pb)[4]) {
    float ps = 0.f;
#pragma unroll
    for (int r = 0; r < 16; ++r) { p0[r] = __builtin_amdgcn_exp2f(p0[r]); p1[r] = __builtin_amdgcn_exp2f(p1[r]); ps += p0[r] + p1[r]; }
    l_part += ps;
    pb[0] = pack8(p0, 0); pb[1] = pack8(p0, 8); pb[2] = pack8(p1, 0); pb[3] = pack8(p1, 8);
}
__device__ __forceinline__ void pv(f32x16 (&o)[4], LAS const unsigned char* Vb, const bf16x8 (&pb)[4], int lane) {
    LAS const unsigned char* vb = Vb + v_rd_base(lane);
#pragma unroll
    for (int d0 = 0; d0 < 4; ++d0) {
        s16x4 lo[4], hh[4];
#pragma unroll
        for (int ks = 0; ks < 4; ++ks) { lo[ks] = vtr(vb + d0 * 512 + ks * 4096); hh[ks] = vtr(vb + d0 * 512 + ks * 4096 + 2048); }
#pragma unroll
        for (int ks = 0; ks < 4; ++ks) {
            const bf16x8 a = (bf16x8){lo[ks][0], lo[ks][1], lo[ks][2], lo[ks][3], hh[ks][0], hh[ks][1], hh[ks][2], hh[ks][3]};
            o[d0] = __builtin_amdgcn_mfma_f32_32x32x16_bf16(a, pb[ks], o[d0], 0, 0, 0); }
    }
}
__device__ __forceinline__ void meta_tile(LAS const unsigned char* Kb, LAS const unsigned char* Vb, LAS const unsigned char* Qw, f32x16 (&o)[4], float& l_part, float negm, int c, int r32, int hi, int lane) {
    f32x16 p0;
#pragma unroll
    for (int r = 0; r < 16; ++r) p0[r] = negm;
#pragma unroll
    for (int d0 = 0; d0 < 4; ++d0) { const int cb = (c * 64 + d0 * 16 + hi * 8) * 2;
        p0 = __builtin_amdgcn_mfma_f32_32x32x16_bf16(*(LAS const bf16x8*)(Kb + kswz(r32, cb)), *(LAS const bf16x8*)(Qw + d0 * 1024), p0, 0, 0, 0); }
    float ps = 0.f;
#pragma unroll
    for (int r = 0; r < 16; ++r) { p0[r] = (crow(r, hi) >= NMETA) ? 0.f : __builtin_amdgcn_exp2f(p0[r]); ps += p0[r]; }
    l_part += ps;
    const bf16x8 pb0 = pack8(p0, 0);
    LAS const unsigned char* vb = Vb + v_rd_base(lane);
#pragma unroll
    for (int d0 = 0; d0 < 4; ++d0) { const s16x4 lo = vtr(vb + d0 * 512), hh = vtr(vb + d0 * 512 + 2048);
        o[d0] = __builtin_amdgcn_mfma_f32_32x32x16_bf16((bf16x8){lo[0], lo[1], lo[2], lo[3], hh[0], hh[1], hh[2], hh[3]}, pb0, o[d0], 0, 0, 0); }
}
constexpr int KB3 = 0, VB3 = 49152, QFR = 98304, MKB = 131072, MVB = 139264;
__device__ __forceinline__ void glds16(const void* g, unsigned lds_base) {
    unsigned sv; asm volatile("s_mov_b32 %0, m0\n\ts_mov_b32 m0, %2\n\ts_nop 0\n\tglobal_load_lds_dwordx4 %1, off\n\ts_mov_b32 m0, %0" : "=&s"(sv) : "v"(g), "s"(lds_base) : "memory"); }
__device__ __forceinline__ void dma_tile(LAS unsigned char* lds, int buf, const bf16* tile0, int wave, int lane_) {
    const int lane = opaque_v(lane_);
    LAS unsigned char* dst = lds + (wave < 4 ? KB3 + buf * KBUF + wave * 4096 : VB3 + buf * VBUF + (wave - 4) * 4096);
#pragma unroll
    for (int i = 0; i < 4; ++i) {
        unsigned off;
        if (wave < 4) { const int p = 4 * wave + i, row = 4 * p + (lane >> 4), colB = ((lane & 15) ^ (row & 7)) << 4; off = (unsigned)(row * NIN + C_K + (colB >> 1)); }
        else { const int p = 4 * (wave - 4) + i, st = 2 * p + (lane >> 5), key = (st >> 2) * 8 + ((lane & 31) >> 2), col = (st & 3) * 32 + (lane & 3) * 8; off = (unsigned)(key * NIN + C_V + col); }
        glds16(tile0 + off, (unsigned)__builtin_amdgcn_readfirstlane((int)(unsigned)(size_t)(dst + i * 1024))); }
}
typedef __bf16 bf16v2_ __attribute__((ext_vector_type(2)));
__device__ __forceinline__ unsigned cvt2(float lo, float hi) { const pg8::f32x2 v = {lo, hi}; return __builtin_bit_cast(unsigned, __builtin_convertvector(v, bf16v2_)); }
#define ATT_SBAR() __builtin_amdgcn_sched_barrier(0)
#define ATT_PIN(x) asm volatile("" : "+v"(x))
__device__ __forceinline__ void fast_step(f32x16 (&o)[4], f32x16& s0, f32x16& s1, float& l_part, const f32x16& negm16, LAS const unsigned char* Vslot, LAS const unsigned char* Kb, LAS const unsigned char* Qw, int c, int r32, int hi, int lane) {
    LAS const unsigned char* vb = Vslot + v_rd_base(lane);
    float ps = 0.f; unsigned pk[4], pn[4];
#pragma unroll
    for (int i = 0; i < 4; ++i) { const float x = __builtin_amdgcn_exp2f(s0[2 * i]), y = __builtin_amdgcn_exp2f(s0[2 * i + 1]); ps += x; ps += y; pk[i] = cvt2(x, y); }
    s16x4 va[8], vn[8];
#pragma unroll
    for (int d0 = 0; d0 < 4; ++d0) { va[2 * d0] = vtr(vb + d0 * 512); va[2 * d0 + 1] = vtr(vb + d0 * 512 + 2048); }
    bf16x8 kb0[4], kb1[4], qf[4];
    ATT_SBAR();
#pragma unroll
    for (int ch = 0; ch < 4; ++ch) {
        const bf16x8 pbc = __builtin_bit_cast(bf16x8, ((v4u){pk[0], pk[1], pk[2], pk[3]}));
#pragma unroll
        for (int d0 = 0; d0 < 4; ++d0) {
            const bf16x8 a = (bf16x8){va[2 * d0][0], va[2 * d0][1], va[2 * d0][2], va[2 * d0][3], va[2 * d0 + 1][0], va[2 * d0 + 1][1], va[2 * d0 + 1][2], va[2 * d0 + 1][3]};
            o[d0] = __builtin_amdgcn_mfma_f32_32x32x16_bf16(a, pbc, o[d0], 0, 0, 0);
            if (ch < 3) {
                const int nb = ((ch + 1) & 1) * 8 + 2 * d0;
                const float x = __builtin_amdgcn_exp2f((ch + 1 < 2) ? s0[nb] : s1[nb]), y = __builtin_amdgcn_exp2f((ch + 1 < 2) ? s0[nb + 1] : s1[nb + 1]);
                ps += x; ps += y; pn[d0] = cvt2(x, y);
                vn[2 * d0] = vtr(vb + d0 * 512 + (ch + 1) * 4096); vn[2 * d0 + 1] = vtr(vb + d0 * 512 + (ch + 1) * 4096 + 2048);
                ATT_PIN(pn[d0]); ATT_PIN(ps);
            } else {
                const int cb = (c * 64 + d0 * 16 + hi * 8) * 2;
                kb0[d0] = *(LAS const bf16x8*)(Kb + kswz(r32, cb)); kb1[d0] = *(LAS const bf16x8*)(Kb + kswz(32 + r32, cb)); qf[d0] = *(LAS const bf16x8*)(Qw + d0 * 1024);
            }
            ATT_SBAR();
        }
        if (ch < 3) {
#pragma unroll
            for (int i = 0; i < 4; ++i) pk[i] = pn[i];
#pragma unroll
            for (int i = 0; i < 8; ++i) va[i] = vn[i];
        }
    }
    l_part += ps;
    s0 = __builtin_amdgcn_mfma_f32_32x32x16_bf16(kb0[0], qf[0], negm16, 0, 0, 0); s1 = __builtin_amdgcn_mfma_f32_32x32x16_bf16(kb1[0], qf[0], negm16, 0, 0, 0);
#pragma unroll
    for (int d0 = 1; d0 < 4; ++d0) { s0 = __builtin_amdgcn_mfma_f32_32x32x16_bf16(kb0[d0], qf[d0], s0, 0, 0, 0); s1 = __builtin_amdgcn_mfma_f32_32x32x16_bf16(kb1[d0], qf[d0], s1, 0, 0, 0); }
}
__device__ __forceinline__ void unit(LAS unsigned char* lds, const bf16* P, const bf16* Pm, bf16* YA, const float* subln, const float* kn, const float* rope, float lam, float mfix, int b, int h, int qb, int tid, int wave, int lane_in) {
    const int c = wave >> 2, jw = wave & 3, q0 = qb * 128, NT = 2 * qb + 2;
    const bf16* tb0 = P + (size_t)(b * SEQ) * NIN + h * 128;
    f32x16 o[4] = {}; float l_part = 0.f; const float negm = -mfix;
    { const int lane = lane_in, r32 = lane & 31, hi = lane >> 5;
    dma_tile(lds, 0, tb0, wave, lane); dma_tile(lds, 1, tb0 + (size_t)64 * NIN, wave, lane);
    if (c == 0 && NT > 2) dma_tile(lds, 2, tb0 + (size_t)128 * NIN, wave, lane);
    LAS unsigned char* Qw = lds + QFR + wave * 4096 + lane * 16;
    { const bf16* qp = P + (size_t)(b * SEQ + q0 + jw * 32 + r32) * NIN + C_Q + h * 128 + c * 64 + hi * 8;
#pragma unroll
      for (int d0 = 0; d0 < 4; ++d0) *(LAS bf16x8*)(Qw + d0 * 1024) = *(const GAS bf16x8*)(qp + d0 * 16); }
    { const int sr = tid >> 4, sc = (tid & 15) * 8, mr = sr & 15;
      if (tid < 256) {
          const v4u raw = *(const GAS v4u*)(Pm + (size_t)mr * NIN + C_K + h * 128 + sc); const int sub = tid & 7;
          float xv[8] = {bflo(raw.x), bfhi(raw.x), bflo(raw.y), bfhi(raw.y), bflo(raw.z), bfhi(raw.z), bflo(raw.w), bfhi(raw.w)};
          float ss = 0.f;
#pragma unroll
          for (int j = 0; j < 8; ++j) ss += xv[j] * xv[j];
          ss += __shfl_xor(ss, 1); ss += __shfl_xor(ss, 2); ss += __shfl_xor(ss, 4);
          const float rstd = 1.f / sqrtf(ss * (1.f / 64.f) + EPS); float ov[8];
#pragma unroll
          for (int j = 0; j < 8; ++j) { const float xn = xv[j] * rstd * kn[sub * 8 + j], pr = __shfl_xor(xn, 1), cs = rope[mr * 16 + j], sn = rope[mr * 16 + 8 + j];
              ov[j] = (sub == 0) ? xn * cs - pr * sn : (sub == 1) ? xn * cs + pr * sn : xn; }
          v4u v; v.x = pk2(ov[0], ov[1]); v.y = pk2(ov[2], ov[3]); v.z = pk2(ov[4], ov[5]); v.w = pk2(ov[6], ov[7]);
          *(LAS v4u*)(lds + MKB + kswz(mr, sc * 2)) = v; }
      else           { const v4u v = *(const GAS v4u*)(Pm + (size_t)mr * NIN + C_V + h * 128 + sc); *(LAS v4u*)(lds + MVB + v_st(mr, sc)) = v; } }
    asm volatile("s_waitcnt vmcnt(0)" ::: "memory"); __syncthreads();
    meta_tile(lds + MKB, lds + MVB, Qw, o, l_part, negm, c, r32, hi, lane);
    f32x16 s0, s1;
    qk(s0, s1, lds + KB3, Qw, negm, c, r32, hi);
    if (qb == 0) mask_diag(s0, s1, hi, 32 * jw + r32);
    int s_j = 0;
    int j = 0;
    { f32x16 negm16;
#pragma unroll
      for (int r = 0; r < 16; ++r) negm16[r] = negm;
      ATT_PIN(negm16);
#pragma unroll 1
      for (; j < NT - 3; ++j) {
        const int s_j1 = (s_j == 2) ? 0 : s_j + 1, s_j2 = (s_j1 == 2) ? 0 : s_j1 + 1;
        asm volatile("s_waitcnt vmcnt(4) lgkmcnt(0)" ::: "memory"); __builtin_amdgcn_s_barrier(); asm volatile("" ::: "memory");
        if (c == 0) dma_tile(lds, s_j, tb0 + (size_t)(j + 3) * 64 * NIN, wave, lane); else dma_tile(lds, s_j2, tb0 + (size_t)(j + 2) * 64 * NIN, wave, lane);
        fast_step(o, s0, s1, l_part, negm16, lds + VB3 + s_j * VBUF, lds + KB3 + s_j1 * KBUF, Qw, c, r32, hi, lane);
        s_j = s_j1;
      } }
#pragma unroll 1
    for (; j < NT; ++j) {
        const int s_j1 = (s_j == 2) ? 0 : s_j + 1, s_j2 = (s_j1 == 2) ? 0 : s_j1 + 1;
        { if ((c == 0) ? (j + 2 < NT) : (j + 1 < NT)) asm volatile("s_waitcnt vmcnt(4) lgkmcnt(0)" ::: "memory"); else asm volatile("s_waitcnt vmcnt(0) lgkmcnt(0)" ::: "memory");
            __builtin_amdgcn_s_barrier(); asm volatile("" ::: "memory"); }
        if (c == 0) { if (j + 3 < NT) dma_tile(lds, s_j, tb0 + (size_t)(j + 3) * 64 * NIN, wave, lane); }
        else        { if (j + 2 < NT) dma_tile(lds, s_j2, tb0 + (size_t)(j + 2) * 64 * NIN, wave, lane); }
        const int dt = j - 2 * qb, dn = dt + 1;
        const bool act = !(dt == 1 && jw < 2), actn = (j + 1 < NT) && !(dn == 1 && jw < 2);
        if (act) { bf16x8 pb[4]; partB(s0, s1, l_part, pb); pv(o, lds + VB3 + s_j * VBUF, pb, lane); }
        if (actn) { qk(s0, s1, lds + KB3 + s_j1 * KBUF, Qw, negm, c, r32, hi); if (dn >= 0) mask_diag(s0, s1, hi, 32 * jw + r32 - 64 * dn); }
        s_j = s_j1;
    }
    }
    __syncthreads();
    LAS float* ex = (LAS float*)lds;
    const int lane = opaque_v(lane_in), r32 = lane & 31, hi = lane >> 5;
    const float l_reg = pl_sum(l_part);
    if (c == 1) { const float s1x = -lam / l_reg;
#pragma unroll
        for (int d0 = 0; d0 < 4; ++d0)
#pragma unroll
            for (int r = 0; r < 16; ++r) ex[((jw * 4 + d0) * 16 + r) * 64 + lane] = o[d0][r] * s1x; }
    __syncthreads();
    if (c == 0) { const float il = 1.f / l_reg; float ss = 0.f;
#pragma unroll
        for (int d0 = 0; d0 < 4; ++d0)
#pragma unroll
            for (int r = 0; r < 16; ++r) { const float v = o[d0][r] * il + ex[((jw * 4 + d0) * 16 + r) * 64 + lane]; o[d0][r] = v; ss += v * v; }
        ss = pl_sum(ss);
        const float rstd = (1.f - LAM_INIT) / sqrtf(ss * (1.f / 128.f) + EPS);
        bf16* yp = YA + (size_t)(b * SEQ + q0 + jw * 32 + r32) * YP + h * 128;
#pragma unroll
        for (int d0 = 0; d0 < 4; ++d0)
#pragma unroll
            for (int g = 0; g < 4; ++g) { const int e = 32 * d0 + 8 * g + 4 * hi; const f32x4 sw = *(const GAS f32x4*)(subln + e);
                const unsigned w0 = pg8::cvt_pk_bf16(o[d0][4 * g + 0] * rstd * sw.x, o[d0][4 * g + 1] * rstd * sw.y), w1 = pg8::cvt_pk_bf16(o[d0][4 * g + 2] * rstd * sw.z, o[d0][4 * g + 3] * rstd * sw.w);
                *(GAS unsigned long long*)(yp + e) = (unsigned long long)w0 | ((unsigned long long)w1 << 32); }
    }
    __syncthreads();
}
}


namespace hg {
using da::f32x16; using da::s16x4; using da::crow; using da::vtr; using da::pl_sum; using da::pack8;
__device__ __forceinline__ int ioff(int row, int ch) { return 2048 * (row >> 3) + 512 * (ch >> 2) + 64 * (row & 7) + 16 * ((ch & 3) ^ ((row >> 2) & 3)); }
constexpr int QD = 0, KI = 16384, VI = 32768, SI = 49152, DECL = 81920, SSQ = 82432;
__device__ __forceinline__ bf16x8 cat(s16x4 lo, s16x4 hh) { return (bf16x8){lo[0], lo[1], lo[2], lo[3], hh[0], hh[1], hh[2], hh[3]}; }
__device__ __forceinline__ void unit(LAS unsigned char* lds, const bf16* P, const bf16* Pm, bf16* YB, const float* DEC, const float* onorm, const float* hlb, int b, int h, int tid, int wave, int lane) {
    const int r32 = lane & 31, hi = lane >> 5, blk = (lane >> 4) & 1, q4 = (lane & 15) >> 2, p4 = lane & 3;
    const int eb = wave & 3, tb = wave >> 2;
    const int trc = 2 * blk + (p4 >> 1), trb = 8 * (p4 & 1);
#pragma unroll
    for (int i = 0; i < 4; ++i) *(LAS v4u*)(lds + SI + (tid * 4 + i) * 16) = (v4u){0u, 0u, 0u, 0u};
    f32x16 acc0 = {}, acc1 = {};
    const int sr = tid >> 4, sch = tid & 15;
    const v4u z4 = (v4u){0u, 0u, 0u, 0u};
    v4u q0 = z4, q1 = z4, k0 = z4, k1 = z4, v0 = z4, v1 = z4; float dcv = 0.f;
    if (sr < NMETA) { const bf16* mp = Pm + (size_t)sr * NIN + h * 128 + sch * 8; v0 = *(const GAS v4u*)(mp + C_HI); }
    LAS float* dec = (LAS float*)(lds + DECL); LAS float* ssq = (LAS float*)(lds + SSQ);
    if (tid < 128) {
        const int col = h * 128 + tid; const float lb = 1.f / (1.f + __expf(hlb[WHD + col] - hlb[col]));
        float xr[NMETA];
#pragma unroll
        for (int r = 0; r < NMETA; ++r) xr[r] = bf2f(Pm[(size_t)r * NIN + C_HF + col]);
        float run = 0.f;
#pragma unroll
        for (int r = 0; r < NMETA; ++r) { const float f = lb + (1.f - lb) * sigmoidf_(xr[r]); run += __logf(f);
            *(LAS unsigned short*)(lds + KI + ioff(r, tid >> 3) + (tid & 7) * 2) = (unsigned short)f2bf((1.f - f) * __expf(-run)); }
        dec[tid] = __expf(run);
    }
#pragma unroll 1
    for (int n = 0; n <= 32; ++n) {
        { const int o0 = ioff(sr, sch), o1 = ioff(32 + sr, sch);
          *(LAS v4u*)(lds + QD + o0) = q0; *(LAS v4u*)(lds + QD + o1) = q1; if (n > 0 || sr >= NMETA) *(LAS v4u*)(lds + KI + o0) = k0; *(LAS v4u*)(lds + KI + o1) = k1; *(LAS v4u*)(lds + VI + o0) = v0; *(LAS v4u*)(lds + VI + o1) = v1; }
        if (tid < 128 && n > 0) dec[tid] = dcv;
        __syncthreads();
        if (n < 32) {
            const bf16* rp = P + (size_t)(b * SEQ + 64 * n + sr) * NIN + h * 128 + sch * 8; const size_t r32o = (size_t)32 * NIN;
            q0 = *(const GAS v4u*)(rp + C_HQ); q1 = *(const GAS v4u*)(rp + C_HQ + r32o); k0 = *(const GAS v4u*)(rp + C_HF); k1 = *(const GAS v4u*)(rp + C_HF + r32o);
            v0 = *(const GAS v4u*)(rp + C_HI); v1 = *(const GAS v4u*)(rp + C_HI + r32o);
            if (tid < 128) dcv = DEC[(size_t)(b * 32 + n) * WHD + h * 128 + tid];
        }
        unsigned long long gw[4] = {0ull, 0ull, 0ull, 0ull};
        if (n > 0) { const bf16* gp = P + (size_t)(b * SEQ + 64 * (n - 1) + 32 * tb + r32) * NIN + C_HG + h * 128 + 32 * eb + 4 * hi;
#pragma unroll
            for (int g = 0; g < 4; ++g) gw[g] = *(const GAS unsigned long long*)(gp + 8 * g); }
        bf16x8 vf[4];
#pragma unroll
        for (int ks = 0; ks < 4; ++ks) vf[ks] = cat(vtr(lds + VI + ioff(16 * ks + 4 * hi + q4, 4 * eb + trc) + trb), vtr(lds + VI + ioff(16 * ks + 8 + 4 * hi + q4, 4 * eb + trc) + trb));
        f32x16 o = {};
        if (n > 0) {
#pragma unroll
            for (int sb = 0; sb < 2; ++sb) if (sb <= tb) {
                f32x16 X = {};
#pragma unroll
                for (int ds = 0; ds < 8; ++ds) { const bf16x8 A = *(const LAS bf16x8*)(lds + KI + ioff(32 * sb + r32, 2 * ds + hi)), B = *(const LAS bf16x8*)(lds + QD + ioff(32 * tb + r32, 2 * ds + hi));
                    X = __builtin_amdgcn_mfma_f32_32x32x16_bf16(A, B, X, 0, 0, 0); }
                if (sb == tb) {
#pragma unroll
                    for (int r = 0; r < 16; ++r) if (crow(r, hi) > r32) X[r] = 0.f; }
                o = __builtin_amdgcn_mfma_f32_32x32x16_bf16(vf[2 * sb], pack8(X, 0), o, 0, 0, 0);
                o = __builtin_amdgcn_mfma_f32_32x32x16_bf16(vf[2 * sb + 1], pack8(X, 8), o, 0, 0, 0);
            }
#pragma unroll
            for (int ds = 0; ds < 8; ++ds) { const bf16x8 A = cat(vtr(lds + SI + ioff(16 * ds + 8 * hi + q4, 4 * eb + trc) + trb), vtr(lds + SI + ioff(16 * ds + 8 * hi + 4 + q4, 4 * eb + trc) + trb));
                const bf16x8 B = *(const LAS bf16x8*)(lds + QD + ioff(32 * tb + r32, 2 * ds + hi));
                o = __builtin_amdgcn_mfma_f32_32x32x16_bf16(A, B, o, 0, 0, 0); }
            float ss = 0.f;
#pragma unroll
            for (int r = 0; r < 16; ++r) ss += o[r] * o[r];
            ss = pl_sum(ss);
            if (hi == 0) ssq[eb * 64 + 32 * tb + r32] = ss;
        }
#pragma unroll
        for (int ks = 0; ks < 4; ++ks) {
            const bf16x8 B0 = cat(vtr(lds + KI + ioff(16 * ks + 4 * hi + q4, 4 * (2 * tb) + trc) + trb), vtr(lds + KI + ioff(16 * ks + 8 + 4 * hi + q4, 4 * (2 * tb) + trc) + trb));
            const bf16x8 B1 = cat(vtr(lds + KI + ioff(16 * ks + 4 * hi + q4, 4 * (2 * tb + 1) + trc) + trb), vtr(lds + KI + ioff(16 * ks + 8 + 4 * hi + q4, 4 * (2 * tb + 1) + trc) + trb));
            acc0 = __builtin_amdgcn_mfma_f32_32x32x16_bf16(vf[ks], B0, acc0, 0, 0, 0); acc1 = __builtin_amdgcn_mfma_f32_32x32x16_bf16(vf[ks], B1, acc1, 0, 0, 0); }
        { const float d0 = dec[32 * (2 * tb) + r32], d1 = dec[32 * (2 * tb + 1) + r32];
#pragma unroll
          for (int r = 0; r < 16; ++r) { acc0[r] *= d0; acc1[r] *= d1; } }
        __syncthreads();
#pragma unroll
        for (int g = 0; g < 4; ++g) {
            *(LAS unsigned long long*)(lds + SI + ioff(32 * (2 * tb) + r32, 4 * eb + g) + 8 * hi) = (unsigned long long)pg8::cvt_pk_bf16(acc0[4 * g], acc0[4 * g + 1]) | ((unsigned long long)pg8::cvt_pk_bf16(acc0[4 * g + 2], acc0[4 * g + 3]) << 32);
            *(LAS unsigned long long*)(lds + SI + ioff(32 * (2 * tb + 1) + r32, 4 * eb + g) + 8 * hi) = (unsigned long long)pg8::cvt_pk_bf16(acc1[4 * g], acc1[4 * g + 1]) | ((unsigned long long)pg8::cvt_pk_bf16(acc1[4 * g + 2], acc1[4 * g + 3]) << 32); }
        if (n > 0) {
            const int t = 32 * tb + r32; const float tot = (ssq[t] + ssq[64 + t]) + (ssq[128 + t] + ssq[192 + t]);
            const float rstd = 1.f / sqrtf(tot * (1.f / 128.f) + EPS);
            const size_t row = (size_t)(b * SEQ + 64 * (n - 1) + t);
#pragma unroll
            for (int g = 0; g < 4; ++g) { const int e = 32 * eb + 8 * g + 4 * hi;
                const unsigned g01 = (unsigned)gw[g], g23 = (unsigned)(gw[g] >> 32);
                const f32x4 on = *(const GAS f32x4*)(onorm + e);
                const float y0 = o[4 * g] * rstd * on.x * sigmoidf_(bflo(g01)), y1 = o[4 * g + 1] * rstd * on.y * sigmoidf_(bfhi(g01)), y2 = o[4 * g + 2] * rstd * on.z * sigmoidf_(bflo(g23)), y3 = o[4 * g + 3] * rstd * on.w * sigmoidf_(bfhi(g23));
                const unsigned w0 = pg8::cvt_pk_bf16(y0, y1);
                const unsigned w1 = pg8::cvt_pk_bf16(y2, y3);
                *(GAS unsigned long long*)(YB + row * YP + h * 128 + e) = (unsigned long long)w0 | ((unsigned long long)w1 << 32); }
        }
    }
    __syncthreads();
}
}

#define PHASE_PTRS unsigned char* ws = (unsigned char*)ldp(lds, 20); \
    gu32* ctl = (gu32*)(ws + WS_CTL); \
    const float* x = (const float*)ldp(lds, 0); const float* meta = (const float*)ldp(lds, 1); const float* norm_mix = (const float*)ldp(lds, 2); const float* w_in = (const float*)ldp(lds, 3); \
    const float* q_norm = (const float*)ldp(lds, 4); const float* k_norm = (const float*)ldp(lds, 5); \
    const float* lq1 = (const float*)ldp(lds, 6); const float* lk1 = (const float*)ldp(lds, 7); const float* lq2 = (const float*)ldp(lds, 8); const float* lk2 = (const float*)ldp(lds, 9); \
    const float* subln = (const float*)ldp(lds, 10); const float* hg_lb = (const float*)ldp(lds, 11); const float* hg_onorm = (const float*)ldp(lds, 12); \
    const float* w_up_a = (const float*)ldp(lds, 13); const float* w_up_b = (const float*)ldp(lds, 14); const float* w_out = (const float*)ldp(lds, 15); const float* norm_mlp = (const float*)ldp(lds, 16); \
    const float* w_ff1 = (const float*)ldp(lds, 17); const float* w_ff2 = (const float*)ldp(lds, 18); \
    float* out = (float*)ldp(lds, 19); \
    bf16* Wt_in = (bf16*)(ws + WS_WIN); bf16* Wt_upa = (bf16*)(ws + WS_WUPA); bf16* Wt_upb = (bf16*)(ws + WS_WUPB); bf16* Wt_out = (bf16*)(ws + WS_WOUT); \
    bf16* Wt_ff1 = (bf16*)(ws + WS_WFF1); bf16* Wt_ff2 = (bf16*)(ws + WS_WFF2); \
    bf16* U = (bf16*)(ws + WS_U); bf16* Umeta = (bf16*)(ws + WS_UMETA); bf16* Pm = (bf16*)(ws + WS_PM); float* ROPE = (float*)(ws + WS_ROPE); \
    float* RSTD = (float*)(ws + WS_RSTD); float* SSQ = (float*)(ws + WS_SSQ); float* DEC = (float*)(ws + WS_DEC); bf16* P = (bf16*)(ws + WS_P); bf16* HID = (bf16*)(ws + WS_P); \
    unsigned char* Y8 = ws + WS_Y8; unsigned char* WUP8 = ws + WS_WUP8; float* SYR = (float*)(ws + WS_SY); float* SYB = SYR + MR; float* SWR = SYB + MR; float* SWB = SWR + DM; \
    unsigned char* U8 = ws + WS_U8; unsigned char* W8 = ws + WS_W8; float* SU = (float*)(ws + WS_SU); float* SW = (float*)(ws + WS_SW); bf16* YA = (bf16*)(ws + WS_YA); bf16* YB = YA + WHD;      bf16* MG = (bf16*)(ws + WS_MG);
__global__ void __launch_bounds__(NWAVES * 64, 2) mk_fwd(Ptrs args) {
    extern __shared__ __attribute__((aligned(16))) unsigned char lds_raw[];
    LAS unsigned char* lds = (LAS unsigned char*)lds_raw;
    volatile LAS unsigned* MISC = (volatile LAS unsigned*)(lds + LDSCTL_OFF);
    const int G = gridDim.x, bx = blockIdx.x;
    const int vcu = (G % 8 == 0) ? (bx % 8) * (G / 8) + bx / 8 : bx;

    { PHASE_IDS
    for (int u = tid; u < (LDS_BYTES - LDSCTL_OFF) / 4; u += NWAVES * 64) ((LAS unsigned*)(lds + LDSCTL_OFF))[u] = 0u;
    __syncthreads();
    if (tid == 0) {
#pragma unroll
        for (int k = 0; k < 21; ++k) { const unsigned long long pv_ = (k < 19) ? (unsigned long long)args.in[k < 19 ? k : 0] : (k == 19 ? (unsigned long long)args.out : (unsigned long long)args.ws);
            MISC[32 + 2 * k] = (unsigned)pv_; MISC[33 + 2 * k] = (unsigned)(pv_ >> 32); } } }
    __syncthreads();
    XcdBarrier bar = xcd_barrier_post((unsigned*)((gu32*)args.ws + CW_BAR), MISC + 8);
    { PHASE_IDS PHASE_PTRS
    if (wave == 0) {
        const float s1 = wave_sum(lq1[lane] * lk1[lane]), s2 = wave_sum(lq2[lane] * lk2[lane]);
        if (lane == 0) ((LAS float*)(lds + LDSCTL_OFF))[16] = expf(s1) - expf(s2) + LAM_INIT;
        const float wqm = wave_max(fabsf(q_norm[lane])), wkm = wave_max(fabsf(k_norm[lane]));
        if (lane == 0) ((LAS float*)(lds + LDSCTL_OFF))[17] = fmaxf(0.f, 64.f * C2 * wqm * wkm - 64.f);
    } }
    __syncthreads();

    { PHASE_IDS PHASE_PTRS
        LAS float* scr = (LAS float*)(lds + wave * 16384);
        const int gw = vcu * NWAVES + wave, NGW = G * NWAVES;
        constexpr int I_QK = (DM / 64) * (NIN / 32);
        for (int it = gw; it < I_QK; it += NGW) p0_transpose_item<true>(w_in, DM, NIN, Wt_in, scr, it, lane, 0, 0, ctl + CW_SWMAX);
        for (int m = gw; m < MR + NMETA; m += NGW) {
            if (m < MR) rms_row_to_bf16(x + (size_t)m * DM, norm_mix, nullptr, lane, U8 + (size_t)m * DM, SU + m);
            else rms_row_to_bf16(meta + (size_t)(m - MR) * DM, norm_mix, Umeta + (size_t)(m - MR) * DM, lane);
        }
        const int gt = tid * G + bx;
        if (gt < TT * 8) {
            const int pos = gt >> 3, j = gt & 7;
            const float invf[8] = {1.0f, 0.1939227432012558f, 0.03760603070259094f, 0.007292664609849453f, 0.0014142135623842478f, 0.00027424818836152554f, 5.3182957344688475e-05f, 1.0313385246263351e-05f};
            float inv = invf[0];
#pragma unroll
            for (int q = 1; q < 8; ++q) inv = (j == q) ? invf[q] : inv;
            const float ang = (float)pos * inv; float sn, cs; sincos_d((double)ang, sn, cs);
            ROPE[pos * 16 + j] = cs; ROPE[pos * 16 + 8 + j] = sn;
        }
    }
    xcd_barrier(bar);

    { PHASE_IDS PHASE_PTRS
        const int gw = vcu * NWAVES + wave, NGW = G * NWAVES;
        for (int r = gw; r < NIN; r += NGW) {
            const float cmax = __uint_as_float(__hip_atomic_load(ctl + CW_SWMAX + r, RLX_AGENT)), inv = cmax > 0.f ? 127.f / cmax : 0.f;
            const GAS v4u* rp = (const GAS v4u*)(Wt_in + (size_t)r * DM) + lane; v4u q[8];
#pragma unroll
            for (int j = 0; j < 8; ++j) q[j] = __builtin_nontemporal_load(rp + 64 * j);
            GAS unsigned long long* op = (GAS unsigned long long*)(W8 + (size_t)r * DM) + lane;
#pragma unroll
            for (int j = 0; j < 8; ++j) op[64 * j] = (unsigned long long)pk4_i8(bflo(q[j].x) * inv, bfhi(q[j].x) * inv, bflo(q[j].y) * inv, bfhi(q[j].y) * inv) | ((unsigned long long)pk4_i8(bflo(q[j].z) * inv, bfhi(q[j].z) * inv, bflo(q[j].w) * inv, bfhi(q[j].w) * inv) << 32);
            if (lane == 0) SW[r] = cmax * (1.f / 127.f);
        }
    }
    xcd_barrier(bar);

    { PHASE_IDS PHASE_PTRS
        { constexpr int UPB = DM * 2 + 16, PART = 16 * UPB;
          for (int i = tid; i < NMETA * DM * 2 / 16; i += NWAVES * 64) { const int r = i >> 9, cch = i & 511; *(LAS v4u*)(lds + r * UPB + cch * 16) = ((const GAS v4u*)Umeta)[i]; }
          __syncthreads();
          const int tsel = wave >> 2, kq = wave & 3, fr = lane & 15, fq = lane >> 4;
#pragma unroll 1
          for (int cb = vcu * 32; cb < 8192; cb += G * 32) {
              const int ci = cb + tsel * 16 + fr; const int c = (ci < 4096) ? (C_K + ci) : (C_HF + (ci - 4096));
              const bf16* wrow = Wt_in + (size_t)wt_row(c) * DM + kq * 1024 + fq * 8;
              LAS const unsigned char* arow = lds + fr * UPB + (kq * 1024 + fq * 8) * 2;
              f32x4 acc = {0.f, 0.f, 0.f, 0.f};
#pragma unroll 1
              for (int kb = 0; kb < 32; kb += 8) {
                  bf16x8 bfr[8];
#pragma unroll
                  for (int i = 0; i < 8; ++i) bfr[i] = *(const GAS bf16x8*)(wrow + (kb + i) * 32);
#pragma unroll
                  for (int i = 0; i < 8; ++i) { const bf16x8 afr = *(LAS const bf16x8*)(arow + (kb + i) * 64); acc = __builtin_amdgcn_mfma_f32_16x16x32_bf16(afr, bfr[i], acc, 0, 0, 0); }
              }
              *(LAS f32x4*)(lds + PART + (wave * 64 + lane) * 16) = acc;
              __syncthreads();
              if (kq == 0) { f32x4 s = acc;
#pragma unroll
                  for (int q = 1; q < 4; ++q) { const f32x4 t = *(LAS const f32x4*)(lds + PART + ((wave + q) * 64 + lane) * 16); s = s + t; }
#pragma unroll
                  for (int reg = 0; reg < 4; ++reg) Pm[(size_t)(4 * fq + reg) * NIN + c] = (bf16)f2bf(s[reg]); }
              __syncthreads();
          }
        }
        { pg8::Gemm g{(const bf16*)U8, (const bf16*)W8, MR, NQK, DM / 2}; pg8::StaticOrder S; S.init(MR, NQK, G, bx);
          EpiProjT<true> E{P, q_norm, k_norm, ROPE, hg_lb, DEC, 0, 1.f, SU, SW};
          pg8::gemm_phase<EpiProjT<true>, pg8::StaticOrder, true, true, false, true>(lds, g, S, E); }
        __syncthreads();
        { pg8::Gemm g{(const bf16*)U8, (const bf16*)(W8 + (size_t)NQK * DM), MR, NIN - NQK, DM / 2}; pg8::StaticOrder S; S.init(MR, NIN - NQK, G, bx);
          EpiProjT<false> E{P, q_norm, k_norm, ROPE, hg_lb, DEC, NQK / 256, 1.f, SU, SW};
          pg8::gemm_phase<EpiProjT<false>, pg8::StaticOrder, true, true, false, true>(lds, g, S, E); }
    }
    xcd_barrier(bar);


    { PHASE_IDS PHASE_PTRS
        { const int nconv = (G > 2 * NCONV) ? NCONV : G, cv = bx - (G - nconv);
          if (cv >= 0) {
              LAS unsigned* scr = (LAS unsigned*)(lds + wave * TSCR_BYTES);
#pragma unroll 1
              for (int it = cv * NWAVES + wave; it < TI_ALL; it += nconv * NWAVES) { const TItem t = t_decode(lds, it); t_convert(t, scr, lane); }
              __syncthreads();
          } }
        gu32* qh_h = ctl + CW_QHEAD; gu32* qh_a = ctl + CW_QHEAD + 64; const float lam = ((volatile LAS float*)(lds + LDSCTL_OFF))[16], mfix = ((volatile LAS float*)(lds + LDSCTL_OFF))[17];
#pragma unroll 1
        for (;;) {
            if (tid == 0) MISC[20] = __hip_atomic_fetch_add(qh_h, 1u, RLX_AGENT);
            __syncthreads();
            const int it = (int)MISC[20];
            __syncthreads();
            if (it >= 64) break;
            hg::unit(lds, P, Pm, YB, DEC, hg_onorm, hg_lb, it >> 4, it & 15, tid, wave, lane);
        }
#pragma unroll 1
        for (;;) {
            if (tid == 0) MISC[20] = __hip_atomic_fetch_add(qh_a, 1u, RLX_AGENT);
            __syncthreads();
            const int u = (int)MISC[20];
            __syncthreads();
            if (u >= NB * NH * 16) break;
            const int qb = 15 - (u >> 6), bh = u & 63;
            da::unit(lds, P, Pm, YA, subln, k_norm, ROPE, lam, mfix, bh >> 4, bh & 15, qb, tid, wave, lane);
        }
    }
    xcd_barrier(bar);

    { PHASE_IDS PHASE_PTRS
        const int gw = vcu * NWAVES + wave, NGW = G * NWAVES;
        for (int r = gw; r < MR + DM; r += NGW) {
            const bool isy = r < MR; const int rr = isy ? r : r - MR;
            const GAS v4u* rp = (const GAS v4u*)((isy ? YA : Wt_upa) + (size_t)rr * YP) + lane; v4u q[8];
#pragma unroll
            for (int j = 0; j < 8; ++j) q[j] = rp[64 * j];
            unsigned ma_ = 0u, mb_ = 0u;
#pragma unroll
            for (int j = 0; j < 8; ++j)
#pragma unroll
                for (int e = 0; e < 4; ++e) { const unsigned w = q[j][e]; const unsigned hi_ = w & 0x7fff0000u, lo_ = (w << 16) & 0x7fff0000u; const unsigned mx = hi_ > lo_ ? hi_ : lo_;
                    if (j < 4) ma_ = ma_ > mx ? ma_ : mx; else mb_ = mb_ > mx ? mb_ : mx; }
            const float ma = wave_max(__uint_as_float(ma_)), mb = wave_max(__uint_as_float(mb_));
            const float sa = ma > 0.f ? ma * (1.f / 127.f) : 1.f, sb = mb > 0.f ? mb * (1.f / 127.f) : 1.f, ia = ma > 0.f ? 127.f / ma : 0.f, ib = mb > 0.f ? 127.f / mb : 0.f;
            GAS unsigned long long* op = (GAS unsigned long long*)((isy ? Y8 : WUP8) + (size_t)rr * YP) + lane;
#pragma unroll
            for (int j = 0; j < 8; ++j) { const float inv = j < 4 ? ia : ib;
                op[64 * j] = (unsigned long long)pk4_i8(bflo(q[j].x) * inv, bfhi(q[j].x) * inv, bflo(q[j].y) * inv, bfhi(q[j].y) * inv) | ((unsigned long long)pk4_i8(bflo(q[j].z) * inv, bfhi(q[j].z) * inv, bflo(q[j].w) * inv, bfhi(q[j].w) * inv) << 32); }
            if (lane == 0) { (isy ? SYR : SWR)[rr] = sa / sb; (isy ? SYB : SWB)[rr] = sb; }
        }
    }
    xcd_barrier(bar);
    { PHASE_IDS PHASE_PTRS
        pg8::Gemm g{(const bf16*)Y8, (const bf16*)WUP8, MR, DM, YP / 2}; HalfOrder8 S; S.init(MR, DM, G, bx); EpiUp8 E{P, MG, SYR, SYB, SWR, SWB};
        pg8::gemm_phase<EpiUp8, HalfOrder8, true, true, false, true>(lds, g, S, E);
    }
    xcd_barrier(bar);

    { PHASE_IDS PHASE_PTRS
        pg8::Gemm g{MG, Wt_out, MR, DM, DM}; pg8::StaticOrder S; S.init(MR, DM, G, bx); EpiOut E{x, U, SSQ};
        pg8::gemm_phase<EpiOut, pg8::StaticOrder, true, true>(lds, g, S, E);
    }
    xcd_barrier(bar);

    { PHASE_IDS PHASE_PTRS
        { const int gt = bx * (NWAVES * 64) + tid;
          for (int row = gt; row < MR; row += G * NWAVES * 64) { float s = 0.f;
#pragma unroll
              for (int i = 0; i < 16; ++i) { const f32x4 v = *(const GAS f32x4*)(SSQ + (size_t)row * 64 + i * 4); s += (v.x + v.y) + (v.z + v.w); }
              RSTD[row] = 1.f / sqrtf(s * (1.f / DM) + EPS); } }
        pg8::Gemm g{U, Wt_ff1, MR, DFF, DM}; pg8::StaticOrder S; S.init(MR, DFF, G, bx); EpiFf1 E{HID};
        pg8::gemm_phase<EpiFf1, pg8::StaticOrder, true, true>(lds, g, S, E);
    }
    xcd_barrier(bar);

    { PHASE_IDS PHASE_PTRS
        pg8::Gemm g{HID, Wt_ff2, MR, DM, DFF}; pg8::StaticOrder S; S.init(MR, DM, G, bx); EpiFf2 E{out, RSTD, U};
        pg8::gemm_phase<EpiFf2, pg8::StaticOrder, true, true>(lds, g, S, E);
    }
}

extern "C" void kernel_launch(void* const* d_in, const int* in_sizes, int n_in, void* d_out, int out_size, void* d_ws, size_t ws_size, hipStream_t stream) {
    static int grid = 0;
    if (grid == 0) {
        if (n_in != 19 || out_size != MR * DM || ws_size < WS_END) { fprintf(stderr, "kernel_launch: unexpected shapes (n_in %d out %d ws %zu)\n", n_in, out_size, ws_size); grid = -1; return; }
        int dev = 0, cus = 0, per_cu = 0;
        if (hipGetDevice(&dev) != hipSuccess || hipDeviceGetAttribute(&cus, hipDeviceAttributeMultiprocessorCount, dev) != hipSuccess) { grid = -1; return; }
        if (hipFuncSetAttribute((const void*)mk_fwd, hipFuncAttributeMaxDynamicSharedMemorySize, LDS_BYTES) != hipSuccess) { fprintf(stderr, "kernel_launch: hipFuncSetAttribute failed\n"); grid = -1; return; }
        if (hipOccupancyMaxActiveBlocksPerMultiprocessor(&per_cu, (const void*)mk_fwd, NWAVES * 64, LDS_BYTES) != hipSuccess || per_cu < 1) { fprintf(stderr, "kernel_launch: occupancy query says %d\n", per_cu); }
        (void)hipGetLastError();
        grid = cus;
    }
    if (grid < 0) return;
    if (hipMemsetAsync((char*)d_ws + WS_CTL, 0, CTL_ZERO_BYTES, stream) != hipSuccess) return;
    Ptrs a{};
    for (int i = 0; i < 19; ++i) a.in[i] = (const float*)d_in[i];
    a.out = (float*)d_out; a.ws = (unsigned char*)d_ws;
    hipLaunchKernelGGL(mk_fwd, dim3(grid), dim3(NWAVES * 64), LDS_BYTES, stream, a);
}
```

```cpp
#include <hip/hip_runtime.h>
#include <cstdio>
#include <cstdint>
namespace pg8 {
#define PG8_LAS __attribute__((address_space(3)))
typedef unsigned short bf16_t;
typedef short bf16x8 __attribute__((ext_vector_type(8)));
typedef float f32x4 __attribute__((ext_vector_type(4)));
typedef unsigned u32x4 __attribute__((ext_vector_type(4)));
typedef int i32x4_ __attribute__((ext_vector_type(4)));
typedef int i32x8_ __attribute__((ext_vector_type(8)));
template <bool FP8> struct Frag;
template <> struct Frag<false> { bf16x8 v[2]; __device__ __forceinline__ void set(int k, bf16x8 x) { v[k] = x; } };
template <> struct Frag<true>  { i32x8_ w;    __device__ __forceinline__ void set(int k, bf16x8 x) { if (k == 0) w.lo = __builtin_bit_cast(i32x4_, x); else w.hi = __builtin_bit_cast(i32x4_, x); } };
constexpr int BM = 256, BK = 64, HALF = 128, HTB = HALF * BK * 2  , STAGE_BYTES = 8 * HTB, NXCD = 8, WGM = 8;

__host__ __device__ __forceinline__ int lds_byte(int r, int c) { const int st = (r >> 4) * 2 + (c >> 5), rr = r & 15, cc = c & 31, ob = rr * 64 + cc * 2; return st * 1024 + (ob ^ (((ob >> 9) & 1) << 5)); }
__host__ __device__ __forceinline__ void stage_rc(int b, int& R, int& C) { const int st = b / 1024, sb = b % 1024, swz = sb ^ (((sb >> 9) & 1) << 5); R = (st >> 1) * 16 + swz / 64; C = (st & 1) * 32 + (swz % 64) / 2; }
__host__ __device__ __forceinline__ int perm32(int rho) { const int n = rho >> 4, i = rho & 15; return 8 * (i >> 2) + 4 * n + (i & 3); }

struct Unit { int pm, pn; };
struct Gemm { const bf16_t* A; const bf16_t* Bt; int M, N, K; };

struct StaticOrder {
    int nM, nN, nwg, G, c;
    __host__ __device__ void init(int M, int N, int G_, int c_) { nM = M / BM; nN = N / BM; nwg = nM * nN; G = G_; c = c_; }
    __host__ __device__ bool next(int i, Unit& u) const {
        const long L = (long)i * G + c; if (L >= nwg) return false;
        int wgid = (int)L; { const int q = nwg / NXCD, r = nwg % NXCD, xcd = wgid % NXCD, off = wgid / NXCD; wgid = (xcd < r ? xcd * (q + 1) : r * (q + 1) + (xcd - r) * q) + off; }
        const int nig = WGM * nN, gid = wgid / nig, fm = gid * WGM, gsz = (nM - fm) < WGM ? (nM - fm) : WGM;
        u.pm = fm + ((wgid % nig) % gsz); u.pn = (wgid % nig) / gsz; return true;
    }
    __device__ __forceinline__ void a_ready(const Unit&) const {}
    __device__ __forceinline__ void done(const Unit&) const {}
    static constexpr int KLOOP = 0;
    __device__ __forceinline__ size_t kofs(const Unit&) const { return 0; }
    __device__ __forceinline__ bool zero_after(const Unit&) const { return true; }
};

__device__ __forceinline__ unsigned cvt_pk_bf16(float lo, float hi) { unsigned r; asm volatile("v_cvt_pk_bf16_f32 %0, %1, %2" : "=v"(r) : "v"(lo), "v"(hi)); return r; }
typedef float f32x2 __attribute__((ext_vector_type(2)));
__device__ __forceinline__ void mfma_f8(f32x4& acc, const i32x8_& a, const i32x8_& b, int sc) {
    asm volatile("v_mfma_scale_f32_16x16x128_f8f6f4 %0, %1, %2, %0, %3, %3 op_sel_hi:[0,0,0]" : "+v"(acc) : "v"(a), "v"(b), "v"(sc));
}
template <class Epi, class Sched, bool ALIGN_EPI = false, bool SP2 = false, bool FP8 = false, bool I8 = false>
__device__ __forceinline__ void gemm_phase(PG8_LAS unsigned char* lds, const Gemm g, const Sched& S, const Epi& E) {
    int tid_ = threadIdx.x; asm volatile("" : "+v"(tid_));
    const int tid = tid_, wid = __builtin_amdgcn_readfirstlane(tid >> 6), lane = tid & 63, wr = wid >> 2, wc = wid & 3, fr = lane & 15, fq = lane >> 4;
    int one_scale = 0x7f7f7f7f; asm volatile("" : "+v"(one_scale));      (void)one_scale;
    const int K = g.K, nt = (Sched::KLOOP ? Sched::KLOOP : K) / BK;
    unsigned voffA[2], voffB[2];
#pragma unroll
    for (int i = 0; i < 2; ++i) { int R, C; stage_rc(tid * 16 + i * 8192, R, C); const int Rb = Epi::PERM ? ((R & ~31) + perm32(R & 31)) : R;
        if (FP8) { const int q8 = C >> 3; C = (2 * (q8 & 3) + (q8 >> 2)) * 8; }
        voffA[i] = (unsigned)(R * K + C) * 2u; voffB[i] = (unsigned)(Rb * K + C) * 2u; }
    const size_t kstep = (size_t)(BK * 2);
    const size_t hstep = (size_t)HALF * K * 2;
    const size_t tstep = 2 * hstep;
    const unsigned ldsw = (unsigned)wid * 1024u;
    const int aoff = lds_byte(wr * 64 + fr, fq * 8), boff = lds_byte(wc * 32 + fr, fq * 8);
#define PG8_SA(b, h) (((b) * 2 + (h)) * HTB)
#define PG8_SB(b, h) ((4 + (b) * 2 + (h)) * HTB)
#define PG8_STAGE(bufoff, gbase, voff) do { _Pragma("unroll") for (int _i = 0; _i < 2; ++_i) \
        __builtin_amdgcn_global_load_lds((const unsigned*)((const char*)(gbase) + (voff)[_i]), (PG8_LAS unsigned*)(lds + (bufoff) + ldsw + _i * 8192), 16, 0, 0); } while (0)
#define PG8_LDA(dst, b, h) do { _Pragma("unroll") for (int m = 0; m < 4; ++m) _Pragma("unroll") for (int k = 0; k < 2; ++k) dst[m].set(k, *(const PG8_LAS bf16x8*)(lds + PG8_SA(b, h) + aoff + m * 2048 + k * 1024)); } while (0)
#define PG8_LDB(dst, b, h) do { _Pragma("unroll") for (int n = 0; n < 2; ++n) _Pragma("unroll") for (int k = 0; k < 2; ++k) dst[n].set(k, *(const PG8_LAS bf16x8*)(lds + PG8_SB(b, h) + boff + n * 2048 + k * 1024)); } while (0)
#define PG8_MMA(ai, bj, At, Bt) do { __builtin_amdgcn_s_setprio(1); _Pragma("unroll") for (int m = 0; m < 4; ++m) _Pragma("unroll") for (int n = 0; n < 2; ++n) { \
        if constexpr (FP8) mfma_f8(acc[ai][bj][m][n], Bt[n].w, At[m].w, one_scale); \
        else if constexpr (I8) { _Pragma("unroll") for (int k = 0; k < 2; ++k) acc[ai][bj][m][n] = __builtin_bit_cast(f32x4, __builtin_amdgcn_mfma_i32_16x16x64_i8(__builtin_bit_cast(i32x4_, Bt[n].v[k]), __builtin_bit_cast(i32x4_, At[m].v[k]), __builtin_bit_cast(i32x4_, acc[ai][bj][m][n]), 0, 0, 0)); } \
        else { _Pragma("unroll") for (int k = 0; k < 2; ++k) acc[ai][bj][m][n] = __builtin_amdgcn_mfma_f32_16x16x32_bf16(Bt[n].v[k], At[m].v[k], acc[ai][bj][m][n], 0, 0, 0); } } \
        if constexpr (FP8) asm volatile("s_nop 15" ::: "memory");     \
        __builtin_amdgcn_s_setprio(0); } while (0)
#define PG8_WAIT_V(n) asm volatile("s_waitcnt vmcnt(" #n ")" ::: "memory")
#define PG8_WAIT_L(n) asm volatile("s_waitcnt lgkmcnt(" #n ")" ::: "memory")
#define PG8_BAR __builtin_amdgcn_s_barrier()
#define PG8_SCHED __builtin_amdgcn_sched_barrier(0)
    Unit cur, nxt; int ui = 0;
    if (!S.next(0, cur)) return;
    f32x4 acc[2][2][4][2];
    if constexpr (Epi::INIT) E.init(acc, cur, wr, wc, fr, fq);
    else {
#pragma unroll
    for (int a = 0; a < 2; ++a)
#pragma unroll
        for (int b = 0; b < 2; ++b)
#pragma unroll
            for (int m = 0; m < 4; ++m)
#pragma unroll
                for (int n = 0; n < 2; ++n) acc[a][b][m][n] = (f32x4){0.f, 0.f, 0.f, 0.f};
    }
    Frag<FP8> At[4], B0[2], B1[2];
    const char* cA = (const char*)g.A + (size_t)cur.pm * tstep + S.kofs(cur); const char* cB = (const char*)g.Bt + (size_t)(cur.pn & 0xffff) * tstep + S.kofs(cur);
    S.a_ready(cur);
    if constexpr (SP2) {
        PG8_STAGE(PG8_SB(0, 0), cB, voffB); PG8_STAGE(PG8_SB(0, 1), cB + hstep, voffB); PG8_STAGE(PG8_SA(0, 0), cA, voffA); PG8_STAGE(PG8_SA(0, 1), cA + hstep, voffA);
        if (wr == 1) PG8_BAR;
        PG8_WAIT_V(2); PG8_BAR;
        PG8_STAGE(PG8_SB(1, 0), cB + kstep, voffB); PG8_STAGE(PG8_SA(1, 0), cA + kstep, voffA); PG8_STAGE(PG8_SB(1, 1), cB + hstep + kstep, voffB);
        PG8_WAIT_V(6); PG8_BAR;
    } else {
        PG8_STAGE(PG8_SB(0, 0), cB, voffB); PG8_STAGE(PG8_SA(0, 0), cA, voffA); PG8_STAGE(PG8_SB(0, 1), cB + hstep, voffB); PG8_STAGE(PG8_SA(0, 1), cA + hstep, voffA);
        if (wr == 1) PG8_BAR;
        PG8_WAIT_V(4); PG8_BAR;
        PG8_STAGE(PG8_SB(1, 0), cB + kstep, voffB); PG8_STAGE(PG8_SA(1, 0), cA + kstep, voffA); PG8_STAGE(PG8_SB(1, 1), cB + hstep + kstep, voffB);
        PG8_WAIT_V(6); PG8_BAR;
    }
    for (;;) {
        const bool has_next = S.next(ui + 1, nxt);
        const char* nA = has_next ? (const char*)g.A + (size_t)nxt.pm * tstep + S.kofs(nxt) : cA; const char* nB = has_next ? (const char*)g.Bt + (size_t)(nxt.pn & 0xffff) * tstep + S.kofs(nxt) : cB;
        for (int t = 0; t < nt; t += 2) {
            const bool last = (t == nt - 2);
            const char* a1 = cA + (size_t)(t + 1) * kstep;
            const char* a2 = last ? nA : cA + (size_t)(t + 2) * kstep; const char* b2 = last ? nB : cB + (size_t)(t + 2) * kstep;
            const char* a3 = a2 + kstep; const char* b3 = b2 + kstep;
            if (last && has_next) S.a_ready(nxt);
            if constexpr (SP2) {
            PG8_LDB(B0, 0, 0); PG8_LDB(B1, 0, 1); PG8_SCHED; PG8_LDA(At, 0, 0); PG8_STAGE(PG8_SA(1, 1), a1 + hstep, voffA);
            PG8_WAIT_V(8); PG8_WAIT_L(0); PG8_BAR; PG8_MMA(0, 0, At, B0); PG8_MMA(0, 1, At, B1); PG8_BAR; PG8_SCHED;
            PG8_LDA(At, 0, 1); PG8_STAGE(PG8_SB(0, 0), b2, voffB); PG8_STAGE(PG8_SB(0, 1), b2 + hstep, voffB); PG8_STAGE(PG8_SA(0, 0), a2, voffA);
            PG8_WAIT_V(8); PG8_WAIT_L(0); PG8_BAR; PG8_MMA(1, 0, At, B0); PG8_MMA(1, 1, At, B1); PG8_BAR; PG8_SCHED;
            PG8_LDB(B0, 1, 0); PG8_LDB(B1, 1, 1); PG8_SCHED; PG8_LDA(At, 1, 0); PG8_STAGE(PG8_SA(0, 1), a2 + hstep, voffA);
            PG8_WAIT_V(8); PG8_WAIT_L(0); PG8_BAR; PG8_MMA(0, 0, At, B0); PG8_MMA(0, 1, At, B1); PG8_BAR; PG8_SCHED;
            PG8_LDA(At, 1, 1); PG8_STAGE(PG8_SB(1, 0), b3, voffB); PG8_STAGE(PG8_SB(1, 1), b3 + hstep, voffB); PG8_STAGE(PG8_SA(1, 0), a3, voffA);
            PG8_WAIT_V(8); PG8_WAIT_L(0); PG8_BAR; PG8_MMA(1, 0, At, B0); PG8_MMA(1, 1, At, B1); PG8_BAR; PG8_SCHED;
            } else {
            PG8_LDB(B0, 0, 0); PG8_SCHED; PG8_LDA(At, 0, 0); PG8_STAGE(PG8_SA(1, 1), a1 + hstep, voffA);
            PG8_WAIT_L(8); PG8_BAR; PG8_WAIT_L(0); PG8_MMA(0, 0, At, B0); PG8_BAR; PG8_SCHED;
            PG8_LDB(B1, 0, 1); PG8_STAGE(PG8_SB(0, 0), b2, voffB);
            PG8_BAR; PG8_WAIT_L(0); PG8_MMA(0, 1, At, B1); PG8_BAR;
            PG8_LDA(At, 0, 1); PG8_STAGE(PG8_SA(0, 0), a2, voffA);
            PG8_BAR; PG8_WAIT_L(0); PG8_MMA(1, 0, At, B0); PG8_BAR; PG8_SCHED;
            PG8_STAGE(PG8_SB(0, 1), b2 + hstep, voffB);
            PG8_WAIT_V(6); PG8_BAR; PG8_MMA(1, 1, At, B1); PG8_BAR;
            PG8_LDB(B0, 1, 0); PG8_SCHED; PG8_LDA(At, 1, 0); PG8_STAGE(PG8_SA(0, 1), a2 + hstep, voffA);
            PG8_WAIT_L(8); PG8_BAR; PG8_WAIT_L(0); PG8_MMA(0, 0, At, B0); PG8_BAR; PG8_SCHED;
            PG8_LDB(B1, 1, 1); PG8_STAGE(PG8_SB(1, 0), b3, voffB);
            PG8_BAR; PG8_WAIT_L(0); PG8_MMA(0, 1, At, B1); PG8_BAR;
            PG8_LDA(At, 1, 1); PG8_STAGE(PG8_SA(1, 0), a3, voffA);
            PG8_BAR; PG8_WAIT_L(0); PG8_MMA(1, 0, At, B0); PG8_BAR; PG8_SCHED;
            PG8_STAGE(PG8_SB(1, 1), b3 + hstep, voffB);
            PG8_WAIT_V(6); PG8_BAR; PG8_MMA(1, 1, At, B1); PG8_BAR;
            }
        }
        if constexpr (ALIGN_EPI) { if (wr == 0) PG8_BAR; }
        if constexpr (FP8) asm volatile("s_nop 15\n\ts_nop 15" ::: "memory");
        if constexpr (!Epi::AFTER_DRAIN) { E(acc, cur, wr, wc, fr, fq); S.done(cur); }
        if (!has_next) break;
        if constexpr (Epi::INIT) E.init(acc, nxt, wr, wc, fr, fq);
        else if (S.zero_after(cur)) {
#pragma unroll
        for (int a = 0; a < 2; ++a)
#pragma unroll
            for (int b = 0; b < 2; ++b)
#pragma unroll
                for (int m = 0; m < 4; ++m)
#pragma unroll
                    for (int n = 0; n < 2; ++n) acc[a][b][m][n] = (f32x4){0.f, 0.f, 0.f, 0.f};
        }
        cur = nxt; cA = nA; cB = nB; ++ui;
        if constexpr (ALIGN_EPI) { if (wr == 1) PG8_BAR; }
    }
    PG8_WAIT_V(0);
    if constexpr (!ALIGN_EPI) { if (wr == 0) PG8_BAR; }
    PG8_BAR;
    if constexpr (Epi::AFTER_DRAIN) { E.fused(acc, cur, wr, wc, fr, fq, lds, wid, lane); S.done(cur); }
#undef PG8_SA
#undef PG8_SB
#undef PG8_STAGE
#undef PG8_LDA
#undef PG8_LDB
#undef PG8_MMA
#undef PG8_WAIT_V
#undef PG8_WAIT_L
#undef PG8_BAR
#undef PG8_SCHED
}
}
#define GAS __attribute__((address_space(1)))
#define LAS __attribute__((address_space(3)))
typedef unsigned short bf16;
typedef unsigned v4u __attribute__((ext_vector_type(4)));
typedef float f32x4 __attribute__((ext_vector_type(4)));
typedef short bf16x8 __attribute__((ext_vector_type(8)));
typedef GAS unsigned gu32;
typedef GAS unsigned long long gu64;
#define RLX_AGENT __ATOMIC_RELAXED, __HIP_MEMORY_SCOPE_AGENT
#define LDS_WAIT() asm volatile("s_waitcnt lgkmcnt(0)" ::: "memory")
#define VM_WAIT() asm volatile("s_waitcnt vmcnt(0)" ::: "memory")
__device__ __forceinline__ unsigned long long rt() { return __builtin_amdgcn_s_memrealtime(); }
__device__ __forceinline__ unsigned f2bf(float f) { unsigned u = __builtin_bit_cast(unsigned, f); return (u + 0x7fffu + ((u >> 16) & 1u)) >> 16; }
__device__ __forceinline__ unsigned pk2(float lo, float hi) { return f2bf(lo) | (f2bf(hi) << 16); }
#define XB_TMO      128
#define XB_XCNT(j)  (256  + 64 * (j))
#define XB_XSUB(j)  (1280 + 64 * (j))
#define XB_XGEN(j)  (2304 + 64 * (j))
#define XB_TOP      3328
#define XB_TOPGEN   3392
#define XCD_BAR_WORDS 3456
#define XB_SPIN_CAP (1u << 22)

__device__ __forceinline__ unsigned xb_ld(unsigned* p)              { return __hip_atomic_load(p, __ATOMIC_RELAXED, __HIP_MEMORY_SCOPE_AGENT); }
__device__ __forceinline__ unsigned xb_add(unsigned* p, unsigned v) { return __hip_atomic_fetch_add(p, v, __ATOMIC_RELAXED, __HIP_MEMORY_SCOPE_AGENT); }
__device__ __forceinline__ unsigned xb_xcc_id() { return (unsigned)__builtin_amdgcn_s_getreg((3 << 11) | 20) & 0xFu; }
#define XB_SPIN(cond, bar) do { unsigned _sp = 0; while (cond) { __builtin_amdgcn_s_sleep(1); \
    if ((++_sp & 255u) == 0u) { if (xb_ld(&(bar)[XB_TMO])) break; if (_sp > XB_SPIN_CAP) { atomicAdd(&(bar)[XB_TMO], 1u); break; } } } } while (0)

struct XcdBarrier {
    unsigned* bar; unsigned x;
    volatile LAS unsigned* st;
};

__device__ __forceinline__ XcdBarrier xcd_barrier_post(unsigned* bar, volatile LAS unsigned* st) {
    XcdBarrier b; b.bar = bar; b.x = xb_xcc_id(); b.st = st;
    if (threadIdx.x == 0) (void)xb_add(&bar[XB_XCNT(b.x)], 1u);
    return b;
}
__device__ __forceinline__ void xcd_barrier_complete(unsigned* bar, unsigned x, unsigned& nloc, unsigned& nx) {
    const unsigned G = gridDim.x * gridDim.y * gridDim.z;
    unsigned sum, cnt, mine, sp = 0u;
    for (;;) {
        sum = 0u; cnt = 0u; mine = 0u;
#pragma unroll
        for (unsigned j = 0; j < 16; ++j) { const unsigned c = xb_ld(&bar[XB_XCNT(j)]); sum += c; cnt += (c > 0u) ? 1u : 0u; mine = (j == x) ? c : mine; }
        if (sum == G) break;
        __builtin_amdgcn_s_sleep(1);
        if ((++sp & 255u) == 0u) { if (xb_ld(&bar[XB_TMO])) break; if (sp > XB_SPIN_CAP) { atomicAdd(&bar[XB_TMO], 1u); break; } }
    }
    nloc = mine > 0u ? mine : 1u; nx = cnt > 0u ? cnt : 1u;
}

__device__ __forceinline__ void xcd_barrier(const XcdBarrier& b) {
    asm volatile("s_waitcnt vmcnt(0)" ::: "memory");
    __syncthreads();
    if (threadIdx.x == 0) {
        unsigned* bar = b.bar;
        __builtin_amdgcn_s_waitcnt(0);
        unsigned nloc = b.st[0], nx = b.st[1];
        if (nloc == 0u) { xcd_barrier_complete(bar, b.x, nloc, nx); b.st[0] = nloc; b.st[1] = nx; }
        const unsigned old = xb_add(&bar[XB_XSUB(b.x)], 1u);
        const unsigned gen = old / nloc;
        if (old + 1u == (gen + 1u) * nloc) {
            __builtin_amdgcn_fence(__ATOMIC_RELEASE, "agent");
            asm volatile("s_waitcnt vmcnt(0)" ::: "memory");
            const unsigned og = xb_add(&bar[XB_TOP], 1u);
            const unsigned tg = og / nx;
            if (og + 1u == (tg + 1u) * nx) xb_add(&bar[XB_TOPGEN], 1u);
            else XB_SPIN(xb_ld(&bar[XB_TOPGEN]) == tg, bar);
            __builtin_amdgcn_fence(__ATOMIC_ACQUIRE, "agent");
            xb_add(&bar[XB_XGEN(b.x)], 1u);
            asm volatile("s_waitcnt vmcnt(0)" ::: "memory");
        } else {
            XB_SPIN(xb_ld(&bar[XB_XGEN(b.x)]) == gen, bar);
            __builtin_amdgcn_fence(__ATOMIC_ACQUIRE, "agent");
            asm volatile("s_waitcnt vmcnt(0)" ::: "memory");
        }
    }
    __syncthreads();
}
constexpr int NWAVES = 8;
constexpr int DM = 4096, NB = 4, SEQ = 2048, NMETA = 16, TT = SEQ + NMETA;
constexpr int MR = NB * SEQ;
constexpr int NIN = 22528, DFF = 16384, NH = 16, WHD = 2048;
constexpr int C_Q = 0, C_K = 2048, C_V = 4096, C_HQ = 6144, C_HF = 8192, C_HI = 10240, C_HG = 12288, C_GA = 14336, C_GB = 18432;
constexpr int YP = 2 * WHD;
constexpr float EPS = 1e-6f;
constexpr float C2 = 0.18033688011112042f;
constexpr float LAM_INIT = 0.2f;

constexpr size_t MiB = 1u << 20;
constexpr size_t WS_CTL = 0, CTL_ZERO_BYTES = 1 * MiB;
constexpr size_t WS_WIN = 2 * MiB, WS_WUPA = 178 * MiB, WS_WUPB = 194 * MiB, WS_WOUT = 210 * MiB, WS_WFF1 = 242 * MiB, WS_WFF2 = 370 * MiB;
constexpr size_t WS_U = 498 * MiB;
constexpr size_t WS_UMETA = 562 * MiB;
constexpr size_t WS_PM = 563 * MiB;
constexpr size_t WS_ROPE = 564 * MiB;
constexpr size_t WS_RSTD = 565 * MiB;
constexpr size_t WS_P = 568 * MiB;
constexpr size_t WS_YA = 920 * MiB, WS_YB = 952 * MiB, WS_MG = 984 * MiB;
constexpr size_t WS_SSQ = 1048 * MiB;
constexpr size_t WS_DEC = 1050 * MiB;
constexpr size_t WS_U8 = 1052 * MiB;
constexpr size_t WS_W8 = 1084 * MiB;
constexpr size_t WS_SU = 1172 * MiB;
constexpr size_t WS_SW = 1173 * MiB;
constexpr size_t WS_Y8 = 1176 * MiB;
constexpr size_t WS_WUP8 = 1208 * MiB;
constexpr size_t WS_SY = 1224 * MiB;
constexpr size_t WS_END = 1225 * MiB;
constexpr int NQK = C_V;
constexpr int CW_QHEAD = 2048;
constexpr int CW_SWMAX = 32768;
constexpr int CW_BAR = 4096;

constexpr int RING_BYTES = 131072, LDSCTL_OFF = 146432, LDS_BYTES = 147456;

__device__ __forceinline__ int opaque_v(int v) { asm volatile("" : "+v"(v)); return v; }
#define PHASE_IDS const int tid = opaque_v((int)threadIdx.x), lane = tid & 63, wave = __builtin_amdgcn_readfirstlane(tid >> 6); (void)lane; (void)wave;
__device__ __forceinline__ float bf2f(bf16 v) { return __builtin_bit_cast(float, (unsigned)v << 16); }
__device__ __forceinline__ float bflo(unsigned w) { return __builtin_bit_cast(float, w << 16); }
__device__ __forceinline__ float bfhi(unsigned w) { return __builtin_bit_cast(float, w & 0xffff0000u); }
__device__ __forceinline__ float wave_sum(float v) {
#pragma unroll
    for (int o = 1; o < 64; o <<= 1) v += __shfl_xor(v, o);
    return v;
}
__device__ __forceinline__ float wave_max(float v) {
#pragma unroll
    for (int o = 1; o < 64; o <<= 1) v = fmaxf(v, __shfl_xor(v, o));
    return v;
}
__device__ __forceinline__ float sigmoidf_(float x) { return __builtin_amdgcn_rcpf(1.0f + __expf(-x)); }

__host__ __device__ __forceinline__ int wt_row(int s) {
    if (s < C_V) { const int base = s & ~2047, t = s & 2047, h = t >> 7, cm = (t >> 6) & 1, d = t & 63; return base + 256 * (h >> 1) + 128 * ((d >> 3) & 1) + 32 * (2 * (h & 1) + cm) + 8 * (d >> 4) + (d & 7); }
    if (s >= C_HQ && s < C_HI) { const int t = s - C_HQ, isf = t >> 11, h = (t & 2047) >> 7, d = t & 127; return C_HQ + 256 * h + 128 * isf + d; }
    return s;
}
__device__ __forceinline__ unsigned pk4_i8(float a, float b, float c, float d) {
    const int ia = (int)__builtin_rintf(a), ib = (int)__builtin_rintf(b), ic = (int)__builtin_rintf(c), id = (int)__builtin_rintf(d);
    return (unsigned)(ia & 0xff) | ((unsigned)(ib & 0xff) << 8) | ((unsigned)(ic & 0xff) << 16) | ((unsigned)id << 24);
}
__device__ __forceinline__ const void* ldp(LAS unsigned char* lds, int k) {
    volatile LAS unsigned* t = (volatile LAS unsigned*)(lds + LDSCTL_OFF) + 32 + 2 * k;
    const unsigned lo = t[0], hi = t[1];
    return (const void*)(const GAS void*)(((unsigned long long)(unsigned)__builtin_amdgcn_readfirstlane((int)hi) << 32) | (unsigned long long)(unsigned)__builtin_amdgcn_readfirstlane((int)lo));
}
struct TItem { const float* src; bf16* dst; int N, KP; const float* gain; };
constexpr int TI_UP = (WHD / 64) * (DM / 32), TI_OUT = (DM / 64) * (DM / 32), TI_F1 = (DM / 64) * (DFF / 32), TI_F2 = (DFF / 64) * (DM / 32), TI_ALL = 2 * TI_UP + TI_OUT + TI_F1 + TI_F2;
constexpr int TSCR_BYTES = 32 * 33 * 4;
__device__ __forceinline__ TItem t_item(const float* W, int N, bf16* WT, int item, int KP, int koff, const float* gain = nullptr) {
    const int nblk = N / 32, kb = item / nblk, nb = item % nblk;
    return TItem{W + (size_t)(64 * kb) * N + 32 * nb, WT + (size_t)(32 * nb) * KP + koff + 64 * kb, N, KP, gain ? gain + 64 * kb : nullptr};
}
__device__ __forceinline__ TItem t_decode(LAS unsigned char* lds, int it) {
    unsigned char* ws = (unsigned char*)ldp(lds, 20);
    int r = it;
    if (r < TI_UP) return t_item((const float*)ldp(lds, 13), DM, (bf16*)(ws + WS_WUPA), r, YP, 0);
    r -= TI_UP; if (r < TI_UP) return t_item((const float*)ldp(lds, 14), DM, (bf16*)(ws + WS_WUPA), r, YP, WHD);
    r -= TI_UP; if (r < TI_OUT) return t_item((const float*)ldp(lds, 15), DM, (bf16*)(ws + WS_WOUT), r, DM, 0);
    r -= TI_OUT; if (r < TI_F1) return t_item((const float*)ldp(lds, 17), DFF, (bf16*)(ws + WS_WFF1), r, DM, 0, (const float*)ldp(lds, 16));
    r -= TI_F1; return t_item((const float*)ldp(lds, 18), DM, (bf16*)(ws + WS_WFF2), r, DFF, 0);
}
__device__ __forceinline__ void t_convert(const TItem& t, LAS unsigned* scr, int lane) {
    const int r = lane >> 3, c4 = lane & 7;
    const unsigned off = (unsigned)(2 * r) * (unsigned)t.N + (unsigned)(4 * c4);
    f32x4 v[8];
#pragma unroll
    for (int i = 0; i < 8; ++i) v[i] = __builtin_nontemporal_load((const GAS f32x4*)((const GAS float*)t.src + (size_t)(16 * (i >> 1) + (i & 1)) * t.N + off));
    if (t.gain) {
#pragma unroll
        for (int i = 0; i < 8; ++i) v[i] = v[i] * t.gain[16 * (i >> 1) + (i & 1) + 2 * r];
    }
#pragma unroll
    for (int m = 0; m < 4; ++m)
#pragma unroll
        for (int e = 0; e < 4; ++e) scr[(8 * m + r) * 33 + 4 * c4 + e] = pg8::cvt_pk_bf16(v[2 * m][e], v[2 * m + 1][e]);
    LDS_WAIT(); asm volatile("" ::: "memory");
    const int c = lane & 7;
#pragma unroll
    for (int j = 0; j < 4; ++j) { const int n = (lane >> 3) + 8 * j; const LAS unsigned* w = scr + (4 * c) * 33 + n;
        v4u o; o.x = w[0]; o.y = w[33]; o.z = w[66]; o.w = w[99];
        *(GAS v4u*)(t.dst + (size_t)n * t.KP + 8 * c) = o; }
    LDS_WAIT(); asm volatile("" ::: "memory");
}
template <bool PERMW = false>
__device__ __forceinline__ void p0_transpose_item(const float* W, int K, int N, bf16* WT, LAS float* scr, int item, int lane, int KP = 0, int koff = 0, gu32* cmaxw = nullptr) {
    if (KP == 0) KP = K;
    const int nblk = N / 32, kb = item / nblk, nb = item % nblk, k0 = 64 * kb, n0 = 32 * nb;
    float cmx = 0.f;
#pragma unroll
    for (int i = 0; i < 32; ++i) { const int kk = 2 * i + (lane >> 5); const float wv = __builtin_nontemporal_load((const GAS float*)W + (size_t)(k0 + kk) * N + n0 + (lane & 31)); scr[kk * 33 + (lane & 31)] = wv; cmx = fmaxf(cmx, fabsf(wv)); }
    if (PERMW && cmaxw) { cmx = fmaxf(cmx, __shfl_xor(cmx, 32));
        if (lane < 32) __hip_atomic_fetch_max(cmaxw + wt_row(n0 + lane), __float_as_uint(cmx), RLX_AGENT); }
    LDS_WAIT(); asm volatile("" ::: "memory");
    const int c = lane & 7;
#pragma unroll
    for (int j = 0; j < 4; ++j) { const int n = (lane >> 3) + 8 * j; const LAS float* s = scr + (8 * c) * 33 + n;
        v4u o; o.x = pk2(s[0 * 33], s[1 * 33]); o.y = pk2(s[2 * 33], s[3 * 33]); o.z = pk2(s[4 * 33], s[5 * 33]); o.w = pk2(s[6 * 33], s[7 * 33]);
        *(GAS v4u*)(WT + (size_t)(PERMW ? wt_row(n0 + n) : (n0 + n)) * KP + koff + k0 + 8 * c) = o; }
    LDS_WAIT(); asm volatile("" ::: "memory");
}
__device__ __forceinline__ void rms_row_to_bf16(const float* xrow, const float* g, bf16* orow, int lane, unsigned char* o8row = nullptr, float* su = nullptr) {
    const GAS f32x4* xr = (const GAS f32x4*)xrow + lane; const GAS f32x4* gr = (const GAS f32x4*)g + lane;
    f32x4 v[16]; float s = 0.f, am = 0.f;
#pragma unroll
    for (int j = 0; j < 16; ++j) { v[j] = __builtin_nontemporal_load(xr + 64 * j); s += (v[j].x * v[j].x + v[j].y * v[j].y) + (v[j].z * v[j].z + v[j].w * v[j].w);
        const f32x4 gg = gr[64 * j]; v[j] = v[j] * gg; am = fmaxf(am, fmaxf(fmaxf(fabsf(v[j].x), fabsf(v[j].y)), fmaxf(fabsf(v[j].z), fabsf(v[j].w)))); }
    const float rstd = 1.f / sqrtf(wave_sum(s) * (1.f / DM) + EPS);
    if (orow) { GAS unsigned long long* o8 = (GAS unsigned long long*)orow + lane;
#pragma unroll
        for (int j = 0; j < 16; ++j) o8[64 * j] = (unsigned long long)pk2(v[j].x * rstd, v[j].y * rstd) | ((unsigned long long)pk2(v[j].z * rstd, v[j].w * rstd) << 32); }
    if (o8row) {
        am = wave_max(am); const float inv = am > 0.f ? 127.f / am : 0.f;
#pragma unroll
        for (int j = 0; j < 16; ++j) ((GAS unsigned*)o8row)[64 * j + lane] = pk4_i8(v[j].x * inv, v[j].y * inv, v[j].z * inv, v[j].w * inv);
        if (lane == 0) *su = am * rstd * (1.f / 127.f); }
}
__device__ __forceinline__ void sincos_d(double a, float& sn, float& cs) {
    const double PI = 3.14159265358979323846;
    const double k = rint(a / PI); const double r = a - k * PI; const double r2 = r * r;
    double s = 1.0, c = 1.0, ts = 1.0, tc = 1.0;
#pragma unroll
    for (int i = 1; i <= 11; ++i) { tc *= -r2 / (double)((2 * i - 1) * (2 * i)); ts *= -r2 / (double)((2 * i) * (2 * i + 1)); c += tc; s += ts; }
    s *= r;
    const bool odd = ((long long)k) & 1;
    sn = (float)(odd ? -s : s); cs = (float)(odd ? -c : c);
}

struct Ptrs {
    const float* in[19]; float* out; unsigned char* ws;
};

__device__ __forceinline__ const bf16* rowptr(const bf16* P, const bf16* Pm, int b, int t) {
    return t < NMETA ? Pm + (size_t)t * NIN : P + (size_t)(b * SEQ + t - NMETA) * NIN;
}

__device__ __forceinline__ float dpp_shr(float v, int n) {
    const int x = __float_as_int(v); int r;
    if (n == 1) r = __builtin_amdgcn_update_dpp(0, x, 0x111, 0xf, 0xf, true); else if (n == 2) r = __builtin_amdgcn_update_dpp(0, x, 0x112, 0xf, 0xf, true);
    else if (n == 4) r = __builtin_amdgcn_update_dpp(0, x, 0x114, 0xf, 0xf, true); else r = __builtin_amdgcn_update_dpp(0, x, 0x118, 0xf, 0xf, true);
    return __int_as_float(r);
}
template <bool QK_ONLY>
struct EpiProjT {
    static constexpr bool PERM = true, AFTER_DRAIN = false, INIT = false;
    bf16* O; const float* qn; const float* kn; const float* rope; const float* hlb; float* dec; int pn0; float oscale; const float* su; const float* sw;
    __device__ __forceinline__ float val(float a, float rs, float cs) const { return su ? (float)__float_as_int(a) * (rs * cs) : a * oscale; }
    __device__ __forceinline__ void operator()(const pg8::f32x4 (&acc)[2][2][4][2], const pg8::Unit& u, int wr, int wc, int fr_, int fq_) const {
        const int fr = opaque_v(fr_), fq = opaque_v(fq_);
        const int row0 = u.pm * 256 + wr * 64 + fr, pn = u.pn + pn0;
        if constexpr (QK_ONLY) {
            const bool isk = pn >= 8; const int h = 2 * (pn & 7) + (wc >> 1), cm = wc & 1; const float* wv = isk ? kn : qn;
            float w0[8], w1[8], cq0[8], cq1[8];
#pragma unroll
            for (int j = 0; j < 8; ++j) { w0[j] = wv[16 * fq + j]; w1[j] = wv[16 * fq + 8 + j]; cq0[j] = su ? sw[pn * 256 + 32 * wc + 8 * fq + j] : 1.f; cq1[j] = su ? sw[pn * 256 + 128 + 32 * wc + 8 * fq + j] : 1.f; }
            bf16* obase = O + (isk ? C_K : C_Q) + h * 128 + cm * 64 + 16 * fq;
#pragma unroll
            for (int ai = 0; ai < 2; ++ai)
#pragma unroll
                for (int m = 0; m < 4; ++m) { const int row = row0 + ai * 128 + m * 16;
                    float x0[8], x1[8]; float ss = 0.f;
                    const float rs_ = su ? su[row] : 1.f;
#pragma unroll
                    for (int j = 0; j < 8; ++j) { x0[j] = val(acc[ai][0][m][j >> 2][j & 3], rs_, cq0[j]); x1[j] = val(acc[ai][1][m][j >> 2][j & 3], rs_, cq1[j]); ss += x0[j] * x0[j] + x1[j] * x1[j]; }
                    ss += __shfl_xor(ss, 16); ss += __shfl_xor(ss, 32);
                    const float rstd = 1.f / sqrtf(ss * (1.f / 64.f) + EPS);
                    const float* rp = rope + (NMETA + (row & (SEQ - 1))) * 16;
                    const f32x4 c0 = *(const GAS f32x4*)rp, c1 = *(const GAS f32x4*)(rp + 4), s0 = *(const GAS f32x4*)(rp + 8), s1 = *(const GAS f32x4*)(rp + 12);
                    const float cs[8] = {c0.x, c0.y, c0.z, c0.w, c1.x, c1.y, c1.z, c1.w}, sn[8] = {s0.x, s0.y, s0.z, s0.w, s1.x, s1.y, s1.z, s1.w};
                    float o0[8], o1[8];
#pragma unroll
                    for (int j = 0; j < 8; ++j) { const float a = x0[j] * rstd * w0[j], bb = x1[j] * rstd * w1[j];
                        float r0 = a, r1 = bb; if (fq == 0) { r0 = a * cs[j] - bb * sn[j]; r1 = bb * cs[j] + a * sn[j]; }
                        o0[j] = isk ? r0 : r0 * C2; o1[j] = isk ? r1 : r1 * C2; }
                    v4u wa, wb; wa.x = pg8::cvt_pk_bf16(o0[0], o0[1]); wa.y = pg8::cvt_pk_bf16(o0[2], o0[3]); wa.z = pg8::cvt_pk_bf16(o0[4], o0[5]); wa.w = pg8::cvt_pk_bf16(o0[6], o0[7]);
                    wb.x = pg8::cvt_pk_bf16(o1[0], o1[1]); wb.y = pg8::cvt_pk_bf16(o1[2], o1[3]); wb.z = pg8::cvt_pk_bf16(o1[4], o1[5]); wb.w = pg8::cvt_pk_bf16(o1[6], o1[7]);
                    bf16* op = obase + (size_t)row * NIN; *(v4u*)op = wa; *(v4u*)(op + 8) = wb; }
        } else { if (pn >= 24 && pn < 40) {
            const int h = pn - 24, d0 = 32 * wc + 8 * fq, colg = h * 128 + d0; const int lane15 = (fq << 4) | 15;
            float lb[8], cq[8], cf[8];
#pragma unroll
            for (int j = 0; j < 8; ++j) { cq[j] = su ? sw[pn * 256 + d0 + j] : 1.f; cf[j] = su ? sw[pn * 256 + 128 + d0 + j] : 1.f; }
#pragma unroll
            for (int j = 0; j < 8; ++j) { const float a = hlb[colg + j], c = hlb[WHD + colg + j]; lb[j] = 1.f / (1.f + __expf(c - a)); }
#pragma unroll
            for (int ai = 0; ai < 2; ++ai) {
                const int rowc = u.pm * 256 + ai * 128 + wr * 64, cj = (rowc >> 11) * 32 + ((rowc & (SEQ - 1)) >> 6);
                unsigned qd[4][4], ki[4][4]; float tot[8]; float rsm[4];
#pragma unroll
                for (int m = 0; m < 4; ++m) rsm[m] = su ? su[row0 + ai * 128 + m * 16] : 1.f;
#pragma unroll
                for (int jp = 0; jp < 4; ++jp) {
                    float qv[2][4], kv[2][4];
#pragma unroll
                    for (int jj = 0; jj < 2; ++jj) { const int j = 2 * jp + jj;
                        float f[4], s[4];
#pragma unroll
                        for (int m = 0; m < 4; ++m) { f[m] = lb[j] + (1.f - lb[j]) * sigmoidf_(val(acc[ai][1][m][j >> 2][j & 3], rsm[m], cf[j])); float g = __logf(f[m]);
                            g += dpp_shr(g, 1); g += dpp_shr(g, 2); g += dpp_shr(g, 4); g += dpp_shr(g, 8); s[m] = g; }
                        float carry = 0.f;
#pragma unroll
                        for (int m = 0; m < 4; ++m) { const float bcur = s[m] + carry; carry += __shfl(s[m], lane15); s[m] = bcur; }
                        tot[j] = carry;
#pragma unroll
                        for (int m = 0; m < 4; ++m) { qv[jj][m] = val(acc[ai][0][m][j >> 2][j & 3], rsm[m], cq[j]) * __expf(s[m]); kv[jj][m] = (1.f - f[m]) * __expf(-s[m]); }
                    }
#pragma unroll
                    for (int m = 0; m < 4; ++m) { qd[m][jp] = pg8::cvt_pk_bf16(qv[0][m], qv[1][m]); ki[m][jp] = pg8::cvt_pk_bf16(kv[0][m], kv[1][m]); }
                }
#pragma unroll
                for (int m = 0; m < 4; ++m) { bf16* op = O + (size_t)(row0 + ai * 128 + m * 16) * NIN + colg;
                    *(v4u*)(op + C_HQ) = (v4u){qd[m][0], qd[m][1], qd[m][2], qd[m][3]}; *(v4u*)(op + C_HF) = (v4u){ki[m][0], ki[m][1], ki[m][2], ki[m][3]}; }
                if (fr == 15) { float* dp = dec + (size_t)cj * WHD + colg;
                    *(f32x4*)dp = (f32x4){__expf(tot[0]), __expf(tot[1]), __expf(tot[2]), __expf(tot[3])}; *(f32x4*)(dp + 4) = (f32x4){__expf(tot[4]), __expf(tot[5]), __expf(tot[6]), __expf(tot[7])}; }
            }
        } else {
            const int col0 = pn * 256 + wc * 32 + 8 * fq; const bool sg = pn >= 56;
            float cw[2][8];
#pragma unroll
            for (int bj = 0; bj < 2; ++bj)
#pragma unroll
                for (int j = 0; j < 8; ++j) cw[bj][j] = su ? sw[col0 + bj * 128 + j] : 1.f;
#pragma unroll
            for (int ai = 0; ai < 2; ++ai)
#pragma unroll
                for (int m = 0; m < 4; ++m) { bf16* rowp = O + (size_t)(row0 + ai * 128 + m * 16) * NIN + col0; const float rs_ = su ? su[row0 + ai * 128 + m * 16] : 1.f;
#pragma unroll
                    for (int bj = 0; bj < 2; ++bj) { pg8::f32x4 v0, v1;
#pragma unroll
                        for (int e = 0; e < 4; ++e) { v0[e] = val(acc[ai][bj][m][0][e], rs_, cw[bj][e]); v1[e] = val(acc[ai][bj][m][1][e], rs_, cw[bj][4 + e]); }
                        if (sg) { for (int e = 0; e < 4; ++e) { v0[e] = sigmoidf_(v0[e]); v1[e] = sigmoidf_(v1[e]); } }
                        v4u w; w.x = pg8::cvt_pk_bf16(v0[0], v0[1]); w.y = pg8::cvt_pk_bf16(v0[2], v0[3]); w.z = pg8::cvt_pk_bf16(v1[0], v1[1]); w.w = pg8::cvt_pk_bf16(v1[2], v1[3]);
                        *(v4u*)(rowp + bj * 128) = w; } }
        } }
    }
};
struct HalfOrder : pg8::StaticOrder {
    static constexpr int KLOOP = WHD;
    __device__ __forceinline__ bool next(int i, pg8::Unit& u) const { if (!pg8::StaticOrder::next(i >> 1, u)) return false; u.pn |= (i & 1) << 16; return true; }
    __device__ __forceinline__ size_t kofs(const pg8::Unit& u) const { return (size_t)(u.pn >> 16) * (size_t)(WHD * 2); }
    __device__ __forceinline__ bool zero_after(const pg8::Unit& u) const { return (u.pn >> 16) != 0; }
};
struct EpiUp {
    static constexpr bool PERM = true, AFTER_DRAIN = false, INIT = false;
    const bf16* P; bf16* MG;
    __device__ __forceinline__ void operator()(pg8::f32x4 (&acc)[2][2][4][2], const pg8::Unit& u, int wr, int wc, int fr, int fq) const {
        const int pn = u.pn & 0xffff; const bool second = (u.pn >> 16) != 0;
        const int row0 = u.pm * 256 + wr * 64 + fr, col0 = pn * 256 + wc * 32 + 8 * fq;
#pragma unroll
        for (int ai = 0; ai < 2; ++ai)
#pragma unroll
            for (int m = 0; m < 4; ++m) { const int row = row0 + ai * 128 + m * 16;
#pragma unroll
                for (int bj = 0; bj < 2; ++bj) { const int col = col0 + bj * 128;
                    const v4u gb = *(const GAS v4u*)(P + (size_t)row * NIN + C_GB + col);
                    pg8::f32x4& v0 = acc[ai][bj][m][0]; pg8::f32x4& v1 = acc[ai][bj][m][1];
                    if (!second) { const v4u ga = *(const GAS v4u*)(P + (size_t)row * NIN + C_GA + col);
                        v0[0] *= bflo(ga.x) * __builtin_amdgcn_rcpf(bflo(gb.x)); v0[1] *= bfhi(ga.x) * __builtin_amdgcn_rcpf(bfhi(gb.x)); v0[2] *= bflo(ga.y) * __builtin_amdgcn_rcpf(bflo(gb.y)); v0[3] *= bfhi(ga.y) * __builtin_amdgcn_rcpf(bfhi(gb.y));
                        v1[0] *= bflo(ga.z) * __builtin_amdgcn_rcpf(bflo(gb.z)); v1[1] *= bfhi(ga.z) * __builtin_amdgcn_rcpf(bfhi(gb.z)); v1[2] *= bflo(ga.w) * __builtin_amdgcn_rcpf(bflo(gb.w)); v1[3] *= bfhi(ga.w) * __builtin_amdgcn_rcpf(bfhi(gb.w));
                    } else {
                        v4u w; w.x = pg8::cvt_pk_bf16(v0[0] * bflo(gb.x), v0[1] * bfhi(gb.x)); w.y = pg8::cvt_pk_bf16(v0[2] * bflo(gb.y), v0[3] * bfhi(gb.y));
                        w.z = pg8::cvt_pk_bf16(v1[0] * bflo(gb.z), v1[1] * bfhi(gb.z)); w.w = pg8::cvt_pk_bf16(v1[2] * bflo(gb.w), v1[3] * bfhi(gb.w));
                        *(v4u*)(MG + (size_t)row * DM + col) = w; } } }
    }
};
struct HalfOrder8 : pg8::StaticOrder {
    static constexpr int KLOOP = WHD / 2;
    __device__ __forceinline__ bool next(int i, pg8::Unit& u) const { if (!pg8::StaticOrder::next(i >> 1, u)) return false; u.pn |= (i & 1) << 16; return true; }
    __device__ __forceinline__ size_t kofs(const pg8::Unit& u) const { return (size_t)(u.pn >> 16) * (size_t)WHD; }
    __device__ __forceinline__ bool zero_after(const pg8::Unit& u) const { return (u.pn >> 16) != 0; }
};
struct EpiUp8 {
    static constexpr bool PERM = true, AFTER_DRAIN = false, INIT = false;
    const bf16* P; bf16* MG; const float* SYR; const float* SYB; const float* SWR; const float* SWB;
    __device__ __forceinline__ void operator()(pg8::f32x4 (&acc)[2][2][4][2], const pg8::Unit& u, int wr, int wc, int fr_, int fq_) const {
        const int fr = opaque_v(fr_), fq = opaque_v(fq_);
        const int pn = u.pn & 0xffff; const bool second = (u.pn >> 16) != 0;
        const int row0 = u.pm * 256 + wr * 64 + fr, col0 = pn * 256 + wc * 32 + 8 * fq;
        const float* CS = second ? SWB : SWR; const float* RS = second ? SYB : SYR;
        float cs[2][8];
#pragma unroll
        for (int bj = 0; bj < 2; ++bj) { const f32x4 c0 = *(const GAS f32x4*)(CS + col0 + bj * 128), c1 = *(const GAS f32x4*)(CS + col0 + bj * 128 + 4);
            cs[bj][0] = c0.x; cs[bj][1] = c0.y; cs[bj][2] = c0.z; cs[bj][3] = c0.w; cs[bj][4] = c1.x; cs[bj][5] = c1.y; cs[bj][6] = c1.z; cs[bj][7] = c1.w; }
#pragma unroll
        for (int ai = 0; ai < 2; ++ai)
#pragma unroll
            for (int m = 0; m < 4; ++m) { const int row = row0 + ai * 128 + m * 16; const float rs = RS[row];
#pragma unroll
                for (int bj = 0; bj < 2; ++bj) { const int col = col0 + bj * 128;
                    const v4u gb = *(const GAS v4u*)(P + (size_t)row * NIN + C_GB + col);
                    const float b_[8] = {bflo(gb.x), bfhi(gb.x), bflo(gb.y), bfhi(gb.y), bflo(gb.z), bfhi(gb.z), bflo(gb.w), bfhi(gb.w)};
                    if (!second) { const v4u ga = *(const GAS v4u*)(P + (size_t)row * NIN + C_GA + col);
                        const float a_[8] = {bflo(ga.x), bfhi(ga.x), bflo(ga.y), bfhi(ga.y), bflo(ga.z), bfhi(ga.z), bflo(ga.w), bfhi(ga.w)};
#pragma unroll
                        for (int e = 0; e < 8; ++e) { float f = (float)__float_as_int(acc[ai][bj][m][e >> 2][e & 3]) * (a_[e] * __builtin_amdgcn_rcpf(b_[e])) * (rs * cs[bj][e]);
                            f = fminf(fmaxf(f, -2.0e9f), 2.0e9f);
                            acc[ai][bj][m][e >> 2][e & 3] = __int_as_float((int)__builtin_rintf(f)); }
                    } else { float o_[8];
#pragma unroll
                        for (int e = 0; e < 8; ++e) o_[e] = (float)__float_as_int(acc[ai][bj][m][e >> 2][e & 3]) * (b_[e] * (rs * cs[bj][e]));
                        v4u w; w.x = pg8::cvt_pk_bf16(o_[0], o_[1]); w.y = pg8::cvt_pk_bf16(o_[2], o_[3]); w.z = pg8::cvt_pk_bf16(o_[4], o_[5]); w.w = pg8::cvt_pk_bf16(o_[6], o_[7]);
                        *(v4u*)(MG + (size_t)row * DM + col) = w; } } }
    }
};
struct EpiOut {
    static constexpr bool PERM = true, AFTER_DRAIN = false, INIT = true;
    const float* X; bf16* H1b; float* SSQ;
    __device__ __forceinline__ void init(pg8::f32x4 (&acc)[2][2][4][2], const pg8::Unit& u, int wr, int wc, int fr_, int fq_) const {
        const int fr = opaque_v(fr_), fq = opaque_v(fq_);
        const float* xp = X + (size_t)(u.pm * 256 + wr * 64 + fr) * DM + u.pn * 256 + wc * 32 + 8 * fq;
#pragma unroll
        for (int ai = 0; ai < 2; ++ai)
#pragma unroll
            for (int bj = 0; bj < 2; ++bj)
#pragma unroll
                for (int m = 0; m < 4; ++m) { const float* q = xp + (size_t)(ai * 128 + m * 16) * DM + bj * 128;
                    acc[ai][bj][m][0] = __builtin_nontemporal_load((const pg8::f32x4*)q); acc[ai][bj][m][1] = __builtin_nontemporal_load((const pg8::f32x4*)(q + 4)); }
    }
    __device__ __forceinline__ void operator()(const pg8::f32x4 (&acc)[2][2][4][2], const pg8::Unit& u, int wr, int wc, int fr, int fq) const {
        const int row0 = u.pm * 256 + wr * 64 + fr, col0 = u.pn * 256 + wc * 32 + 8 * fq;
#pragma unroll
        for (int ai = 0; ai < 2; ++ai)
#pragma unroll
            for (int m = 0; m < 4; ++m) { const int row = row0 + ai * 128 + m * 16; float ss = 0.f;
#pragma unroll
                for (int bj = 0; bj < 2; ++bj) { const int col = col0 + bj * 128; const size_t off = (size_t)row * DM + col;
                    const pg8::f32x4 h0 = acc[ai][bj][m][0], h1 = acc[ai][bj][m][1];
                    ss += (h0[0] * h0[0] + h0[1] * h0[1]) + (h0[2] * h0[2] + h0[3] * h0[3]) + (h1[0] * h1[0] + h1[1] * h1[1]) + (h1[2] * h1[2] + h1[3] * h1[3]);
                    v4u w; w.x = pg8::cvt_pk_bf16(h0[0], h0[1]); w.y = pg8::cvt_pk_bf16(h0[2], h0[3]); w.z = pg8::cvt_pk_bf16(h1[0], h1[1]); w.w = pg8::cvt_pk_bf16(h1[2], h1[3]);
                    *(v4u*)(H1b + off) = w; }
                ss += __shfl_xor(ss, 16); ss += __shfl_xor(ss, 32);
                if (fq == 0) SSQ[(size_t)row * 64 + u.pn * 4 + wc] = ss; }
    }
};
struct EpiFf1 {
    static constexpr bool PERM = true, AFTER_DRAIN = false, INIT = false;
    bf16* H;
    __device__ __forceinline__ void operator()(const pg8::f32x4 (&acc)[2][2][4][2], const pg8::Unit& u, int wr, int wc, int fr, int fq) const {
        const int row0 = u.pm * 256 + wr * 64 + fr, col0 = u.pn * 256 + wc * 32 + 8 * fq;
#pragma unroll
        for (int ai = 0; ai < 2; ++ai)
#pragma unroll
            for (int m = 0; m < 4; ++m) { const int row = row0 + ai * 128 + m * 16;
#pragma unroll
                for (int bj = 0; bj < 2; ++bj) { pg8::f32x4 v0 = acc[ai][bj][m][0], v1 = acc[ai][bj][m][1];
#pragma unroll
                    for (int e = 0; e < 4; ++e) { const float a = fmaxf(v0[e], 0.f), b = fmaxf(v1[e], 0.f); v0[e] = a * a; v1[e] = b * b; }
                    v4u w; w.x = pg8::cvt_pk_bf16(v0[0], v0[1]); w.y = pg8::cvt_pk_bf16(v0[2], v0[3]); w.z = pg8::cvt_pk_bf16(v1[0], v1[1]); w.w = pg8::cvt_pk_bf16(v1[2], v1[3]);
                    *(v4u*)(H + (size_t)row * DFF + col0 + bj * 128) = w; } }
    }
};
struct EpiFf2 {
    static constexpr bool PERM = false, AFTER_DRAIN = false, INIT = true;
    float* O; const float* RSTD; const bf16* H1b;
    __device__ __forceinline__ void init(pg8::f32x4 (&acc)[2][2][4][2], const pg8::Unit& u, int wr, int wc, int fr_, int fq_) const {
        const int fr = opaque_v(fr_), fq = opaque_v(fq_);
        const int row0 = u.pm * 256 + wr * 64 + fr, col0 = u.pn * 256 + wc * 32 + 4 * fq;
#pragma unroll
        for (int ai = 0; ai < 2; ++ai)
#pragma unroll
            for (int bj = 0; bj < 2; ++bj)
#pragma unroll
                for (int m = 0; m < 4; ++m) { const int row = row0 + ai * 128 + m * 16; const float rs = RSTD[row], ir2 = 1.f / (rs * rs); const bf16* rowp = H1b + (size_t)row * DM + col0 + bj * 128;
#pragma unroll
                    for (int n = 0; n < 2; ++n) { const unsigned long long w = *(const GAS unsigned long long*)(rowp + n * 16); const unsigned lo = (unsigned)w, hh = (unsigned)(w >> 32);
                        acc[ai][bj][m][n] = (pg8::f32x4){bflo(lo) * ir2, bfhi(lo) * ir2, bflo(hh) * ir2, bfhi(hh) * ir2}; } }
    }
    __device__ __forceinline__ void operator()(const pg8::f32x4 (&acc)[2][2][4][2], const pg8::Unit& u, int wr, int wc, int fr, int fq) const {
        const int row0 = u.pm * 256 + wr * 64 + fr, col0 = u.pn * 256 + wc * 32 + 4 * fq;
#pragma unroll
        for (int ai = 0; ai < 2; ++ai)
#pragma unroll
            for (int m = 0; m < 4; ++m) { const int row = row0 + ai * 128 + m * 16; const float rs = RSTD[row], r2 = rs * rs; float* rowp = O + (size_t)row * DM + col0;
#pragma unroll
                for (int bj = 0; bj < 2; ++bj)
#pragma unroll
                    for (int n = 0; n < 2; ++n) __builtin_nontemporal_store(acc[ai][bj][m][n] * r2, (pg8::f32x4*)(rowp + bj * 128 + n * 16)); }
    }
};

constexpr int NCONV = 96;
namespace da {
typedef float f32x16 __attribute__((ext_vector_type(16)));
typedef short s16x4 __attribute__((ext_vector_type(4)));
constexpr int KBUF = 16384, VBUF = 16384, K_OFF = 0, V_OFF = 32768;
__device__ __forceinline__ int crow(int r, int hi) { return (r & 3) + 8 * (r >> 2) + 4 * hi; }
__device__ __forceinline__ int kswz(int row, int colB) { return row * 256 + (colB ^ ((row & 7) << 4)); }
__device__ __forceinline__ int v_st(int k, int c) { return ((k >> 3) * 4 + (c >> 5)) * 512 + ((k & 7) * 32 + (c & 31)) * 2; }
__device__ __forceinline__ int v_rd_base(int lane) { return ((lane & 3) << 3) | (((lane >> 2) & 3) << 6) | (((lane >> 4) & 1) << 5) | (((lane >> 5) & 1) << 8); }
__device__ __forceinline__ s16x4 vtr(LAS const unsigned char* p) { return __builtin_bit_cast(s16x4, __builtin_amdgcn_ds_read_tr16_b64_v4i16((LAS s16x4*)p)); }
__device__ __forceinline__ float pl_max(float v) { auto rr = __builtin_amdgcn_permlane32_swap(__float_as_uint(v), __float_as_uint(v), false, false); return fmaxf(__uint_as_float(rr[0]), __uint_as_float(rr[1])); }
__device__ __forceinline__ float pl_sum(float v) { auto rr = __builtin_amdgcn_permlane32_swap(__float_as_uint(v), __float_as_uint(v), false, false); return __uint_as_float(rr[0]) + __uint_as_float(rr[1]); }
__device__ __forceinline__ bf16x8 pack8(const f32x16& p, int base) {
    v4u w; w.x = pg8::cvt_pk_bf16(p[base + 0], p[base + 1]); w.y = pg8::cvt_pk_bf16(p[base + 2], p[base + 3]); w.z = pg8::cvt_pk_bf16(p[base + 4], p[base + 5]); w.w = pg8::cvt_pk_bf16(p[base + 6], p[base + 7]);
    return __builtin_bit_cast(bf16x8, w);
}
__device__ __forceinline__ void qk(f32x16& p0, f32x16& p1, LAS const unsigned char* Kb, LAS const unsigned char* Qw, float negm, int c, int r32, int hi) {
#pragma unroll
    for (int r = 0; r < 16; ++r) { p0[r] = negm; p1[r] = negm; }
#pragma unroll
    for (int d0 = 0; d0 < 4; ++d0) { const int cb = (c * 64 + d0 * 16 + hi * 8) * 2;
        const bf16x8 b0 = *(LAS const bf16x8*)(Kb + kswz(r32, cb)), b1 = *(LAS const bf16x8*)(Kb + kswz(32 + r32, cb)), qf = *(LAS const bf16x8*)(Qw + d0 * 1024);
        p0 = __builtin_amdgcn_mfma_f32_32x32x16_bf16(b0, qf, p0, 0, 0, 0); p1 = __builtin_amdgcn_mfma_f32_32x32x16_bf16(b1, qf, p1, 0, 0, 0); }
}
__device__ __forceinline__ void mask_diag(f32x16& p0, f32x16& p1, int hi, int rel) {
#pragma unroll
    for (int r = 0; r < 16; ++r) { if (crow(r, hi) > rel) p0[r] = -1e30f; if (32 + crow(r, hi) > rel) p1[r] = -1e30f; }
}
__device__ __forceinline__ void partB(f32x16& p0, f32x16& p1, float& l_part, bf16x8 (&pb)[4]) {
    float ps = 0.f;
#pragma unroll
    for (int r = 0; r < 16; ++r) { p0[r] = __builtin_amdgcn_exp2f(p0[r]); p1[r] = __builtin_amdgcn_exp2f(p1[r]); ps += p0[r] + p1[r]; }
    l_part += ps;
    pb[0] = pack8(p0, 0); pb[1] = pack8(p0, 8); pb[2] = pack8(p1, 0); pb[3] = pack8(p1, 8);
}
__device__ __forceinline__ void pv(f32x16 (&o)[4], LAS const unsigned char* Vb, const bf16x8 (&pb)[4], int lane) {
    LAS const unsigned char* vb = Vb + v_rd_base(lane);
#pragma unroll
    for (int d0 = 0; d0 < 4; ++d0) {
        s16x4 lo[4], hh[4];
#pragma unroll
        for (int ks = 0; ks < 4; ++ks) { lo[ks] = vtr(vb + d0 * 512 + ks * 4096); hh[ks] = vtr(vb + d0 * 512 + ks * 4096 + 2048); }
#pragma unroll
        for (int ks = 0; ks < 4; ++ks) {
            const bf16x8 a = (bf16x8){lo[ks][0], lo[ks][1], lo[ks][2], lo[ks][3], hh[ks][0], hh[ks][1], hh[ks][2], hh[ks][3]};
            o[d0] = __builtin_amdgcn_mfma_f32_32x32x16_bf16(a, pb[ks], o[d0], 0, 0, 0); }
    }
}
__device__ __forceinline__ void meta_tile(LAS const unsigned char* Kb, LAS const unsigned char* Vb, LAS const unsigned char* Qw, f32x16 (&o)[4], float& l_part, float negm, int c, int r32, int hi, int lane) {
    f32x16 p0;
#pragma unroll
    for (int r = 0; r < 16; ++r) p0[r] = negm;
#pragma unroll
    for (int d0 = 0; d0 < 4; ++d0) { const int cb = (c * 64 + d0 * 16 + hi * 8) * 2;
        p0 = __builtin_amdgcn_mfma_f32_32x32x16_bf16(*(LAS const bf16x8*)(Kb + kswz(r32, cb)), *(LAS const bf16x8*)(Qw + d0 * 1024), p0, 0, 0, 0); }
    float ps = 0.f;
#pragma unroll
    for (int r = 0; r < 16; ++r) { p0[r] = (crow(r, hi) >= NMETA) ? 0.f : __builtin_amdgcn_exp2f(p0[r]); ps += p0[r]; }
    l_part += ps;
    const bf16x8 pb0 = pack8(p0, 0);
    LAS const unsigned char* vb = Vb + v_rd_base(lane);
#pragma unroll
    for (int d0 = 0; d0 < 4; ++d0) { const s16x4 lo = vtr(vb + d0 * 512), hh = vtr(vb + d0 * 512 + 2048);
        o[d0] = __builtin_amdgcn_mfma_f32_32x32x16_bf16((bf16x8){lo[0], lo[1], lo[2], lo[3], hh[0], hh[1], hh[2], hh[3]}, pb0, o[d0], 0, 0, 0); }
}
constexpr int KB3 = 0, VB3 = 49152, QFR = 98304, MKB = 131072, MVB = 139264;
__device__ __forceinline__ void glds16(const void* g, unsigned lds_base) {
    unsigned sv; asm volatile("s_mov_b32 %0, m0\n\ts_mov_b32 m0, %2\n\ts_nop 0\n\tglobal_load_lds_dwordx4 %1, off\n\ts_mov_b32 m0, %0" : "=&s"(sv) : "v"(g), "s"(lds_base) : "memory"); }
__device__ __forceinline__ void dma_tile(LAS unsigned char* lds, int buf, const bf16* tile0, int wave, int lane_) {
    const int lane = opaque_v(lane_);
    LAS unsigned char* dst = lds + (wave < 4 ? KB3 + buf * KBUF + wave * 4096 : VB3 + buf * VBUF + (wave - 4) * 4096);
#pragma unroll
    for (int i = 0; i < 4; ++i) {
        unsigned off;
        if (wave < 4) { const int p = 4 * wave + i, row = 4 * p + (lane >> 4), colB = ((lane & 15) ^ (row & 7)) << 4; off = (unsigned)(row * NIN + C_K + (colB >> 1)); }
        else { const int p = 4 * (wave - 4) + i, st = 2 * p + (lane >> 5), key = (st >> 2) * 8 + ((lane & 31) >> 2), col = (st & 3) * 32 + (lane & 3) * 8; off = (unsigned)(key * NIN + C_V + col); }
        glds16(tile0 + off, (unsigned)__builtin_amdgcn_readfirstlane((int)(unsigned)(size_t)(dst + i * 1024))); }
}
typedef __bf16 bf16v2_ __attribute__((ext_vector_type(2)));
__device__ __forceinline__ unsigned cvt2(float lo, float hi) { const pg8::f32x2 v = {lo, hi}; return __builtin_bit_cast(unsigned, __builtin_convertvector(v, bf16v2_)); }
#define ATT_SBAR() __builtin_amdgcn_sched_barrier(0)
#define ATT_PIN(x) asm volatile("" : "+v"(x))
__device__ __forceinline__ void fast_step(f32x16 (&o)[4], f32x16& s0, f32x16& s1, float& l_part, const f32x16& negm16, LAS const unsigned char* Vslot, LAS const unsigned char* Kb, LAS const unsigned char* Qw, int c, int r32, int hi, int lane) {
    LAS const unsigned char* vb = Vslot + v_rd_base(lane);
    float ps = 0.f; unsigned pk[4], pn[4];
#pragma unroll
    for (int i = 0; i < 4; ++i) { const float x = __builtin_amdgcn_exp2f(s0[2 * i]), y = __builtin_amdgcn_exp2f(s0[2 * i + 1]); ps += x; ps += y; pk[i] = cvt2(x, y); }
    s16x4 va[8], vn[8];
#pragma unroll
    for (int d0 = 0; d0 < 4; ++d0) { va[2 * d0] = vtr(vb + d0 * 512); va[2 * d0 + 1] = vtr(vb + d0 * 512 + 2048); }
    bf16x8 kb0[4], kb1[4], qf[4];
    ATT_SBAR();
#pragma unroll
    for (int ch = 0; ch < 4; ++ch) {
        const bf16x8 pbc = __builtin_bit_cast(bf16x8, ((v4u){pk[0], pk[1], pk[2], pk[3]}));
#pragma unroll
        for (int d0 = 0; d0 < 4; ++d0) {
            const bf16x8 a = (bf16x8){va[2 * d0][0], va[2 * d0][1], va[2 * d0][2], va[2 * d0][3], va[2 * d0 + 1][0], va[2 * d0 + 1][1], va[2 * d0 + 1][2], va[2 * d0 + 1][3]};
            o[d0] = __builtin_amdgcn_mfma_f32_32x32x16_bf16(a, pbc, o[d0], 0, 0, 0);
            if (ch < 3) {
                const int nb = ((ch + 1) & 1) * 8 + 2 * d0;
                const float x = __builtin_amdgcn_exp2f((ch + 1 < 2) ? s0[nb] : s1[nb]), y = __builtin_amdgcn_exp2f((ch + 1 < 2) ? s0[nb + 1] : s1[nb + 1]);
                ps += x; ps += y; pn[d0] = cvt2(x, y);
                vn[2 * d0] = vtr(vb + d0 * 512 + (ch + 1) * 4096); vn[2 * d0 + 1] = vtr(vb + d0 * 512 + (ch + 1) * 4096 + 2048);
                ATT_PIN(pn[d0]); ATT_PIN(ps);
            } else {
                const int cb = (c * 64 + d0 * 16 + hi * 8) * 2;
                kb0[d0] = *(LAS const bf16x8*)(Kb + kswz(r32, cb)); kb1[d0] = *(LAS const bf16x8*)(Kb + kswz(32 + r32, cb)); qf[d0] = *(LAS const bf16x8*)(Qw + d0 * 1024);
            }
            ATT_SBAR();
        }
        if (ch < 3) {
#pragma unroll
            for (int i = 0; i < 4; ++i) pk[i] = pn[i];
#pragma unroll
            for (int i = 0; i < 8; ++i) va[i] = vn[i];
        }
    }
    l_part += ps;
    s0 = __builtin_amdgcn_mfma_f32_32x32x16_bf16(kb0[0], qf[0], negm16, 0, 0, 0); s1 = __builtin_amdgcn_mfma_f32_32x32x16_bf16(kb1[0], qf[0], negm16, 0, 0, 0);
#pragma unroll
    for (int d0 = 1; d0 < 4; ++d0) { s0 = __builtin_amdgcn_mfma_f32_32x32x16_bf16(kb0[d0], qf[d0], s0, 0, 0, 0); s1 = __builtin_amdgcn_mfma_f32_32x32x16_bf16(kb1[d0], qf[d0], s1, 0, 0, 0); }
}
__device__ __forceinline__ void unit(LAS unsigned char* lds, const bf16* P, const bf16* Pm, bf16* YA, const float* subln, const float* kn, const float* rope, float lam, float mfix, int b, int h, int qb, int tid, int wave, int lane_in) {
    const int c = wave >> 2, jw = wave & 3, q0 = qb * 128, NT = 2 * qb + 2;
    const bf16* tb0 = P + (size_t)(b * SEQ) * NIN + h * 128;
    f32x16 o[4] = {}; float l_part = 0.f; const float negm = -mfix;
    { const int lane = lane_in, r32 = lane & 31, hi = lane >> 5;
    dma_tile(lds, 0, tb0, wave, lane); dma_tile(lds, 1, tb0 + (size_t)64 * NIN, wave, lane);
    if (c == 0 && NT > 2) dma_tile(lds, 2, tb0 + (size_t)128 * NIN, wave, lane);
    LAS unsigned char* Qw = lds + QFR + wave * 4096 + lane * 16;
    { const bf16* qp = P + (size_t)(b * SEQ + q0 + jw * 32 + r32) * NIN + C_Q + h * 128 + c * 64 + hi * 8;
#pragma unroll
      for (int d0 = 0; d0 < 4; ++d0) *(LAS bf16x8*)(Qw + d0 * 1024) = *(const GAS bf16x8*)(qp + d0 * 16); }
    { const int sr = tid >> 4, sc = (tid & 15) * 8, mr = sr & 15;
      if (tid < 256) {
          const v4u raw = *(const GAS v4u*)(Pm + (size_t)mr * NIN + C_K + h * 128 + sc); const int sub = tid & 7;
          float xv[8] = {bflo(raw.x), bfhi(raw.x), bflo(raw.y), bfhi(raw.y), bflo(raw.z), bfhi(raw.z), bflo(raw.w), bfhi(raw.w)};
          float ss = 0.f;
#pragma unroll
          for (int j = 0; j < 8; ++j) ss += xv[j] * xv[j];
          ss += __shfl_xor(ss, 1); ss += __shfl_xor(ss, 2); ss += __shfl_xor(ss, 4);
          const float rstd = 1.f / sqrtf(ss * (1.f / 64.f) + EPS); float ov[8];
#pragma unroll
          for (int j = 0; j < 8; ++j) { const float xn = xv[j] * rstd * kn[sub * 8 + j], pr = __shfl_xor(xn, 1), cs = rope[mr * 16 + j], sn = rope[mr * 16 + 8 + j];
              ov[j] = (sub == 0) ? xn * cs - pr * sn : (sub == 1) ? xn * cs + pr * sn : xn; }
          v4u v; v.x = pk2(ov[0], ov[1]); v.y = pk2(ov[2], ov[3]); v.z = pk2(ov[4], ov[5]); v.w = pk2(ov[6], ov[7]);
          *(LAS v4u*)(lds + MKB + kswz(mr, sc * 2)) = v; }
      else           { const v4u v = *(const GAS v4u*)(Pm + (size_t)mr * NIN + C_V + h * 128 + sc); *(LAS v4u*)(lds + MVB + v_st(mr, sc)) = v; } }
    asm volatile("s_waitcnt vmcnt(0)" ::: "memory"); __syncthreads();
    meta_tile(lds + MKB, lds + MVB, Qw, o, l_part, negm, c, r32, hi, lane);
    f32x16 s0, s1;
    qk(s0, s1, lds + KB3, Qw, negm, c, r32, hi);
    if (qb == 0) mask_diag(s0, s1, hi, 32 * jw + r32);
    int s_j = 0;
    int j = 0;
    { f32x16 negm16;
#pragma unroll
      for (int r = 0; r < 16; ++r) negm16[r] = negm;
      ATT_PIN(negm16);
#pragma unroll 1
      for (; j < NT - 3; ++j) {
        const int s_j1 = (s_j == 2) ? 0 : s_j + 1, s_j2 = (s_j1 == 2) ? 0 : s_j1 + 1;
        asm volatile("s_waitcnt vmcnt(4) lgkmcnt(0)" ::: "memory"); __builtin_amdgcn_s_barrier(); asm volatile("" ::: "memory");
        if (c == 0) dma_tile(lds, s_j, tb0 + (size_t)(j + 3) * 64 * NIN, wave, lane); else dma_tile(lds, s_j2, tb0 + (size_t)(j + 2) * 64 * NIN, wave, lane);
        fast_step(o, s0, s1, l_part, negm16, lds + VB3 + s_j * VBUF, lds + KB3 + s_j1 * KBUF, Qw, c, r32, hi, lane);
        s_j = s_j1;
      } }
#pragma unroll 1
    for (; j < NT; ++j) {
        const int s_j1 = (s_j == 2) ? 0 : s_j + 1, s_j2 = (s_j1 == 2) ? 0 : s_j1 + 1;
        { if ((c == 0) ? (j + 2 < NT) : (j + 1 < NT)) asm volatile("s_waitcnt vmcnt(4) lgkmcnt(0)" ::: "memory"); else asm volatile("s_waitcnt vmcnt(0) lgkmcnt(0)" ::: "memory");
            __builtin_amdgcn_s_barrier(); asm volatile("" ::: "memory"); }
        if (c == 0) { if (j + 3 < NT) dma_tile(lds, s_j, tb0 + (size_t)(j + 3) * 64 * NIN, wave, lane); }
        else        { if (j + 2 < NT) dma_tile(lds, s_j2, tb0 + (size_t)(j + 2) * 64 * NIN, wave, lane); }
        const int dt = j - 2 * qb, dn = dt + 1;
        const bool act = !(dt == 1 && jw < 2), actn = (j + 1 < NT) && !(dn == 1 && jw < 2);
        if (act) { bf16x8 pb[4]; partB(s0, s1, l_part, pb); pv(o, lds + VB3 + s_j * VBUF, pb, lane); }
        if (actn) { qk(s0, s1, lds + KB3 + s_j1 * KBUF, Qw, negm, c, r32, hi); if (dn >= 0) mask_diag(s0, s1, hi, 32 * jw + r32 - 64 * dn); }
        s_j = s_j1;
    }
    }
    __syncthreads();
    LAS float* ex = (LAS float*)lds;
    const int lane = opaque_v(lane_in), r32 = lane & 31, hi = lane >> 5;
    const float l_reg = pl_sum(l_part);
    if (c == 1) { const float s1x = -lam / l_reg;
#pragma unroll
        for (int d0 = 0; d0 < 4; ++d0)
#pragma unroll
            for (int r = 0; r < 16; ++r) ex[((jw * 4 + d0) * 16 + r) * 64 + lane] = o[d0][r] * s1x; }
    __syncthreads();
    if (c == 0) { const float il = 1.f / l_reg; float ss = 0.f;
#pragma unroll
        for (int d0 = 0; d0 < 4; ++d0)
#pragma unroll
            for (int r = 0; r < 16; ++r) { const float v = o[d0][r] * il + ex[((jw * 4 + d0) * 16 + r) * 64 + lane]; o[d0][r] = v; ss += v * v; }
        ss = pl_sum(ss);
        const float rstd = (1.f - LAM_INIT) / sqrtf(ss * (1.f / 128.f) + EPS);
        bf16* yp = YA + (size_t)(b * SEQ + q0 + jw * 32 + r32) * YP + h * 128;
#pragma unroll
        for (int d0 = 0; d0 < 4; ++d0)
#pragma unroll
            for (int g = 0; g < 4; ++g) { const int e = 32 * d0 + 8 * g + 4 * hi; const f32x4 sw = *(const GAS f32x4*)(subln + e);
                const unsigned w0 = pg8::cvt_pk_bf16(o[d0][4 * g + 0] * rstd * sw.x, o[d0][4 * g + 1] * rstd * sw.y), w1 = pg8::cvt_pk_bf16(o[d0][4 * g + 2] * rstd * sw.z, o[d0][4 * g + 3] * rstd * sw.w);
                *(GAS unsigned long long*)(yp + e) = (unsigned long long)w0 | ((unsigned long long)w1 << 32); }
    }
    __syncthreads();
}
}


namespace hg {
using da::f32x16; using da::s16x4; using da::crow; using da::vtr; using da::pl_sum; using da::pack8;
__device__ __forceinline__ int ioff(int row, int ch) { return 2048 * (row >> 3) + 512 * (ch >> 2) + 64 * (row & 7) + 16 * ((ch & 3) ^ ((row >> 2) & 3)); }
constexpr int QD = 0, KI = 16384, VI = 32768, SI = 49152, DECL = 81920, SSQ = 82432;
__device__ __forceinline__ bf16x8 cat(s16x4 lo, s16x4 hh) { return (bf16x8){lo[0], lo[1], lo[2], lo[3], hh[0], hh[1], hh[2], hh[3]}; }
__device__ __forceinline__ void unit(LAS unsigned char* lds, const bf16* P, const bf16* Pm, bf16* YB, const float* DEC, const float* onorm, const float* hlb, int b, int h, int tid, int wave, int lane) {
    const int r32 = lane & 31, hi = lane >> 5, blk = (lane >> 4) & 1, q4 = (lane & 15) >> 2, p4 = lane & 3;
    const int eb = wave & 3, tb = wave >> 2;
    const int trc = 2 * blk + (p4 >> 1), trb = 8 * (p4 & 1);
#pragma unroll
    for (int i = 0; i < 4; ++i) *(LAS v4u*)(lds + SI + (tid * 4 + i) * 16) = (v4u){0u, 0u, 0u, 0u};
    f32x16 acc0 = {}, acc1 = {};
    const int sr = tid >> 4, sch = tid & 15;
    const v4u z4 = (v4u){0u, 0u, 0u, 0u};
    v4u q0 = z4, q1 = z4, k0 = z4, k1 = z4, v0 = z4, v1 = z4; float dcv = 0.f;
    if (sr < NMETA) { const bf16* mp = Pm + (size_t)sr * NIN + h * 128 + sch * 8; v0 = *(const GAS v4u*)(mp + C_HI); }
    LAS float* dec = (LAS float*)(lds + DECL); LAS float* ssq = (LAS float*)(lds + SSQ);
    if (tid < 128) {
        const int col = h * 128 + tid; const float lb = 1.f / (1.f + __expf(hlb[WHD + col] - hlb[col]));
        float xr[NMETA];
#pragma unroll
        for (int r = 0; r < NMETA; ++r) xr[r] = bf2f(Pm[(size_t)r * NIN + C_HF + col]);
        float run = 0.f;
#pragma unroll
        for (int r = 0; r < NMETA; ++r) { const float f = lb + (1.f - lb) * sigmoidf_(xr[r]); run += __logf(f);
            *(LAS unsigned short*)(lds + KI + ioff(r, tid >> 3) + (tid & 7) * 2) = (unsigned short)f2bf((1.f - f) * __expf(-run)); }
        dec[tid] = __expf(run);
    }
#pragma unroll 1
    for (int n = 0; n <= 32; ++n) {
        { const int o0 = ioff(sr, sch), o1 = ioff(32 + sr, sch);
          *(LAS v4u*)(lds + QD + o0) = q0; *(LAS v4u*)(lds + QD + o1) = q1; if (n > 0 || sr >= NMETA) *(LAS v4u*)(lds + KI + o0) = k0; *(LAS v4u*)(lds + KI + o1) = k1; *(LAS v4u*)(lds + VI + o0) = v0; *(LAS v4u*)(lds + VI + o1) = v1; }
        if (tid < 128 && n > 0) dec[tid] = dcv;
        __syncthreads();
        if (n < 32) {
            const bf16* rp = P + (size_t)(b * SEQ + 64 * n + sr) * NIN + h * 128 + sch * 8; const size_t r32o = (size_t)32 * NIN;
            q0 = *(const GAS v4u*)(rp + C_HQ); q1 = *(const GAS v4u*)(rp + C_HQ + r32o); k0 = *(const GAS v4u*)(rp + C_HF); k1 = *(const GAS v4u*)(rp + C_HF + r32o);
            v0 = *(const GAS v4u*)(rp + C_HI); v1 = *(const GAS v4u*)(rp + C_HI + r32o);
            if (tid < 128) dcv = DEC[(size_t)(b * 32 + n) * WHD + h * 128 + tid];
        }
        unsigned long long gw[4] = {0ull, 0ull, 0ull, 0ull};
        if (n > 0) { const bf16* gp = P + (size_t)(b * SEQ + 64 * (n - 1) + 32 * tb + r32) * NIN + C_HG + h * 128 + 32 * eb + 4 * hi;
#pragma unroll
            for (int g = 0; g < 4; ++g) gw[g] = *(const GAS unsigned long long*)(gp + 8 * g); }
        bf16x8 vf[4];
#pragma unroll
        for (int ks = 0; ks < 4; ++ks) vf[ks] = cat(vtr(lds + VI + ioff(16 * ks + 4 * hi + q4, 4 * eb + trc) + trb), vtr(lds + VI + ioff(16 * ks + 8 + 4 * hi + q4, 4 * eb + trc) + trb));
        f32x16 o = {};
        if (n > 0) {
#pragma unroll
            for (int sb = 0; sb < 2; ++sb) if (sb <= tb) {
                f32x16 X = {};
#pragma unroll
                for (int ds = 0; ds < 8; ++ds) { const bf16x8 A = *(const LAS bf16x8*)(lds + KI + ioff(32 * sb + r32, 2 * ds + hi)), B = *(const LAS bf16x8*)(lds + QD + ioff(32 * tb + r32, 2 * ds + hi));
                    X = __builtin_amdgcn_mfma_f32_32x32x16_bf16(A, B, X, 0, 0, 0); }
                if (sb == tb) {
#pragma unroll
                    for (int r = 0; r < 16; ++r) if (crow(r, hi) > r32) X[r] = 0.f; }
                o = __builtin_amdgcn_mfma_f32_32x32x16_bf16(vf[2 * sb], pack8(X, 0), o, 0, 0, 0);
                o = __builtin_amdgcn_mfma_f32_32x32x16_bf16(vf[2 * sb + 1], pack8(X, 8), o, 0, 0, 0);
            }
#pragma unroll
            for (int ds = 0; ds < 8; ++ds) { const bf16x8 A = cat(vtr(lds + SI + ioff(16 * ds + 8 * hi + q4, 4 * eb + trc) + trb), vtr(lds + SI + ioff(16 * ds + 8 * hi + 4 + q4, 4 * eb + trc) + trb));
                const bf16x8 B = *(const LAS bf16x8*)(lds + QD + ioff(32 * tb + r32, 2 * ds + hi));
                o = __builtin_amdgcn_mfma_f32_32x32x16_bf16(A, B, o, 0, 0, 0); }
            float ss = 0.f;
#pragma unroll
            for (int r = 0; r < 16; ++r) ss += o[r] * o[r];
            ss = pl_sum(ss);
            if (hi == 0) ssq[eb * 64 + 32 * tb + r32] = ss;
        }
#pragma unroll
        for (int ks = 0; ks < 4; ++ks) {
            const bf16x8 B0 = cat(vtr(lds + KI + ioff(16 * ks + 4 * hi + q4, 4 * (2 * tb) + trc) + trb), vtr(lds + KI + ioff(16 * ks + 8 + 4 * hi + q4, 4 * (2 * tb) + trc) + trb));
            const bf16x8 B1 = cat(vtr(lds + KI + ioff(16 * ks + 4 * hi + q4, 4 * (2 * tb + 1) + trc) + trb), vtr(lds + KI + ioff(16 * ks + 8 + 4 * hi + q4, 4 * (2 * tb + 1) + trc) + trb));
            acc0 = __builtin_amdgcn_mfma_f32_32x32x16_bf16(vf[ks], B0, acc0, 0, 0, 0); acc1 = __builtin_amdgcn_mfma_f32_32x32x16_bf16(vf[ks], B1, acc1, 0, 0, 0); }
        { const float d0 = dec[32 * (2 * tb) + r32], d1 = dec[32 * (2 * tb + 1) + r32];
#pragma unroll
          for (int r = 0; r < 16; ++r) { acc0[r] *= d0; acc1[r] *= d1; } }
        __syncthreads();
#pragma unroll
        for (int g = 0; g < 4; ++g) {
            *(LAS unsigned long long*)(lds + SI + ioff(32 * (2 * tb) + r32, 4 * eb + g) + 8 * hi) = (unsigned long long)pg8::cvt_pk_bf16(acc0[4 * g], acc0[4 * g + 1]) | ((unsigned long long)pg8::cvt_pk_bf16(acc0[4 * g + 2], acc0[4 * g + 3]) << 32);
            *(LAS unsigned long long*)(lds + SI + ioff(32 * (2 * tb + 1) + r32, 4 * eb + g) + 8 * hi) = (unsigned long long)pg8::cvt_pk_bf16(acc1[4 * g], acc1[4 * g + 1]) | ((unsigned long long)pg8::cvt_pk_bf16(acc1[4 * g + 2], acc1[4 * g + 3]) << 32); }
        if (n > 0) {
            const int t = 32 * tb + r32; const float tot = (ssq[t] + ssq[64 + t]) + (ssq[128 + t] + ssq[192 + t]);
            const float rstd = 1.f / sqrtf(tot * (1.f / 128.f) + EPS);
            const size_t row = (size_t)(b * SEQ + 64 * (n - 1) + t);
#pragma unroll
            for (int g = 0; g < 4; ++g) { const int e = 32 * eb + 8 * g + 4 * hi;
                const unsigned g01 = (unsigned)gw[g], g23 = (unsigned)(gw[g] >> 32);
                const f32x4 on = *(const GAS f32x4*)(onorm + e);
                const float y0 = o[4 * g] * rstd * on.x * sigmoidf_(bflo(g01)), y1 = o[4 * g + 1] * rstd * on.y * sigmoidf_(bfhi(g01)), y2 = o[4 * g + 2] * rstd * on.z * sigmoidf_(bflo(g23)), y3 = o[4 * g + 3] * rstd * on.w * sigmoidf_(bfhi(g23));
                const unsigned w0 = pg8::cvt_pk_bf16(y0, y1);
                const unsigned w1 = pg8::cvt_pk_bf16(y2, y3);
                *(GAS unsigned long long*)(YB + row * YP + h * 128 + e) = (unsigned long long)w0 | ((unsigned long long)w1 << 32); }
        }
    }
    __syncthreads();
}
}

#define PHASE_PTRS unsigned char* ws = (unsigned char*)ldp(lds, 20); \
    gu32* ctl = (gu32*)(ws + WS_CTL); \
    const float* x = (const float*)ldp(lds, 0); const float* meta = (const float*)ldp(lds, 1); const float* norm_mix = (const float*)ldp(lds, 2); const float* w_in = (const float*)ldp(lds, 3); \
    const float* q_norm = (const float*)ldp(lds, 4); const float* k_norm = (const float*)ldp(lds, 5); \
    const float* lq1 = (const float*)ldp(lds, 6); const float* lk1 = (const float*)ldp(lds, 7); const float* lq2 = (const float*)ldp(lds, 8); const float* lk2 = (const float*)ldp(lds, 9); \
    const float* subln = (const float*)ldp(lds, 10); const float* hg_lb = (const float*)ldp(lds, 11); const float* hg_onorm = (const float*)ldp(lds, 12); \
    const float* w_up_a = (const float*)ldp(lds, 13); const float* w_up_b = (const float*)ldp(lds, 14); const float* w_out = (const float*)ldp(lds, 15); const float* norm_mlp = (const float*)ldp(lds, 16); \
    const float* w_ff1 = (const float*)ldp(lds, 17); const float* w_ff2 = (const float*)ldp(lds, 18); \
    float* out = (float*)ldp(lds, 19); \
    bf16* Wt_in = (bf16*)(ws + WS_WIN); bf16* Wt_upa = (bf16*)(ws + WS_WUPA); bf16* Wt_upb = (bf16*)(ws + WS_WUPB); bf16* Wt_out = (bf16*)(ws + WS_WOUT); \
    bf16* Wt_ff1 = (bf16*)(ws + WS_WFF1); bf16* Wt_ff2 = (bf16*)(ws + WS_WFF2); \
    bf16* U = (bf16*)(ws + WS_U); bf16* Umeta = (bf16*)(ws + WS_UMETA); bf16* Pm = (bf16*)(ws + WS_PM); float* ROPE = (float*)(ws + WS_ROPE); \
    float* RSTD = (float*)(ws + WS_RSTD); float* SSQ = (float*)(ws + WS_SSQ); float* DEC = (float*)(ws + WS_DEC); bf16* P = (bf16*)(ws + WS_P); bf16* HID = (bf16*)(ws + WS_P); \
    unsigned char* Y8 = ws + WS_Y8; unsigned char* WUP8 = ws + WS_WUP8; float* SYR = (float*)(ws + WS_SY); float* SYB = SYR + MR; float* SWR = SYB + MR; float* SWB = SWR + DM; \
    unsigned char* U8 = ws + WS_U8; unsigned char* W8 = ws + WS_W8; float* SU = (float*)(ws + WS_SU); float* SW = (float*)(ws + WS_SW); bf16* YA = (bf16*)(ws + WS_YA); bf16* YB = YA + WHD;      bf16* MG = (bf16*)(ws + WS_MG);
__global__ void __launch_bounds__(NWAVES * 64, 2) mk_fwd(Ptrs args) {
    extern __shared__ __attribute__((aligned(16))) unsigned char lds_raw[];
    LAS unsigned char* lds = (LAS unsigned char*)lds_raw;
    volatile LAS unsigned* MISC = (volatile LAS unsigned*)(lds + LDSCTL_OFF);
    const int G = gridDim.x, bx = blockIdx.x;
    const int vcu = (G % 8 == 0) ? (bx % 8) * (G / 8) + bx / 8 : bx;

    { PHASE_IDS
    for (int u = tid; u < (LDS_BYTES - LDSCTL_OFF) / 4; u += NWAVES * 64) ((LAS unsigned*)(lds + LDSCTL_OFF))[u] = 0u;
    __syncthreads();
    if (tid == 0) {
#pragma unroll
        for (int k = 0; k < 21; ++k) { const unsigned long long pv_ = (k < 19) ? (unsigned long long)args.in[k < 19 ? k : 0] : (k == 19 ? (unsigned long long)args.out : (unsigned long long)args.ws);
            MISC[32 + 2 * k] = (unsigned)pv_; MISC[33 + 2 * k] = (unsigned)(pv_ >> 32); } } }
    __syncthreads();
    XcdBarrier bar = xcd_barrier_post((unsigned*)((gu32*)args.ws + CW_BAR), MISC + 8);
    { PHASE_IDS PHASE_PTRS
    if (wave == 0) {
        const float s1 = wave_sum(lq1[lane] * lk1[lane]), s2 = wave_sum(lq2[lane] * lk2[lane]);
        if (lane == 0) ((LAS float*)(lds + LDSCTL_OFF))[16] = expf(s1) - expf(s2) + LAM_INIT;
        const float wqm = wave_max(fabsf(q_norm[lane])), wkm = wave_max(fabsf(k_norm[lane]));
        if (lane == 0) ((LAS float*)(lds + LDSCTL_OFF))[17] = fmaxf(0.f, 64.f * C2 * wqm * wkm - 64.f);
    } }
    __syncthreads();

    { PHASE_IDS PHASE_PTRS
        LAS float* scr = (LAS float*)(lds + wave * 16384);
        const int gw = vcu * NWAVES + wave, NGW = G * NWAVES;
        constexpr int I_QK = (DM / 64) * (NIN / 32);
        for (int it = gw; it < I_QK; it += NGW) p0_transpose_item<true>(w_in, DM, NIN, Wt_in, scr, it, lane, 0, 0, ctl + CW_SWMAX);
        for (int m = gw; m < MR + NMETA; m += NGW) {
            if (m < MR) rms_row_to_bf16(x + (size_t)m * DM, norm_mix, nullptr, lane, U8 + (size_t)m * DM, SU + m);
            else rms_row_to_bf16(meta + (size_t)(m - MR) * DM, norm_mix, Umeta + (size_t)(m - MR) * DM, lane);
        }
        const int gt = tid * G + bx;
        if (gt < TT * 8) {
            const int pos = gt >> 3, j = gt & 7;
            const float invf[8] = {1.0f, 0.1939227432012558f, 0.03760603070259094f, 0.007292664609849453f, 0.0014142135623842478f, 0.00027424818836152554f, 5.3182957344688475e-05f, 1.0313385246263351e-05f};
            float inv = invf[0];
#pragma unroll
            for (int q = 1; q < 8; ++q) inv = (j == q) ? invf[q] : inv;
            const float ang = (float)pos * inv; float sn, cs; sincos_d((double)ang, sn, cs);
            ROPE[pos * 16 + j] = cs; ROPE[pos * 16 + 8 + j] = sn;
        }
    }
    xcd_barrier(bar);

    { PHASE_IDS PHASE_PTRS
        const int gw = vcu * NWAVES + wave, NGW = G * NWAVES;
        for (int r = gw; r < NIN; r += NGW) {
            const float cmax = __uint_as_float(__hip_atomic_load(ctl + CW_SWMAX + r, RLX_AGENT)), inv = cmax > 0.f ? 127.f / cmax : 0.f;
            const GAS v4u* rp = (const GAS v4u*)(Wt_in + (size_t)r * DM) + lane; v4u q[8];
#pragma unroll
            for (int j = 0; j < 8; ++j) q[j] = __builtin_nontemporal_load(rp + 64 * j);
            GAS unsigned long long* op = (GAS unsigned long long*)(W8 + (size_t)r * DM) + lane;
#pragma unroll
            for (int j = 0; j < 8; ++j) op[64 * j] = (unsigned long long)pk4_i8(bflo(q[j].x) * inv, bfhi(q[j].x) * inv, bflo(q[j].y) * inv, bfhi(q[j].y) * inv) | ((unsigned long long)pk4_i8(bflo(q[j].z) * inv, bfhi(q[j].z) * inv, bflo(q[j].w) * inv, bfhi(q[j].w) * inv) << 32);
            if (lane == 0) SW[r] = cmax * (1.f / 127.f);
        }
    }
    xcd_barrier(bar);

    { PHASE_IDS PHASE_PTRS
        { constexpr int UPB = DM * 2 + 16, PART = 16 * UPB;
          for (int i = tid; i < NMETA * DM * 2 / 16; i += NWAVES * 64) { const int r = i >> 9, cch = i & 511; *(LAS v4u*)(lds + r * UPB + cch * 16) = ((const GAS v4u*)Umeta)[i]; }
          __syncthreads();
          const int tsel = wave >> 2, kq = wave & 3, fr = lane & 15, fq = lane >> 4;
#pragma unroll 1
          for (int cb = vcu * 32; cb < 8192; cb += G * 32) {
              const int ci = cb + tsel * 16 + fr; const int c = (ci < 4096) ? (C_K + ci) : (C_HF + (ci - 4096));
              const bf16* wrow = Wt_in + (size_t)wt_row(c) * DM + kq * 1024 + fq * 8;
              LAS const unsigned char* arow = lds + fr * UPB + (kq * 1024 + fq * 8) * 2;
              f32x4 acc = {0.f, 0.f, 0.f, 0.f};
#pragma unroll 1
              for (int kb = 0; kb < 32; kb += 8) {
                  bf16x8 bfr[8];
#pragma unroll
                  for (int i = 0; i < 8; ++i) bfr[i] = *(const GAS bf16x8*)(wrow + (kb + i) * 32);
#pragma unroll
                  for (int i = 0; i < 8; ++i) { const bf16x8 afr = *(LAS const bf16x8*)(arow + (kb + i) * 64); acc = __builtin_amdgcn_mfma_f32_16x16x32_bf16(afr, bfr[i], acc, 0, 0, 0); }
              }
              *(LAS f32x4*)(lds + PART + (wave * 64 + lane) * 16) = acc;
              __syncthreads();
              if (kq == 0) { f32x4 s = acc;
#pragma unroll
                  for (int q = 1; q < 4; ++q) { const f32x4 t = *(LAS const f32x4*)(lds + PART + ((wave + q) * 64 + lane) * 16); s = s + t; }
#pragma unroll
                  for (int reg = 0; reg < 4; ++reg) Pm[(size_t)(4 * fq + reg) * NIN + c] = (bf16)f2bf(s[reg]); }
              __syncthreads();
          }
        }
        { pg8::Gemm g{(const bf16*)U8, (const bf16*)W8, MR, NQK, DM / 2}; pg8::StaticOrder S; S.init(MR, NQK, G, bx);
          EpiProjT<true> E{P, q_norm, k_norm, ROPE, hg_lb, DEC, 0, 1.f, SU, SW};
          pg8::gemm_phase<EpiProjT<true>, pg8::StaticOrder, true, true, false, true>(lds, g, S, E); }
        __syncthreads();
        { pg8::Gemm g{(const bf16*)U8, (const bf16*)(W8 + (size_t)NQK * DM), MR, NIN - NQK, DM / 2}; pg8::StaticOrder S; S.init(MR, NIN - NQK, G, bx);
          EpiProjT<false> E{P, q_norm, k_norm, ROPE, hg_lb, DEC, NQK / 256, 1.f, SU, SW};
          pg8::gemm_phase<EpiProjT<false>, pg8::StaticOrder, true, true, false, true>(lds, g, S, E); }
    }
    xcd_barrier(bar);


    { PHASE_IDS PHASE_PTRS
        { const int nconv = (G > 2 * NCONV) ? NCONV : G, cv = bx - (G - nconv);
          if (cv >= 0) {
              LAS unsigned* scr = (LAS unsigned*)(lds + wave * TSCR_BYTES);
#pragma unroll 1
              for (int it = cv * NWAVES + wave; it < TI_ALL; it += nconv * NWAVES) { const TItem t = t_decode(lds, it); t_convert(t, scr, lane); }
              __syncthreads();
          } }
        gu32* qh_h = ctl + CW_QHEAD; gu32* qh_a = ctl + CW_QHEAD + 64; const float lam = ((volatile LAS float*)(lds + LDSCTL_OFF))[16], mfix = ((volatile LAS float*)(lds + LDSCTL_OFF))[17];
#pragma unroll 1
        for (;;) {
            if (tid == 0) MISC[20] = __hip_atomic_fetch_add(qh_h, 1u, RLX_AGENT);
            __syncthreads();
            const int it = (int)MISC[20];
            __syncthreads();
            if (it >= 64) break;
            hg::unit(lds, P, Pm, YB, DEC, hg_onorm, hg_lb, it >> 4, it & 15, tid, wave, lane);
        }
#pragma unroll 1
        for (;;) {
            if (tid == 0) MISC[20] = __hip_atomic_fetch_add(qh_a, 1u, RLX_AGENT);
            __syncthreads();
            const int u = (int)MISC[20];
            __syncthreads();
            if (u >= NB * NH * 16) break;
            const int qb = 15 - (u >> 6), bh = u & 63;
            da::unit(lds, P, Pm, YA, subln, k_norm, ROPE, lam, mfix, bh >> 4, bh & 15, qb, tid, wave, lane);
        }
    }
    xcd_barrier(bar);

    { PHASE_IDS PHASE_PTRS
        const int gw = vcu * NWAVES + wave, NGW = G * NWAVES, NR = MR + DM;
        auto ldrow = [&](v4u (&q)[8], int r) {
            const bool isy = r < MR; const int rr = isy ? r : r - MR;
            const GAS v4u* rp = (const GAS v4u*)((isy ? YA : Wt_upa) + (size_t)rr * YP) + lane;
#pragma unroll
            for (int j = 0; j < 8; ++j) q[j] = rp[64 * j]; };
        auto dorow = [&](const v4u (&q)[8], int r) {
            const bool isy = r < MR; const int rr = isy ? r : r - MR;
            unsigned ma_ = 0u, mb_ = 0u;
#pragma unroll
            for (int j = 0; j < 8; ++j)
#pragma unroll
                for (int e = 0; e < 4; ++e) { const unsigned w = q[j][e]; const unsigned hi_ = w & 0x7fff0000u, lo_ = (w << 16) & 0x7fff0000u; const unsigned mx = hi_ > lo_ ? hi_ : lo_;
                    if (j < 4) ma_ = ma_ > mx ? ma_ : mx; else mb_ = mb_ > mx ? mb_ : mx; }
            const float ma = wave_max(__uint_as_float(ma_)), mb = wave_max(__uint_as_float(mb_));
            const float sa = ma > 0.f ? ma * (1.f / 127.f) : 1.f, sb = mb > 0.f ? mb * (1.f / 127.f) : 1.f, ia = ma > 0.f ? 127.f / ma : 0.f, ib = mb > 0.f ? 127.f / mb : 0.f;
            GAS unsigned long long* op = (GAS unsigned long long*)((isy ? Y8 : WUP8) + (size_t)rr * YP) + lane;
#pragma unroll
            for (int j = 0; j < 8; ++j) { const float inv = j < 4 ? ia : ib;
                op[64 * j] = (unsigned long long)pk4_i8(bflo(q[j].x) * inv, bfhi(q[j].x) * inv, bflo(q[j].y) * inv, bfhi(q[j].y) * inv) | ((unsigned long long)pk4_i8(bflo(q[j].z) * inv, bfhi(q[j].z) * inv, bflo(q[j].w) * inv, bfhi(q[j].w) * inv) << 32); }
            if (lane == 0) { (isy ? SYR : SWR)[rr] = sa / sb; (isy ? SYB : SWB)[rr] = sb; } };
        int r = gw;
        if (r < NR) {
            v4u qa[8], qb[8]; ldrow(qa, r);
#pragma unroll 1
            for (;;) {
                const int r1 = r + NGW; ldrow(qb, r1 < NR ? r1 : r);
                dorow(qa, r);
                if (r1 >= NR) break;
                const int r2 = r1 + NGW; ldrow(qa, r2 < NR ? r2 : r1);
                dorow(qb, r1);
                if (r2 >= NR) break;
                r = r2;
            }
        }
    }
    xcd_barrier(bar);
    { PHASE_IDS PHASE_PTRS
        pg8::Gemm g{(const bf16*)Y8, (const bf16*)WUP8, MR, DM, YP / 2}; HalfOrder8 S; S.init(MR, DM, G, bx); EpiUp8 E{P, MG, SYR, SYB, SWR, SWB};
        pg8::gemm_phase<EpiUp8, HalfOrder8, true, true, false, true>(lds, g, S, E);
    }
    xcd_barrier(bar);

    { PHASE_IDS PHASE_PTRS
        pg8::Gemm g{MG, Wt_out, MR, DM, DM}; pg8::StaticOrder S; S.init(MR, DM, G, bx); EpiOut E{x, U, SSQ};
        pg8::gemm_phase<EpiOut, pg8::StaticOrder, true, true>(lds, g, S, E);
    }
    xcd_barrier(bar);

    { PHASE_IDS PHASE_PTRS
        { const int gt = bx * (NWAVES * 64) + tid;
          for (int row = gt; row < MR; row += G * NWAVES * 64) { float s = 0.f;
#pragma unroll
              for (int i = 0; i < 16; ++i) { const f32x4 v = *(const GAS f32x4*)(SSQ + (size_t)row * 64 + i * 4); s += (v.x + v.y) + (v.z + v.w); }
              RSTD[row] = 1.f / sqrtf(s * (1.f / DM) + EPS); } }
        pg8::Gemm g{U, Wt_ff1, MR, DFF, DM}; pg8::StaticOrder S; S.init(MR, DFF, G, bx); EpiFf1 E{HID};
        pg8::gemm_phase<EpiFf1, pg8::StaticOrder, true, true>(lds, g, S, E);
    }
    xcd_barrier(bar);

    { PHASE_IDS PHASE_PTRS
        pg8::Gemm g{HID, Wt_ff2, MR, DM, DFF}; pg8::StaticOrder S; S.init(MR, DM, G, bx); EpiFf2 E{out, RSTD, U};
        pg8::gemm_phase<EpiFf2, pg8::StaticOrder, true, true>(lds, g, S, E);
    }
}

extern "C" void kernel_launch(void* const* d_in, const int* in_sizes, int n_in, void* d_out, int out_size, void* d_ws, size_t ws_size, hipStream_t stream) {
    static int grid = 0;
    if (grid == 0) {
        if (n_in != 19 || out_size != MR * DM || ws_size < WS_END) { fprintf(stderr, "kernel_launch: unexpected shapes (n_in %d out %d ws %zu)\n", n_in, out_size, ws_size); grid = -1; return; }
        int dev = 0, cus = 0, per_cu = 0;
        if (hipGetDevice(&dev) != hipSuccess || hipDeviceGetAttribute(&cus, hipDeviceAttributeMultiprocessorCount, dev) != hipSuccess) { grid = -1; return; }
        if (hipFuncSetAttribute((const void*)mk_fwd, hipFuncAttributeMaxDynamicSharedMemorySize, LDS_BYTES) != hipSuccess) { fprintf(stderr, "kernel_launch: hipFuncSetAttribute failed\n"); grid = -1; return; }
        if (hipOccupancyMaxActiveBlocksPerMultiprocessor(&per_cu, (const void*)mk_fwd, NWAVES * 64, LDS_BYTES) != hipSuccess || per_cu < 1) { fprintf(stderr, "kernel_launch: occupancy query says %d\n", per_cu); }
        (void)hipGetLastError();
        grid = cus;
    }
    if (grid < 0) return;
    if (hipMemsetAsync((char*)d_ws + WS_CTL, 0, CTL_ZERO_BYTES, stream) != hipSuccess) return;
    Ptrs a{};
    for (int i = 0; i < 19; ++i) a.in[i] = (const float*)d_in[i];
    a.out = (float*)d_out; a.ws = (unsigned char*)d_ws;
    hipLaunchKernelGGL(mk_fwd, dim3(grid), dim3(NWAVES * 64), LDS_BYTES, stream, a);
}
```

```cpp
#include <hip/hip_runtime.h>
#include <cstdio>
#include <cstdint>
namespace pg8 {
#define PG8_LAS __attribute__((address_space(3)))
typedef unsigned short bf16_t;
typedef short bf16x8 __attribute__((ext_vector_type(8)));
typedef float f32x4 __attribute__((ext_vector_type(4)));
typedef unsigned u32x4 __attribute__((ext_vector_type(4)));
typedef int i32x4_ __attribute__((ext_vector_type(4)));
typedef int i32x8_ __attribute__((ext_vector_type(8)));
template <bool FP8> struct Frag;
template <> struct Frag<false> { bf16x8 v[2]; __device__ __forceinline__ void set(int k, bf16x8 x) { v[k] = x; } };
template <> struct Frag<true>  { i32x8_ w;    __device__ __forceinline__ void set(int k, bf16x8 x) { if (k == 0) w.lo = __builtin_bit_cast(i32x4_, x); else w.hi = __builtin_bit_cast(i32x4_, x); } };
constexpr int BM = 256, BK = 64, HALF = 128, HTB = HALF * BK * 2  , STAGE_BYTES = 8 * HTB, NXCD = 8, WGM = 8;

__host__ __device__ __forceinline__ int lds_byte(int r, int c) { const int st = (r >> 4) * 2 + (c >> 5), rr = r & 15, cc = c & 31, ob = rr * 64 + cc * 2; return st * 1024 + (ob ^ (((ob >> 9) & 1) << 5)); }
__host__ __device__ __forceinline__ void stage_rc(int b, int& R, int& C) { const int st = b / 1024, sb = b % 1024, swz = sb ^ (((sb >> 9) & 1) << 5); R = (st >> 1) * 16 + swz / 64; C = (st & 1) * 32 + (swz % 64) / 2; }
__host__ __device__ __forceinline__ int perm32(int rho) { const int n = rho >> 4, i = rho & 15; return 8 * (i >> 2) + 4 * n + (i & 3); }

struct Unit { int pm, pn; };
struct Gemm { const bf16_t* A; const bf16_t* Bt; int M, N, K; };

struct StaticOrder {
    int nM, nN, nwg, G, c;
    __host__ __device__ void init(int M, int N, int G_, int c_) { nM = M / BM; nN = N / BM; nwg = nM * nN; G = G_; c = c_; }
    __host__ __device__ bool next(int i, Unit& u) const {
        const long L = (long)i * G + c; if (L >= nwg) return false;
        int wgid = (int)L; { const int q = nwg / NXCD, r = nwg % NXCD, xcd = wgid % NXCD, off = wgid / NXCD; wgid = (xcd < r ? xcd * (q + 1) : r * (q + 1) + (xcd - r) * q) + off; }
        const int nig = WGM * nN, gid = wgid / nig, fm = gid * WGM, gsz = (nM - fm) < WGM ? (nM - fm) : WGM;
        u.pm = fm + ((wgid % nig) % gsz); u.pn = (wgid % nig) / gsz; return true;
    }
    __device__ __forceinline__ void a_ready(const Unit&) const {}
    __device__ __forceinline__ void done(const Unit&) const {}
    static constexpr int KLOOP = 0;
    __device__ __forceinline__ size_t kofs(const Unit&) const { return 0; }
    __device__ __forceinline__ bool zero_after(const Unit&) const { return true; }
};

__device__ __forceinline__ unsigned cvt_pk_bf16(float lo, float hi) { unsigned r; asm volatile("v_cvt_pk_bf16_f32 %0, %1, %2" : "=v"(r) : "v"(lo), "v"(hi)); return r; }
typedef float f32x2 __attribute__((ext_vector_type(2)));
__device__ __forceinline__ void mfma_f8(f32x4& acc, const i32x8_& a, const i32x8_& b, int sc) {
    asm volatile("v_mfma_scale_f32_16x16x128_f8f6f4 %0, %1, %2, %0, %3, %3 op_sel_hi:[0,0,0]" : "+v"(acc) : "v"(a), "v"(b), "v"(sc));
}
template <class Epi, class Sched, bool ALIGN_EPI = false, bool SP2 = false, bool FP8 = false, bool I8 = false>
__device__ __forceinline__ void gemm_phase(PG8_LAS unsigned char* lds, const Gemm g, const Sched& S, const Epi& E) {
    int tid_ = threadIdx.x; asm volatile("" : "+v"(tid_));
    const int tid = tid_, wid = __builtin_amdgcn_readfirstlane(tid >> 6), lane = tid & 63, wr = wid >> 2, wc = wid & 3, fr = lane & 15, fq = lane >> 4;
    int one_scale = 0x7f7f7f7f; asm volatile("" : "+v"(one_scale));      (void)one_scale;
    const int K = g.K, nt = (Sched::KLOOP ? Sched::KLOOP : K) / BK;
    unsigned voffA[2], voffB[2];
#pragma unroll
    for (int i = 0; i < 2; ++i) { int R, C; stage_rc(tid * 16 + i * 8192, R, C); const int Rb = Epi::PERM ? ((R & ~31) + perm32(R & 31)) : R;
        if (FP8) { const int q8 = C >> 3; C = (2 * (q8 & 3) + (q8 >> 2)) * 8; }
        voffA[i] = (unsigned)(R * K + C) * 2u; voffB[i] = (unsigned)(Rb * K + C) * 2u; }
    const size_t kstep = (size_t)(BK * 2);
    const size_t hstep = (size_t)HALF * K * 2;
    const size_t tstep = 2 * hstep;
    const unsigned ldsw = (unsigned)wid * 1024u;
    const int aoff = lds_byte(wr * 64 + fr, fq * 8), boff = lds_byte(wc * 32 + fr, fq * 8);
#define PG8_SA(b, h) (((b) * 2 + (h)) * HTB)
#define PG8_SB(b, h) ((4 + (b) * 2 + (h)) * HTB)
#define PG8_STAGE(bufoff, gbase, voff) do { _Pragma("unroll") for (int _i = 0; _i < 2; ++_i) \
        __builtin_amdgcn_global_load_lds((const unsigned*)((const char*)(gbase) + (voff)[_i]), (PG8_LAS unsigned*)(lds + (bufoff) + ldsw + _i * 8192), 16, 0, 0); } while (0)
#define PG8_LDA(dst, b, h) do { _Pragma("unroll") for (int m = 0; m < 4; ++m) _Pragma("unroll") for (int k = 0; k < 2; ++k) dst[m].set(k, *(const PG8_LAS bf16x8*)(lds + PG8_SA(b, h) + aoff + m * 2048 + k * 1024)); } while (0)
#define PG8_LDB(dst, b, h) do { _Pragma("unroll") for (int n = 0; n < 2; ++n) _Pragma("unroll") for (int k = 0; k < 2; ++k) dst[n].set(k, *(const PG8_LAS bf16x8*)(lds + PG8_SB(b, h) + boff + n * 2048 + k * 1024)); } while (0)
#define PG8_MMA(ai, bj, At, Bt) do { __builtin_amdgcn_s_setprio(1); _Pragma("unroll") for (int m = 0; m < 4; ++m) _Pragma("unroll") for (int n = 0; n < 2; ++n) { \
        if constexpr (FP8) mfma_f8(acc[ai][bj][m][n], Bt[n].w, At[m].w, one_scale); \
        else if constexpr (I8) { _Pragma("unroll") for (int k = 0; k < 2; ++k) acc[ai][bj][m][n] = __builtin_bit_cast(f32x4, __builtin_amdgcn_mfma_i32_16x16x64_i8(__builtin_bit_cast(i32x4_, Bt[n].v[k]), __builtin_bit_cast(i32x4_, At[m].v[k]), __builtin_bit_cast(i32x4_, acc[ai][bj][m][n]), 0, 0, 0)); } \
        else { _Pragma("unroll") for (int k = 0; k < 2; ++k) acc[ai][bj][m][n] = __builtin_amdgcn_mfma_f32_16x16x32_bf16(Bt[n].v[k], At[m].v[k], acc[ai][bj][m][n], 0, 0, 0); } } \
        if constexpr (FP8) asm volatile("s_nop 15" ::: "memory");     \
        __builtin_amdgcn_s_setprio(0); } while (0)
#define PG8_WAIT_V(n) asm volatile("s_waitcnt vmcnt(" #n ")" ::: "memory")
#define PG8_WAIT_L(n) asm volatile("s_waitcnt lgkmcnt(" #n ")" ::: "memory")
#define PG8_BAR __builtin_amdgcn_s_barrier()
#define PG8_SCHED __builtin_amdgcn_sched_barrier(0)
    Unit cur, nxt; int ui = 0;
    if (!S.next(0, cur)) return;
    f32x4 acc[2][2][4][2];
    if constexpr (Epi::INIT) E.init(acc, cur, wr, wc, fr, fq);
    else {
#pragma unroll
    for (int a = 0; a < 2; ++a)
#pragma unroll
        for (int b = 0; b < 2; ++b)
#pragma unroll
            for (int m = 0; m < 4; ++m)
#pragma unroll
                for (int n = 0; n < 2; ++n) acc[a][b][m][n] = (f32x4){0.f, 0.f, 0.f, 0.f};
    }
    Frag<FP8> At[4], B0[2], B1[2];
    const char* cA = (const char*)g.A + (size_t)cur.pm * tstep + S.kofs(cur); const char* cB = (const char*)g.Bt + (size_t)(cur.pn & 0xffff) * tstep + S.kofs(cur);
    S.a_ready(cur);
    if constexpr (SP2) {
        PG8_STAGE(PG8_SB(0, 0), cB, voffB); PG8_STAGE(PG8_SB(0, 1), cB + hstep, voffB); PG8_STAGE(PG8_SA(0, 0), cA, voffA); PG8_STAGE(PG8_SA(0, 1), cA + hstep, voffA);
        if (wr == 1) PG8_BAR;
        PG8_WAIT_V(2); PG8_BAR;
        PG8_STAGE(PG8_SB(1, 0), cB + kstep, voffB); PG8_STAGE(PG8_SA(1, 0), cA + kstep, voffA); PG8_STAGE(PG8_SB(1, 1), cB + hstep + kstep, voffB);
        PG8_WAIT_V(6); PG8_BAR;
    } else {
        PG8_STAGE(PG8_SB(0, 0), cB, voffB); PG8_STAGE(PG8_SA(0, 0), cA, voffA); PG8_STAGE(PG8_SB(0, 1), cB + hstep, voffB); PG8_STAGE(PG8_SA(0, 1), cA + hstep, voffA);
        if (wr == 1) PG8_BAR;
        PG8_WAIT_V(4); PG8_BAR;
        PG8_STAGE(PG8_SB(1, 0), cB + kstep, voffB); PG8_STAGE(PG8_SA(1, 0), cA + kstep, voffA); PG8_STAGE(PG8_SB(1, 1), cB + hstep + kstep, voffB);
        PG8_WAIT_V(6); PG8_BAR;
    }
    for (;;) {
        const bool has_next = S.next(ui + 1, nxt);
        const char* nA = has_next ? (const char*)g.A + (size_t)nxt.pm * tstep + S.kofs(nxt) : cA; const char* nB = has_next ? (const char*)g.Bt + (size_t)(nxt.pn & 0xffff) * tstep + S.kofs(nxt) : cB;
        for (int t = 0; t < nt; t += 2) {
            const bool last = (t == nt - 2);
            const char* a1 = cA + (size_t)(t + 1) * kstep;
            const char* a2 = last ? nA : cA + (size_t)(t + 2) * kstep; const char* b2 = last ? nB : cB + (size_t)(t + 2) * kstep;
            const char* a3 = a2 + kstep; const char* b3 = b2 + kstep;
            if (last && has_next) S.a_ready(nxt);
            if constexpr (SP2) {
            PG8_LDB(B0, 0, 0); PG8_LDB(B1, 0, 1); PG8_SCHED; PG8_LDA(At, 0, 0); PG8_STAGE(PG8_SA(1, 1), a1 + hstep, voffA);
            PG8_WAIT_V(8); PG8_WAIT_L(0); PG8_BAR; PG8_MMA(0, 0, At, B0); PG8_MMA(0, 1, At, B1); PG8_BAR; PG8_SCHED;
            PG8_LDA(At, 0, 1); PG8_STAGE(PG8_SB(0, 0), b2, voffB); PG8_STAGE(PG8_SB(0, 1), b2 + hstep, voffB); PG8_STAGE(PG8_SA(0, 0), a2, voffA);
            PG8_WAIT_V(8); PG8_WAIT_L(0); PG8_BAR; PG8_MMA(1, 0, At, B0); PG8_MMA(1, 1, At, B1); PG8_BAR; PG8_SCHED;
            PG8_LDB(B0, 1, 0); PG8_LDB(B1, 1, 1); PG8_SCHED; PG8_LDA(At, 1, 0); PG8_STAGE(PG8_SA(0, 1), a2 + hstep, voffA);
            PG8_WAIT_V(8); PG8_WAIT_L(0); PG8_BAR; PG8_MMA(0, 0, At, B0); PG8_MMA(0, 1, At, B1); PG8_BAR; PG8_SCHED;
            PG8_LDA(At, 1, 1); PG8_STAGE(PG8_SB(1, 0), b3, voffB); PG8_STAGE(PG8_SB(1, 1), b3 + hstep, voffB); PG8_STAGE(PG8_SA(1, 0), a3, voffA);
            PG8_WAIT_V(8); PG8_WAIT_L(0); PG8_BAR; PG8_MMA(1, 0, At, B0); PG8_MMA(1, 1, At, B1); PG8_BAR; PG8_SCHED;
            } else {
            PG8_LDB(B0, 0, 0); PG8_SCHED; PG8_LDA(At, 0, 0); PG8_STAGE(PG8_SA(1, 1), a1 + hstep, voffA);
            PG8_WAIT_L(8); PG8_BAR; PG8_WAIT_L(0); PG8_MMA(0, 0, At, B0); PG8_BAR; PG8_SCHED;
            PG8_LDB(B1, 0, 1); PG8_STAGE(PG8_SB(0, 0), b2, voffB);
            PG8_BAR; PG8_WAIT_L(0); PG8_MMA(0, 1, At, B1); PG8_BAR;
            PG8_LDA(At, 0, 1); PG8_STAGE(PG8_SA(0, 0), a2, voffA);
            PG8_BAR; PG8_WAIT_L(0); PG8_MMA(1, 0, At, B0); PG8_BAR; PG8_SCHED;
            PG8_STAGE(PG8_SB(0, 1), b2 + hstep, voffB);
            PG8_WAIT_V(6); PG8_BAR; PG8_MMA(1, 1, At, B1); PG8_BAR;
            PG8_LDB(B0, 1, 0); PG8_SCHED; PG8_LDA(At, 1, 0); PG8_STAGE(PG8_SA(0, 1), a2 + hstep, voffA);
            PG8_WAIT_L(8); PG8_BAR; PG8_WAIT_L(0); PG8_MMA(0, 0, At, B0); PG8_BAR; PG8_SCHED;
            PG8_LDB(B1, 1, 1); PG8_STAGE(PG8_SB(1, 0), b3, voffB);
            PG8_BAR; PG8_WAIT_L(0); PG8_MMA(0, 1, At, B1); PG8_BAR;
            PG8_LDA(At, 1, 1); PG8_STAGE(PG8_SA(1, 0), a3, voffA);
            PG8_BAR; PG8_WAIT_L(0); PG8_MMA(1, 0, At, B0); PG8_BAR; PG8_SCHED;
            PG8_STAGE(PG8_SB(1, 1), b3 + hstep, voffB);
            PG8_WAIT_V(6); PG8_BAR; PG8_MMA(1, 1, At, B1); PG8_BAR;
            }
        }
        if constexpr (ALIGN_EPI) { if (wr == 0) PG8_BAR; }
        if constexpr (FP8) asm volatile("s_nop 15\n\ts_nop 15" ::: "memory");
        if constexpr (!Epi::AFTER_DRAIN) { E(acc, cur, wr, wc, fr, fq); S.done(cur); }
        if (!has_next) break;
        if constexpr (Epi::INIT) E.init(acc, nxt, wr, wc, fr, fq);
        else if (S.zero_after(cur)) {
#pragma unroll
        for (int a = 0; a < 2; ++a)
#pragma unroll
            for (int b = 0; b < 2; ++b)
#pragma unroll
                for (int m = 0; m < 4; ++m)
#pragma unroll
                    for (int n = 0; n < 2; ++n) acc[a][b][m][n] = (f32x4){0.f, 0.f, 0.f, 0.f};
        }
        cur = nxt; cA = nA; cB = nB; ++ui;
        if constexpr (ALIGN_EPI) { if (wr == 1) PG8_BAR; }
    }
    PG8_WAIT_V(0);
    if constexpr (!ALIGN_EPI) { if (wr == 0) PG8_BAR; }
    PG8_BAR;
    if constexpr (Epi::AFTER_DRAIN) { E.fused(acc, cur, wr, wc, fr, fq, lds, wid, lane); S.done(cur); }
#undef PG8_SA
#undef PG8_SB
#undef PG8_STAGE
#undef PG8_LDA
#undef PG8_LDB
#undef PG8_MMA
#undef PG8_WAIT_V
#undef PG8_WAIT_L
#undef PG8_BAR
#undef PG8_SCHED
}
}
#define GAS __attribute__((address_space(1)))
#define LAS __attribute__((address_space(3)))
typedef unsigned short bf16;
typedef unsigned v4u __attribute__((ext_vector_type(4)));
typedef float f32x4 __attribute__((ext_vector_type(4)));
typedef short bf16x8 __attribute__((ext_vector_type(8)));
typedef GAS unsigned gu32;
typedef GAS unsigned long long gu64;
#define RLX_AGENT __ATOMIC_RELAXED, __HIP_MEMORY_SCOPE_AGENT
#define LDS_WAIT() asm volatile("s_waitcnt lgkmcnt(0)" ::: "memory")
#define VM_WAIT() asm volatile("s_waitcnt vmcnt(0)" ::: "memory")
__device__ __forceinline__ unsigned long long rt() { return __builtin_amdgcn_s_memrealtime(); }
__device__ __forceinline__ unsigned f2bf(float f) { unsigned u = __builtin_bit_cast(unsigned, f); return (u + 0x7fffu + ((u >> 16) & 1u)) >> 16; }
__device__ __forceinline__ unsigned pk2(float lo, float hi) { return f2bf(lo) | (f2bf(hi) << 16); }
#define XB_TMO      128
#define XB_XCNT(j)  (256  + 64 * (j))
#define XB_XSUB(j)  (1280 + 64 * (j))
#define XB_XGEN(j)  (2304 + 64 * (j))
#define XB_TOP      3328
#define XB_TOPGEN   3392
#define XCD_BAR_WORDS 3456
#define XB_SPIN_CAP (1u << 22)

__device__ __forceinline__ unsigned xb_ld(unsigned* p)              { return __hip_atomic_load(p, __ATOMIC_RELAXED, __HIP_MEMORY_SCOPE_AGENT); }
__device__ __forceinline__ unsigned xb_add(unsigned* p, unsigned v) { return __hip_atomic_fetch_add(p, v, __ATOMIC_RELAXED, __HIP_MEMORY_SCOPE_AGENT); }
__device__ __forceinline__ unsigned xb_xcc_id() { return (unsigned)__builtin_amdgcn_s_getreg((3 << 11) | 20) & 0xFu; }
#define XB_SPIN(cond, bar) do { unsigned _sp = 0; while (cond) { __builtin_amdgcn_s_sleep(1); \
    if ((++_sp & 255u) == 0u) { if (xb_ld(&(bar)[XB_TMO])) break; if (_sp > XB_SPIN_CAP) { atomicAdd(&(bar)[XB_TMO], 1u); break; } } } } while (0)

struct XcdBarrier {
    unsigned* bar; unsigned x;
    volatile LAS unsigned* st;
};

__device__ __forceinline__ XcdBarrier xcd_barrier_post(unsigned* bar, volatile LAS unsigned* st) {
    XcdBarrier b; b.bar = bar; b.x = xb_xcc_id(); b.st = st;
    if (threadIdx.x == 0) (void)xb_add(&bar[XB_XCNT(b.x)], 1u);
    return b;
}
__device__ __forceinline__ void xcd_barrier_complete(unsigned* bar, unsigned x, unsigned& nloc, unsigned& nx) {
    const unsigned G = gridDim.x * gridDim.y * gridDim.z;
    unsigned sum, cnt, mine, sp = 0u;
    for (;;) {
        sum = 0u; cnt = 0u; mine = 0u;
#pragma unroll
        for (unsigned j = 0; j < 16; ++j) { const unsigned c = xb_ld(&bar[XB_XCNT(j)]); sum += c; cnt += (c > 0u) ? 1u : 0u; mine = (j == x) ? c : mine; }
        if (sum == G) break;
        __builtin_amdgcn_s_sleep(1);
        if ((++sp & 255u) == 0u) { if (xb_ld(&bar[XB_TMO])) break; if (sp > XB_SPIN_CAP) { atomicAdd(&bar[XB_TMO], 1u); break; } }
    }
    nloc = mine > 0u ? mine : 1u; nx = cnt > 0u ? cnt : 1u;
}

__device__ __forceinline__ void xcd_barrier(const XcdBarrier& b) {
    asm volatile("s_waitcnt vmcnt(0)" ::: "memory");
    __syncthreads();
    if (threadIdx.x == 0) {
        unsigned* bar = b.bar;
        __builtin_amdgcn_s_waitcnt(0);
        unsigned nloc = b.st[0], nx = b.st[1];
        if (nloc == 0u) { xcd_barrier_complete(bar, b.x, nloc, nx); b.st[0] = nloc; b.st[1] = nx; }
        const unsigned old = xb_add(&bar[XB_XSUB(b.x)], 1u);
        const unsigned gen = old / nloc;
        if (old + 1u == (gen + 1u) * nloc) {
            __builtin_amdgcn_fence(__ATOMIC_RELEASE, "agent");
            asm volatile("s_waitcnt vmcnt(0)" ::: "memory");
            const unsigned og = xb_add(&bar[XB_TOP], 1u);
            const unsigned tg = og / nx;
            if (og + 1u == (tg + 1u) * nx) xb_add(&bar[XB_TOPGEN], 1u);
            else XB_SPIN(xb_ld(&bar[XB_TOPGEN]) == tg, bar);
            __builtin_amdgcn_fence(__ATOMIC_ACQUIRE, "agent");
            xb_add(&bar[XB_XGEN(b.x)], 1u);
            asm volatile("s_waitcnt vmcnt(0)" ::: "memory");
        } else {
            XB_SPIN(xb_ld(&bar[XB_XGEN(b.x)]) == gen, bar);
            __builtin_amdgcn_fence(__ATOMIC_ACQUIRE, "agent");
            asm volatile("s_waitcnt vmcnt(0)" ::: "memory");
        }
    }
    __syncthreads();
}
constexpr int NWAVES = 8;
constexpr int DM = 4096, NB = 4, SEQ = 2048, NMETA = 16, TT = SEQ + NMETA;
constexpr int MR = NB * SEQ;
constexpr int NIN = 22528, DFF = 16384, NH = 16, WHD = 2048;
constexpr int C_Q = 0, C_K = 2048, C_V = 4096, C_HQ = 6144, C_HF = 8192, C_HI = 10240, C_HG = 12288, C_GA = 14336, C_GB = 18432;
constexpr int YP = 2 * WHD;
constexpr float EPS = 1e-6f;
constexpr float C2 = 0.18033688011112042f;
constexpr float LAM_INIT = 0.2f;

constexpr size_t MiB = 1u << 20;
constexpr size_t WS_CTL = 0, CTL_ZERO_BYTES = 1 * MiB;
constexpr size_t WS_WIN = 2 * MiB, WS_WUPA = 178 * MiB, WS_WUPB = 194 * MiB, WS_WOUT = 210 * MiB, WS_WFF1 = 242 * MiB, WS_WFF2 = 370 * MiB;
constexpr size_t WS_U = 498 * MiB;
constexpr size_t WS_UMETA = 562 * MiB;
constexpr size_t WS_PM = 563 * MiB;
constexpr size_t WS_ROPE = 564 * MiB;
constexpr size_t WS_RSTD = 565 * MiB;
constexpr size_t WS_P = 568 * MiB;
constexpr size_t WS_YA = 920 * MiB, WS_YB = 952 * MiB, WS_MG = 984 * MiB;
constexpr size_t WS_SSQ = 1048 * MiB;
constexpr size_t WS_DEC = 1050 * MiB;
constexpr size_t WS_U8 = 1052 * MiB;
constexpr size_t WS_W8 = 1084 * MiB;
constexpr size_t WS_SU = 1172 * MiB;
constexpr size_t WS_SW = 1173 * MiB;
constexpr size_t WS_Y8 = 1176 * MiB;
constexpr size_t WS_WUP8 = 1208 * MiB;
constexpr size_t WS_SY = 1224 * MiB;
constexpr size_t WS_MG8 = 1226 * MiB;
constexpr size_t WS_WO8 = 1258 * MiB;
constexpr size_t WS_SO = 1274 * MiB;
constexpr size_t WS_END = 1275 * MiB;
constexpr int NQK = C_V;
constexpr int CW_QHEAD = 2048;
constexpr int CW_SWMAX = 32768;
constexpr int CW_BAR = 4096;

constexpr int RING_BYTES = 131072, LDSCTL_OFF = 146432, LDS_BYTES = 147456;

__device__ __forceinline__ int opaque_v(int v) { asm volatile("" : "+v"(v)); return v; }
#define PHASE_IDS const int tid = opaque_v((int)threadIdx.x), lane = tid & 63, wave = __builtin_amdgcn_readfirstlane(tid >> 6); (void)lane; (void)wave;
__device__ __forceinline__ float bf2f(bf16 v) { return __builtin_bit_cast(float, (unsigned)v << 16); }
__device__ __forceinline__ float bflo(unsigned w) { return __builtin_bit_cast(float, w << 16); }
__device__ __forceinline__ float bfhi(unsigned w) { return __builtin_bit_cast(float, w & 0xffff0000u); }
__device__ __forceinline__ float wave_sum(float v) {
#pragma unroll
    for (int o = 1; o < 64; o <<= 1) v += __shfl_xor(v, o);
    return v;
}
__device__ __forceinline__ float wave_max(float v) {
#pragma unroll
    for (int o = 1; o < 64; o <<= 1) v = fmaxf(v, __shfl_xor(v, o));
    return v;
}
__device__ __forceinline__ float sigmoidf_(float x) { return __builtin_amdgcn_rcpf(1.0f + __expf(-x)); }

__host__ __device__ __forceinline__ int wt_row(int s) {
    if (s < C_V) { const int base = s & ~2047, t = s & 2047, h = t >> 7, cm = (t >> 6) & 1, d = t & 63; return base + 256 * (h >> 1) + 128 * ((d >> 3) & 1) + 32 * (2 * (h & 1) + cm) + 8 * (d >> 4) + (d & 7); }
    if (s >= C_HQ && s < C_HI) { const int t = s - C_HQ, isf = t >> 11, h = (t & 2047) >> 7, d = t & 127; return C_HQ + 256 * h + 128 * isf + d; }
    return s;
}
__device__ __forceinline__ unsigned pk4_i8(float a, float b, float c, float d) {
    const int ia = (int)__builtin_rintf(a), ib = (int)__builtin_rintf(b), ic = (int)__builtin_rintf(c), id = (int)__builtin_rintf(d);
    return (unsigned)(ia & 0xff) | ((unsigned)(ib & 0xff) << 8) | ((unsigned)(ic & 0xff) << 16) | ((unsigned)id << 24);
}
__device__ __forceinline__ const void* ldp(LAS unsigned char* lds, int k) {
    volatile LAS unsigned* t = (volatile LAS unsigned*)(lds + LDSCTL_OFF) + 32 + 2 * k;
    const unsigned lo = t[0], hi = t[1];
    return (const void*)(const GAS void*)(((unsigned long long)(unsigned)__builtin_amdgcn_readfirstlane((int)hi) << 32) | (unsigned long long)(unsigned)__builtin_amdgcn_readfirstlane((int)lo));
}
struct TItem { const float* src; bf16* dst; int N, KP; const float* gain; };
constexpr int TI_UP = (WHD / 64) * (DM / 32), TI_OUT = (DM / 64) * (DM / 32), TI_F1 = (DM / 64) * (DFF / 32), TI_F2 = (DFF / 64) * (DM / 32), TI_ALL = 2 * TI_UP + TI_OUT + TI_F1 + TI_F2;
constexpr int TSCR_BYTES = 32 * 33 * 4;
__device__ __forceinline__ TItem t_item(const float* W, int N, bf16* WT, int item, int KP, int koff, const float* gain = nullptr) {
    const int nblk = N / 32, kb = item / nblk, nb = item % nblk;
    return TItem{W + (size_t)(64 * kb) * N + 32 * nb, WT + (size_t)(32 * nb) * KP + koff + 64 * kb, N, KP, gain ? gain + 64 * kb : nullptr};
}
__device__ __forceinline__ TItem t_decode(LAS unsigned char* lds, int it) {
    unsigned char* ws = (unsigned char*)ldp(lds, 20);
    int r = it;
    if (r < TI_UP) return t_item((const float*)ldp(lds, 13), DM, (bf16*)(ws + WS_WUPA), r, YP, 0);
    r -= TI_UP; if (r < TI_UP) return t_item((const float*)ldp(lds, 14), DM, (bf16*)(ws + WS_WUPA), r, YP, WHD);
    r -= TI_UP; if (r < TI_OUT) return t_item((const float*)ldp(lds, 15), DM, (bf16*)(ws + WS_WOUT), r, DM, 0);
    r -= TI_OUT; if (r < TI_F1) return t_item((const float*)ldp(lds, 17), DFF, (bf16*)(ws + WS_WFF1), r, DM, 0, (const float*)ldp(lds, 16));
    r -= TI_F1; return t_item((const float*)ldp(lds, 18), DM, (bf16*)(ws + WS_WFF2), r, DFF, 0);
}
__device__ __forceinline__ void t_convert(const TItem& t, LAS unsigned* scr, int lane) {
    const int r = lane >> 3, c4 = lane & 7;
    const unsigned off = (unsigned)(2 * r) * (unsigned)t.N + (unsigned)(4 * c4);
    f32x4 v[8];
#pragma unroll
    for (int i = 0; i < 8; ++i) v[i] = __builtin_nontemporal_load((const GAS f32x4*)((const GAS float*)t.src + (size_t)(16 * (i >> 1) + (i & 1)) * t.N + off));
    if (t.gain) {
#pragma unroll
        for (int i = 0; i < 8; ++i) v[i] = v[i] * t.gain[16 * (i >> 1) + (i & 1) + 2 * r];
    }
#pragma unroll
    for (int m = 0; m < 4; ++m)
#pragma unroll
        for (int e = 0; e < 4; ++e) scr[(8 * m + r) * 33 + 4 * c4 + e] = pg8::cvt_pk_bf16(v[2 * m][e], v[2 * m + 1][e]);
    LDS_WAIT(); asm volatile("" ::: "memory");
    const int c = lane & 7;
#pragma unroll
    for (int j = 0; j < 4; ++j) { const int n = (lane >> 3) + 8 * j; const LAS unsigned* w = scr + (4 * c) * 33 + n;
        v4u o; o.x = w[0]; o.y = w[33]; o.z = w[66]; o.w = w[99];
        *(GAS v4u*)(t.dst + (size_t)n * t.KP + 8 * c) = o; }
    LDS_WAIT(); asm volatile("" ::: "memory");
}
template <bool PERMW = false>
__device__ __forceinline__ void p0_transpose_item(const float* W, int K, int N, bf16* WT, LAS float* scr, int item, int lane, int KP = 0, int koff = 0, gu32* cmaxw = nullptr) {
    if (KP == 0) KP = K;
    const int nblk = N / 32, kb = item / nblk, nb = item % nblk, k0 = 64 * kb, n0 = 32 * nb;
    float cmx = 0.f;
#pragma unroll
    for (int i = 0; i < 32; ++i) { const int kk = 2 * i + (lane >> 5); const float wv = __builtin_nontemporal_load((const GAS float*)W + (size_t)(k0 + kk) * N + n0 + (lane & 31)); scr[kk * 33 + (lane & 31)] = wv; cmx = fmaxf(cmx, fabsf(wv)); }
    if (PERMW && cmaxw) { cmx = fmaxf(cmx, __shfl_xor(cmx, 32));
        if (lane < 32) __hip_atomic_fetch_max(cmaxw + wt_row(n0 + lane), __float_as_uint(cmx), RLX_AGENT); }
    LDS_WAIT(); asm volatile("" ::: "memory");
    const int c = lane & 7;
#pragma unroll
    for (int j = 0; j < 4; ++j) { const int n = (lane >> 3) + 8 * j; const LAS float* s = scr + (8 * c) * 33 + n;
        v4u o; o.x = pk2(s[0 * 33], s[1 * 33]); o.y = pk2(s[2 * 33], s[3 * 33]); o.z = pk2(s[4 * 33], s[5 * 33]); o.w = pk2(s[6 * 33], s[7 * 33]);
        *(GAS v4u*)(WT + (size_t)(PERMW ? wt_row(n0 + n) : (n0 + n)) * KP + koff + k0 + 8 * c) = o; }
    LDS_WAIT(); asm volatile("" ::: "memory");
}
__device__ __forceinline__ void rms_row_to_bf16(const float* xrow, const float* g, bf16* orow, int lane, unsigned char* o8row = nullptr, float* su = nullptr) {
    const GAS f32x4* xr = (const GAS f32x4*)xrow + lane; const GAS f32x4* gr = (const GAS f32x4*)g + lane;
    f32x4 v[16]; float s = 0.f, am = 0.f;
#pragma unroll
    for (int j = 0; j < 16; ++j) { v[j] = __builtin_nontemporal_load(xr + 64 * j); s += (v[j].x * v[j].x + v[j].y * v[j].y) + (v[j].z * v[j].z + v[j].w * v[j].w);
        const f32x4 gg = gr[64 * j]; v[j] = v[j] * gg; am = fmaxf(am, fmaxf(fmaxf(fabsf(v[j].x), fabsf(v[j].y)), fmaxf(fabsf(v[j].z), fabsf(v[j].w)))); }
    const float rstd = 1.f / sqrtf(wave_sum(s) * (1.f / DM) + EPS);
    if (orow) { GAS unsigned long long* o8 = (GAS unsigned long long*)orow + lane;
#pragma unroll
        for (int j = 0; j < 16; ++j) o8[64 * j] = (unsigned long long)pk2(v[j].x * rstd, v[j].y * rstd) | ((unsigned long long)pk2(v[j].z * rstd, v[j].w * rstd) << 32); }
    if (o8row) {
        am = wave_max(am); const float inv = am > 0.f ? 127.f / am : 0.f;
#pragma unroll
        for (int j = 0; j < 16; ++j) ((GAS unsigned*)o8row)[64 * j + lane] = pk4_i8(v[j].x * inv, v[j].y * inv, v[j].z * inv, v[j].w * inv);
        if (lane == 0) *su = am * rstd * (1.f / 127.f); }
}
__device__ __forceinline__ void sincos_d(double a, float& sn, float& cs) {
    const double PI = 3.14159265358979323846;
    const double k = rint(a / PI); const double r = a - k * PI; const double r2 = r * r;
    double s = 1.0, c = 1.0, ts = 1.0, tc = 1.0;
#pragma unroll
    for (int i = 1; i <= 11; ++i) { tc *= -r2 / (double)((2 * i - 1) * (2 * i)); ts *= -r2 / (double)((2 * i) * (2 * i + 1)); c += tc; s += ts; }
    s *= r;
    const bool odd = ((long long)k) & 1;
    sn = (float)(odd ? -s : s); cs = (float)(odd ? -c : c);
}

struct Ptrs {
    const float* in[19]; float* out; unsigned char* ws;
};

__device__ __forceinline__ const bf16* rowptr(const bf16* P, const bf16* Pm, int b, int t) {
    return t < NMETA ? Pm + (size_t)t * NIN : P + (size_t)(b * SEQ + t - NMETA) * NIN;
}

__device__ __forceinline__ float dpp_shr(float v, int n) {
    const int x = __float_as_int(v); int r;
    if (n == 1) r = __builtin_amdgcn_update_dpp(0, x, 0x111, 0xf, 0xf, true); else if (n == 2) r = __builtin_amdgcn_update_dpp(0, x, 0x112, 0xf, 0xf, true);
    else if (n == 4) r = __builtin_amdgcn_update_dpp(0, x, 0x114, 0xf, 0xf, true); else r = __builtin_amdgcn_update_dpp(0, x, 0x118, 0xf, 0xf, true);
    return __int_as_float(r);
}
template <bool QK_ONLY>
struct EpiProjT {
    static constexpr bool PERM = true, AFTER_DRAIN = false, INIT = false;
    bf16* O; const float* qn; const float* kn; const float* rope; const float* hlb; float* dec; int pn0; float oscale; const float* su; const float* sw;
    __device__ __forceinline__ float val(float a, float rs, float cs) const { return su ? (float)__float_as_int(a) * (rs * cs) : a * oscale; }
    __device__ __forceinline__ void operator()(const pg8::f32x4 (&acc)[2][2][4][2], const pg8::Unit& u, int wr, int wc, int fr_, int fq_) const {
        const int fr = opaque_v(fr_), fq = opaque_v(fq_);
        const int row0 = u.pm * 256 + wr * 64 + fr, pn = u.pn + pn0;
        if constexpr (QK_ONLY) {
            const bool isk = pn >= 8; const int h = 2 * (pn & 7) + (wc >> 1), cm = wc & 1; const float* wv = isk ? kn : qn;
            float w0[8], w1[8], cq0[8], cq1[8];
#pragma unroll
            for (int j = 0; j < 8; ++j) { w0[j] = wv[16 * fq + j]; w1[j] = wv[16 * fq + 8 + j]; cq0[j] = su ? sw[pn * 256 + 32 * wc + 8 * fq + j] : 1.f; cq1[j] = su ? sw[pn * 256 + 128 + 32 * wc + 8 * fq + j] : 1.f; }
            bf16* obase = O + (isk ? C_K : C_Q) + h * 128 + cm * 64 + 16 * fq;
#pragma unroll
            for (int ai = 0; ai < 2; ++ai)
#pragma unroll
                for (int m = 0; m < 4; ++m) { const int row = row0 + ai * 128 + m * 16;
                    float x0[8], x1[8]; float ss = 0.f;
                    const float rs_ = su ? su[row] : 1.f;
#pragma unroll
                    for (int j = 0; j < 8; ++j) { x0[j] = val(acc[ai][0][m][j >> 2][j & 3], rs_, cq0[j]); x1[j] = val(acc[ai][1][m][j >> 2][j & 3], rs_, cq1[j]); ss += x0[j] * x0[j] + x1[j] * x1[j]; }
                    ss += __shfl_xor(ss, 16); ss += __shfl_xor(ss, 32);
                    const float rstd = 1.f / sqrtf(ss * (1.f / 64.f) + EPS);
                    const float* rp = rope + (NMETA + (row & (SEQ - 1))) * 16;
                    const f32x4 c0 = *(const GAS f32x4*)rp, c1 = *(const GAS f32x4*)(rp + 4), s0 = *(const GAS f32x4*)(rp + 8), s1 = *(const GAS f32x4*)(rp + 12);
                    const float cs[8] = {c0.x, c0.y, c0.z, c0.w, c1.x, c1.y, c1.z, c1.w}, sn[8] = {s0.x, s0.y, s0.z, s0.w, s1.x, s1.y, s1.z, s1.w};
                    float o0[8], o1[8];
#pragma unroll
                    for (int j = 0; j < 8; ++j) { const float a = x0[j] * rstd * w0[j], bb = x1[j] * rstd * w1[j];
                        float r0 = a, r1 = bb; if (fq == 0) { r0 = a * cs[j] - bb * sn[j]; r1 = bb * cs[j] + a * sn[j]; }
                        o0[j] = isk ? r0 : r0 * C2; o1[j] = isk ? r1 : r1 * C2; }
                    v4u wa, wb; wa.x = pg8::cvt_pk_bf16(o0[0], o0[1]); wa.y = pg8::cvt_pk_bf16(o0[2], o0[3]); wa.z = pg8::cvt_pk_bf16(o0[4], o0[5]); wa.w = pg8::cvt_pk_bf16(o0[6], o0[7]);
                    wb.x = pg8::cvt_pk_bf16(o1[0], o1[1]); wb.y = pg8::cvt_pk_bf16(o1[2], o1[3]); wb.z = pg8::cvt_pk_bf16(o1[4], o1[5]); wb.w = pg8::cvt_pk_bf16(o1[6], o1[7]);
                    bf16* op = obase + (size_t)row * NIN; *(v4u*)op = wa; *(v4u*)(op + 8) = wb; }
        } else { if (pn >= 24 && pn < 40) {
            const int h = pn - 24, d0 = 32 * wc + 8 * fq, colg = h * 128 + d0; const int lane15 = (fq << 4) | 15;
            float lb[8], cq[8], cf[8];
#pragma unroll
            for (int j = 0; j < 8; ++j) { cq[j] = su ? sw[pn * 256 + d0 + j] : 1.f; cf[j] = su ? sw[pn * 256 + 128 + d0 + j] : 1.f; }
#pragma unroll
            for (int j = 0; j < 8; ++j) { const float a = hlb[colg + j], c = hlb[WHD + colg + j]; lb[j] = 1.f / (1.f + __expf(c - a)); }
#pragma unroll
            for (int ai = 0; ai < 2; ++ai) {
                const int rowc = u.pm * 256 + ai * 128 + wr * 64, cj = (rowc >> 11) * 32 + ((rowc & (SEQ - 1)) >> 6);
                unsigned qd[4][4], ki[4][4]; float tot[8]; float rsm[4];
#pragma unroll
                for (int m = 0; m < 4; ++m) rsm[m] = su ? su[row0 + ai * 128 + m * 16] : 1.f;
#pragma unroll
                for (int jp = 0; jp < 4; ++jp) {
                    float qv[2][4], kv[2][4];
#pragma unroll
                    for (int jj = 0; jj < 2; ++jj) { const int j = 2 * jp + jj;
                        float f[4], s[4];
#pragma unroll
                        for (int m = 0; m < 4; ++m) { f[m] = lb[j] + (1.f - lb[j]) * sigmoidf_(val(acc[ai][1][m][j >> 2][j & 3], rsm[m], cf[j])); float g = __logf(f[m]);
                            g += dpp_shr(g, 1); g += dpp_shr(g, 2); g += dpp_shr(g, 4); g += dpp_shr(g, 8); s[m] = g; }
                        float carry = 0.f;
#pragma unroll
                        for (int m = 0; m < 4; ++m) { const float bcur = s[m] + carry; carry += __shfl(s[m], lane15); s[m] = bcur; }
                        tot[j] = carry;
#pragma unroll
                        for (int m = 0; m < 4; ++m) { qv[jj][m] = val(acc[ai][0][m][j >> 2][j & 3], rsm[m], cq[j]) * __expf(s[m]); kv[jj][m] = (1.f - f[m]) * __expf(-s[m]); }
                    }
#pragma unroll
                    for (int m = 0; m < 4; ++m) { qd[m][jp] = pg8::cvt_pk_bf16(qv[0][m], qv[1][m]); ki[m][jp] = pg8::cvt_pk_bf16(kv[0][m], kv[1][m]); }
                }
#pragma unroll
                for (int m = 0; m < 4; ++m) { bf16* op = O + (size_t)(row0 + ai * 128 + m * 16) * NIN + colg;
                    *(v4u*)(op + C_HQ) = (v4u){qd[m][0], qd[m][1], qd[m][2], qd[m][3]}; *(v4u*)(op + C_HF) = (v4u){ki[m][0], ki[m][1], ki[m][2], ki[m][3]}; }
                if (fr == 15) { float* dp = dec + (size_t)cj * WHD + colg;
                    *(f32x4*)dp = (f32x4){__expf(tot[0]), __expf(tot[1]), __expf(tot[2]), __expf(tot[3])}; *(f32x4*)(dp + 4) = (f32x4){__expf(tot[4]), __expf(tot[5]), __expf(tot[6]), __expf(tot[7])}; }
            }
        } else {
            const int col0 = pn * 256 + wc * 32 + 8 * fq; const bool sg = pn >= 56;
            float cw[2][8];
#pragma unroll
            for (int bj = 0; bj < 2; ++bj)
#pragma unroll
                for (int j = 0; j < 8; ++j) cw[bj][j] = su ? sw[col0 + bj * 128 + j] : 1.f;
#pragma unroll
            for (int ai = 0; ai < 2; ++ai)
#pragma unroll
                for (int m = 0; m < 4; ++m) { bf16* rowp = O + (size_t)(row0 + ai * 128 + m * 16) * NIN + col0; const float rs_ = su ? su[row0 + ai * 128 + m * 16] : 1.f;
#pragma unroll
                    for (int bj = 0; bj < 2; ++bj) { pg8::f32x4 v0, v1;
#pragma unroll
                        for (int e = 0; e < 4; ++e) { v0[e] = val(acc[ai][bj][m][0][e], rs_, cw[bj][e]); v1[e] = val(acc[ai][bj][m][1][e], rs_, cw[bj][4 + e]); }
                        if (sg) { for (int e = 0; e < 4; ++e) { v0[e] = sigmoidf_(v0[e]); v1[e] = sigmoidf_(v1[e]); } }
                        v4u w; w.x = pg8::cvt_pk_bf16(v0[0], v0[1]); w.y = pg8::cvt_pk_bf16(v0[2], v0[3]); w.z = pg8::cvt_pk_bf16(v1[0], v1[1]); w.w = pg8::cvt_pk_bf16(v1[2], v1[3]);
                        *(v4u*)(rowp + bj * 128) = w; } }
        } }
    }
};
struct HalfOrder : pg8::StaticOrder {
    static constexpr int KLOOP = WHD;
    __device__ __forceinline__ bool next(int i, pg8::Unit& u) const { if (!pg8::StaticOrder::next(i >> 1, u)) return false; u.pn |= (i & 1) << 16; return true; }
    __device__ __forceinline__ size_t kofs(const pg8::Unit& u) const { return (size_t)(u.pn >> 16) * (size_t)(WHD * 2); }
    __device__ __forceinline__ bool zero_after(const pg8::Unit& u) const { return (u.pn >> 16) != 0; }
};
struct EpiUp {
    static constexpr bool PERM = true, AFTER_DRAIN = false, INIT = false;
    const bf16* P; bf16* MG;
    __device__ __forceinline__ void operator()(pg8::f32x4 (&acc)[2][2][4][2], const pg8::Unit& u, int wr, int wc, int fr, int fq) const {
        const int pn = u.pn & 0xffff; const bool second = (u.pn >> 16) != 0;
        const int row0 = u.pm * 256 + wr * 64 + fr, col0 = pn * 256 + wc * 32 + 8 * fq;
#pragma unroll
        for (int ai = 0; ai < 2; ++ai)
#pragma unroll
            for (int m = 0; m < 4; ++m) { const int row = row0 + ai * 128 + m * 16;
#pragma unroll
                for (int bj = 0; bj < 2; ++bj) { const int col = col0 + bj * 128;
                    const v4u gb = *(const GAS v4u*)(P + (size_t)row * NIN + C_GB + col);
                    pg8::f32x4& v0 = acc[ai][bj][m][0]; pg8::f32x4& v1 = acc[ai][bj][m][1];
                    if (!second) { const v4u ga = *(const GAS v4u*)(P + (size_t)row * NIN + C_GA + col);
                        v0[0] *= bflo(ga.x) * __builtin_amdgcn_rcpf(bflo(gb.x)); v0[1] *= bfhi(ga.x) * __builtin_amdgcn_rcpf(bfhi(gb.x)); v0[2] *= bflo(ga.y) * __builtin_amdgcn_rcpf(bflo(gb.y)); v0[3] *= bfhi(ga.y) * __builtin_amdgcn_rcpf(bfhi(gb.y));
                        v1[0] *= bflo(ga.z) * __builtin_amdgcn_rcpf(bflo(gb.z)); v1[1] *= bfhi(ga.z) * __builtin_amdgcn_rcpf(bfhi(gb.z)); v1[2] *= bflo(ga.w) * __builtin_amdgcn_rcpf(bflo(gb.w)); v1[3] *= bfhi(ga.w) * __builtin_amdgcn_rcpf(bfhi(gb.w));
                    } else {
                        v4u w; w.x = pg8::cvt_pk_bf16(v0[0] * bflo(gb.x), v0[1] * bfhi(gb.x)); w.y = pg8::cvt_pk_bf16(v0[2] * bflo(gb.y), v0[3] * bfhi(gb.y));
                        w.z = pg8::cvt_pk_bf16(v1[0] * bflo(gb.z), v1[1] * bfhi(gb.z)); w.w = pg8::cvt_pk_bf16(v1[2] * bflo(gb.w), v1[3] * bfhi(gb.w));
                        *(v4u*)(MG + (size_t)row * DM + col) = w; } } }
    }
};
struct HalfOrder8 : pg8::StaticOrder {
    static constexpr int KLOOP = WHD / 2;
    __device__ __forceinline__ bool next(int i, pg8::Unit& u) const { if (!pg8::StaticOrder::next(i >> 1, u)) return false; u.pn |= (i & 1) << 16; return true; }
    __device__ __forceinline__ size_t kofs(const pg8::Unit& u) const { return (size_t)(u.pn >> 16) * (size_t)WHD; }
    __device__ __forceinline__ bool zero_after(const pg8::Unit& u) const { return (u.pn >> 16) != 0; }
};
struct EpiUp8 {
    static constexpr bool PERM = true, AFTER_DRAIN = false, INIT = false;
    const bf16* P; bf16* MG; const float* SYR; const float* SYB; const float* SWR; const float* SWB;
    __device__ __forceinline__ void operator()(pg8::f32x4 (&acc)[2][2][4][2], const pg8::Unit& u, int wr, int wc, int fr_, int fq_) const {
        const int fr = opaque_v(fr_), fq = opaque_v(fq_);
        const int pn = u.pn & 0xffff; const bool second = (u.pn >> 16) != 0;
        const int row0 = u.pm * 256 + wr * 64 + fr, col0 = pn * 256 + wc * 32 + 8 * fq;
        const float* CS = second ? SWB : SWR; const float* RS = second ? SYB : SYR;
        float cs[2][8];
#pragma unroll
        for (int bj = 0; bj < 2; ++bj) { const f32x4 c0 = *(const GAS f32x4*)(CS + col0 + bj * 128), c1 = *(const GAS f32x4*)(CS + col0 + bj * 128 + 4);
            cs[bj][0] = c0.x; cs[bj][1] = c0.y; cs[bj][2] = c0.z; cs[bj][3] = c0.w; cs[bj][4] = c1.x; cs[bj][5] = c1.y; cs[bj][6] = c1.z; cs[bj][7] = c1.w; }
#pragma unroll
        for (int ai = 0; ai < 2; ++ai)
#pragma unroll
            for (int m = 0; m < 4; ++m) { const int row = row0 + ai * 128 + m * 16; const float rs = RS[row];
#pragma unroll
                for (int bj = 0; bj < 2; ++bj) { const int col = col0 + bj * 128;
                    const v4u gb = *(const GAS v4u*)(P + (size_t)row * NIN + C_GB + col);
                    const float b_[8] = {bflo(gb.x), bfhi(gb.x), bflo(gb.y), bfhi(gb.y), bflo(gb.z), bfhi(gb.z), bflo(gb.w), bfhi(gb.w)};
                    if (!second) { const v4u ga = *(const GAS v4u*)(P + (size_t)row * NIN + C_GA + col);
                        const float a_[8] = {bflo(ga.x), bfhi(ga.x), bflo(ga.y), bfhi(ga.y), bflo(ga.z), bfhi(ga.z), bflo(ga.w), bfhi(ga.w)};
#pragma unroll
                        for (int e = 0; e < 8; ++e) { float f = (float)__float_as_int(acc[ai][bj][m][e >> 2][e & 3]) * (a_[e] * __builtin_amdgcn_rcpf(b_[e])) * (rs * cs[bj][e]);
                            f = fminf(fmaxf(f, -2.0e9f), 2.0e9f);
                            acc[ai][bj][m][e >> 2][e & 3] = __int_as_float((int)__builtin_rintf(f)); }
                    } else { float o_[8];
#pragma unroll
                        for (int e = 0; e < 8; ++e) o_[e] = (float)__float_as_int(acc[ai][bj][m][e >> 2][e & 3]) * (b_[e] * (rs * cs[bj][e]));
                        v4u w; w.x = pg8::cvt_pk_bf16(o_[0], o_[1]); w.y = pg8::cvt_pk_bf16(o_[2], o_[3]); w.z = pg8::cvt_pk_bf16(o_[4], o_[5]); w.w = pg8::cvt_pk_bf16(o_[6], o_[7]);
                        *(v4u*)(MG + (size_t)row * DM + col) = w; } } }
    }
};
struct EpiOut {
    static constexpr bool PERM = true, AFTER_DRAIN = false, INIT = true;
    const float* X; bf16* H1b; float* SSQ;
    __device__ __forceinline__ void init(pg8::f32x4 (&acc)[2][2][4][2], const pg8::Unit& u, int wr, int wc, int fr_, int fq_) const {
        const int fr = opaque_v(fr_), fq = opaque_v(fq_);
        const float* xp = X + (size_t)(u.pm * 256 + wr * 64 + fr) * DM + u.pn * 256 + wc * 32 + 8 * fq;
#pragma unroll
        for (int ai = 0; ai < 2; ++ai)
#pragma unroll
            for (int bj = 0; bj < 2; ++bj)
#pragma unroll
                for (int m = 0; m < 4; ++m) { const float* q = xp + (size_t)(ai * 128 + m * 16) * DM + bj * 128;
                    acc[ai][bj][m][0] = __builtin_nontemporal_load((const pg8::f32x4*)q); acc[ai][bj][m][1] = __builtin_nontemporal_load((const pg8::f32x4*)(q + 4)); }
    }
    __device__ __forceinline__ void operator()(const pg8::f32x4 (&acc)[2][2][4][2], const pg8::Unit& u, int wr, int wc, int fr, int fq) const {
        const int row0 = u.pm * 256 + wr * 64 + fr, col0 = u.pn * 256 + wc * 32 + 8 * fq;
#pragma unroll
        for (int ai = 0; ai < 2; ++ai)
#pragma unroll
            for (int m = 0; m < 4; ++m) { const int row = row0 + ai * 128 + m * 16; float ss = 0.f;
#pragma unroll
                for (int bj = 0; bj < 2; ++bj) { const int col = col0 + bj * 128; const size_t off = (size_t)row * DM + col;
                    const pg8::f32x4 h0 = acc[ai][bj][m][0], h1 = acc[ai][bj][m][1];
                    ss += (h0[0] * h0[0] + h0[1] * h0[1]) + (h0[2] * h0[2] + h0[3] * h0[3]) + (h1[0] * h1[0] + h1[1] * h1[1]) + (h1[2] * h1[2] + h1[3] * h1[3]);
                    v4u w; w.x = pg8::cvt_pk_bf16(h0[0], h0[1]); w.y = pg8::cvt_pk_bf16(h0[2], h0[3]); w.z = pg8::cvt_pk_bf16(h1[0], h1[1]); w.w = pg8::cvt_pk_bf16(h1[2], h1[3]);
                    *(v4u*)(H1b + off) = w; }
                ss += __shfl_xor(ss, 16); ss += __shfl_xor(ss, 32);
                if (fq == 0) SSQ[(size_t)row * 64 + u.pn * 4 + wc] = ss; }
    }
};
struct EpiOut8 {
    static constexpr bool PERM = true, AFTER_DRAIN = false, INIT = true;
    const float* X; bf16* H1b; float* SSQ; const float* SMG; const float* ISMG; const float* SWO; const float* ISWO;
    __device__ __forceinline__ void init(pg8::f32x4 (&acc)[2][2][4][2], const pg8::Unit& u, int wr, int wc, int fr_, int fq_) const {
        const int fr = opaque_v(fr_), fq = opaque_v(fq_);
        const int row0 = u.pm * 256 + wr * 64 + fr, col0 = u.pn * 256 + wc * 32 + 8 * fq;
        const float* xp = X + (size_t)row0 * DM + col0;
#pragma unroll
        for (int ai = 0; ai < 2; ++ai)
#pragma unroll
            for (int bj = 0; bj < 2; ++bj) { const f32x4 c0 = *(const GAS f32x4*)(ISWO + col0 + bj * 128), c1 = *(const GAS f32x4*)(ISWO + col0 + bj * 128 + 4);
#pragma unroll
                for (int m = 0; m < 4; ++m) { const float* q = xp + (size_t)(ai * 128 + m * 16) * DM + bj * 128; const float ir = ISMG[row0 + ai * 128 + m * 16];
                    const pg8::f32x4 x0 = __builtin_nontemporal_load((const pg8::f32x4*)q), x1 = __builtin_nontemporal_load((const pg8::f32x4*)(q + 4));
                    pg8::f32x4 a0, a1;
                    a0[0] = __int_as_float((int)__builtin_rintf(x0[0] * (ir * c0.x))); a0[1] = __int_as_float((int)__builtin_rintf(x0[1] * (ir * c0.y))); a0[2] = __int_as_float((int)__builtin_rintf(x0[2] * (ir * c0.z))); a0[3] = __int_as_float((int)__builtin_rintf(x0[3] * (ir * c0.w)));
                    a1[0] = __int_as_float((int)__builtin_rintf(x1[0] * (ir * c1.x))); a1[1] = __int_as_float((int)__builtin_rintf(x1[1] * (ir * c1.y))); a1[2] = __int_as_float((int)__builtin_rintf(x1[2] * (ir * c1.z))); a1[3] = __int_as_float((int)__builtin_rintf(x1[3] * (ir * c1.w)));
                    acc[ai][bj][m][0] = a0; acc[ai][bj][m][1] = a1; } }
    }
    __device__ __forceinline__ void operator()(const pg8::f32x4 (&acc)[2][2][4][2], const pg8::Unit& u, int wr, int wc, int fr, int fq) const {
        const int row0 = u.pm * 256 + wr * 64 + fr, col0 = u.pn * 256 + wc * 32 + 8 * fq;
        float cs[2][8];
#pragma unroll
        for (int bj = 0; bj < 2; ++bj) { const f32x4 c0 = *(const GAS f32x4*)(SWO + col0 + bj * 128), c1 = *(const GAS f32x4*)(SWO + col0 + bj * 128 + 4);
            cs[bj][0] = c0.x; cs[bj][1] = c0.y; cs[bj][2] = c0.z; cs[bj][3] = c0.w; cs[bj][4] = c1.x; cs[bj][5] = c1.y; cs[bj][6] = c1.z; cs[bj][7] = c1.w; }
#pragma unroll
        for (int ai = 0; ai < 2; ++ai)
#pragma unroll
            for (int m = 0; m < 4; ++m) { const int row = row0 + ai * 128 + m * 16; const float rs = SMG[row]; float ss = 0.f;
#pragma unroll
                for (int bj = 0; bj < 2; ++bj) { const int col = col0 + bj * 128; const size_t off = (size_t)row * DM + col; float h[8];
#pragma unroll
                    for (int e = 0; e < 8; ++e) { h[e] = (float)__float_as_int(acc[ai][bj][m][e >> 2][e & 3]) * (rs * cs[bj][e]); ss += h[e] * h[e]; }
                    v4u w; w.x = pg8::cvt_pk_bf16(h[0], h[1]); w.y = pg8::cvt_pk_bf16(h[2], h[3]); w.z = pg8::cvt_pk_bf16(h[4], h[5]); w.w = pg8::cvt_pk_bf16(h[6], h[7]);
                    *(v4u*)(H1b + off) = w; }
                ss += __shfl_xor(ss, 16); ss += __shfl_xor(ss, 32);
                if (fq == 0) SSQ[(size_t)row * 64 + u.pn * 4 + wc] = ss; }
    }
};
struct EpiFf1 {
    static constexpr bool PERM = true, AFTER_DRAIN = false, INIT = false;
    bf16* H;
    __device__ __forceinline__ void operator()(const pg8::f32x4 (&acc)[2][2][4][2], const pg8::Unit& u, int wr, int wc, int fr, int fq) const {
        const int row0 = u.pm * 256 + wr * 64 + fr, col0 = u.pn * 256 + wc * 32 + 8 * fq;
#pragma unroll
        for (int ai = 0; ai < 2; ++ai)
#pragma unroll
            for (int m = 0; m < 4; ++m) { const int row = row0 + ai * 128 + m * 16;
#pragma unroll
                for (int bj = 0; bj < 2; ++bj) { pg8::f32x4 v0 = acc[ai][bj][m][0], v1 = acc[ai][bj][m][1];
#pragma unroll
                    for (int e = 0; e < 4; ++e) { const float a = fmaxf(v0[e], 0.f), b = fmaxf(v1[e], 0.f); v0[e] = a * a; v1[e] = b * b; }
                    v4u w; w.x = pg8::cvt_pk_bf16(v0[0], v0[1]); w.y = pg8::cvt_pk_bf16(v0[2], v0[3]); w.z = pg8::cvt_pk_bf16(v1[0], v1[1]); w.w = pg8::cvt_pk_bf16(v1[2], v1[3]);
                    *(v4u*)(H + (size_t)row * DFF + col0 + bj * 128) = w; } }
    }
};
struct EpiFf2 {
    static constexpr bool PERM = false, AFTER_DRAIN = false, INIT = true;
    float* O; const float* RSTD; const bf16* H1b;
    __device__ __forceinline__ void init(pg8::f32x4 (&acc)[2][2][4][2], const pg8::Unit& u, int wr, int wc, int fr_, int fq_) const {
        const int fr = opaque_v(fr_), fq = opaque_v(fq_);
        const int row0 = u.pm * 256 + wr * 64 + fr, col0 = u.pn * 256 + wc * 32 + 4 * fq;
#pragma unroll
        for (int ai = 0; ai < 2; ++ai)
#pragma unroll
            for (int bj = 0; bj < 2; ++bj)
#pragma unroll
                for (int m = 0; m < 4; ++m) { const int row = row0 + ai * 128 + m * 16; const float rs = RSTD[row], ir2 = 1.f / (rs * rs); const bf16* rowp = H1b + (size_t)row * DM + col0 + bj * 128;
#pragma unroll
                    for (int n = 0; n < 2; ++n) { const unsigned long long w = *(const GAS unsigned long long*)(rowp + n * 16); const unsigned lo = (unsigned)w, hh = (unsigned)(w >> 32);
                        acc[ai][bj][m][n] = (pg8::f32x4){bflo(lo) * ir2, bfhi(lo) * ir2, bflo(hh) * ir2, bfhi(hh) * ir2}; } }
    }
    __device__ __forceinline__ void operator()(const pg8::f32x4 (&acc)[2][2][4][2], const pg8::Unit& u, int wr, int wc, int fr, int fq) const {
        const int row0 = u.pm * 256 + wr * 64 + fr, col0 = u.pn * 256 + wc * 32 + 4 * fq;
#pragma unroll
        for (int ai = 0; ai < 2; ++ai)
#pragma unroll
            for (int m = 0; m < 4; ++m) { const int row = row0 + ai * 128 + m * 16; const float rs = RSTD[row], r2 = rs * rs; float* rowp = O + (size_t)row * DM + col0;
#pragma unroll
                for (int bj = 0; bj < 2; ++bj)
#pragma unroll
                    for (int n = 0; n < 2; ++n) __builtin_nontemporal_store(acc[ai][bj][m][n] * r2, (pg8::f32x4*)(rowp + bj * 128 + n * 16)); }
    }
};

constexpr int NCONV = 96;
namespace da {
typedef float f32x16 __attribute__((ext_vector_type(16)));
typedef short s16x4 __attribute__((ext_vector_type(4)));
constexpr int KBUF = 16384, VBUF = 16384, K_OFF = 0, V_OFF = 32768;
__device__ __forceinline__ int crow(int r, int hi) { return (r & 3) + 8 * (r >> 2) + 4 * hi; }
__device__ __forceinline__ int kswz(int row, int colB) { return row * 256 + (colB ^ ((row & 7) << 4)); }
__device__ __forceinline__ int v_st(int k, int c) { return ((k >> 3) * 4 + (c >> 5)) * 512 + ((k & 7) * 32 + (c & 31)) * 2; }
__device__ __forceinline__ int v_rd_base(int lane) { return ((lane & 3) << 3) | (((lane >> 2) & 3) << 6) | (((lane >> 4) & 1) << 5) | (((lane >> 5) & 1) << 8); }
__device__ __forceinline__ s16x4 vtr(LAS const unsigned char* p) { return __builtin_bit_cast(s16x4, __builtin_amdgcn_ds_read_tr16_b64_v4i16((LAS s16x4*)p)); }
__device__ __forceinline__ float pl_max(float v) { auto rr = __builtin_amdgcn_permlane32_swap(__float_as_uint(v), __float_as_uint(v), false, false); return fmaxf(__uint_as_float(rr[0]), __uint_as_float(rr[1])); }
__device__ __forceinline__ float pl_sum(float v) { auto rr = __builtin_amdgcn_permlane32_swap(__float_as_uint(v), __float_as_uint(v), false, false); return __uint_as_float(rr[0]) + __uint_as_float(rr[1]); }
__device__ __forceinline__ bf16x8 pack8(const f32x16& p, int base) {
    v4u w; w.x = pg8::cvt_pk_bf16(p[base + 0], p[base + 1]); w.y = pg8::cvt_pk_bf16(p[base + 2], p[base + 3]); w.z = pg8::cvt_pk_bf16(p[base + 4], p[base + 5]); w.w = pg8::cvt_pk_bf16(p[base + 6], p[base + 7]);
    return __builtin_bit_cast(bf16x8, w);
}
__device__ __forceinline__ void qk(f32x16& p0, f32x16& p1, LAS const unsigned char* Kb, LAS const unsigned char* Qw, float negm, int c, int r32, int hi) {
#pragma unroll
    for (int r = 0; r < 16; ++r) { p0[r] = negm; p1[r] = negm; }
#pragma unroll
    for (int d0 = 0; d0 < 4; ++d0) { const int cb = (c * 64 + d0 * 16 + hi * 8) * 2;
        const bf16x8 b0 = *(LAS const bf16x8*)(Kb + kswz(r32, cb)), b1 = *(LAS const bf16x8*)(Kb + kswz(32 + r32, cb)), qf = *(LAS const bf16x8*)(Qw + d0 * 1024);
        p0 = __builtin_amdgcn_mfma_f32_32x32x16_bf16(b0, qf, p0, 0, 0, 0); p1 = __builtin_amdgcn_mfma_f32_32x32x16_bf16(b1, qf, p1, 0, 0, 0); }
}
__device__ __forceinline__ void mask_diag(f32x16& p0, f32x16& p1, int hi, int rel) {
#pragma unroll
    for (int r = 0; r < 16; ++r) { if (crow(r, hi) > rel) p0[r] = -1e30f; if (32 + crow(r, hi) > rel) p1[r] = -1e30f; }
}
__device__ __forceinline__ void partB(f32x16& p0, f32x16& p1, float& l_part, bf16x8 (&pb)[4]) {
    float ps = 0.f;
#pragma unroll
    for (int r = 0; r < 16; ++r) { p0[r] = __builtin_amdgcn_exp2f(p0[r]); p1[r] = __builtin_amdgcn_exp2f(p1[r]); ps += p0[r] + p1[r]; }
    l_part += ps;
    pb[0] = pack8(p0, 0); pb[1] = pack8(p0, 8); pb[2] = pack8(p1, 0); pb[3] = pack8(p1, 8);
}
__device__ __forceinline__ void pv(f32x16 (&o)[4], LAS const unsigned char* Vb, const bf16x8 (&pb)[4], int lane) {
    LAS const unsigned char* vb = Vb + v_rd_base(lane);
#pragma unroll
    for (int d0 = 0; d0 < 4; ++d0) {
        s16x4 lo[4], hh[4];
#pragma unroll
        for (int ks = 0; ks < 4; ++ks) { lo[ks] = vtr(vb + d0 * 512 + ks * 4096); hh[ks] = vtr(vb + d0 * 512 + ks * 4096 + 2048); }
#pragma unroll
        for (int ks = 0; ks < 4; ++ks) {
            const bf16x8 a = (bf16x8){lo[ks][0], lo[ks][1], lo[ks][2], lo[ks][3], hh[ks][0], hh[ks][1], hh[ks][2], hh[ks][3]};
            o[d0] = __builtin_amdgcn_mfma_f32_32x32x16_bf16(a, pb[ks], o[d0], 0, 0, 0); }
    }
}
__device__ __forceinline__ void meta_tile(LAS const unsigned char* Kb, LAS const unsigned char* Vb, LAS const unsigned char* Qw, f32x16 (&o)[4], float& l_part, float negm, int c, int r32, int hi, int lane) {
    f32x16 p0;
#pragma unroll
    for (int r = 0; r < 16; ++r) p0[r] = negm;
#pragma unroll
    for (int d0 = 0; d0 < 4; ++d0) { const int cb = (c * 64 + d0 * 16 + hi * 8) * 2;
        p0 = __builtin_amdgcn_mfma_f32_32x32x16_bf16(*(LAS const bf16x8*)(Kb + kswz(r32, cb)), *(LAS const bf16x8*)(Qw + d0 * 1024), p0, 0, 0, 0); }
    float ps = 0.f;
#pragma unroll
    for (int r = 0; r < 16; ++r) { p0[r] = (crow(r, hi) >= NMETA) ? 0.f : __builtin_amdgcn_exp2f(p0[r]); ps += p0[r]; }
    l_part += ps;
    const bf16x8 pb0 = pack8(p0, 0);
    LAS const unsigned char* vb = Vb + v_rd_base(lane);
#pragma unroll
    for (int d0 = 0; d0 < 4; ++d0) { const s16x4 lo = vtr(vb + d0 * 512), hh = vtr(vb + d0 * 512 + 2048);
        o[d0] = __builtin_amdgcn_mfma_f32_32x32x16_bf16((bf16x8){lo[0], lo[1], lo[2], lo[3], hh[0], hh[1], hh[2], hh[3]}, pb0, o[d0], 0, 0, 0); }
}
constexpr int KB3 = 0, VB3 = 49152, QFR = 98304, MKB = 131072, MVB = 139264;
__device__ __forceinline__ void glds16(const void* g, unsigned lds_base) {
    unsigned sv; asm volatile("s_mov_b32 %0, m0\n\ts_mov_b32 m0, %2\n\ts_nop 0\n\tglobal_load_lds_dwordx4 %1, off\n\ts_mov_b32 m0, %0" : "=&s"(sv) : "v"(g), "s"(lds_base) : "memory"); }
__device__ __forceinline__ void dma_tile(LAS unsigned char* lds, int buf, const bf16* tile0, int wave, int lane_) {
    const int lane = opaque_v(lane_);
    LAS unsigned char* dst = lds + (wave < 4 ? KB3 + buf * KBUF + wave * 4096 : VB3 + buf * VBUF + (wave - 4) * 4096);
#pragma unroll
    for (int i = 0; i < 4; ++i) {
        unsigned off;
        if (wave < 4) { const int p = 4 * wave + i, row = 4 * p + (lane >> 4), colB = ((lane & 15) ^ (row & 7)) << 4; off = (unsigned)(row * NIN + C_K + (colB >> 1)); }
        else { const int p = 4 * (wave - 4) + i, st = 2 * p + (lane >> 5), key = (st >> 2) * 8 + ((lane & 31) >> 2), col = (st & 3) * 32 + (lane & 3) * 8; off = (unsigned)(key * NIN + C_V + col); }
        glds16(tile0 + off, (unsigned)__builtin_amdgcn_readfirstlane((int)(unsigned)(size_t)(dst + i * 1024))); }
}
typedef __bf16 bf16v2_ __attribute__((ext_vector_type(2)));
__device__ __forceinline__ unsigned cvt2(float lo, float hi) { const pg8::f32x2 v = {lo, hi}; return __builtin_bit_cast(unsigned, __builtin_convertvector(v, bf16v2_)); }
#define ATT_SBAR() __builtin_amdgcn_sched_barrier(0)
#define ATT_PIN(x) asm volatile("" : "+v"(x))
__device__ __forceinline__ void fast_step(f32x16 (&o)[4], f32x16& s0, f32x16& s1, float& l_part, const f32x16& negm16, LAS const unsigned char* Vslot, LAS const unsigned char* Kb, LAS const unsigned char* Qw, int c, int r32, int hi, int lane) {
    LAS const unsigned char* vb = Vslot + v_rd_base(lane);
    float ps = 0.f; unsigned pk[4], pn[4];
#pragma unroll
    for (int i = 0; i < 4; ++i) { const float x = __builtin_amdgcn_exp2f(s0[2 * i]), y = __builtin_amdgcn_exp2f(s0[2 * i + 1]); ps += x; ps += y; pk[i] = cvt2(x, y); }
    s16x4 va[8], vn[8];
#pragma unroll
    for (int d0 = 0; d0 < 4; ++d0) { va[2 * d0] = vtr(vb + d0 * 512); va[2 * d0 + 1] = vtr(vb + d0 * 512 + 2048); }
    bf16x8 kb0[4], kb1[4], qf[4];
    ATT_SBAR();
#pragma unroll
    for (int ch = 0; ch < 4; ++ch) {
        const bf16x8 pbc = __builtin_bit_cast(bf16x8, ((v4u){pk[0], pk[1], pk[2], pk[3]}));
#pragma unroll
        for (int d0 = 0; d0 < 4; ++d0) {
            const bf16x8 a = (bf16x8){va[2 * d0][0], va[2 * d0][1], va[2 * d0][2], va[2 * d0][3], va[2 * d0 + 1][0], va[2 * d0 + 1][1], va[2 * d0 + 1][2], va[2 * d0 + 1][3]};
            o[d0] = __builtin_amdgcn_mfma_f32_32x32x16_bf16(a, pbc, o[d0], 0, 0, 0);
            if (ch < 3) {
                const int nb = ((ch + 1) & 1) * 8 + 2 * d0;
                const float x = __builtin_amdgcn_exp2f((ch + 1 < 2) ? s0[nb] : s1[nb]), y = __builtin_amdgcn_exp2f((ch + 1 < 2) ? s0[nb + 1] : s1[nb + 1]);
                ps += x; ps += y; pn[d0] = cvt2(x, y);
                vn[2 * d0] = vtr(vb + d0 * 512 + (ch + 1) * 4096); vn[2 * d0 + 1] = vtr(vb + d0 * 512 + (ch + 1) * 4096 + 2048);
                ATT_PIN(pn[d0]); ATT_PIN(ps);
            } else {
                const int cb = (c * 64 + d0 * 16 + hi * 8) * 2;
                kb0[d0] = *(LAS const bf16x8*)(Kb + kswz(r32, cb)); kb1[d0] = *(LAS const bf16x8*)(Kb + kswz(32 + r32, cb)); qf[d0] = *(LAS const bf16x8*)(Qw + d0 * 1024);
            }
            ATT_SBAR();
        }
        if (ch < 3) {
#pragma unroll
            for (int i = 0; i < 4; ++i) pk[i] = pn[i];
#pragma unroll
            for (int i = 0; i < 8; ++i) va[i] = vn[i];
        }
    }
    l_part += ps;
    s0 = __builtin_amdgcn_mfma_f32_32x32x16_bf16(kb0[0], qf[0], negm16, 0, 0, 0); s1 = __builtin_amdgcn_mfma_f32_32x32x16_bf16(kb1[0], qf[0], negm16, 0, 0, 0);
#pragma unroll
    for (int d0 = 1; d0 < 4; ++d0) { s0 = __builtin_amdgcn_mfma_f32_32x32x16_bf16(kb0[d0], qf[d0], s0, 0, 0, 0); s1 = __builtin_amdgcn_mfma_f32_32x32x16_bf16(kb1[d0], qf[d0], s1, 0, 0, 0); }
}
__device__ __forceinline__ void unit(LAS unsigned char* lds, const bf16* P, const bf16* Pm, bf16* YA, const float* subln, const float* kn, const float* rope, float lam, float mfix, int b, int h, int qb, int tid, int wave, int lane_in) {
    const int c = wave >> 2, jw = wave & 3, q0 = qb * 128, NT = 2 * qb + 2;
    const bf16* tb0 = P + (size_t)(b * SEQ) * NIN + h * 128;
    f32x16 o[4] = {}; float l_part = 0.f; const float negm = -mfix;
    { const int lane = lane_in, r32 = lane & 31, hi = lane >> 5;
    dma_tile(lds, 0, tb0, wave, lane); dma_tile(lds, 1, tb0 + (size_t)64 * NIN, wave, lane);
    if (c == 0 && NT > 2) dma_tile(lds, 2, tb0 + (size_t)128 * NIN, wave, lane);
    LAS unsigned char* Qw = lds + QFR + wave * 4096 + lane * 16;
    { const bf16* qp = P + (size_t)(b * SEQ + q0 + jw * 32 + r32) * NIN + C_Q + h * 128 + c * 64 + hi * 8;
#pragma unroll
      for (int d0 = 0; d0 < 4; ++d0) *(LAS bf16x8*)(Qw + d0 * 1024) = *(const GAS bf16x8*)(qp + d0 * 16); }
    { const int sr = tid >> 4, sc = (tid & 15) * 8, mr = sr & 15;
      if (tid < 256) {
          const v4u raw = *(const GAS v4u*)(Pm + (size_t)mr * NIN + C_K + h * 128 + sc); const int sub = tid & 7;
          float xv[8] = {bflo(raw.x), bfhi(raw.x), bflo(raw.y), bfhi(raw.y), bflo(raw.z), bfhi(raw.z), bflo(raw.w), bfhi(raw.w)};
          float ss = 0.f;
#pragma unroll
          for (int j = 0; j < 8; ++j) ss += xv[j] * xv[j];
          ss += __shfl_xor(ss, 1); ss += __shfl_xor(ss, 2); ss += __shfl_xor(ss, 4);
          const float rstd = 1.f / sqrtf(ss * (1.f / 64.f) + EPS); float ov[8];
#pragma unroll
          for (int j = 0; j < 8; ++j) { const float xn = xv[j] * rstd * kn[sub * 8 + j], pr = __shfl_xor(xn, 1), cs = rope[mr * 16 + j], sn = rope[mr * 16 + 8 + j];
              ov[j] = (sub == 0) ? xn * cs - pr * sn : (sub == 1) ? xn * cs + pr * sn : xn; }
          v4u v; v.x = pk2(ov[0], ov[1]); v.y = pk2(ov[2], ov[3]); v.z = pk2(ov[4], ov[5]); v.w = pk2(ov[6], ov[7]);
          *(LAS v4u*)(lds + MKB + kswz(mr, sc * 2)) = v; }
      else           { const v4u v = *(const GAS v4u*)(Pm + (size_t)mr * NIN + C_V + h * 128 + sc); *(LAS v4u*)(lds + MVB + v_st(mr, sc)) = v; } }
    asm volatile("s_waitcnt vmcnt(0)" ::: "memory"); __syncthreads();
    meta_tile(lds + MKB, lds + MVB, Qw, o, l_part, negm, c, r32, hi, lane);
    f32x16 s0, s1;
    qk(s0, s1, lds + KB3, Qw, negm, c, r32, hi);
    if (qb == 0) mask_diag(s0, s1, hi, 32 * jw + r32);
    int s_j = 0;
    int j = 0;
    { f32x16 negm16;
#pragma unroll
      for (int r = 0; r < 16; ++r) negm16[r] = negm;
      ATT_PIN(negm16);
#pragma unroll 1
      for (; j < NT - 3; ++j) {
        const int s_j1 = (s_j == 2) ? 0 : s_j + 1, s_j2 = (s_j1 == 2) ? 0 : s_j1 + 1;
        asm volatile("s_waitcnt vmcnt(4) lgkmcnt(0)" ::: "memory"); __builtin_amdgcn_s_barrier(); asm volatile("" ::: "memory");
        if (c == 0) dma_tile(lds, s_j, tb0 + (size_t)(j + 3) * 64 * NIN, wave, lane); else dma_tile(lds, s_j2, tb0 + (size_t)(j + 2) * 64 * NIN, wave, lane);
        fast_step(o, s0, s1, l_part, negm16, lds + VB3 + s_j * VBUF, lds + KB3 + s_j1 * KBUF, Qw, c, r32, hi, lane);
        s_j = s_j1;
      } }
#pragma unroll 1
    for (; j < NT; ++j) {
        const int s_j1 = (s_j == 2) ? 0 : s_j + 1, s_j2 = (s_j1 == 2) ? 0 : s_j1 + 1;
        { if ((c == 0) ? (j + 2 < NT) : (j + 1 < NT)) asm volatile("s_waitcnt vmcnt(4) lgkmcnt(0)" ::: "memory"); else asm volatile("s_waitcnt vmcnt(0) lgkmcnt(0)" ::: "memory");
            __builtin_amdgcn_s_barrier(); asm volatile("" ::: "memory"); }
        if (c == 0) { if (j + 3 < NT) dma_tile(lds, s_j, tb0 + (size_t)(j + 3) * 64 * NIN, wave, lane); }
        else        { if (j + 2 < NT) dma_tile(lds, s_j2, tb0 + (size_t)(j + 2) * 64 * NIN, wave, lane); }
        const int dt = j - 2 * qb, dn = dt + 1;
        const bool act = !(dt == 1 && jw < 2), actn = (j + 1 < NT) && !(dn == 1 && jw < 2);
        if (act) { bf16x8 pb[4]; partB(s0, s1, l_part, pb); pv(o, lds + VB3 + s_j * VBUF, pb, lane); }
        if (actn) { qk(s0, s1, lds + KB3 + s_j1 * KBUF, Qw, negm, c, r32, hi); if (dn >= 0) mask_diag(s0, s1, hi, 32 * jw + r32 - 64 * dn); }
        s_j = s_j1;
    }
    }
    __syncthreads();
    LAS float* ex = (LAS float*)lds;
    const int lane = opaque_v(lane_in), r32 = lane & 31, hi = lane >> 5;
    const float l_reg = pl_sum(l_part);
    if (c == 1) { const float s1x = -lam / l_reg;
#pragma unroll
        for (int d0 = 0; d0 < 4; ++d0)
#pragma unroll
            for (int r = 0; r < 16; ++r) ex[((jw * 4 + d0) * 16 + r) * 64 + lane] = o[d0][r] * s1x; }
    __syncthreads();
    if (c == 0) { const float il = 1.f / l_reg; float ss = 0.f;
#pragma unroll
        for (int d0 = 0; d0 < 4; ++d0)
#pragma unroll
            for (int r = 0; r < 16; ++r) { const float v = o[d0][r] * il + ex[((jw * 4 + d0) * 16 + r) * 64 + lane]; o[d0][r] = v; ss += v * v; }
        ss = pl_sum(ss);
        const float rstd = (1.f - LAM_INIT) / sqrtf(ss * (1.f / 128.f) + EPS);
        bf16* yp = YA + (size_t)(b * SEQ + q0 + jw * 32 + r32) * YP + h * 128;
#pragma unroll
        for (int d0 = 0; d0 < 4; ++d0)
#pragma unroll
            for (int g = 0; g < 4; ++g) { const int e = 32 * d0 + 8 * g + 4 * hi; const f32x4 sw = *(const GAS f32x4*)(subln + e);
                const unsigned w0 = pg8::cvt_pk_bf16(o[d0][4 * g + 0] * rstd * sw.x, o[d0][4 * g + 1] * rstd * sw.y), w1 = pg8::cvt_pk_bf16(o[d0][4 * g + 2] * rstd * sw.z, o[d0][4 * g + 3] * rstd * sw.w);
                *(GAS unsigned long long*)(yp + e) = (unsigned long long)w0 | ((unsigned long long)w1 << 32); }
    }
    __syncthreads();
}
}


namespace hg {
using da::f32x16; using da::s16x4; using da::crow; using da::vtr; using da::pl_sum; using da::pack8;
__device__ __forceinline__ int ioff(int row, int ch) { return 2048 * (row >> 3) + 512 * (ch >> 2) + 64 * (row & 7) + 16 * ((ch & 3) ^ ((row >> 2) & 3)); }
constexpr int QD = 0, KI = 16384, VI = 32768, SI = 49152, DECL = 81920, SSQ = 82432;
__device__ __forceinline__ bf16x8 cat(s16x4 lo, s16x4 hh) { return (bf16x8){lo[0], lo[1], lo[2], lo[3], hh[0], hh[1], hh[2], hh[3]}; }
__device__ __forceinline__ void unit(LAS unsigned char* lds, const bf16* P, const bf16* Pm, bf16* YB, const float* DEC, const float* onorm, const float* hlb, int b, int h, int tid, int wave, int lane) {
    const int r32 = lane & 31, hi = lane >> 5, blk = (lane >> 4) & 1, q4 = (lane & 15) >> 2, p4 = lane & 3;
    const int eb = wave & 3, tb = wave >> 2;
    const int trc = 2 * blk + (p4 >> 1), trb = 8 * (p4 & 1);
#pragma unroll
    for (int i = 0; i < 4; ++i) *(LAS v4u*)(lds + SI + (tid * 4 + i) * 16) = (v4u){0u, 0u, 0u, 0u};
    f32x16 acc0 = {}, acc1 = {};
    const int sr = tid >> 4, sch = tid & 15;
    const v4u z4 = (v4u){0u, 0u, 0u, 0u};
    v4u q0 = z4, q1 = z4, k0 = z4, k1 = z4, v0 = z4, v1 = z4; float dcv = 0.f;
    if (sr < NMETA) { const bf16* mp = Pm + (size_t)sr * NIN + h * 128 + sch * 8; v0 = *(const GAS v4u*)(mp + C_HI); }
    LAS float* dec = (LAS float*)(lds + DECL); LAS float* ssq = (LAS float*)(lds + SSQ);
    if (tid < 128) {
        const int col = h * 128 + tid; const float lb = 1.f / (1.f + __expf(hlb[WHD + col] - hlb[col]));
        float xr[NMETA];
#pragma unroll
        for (int r = 0; r < NMETA; ++r) xr[r] = bf2f(Pm[(size_t)r * NIN + C_HF + col]);
        float run = 0.f;
#pragma unroll
        for (int r = 0; r < NMETA; ++r) { const float f = lb + (1.f - lb) * sigmoidf_(xr[r]); run += __logf(f);
            *(LAS unsigned short*)(lds + KI + ioff(r, tid >> 3) + (tid & 7) * 2) = (unsigned short)f2bf((1.f - f) * __expf(-run)); }
        dec[tid] = __expf(run);
    }
#pragma unroll 1
    for (int n = 0; n <= 32; ++n) {
        { const int o0 = ioff(sr, sch), o1 = ioff(32 + sr, sch);
          *(LAS v4u*)(lds + QD + o0) = q0; *(LAS v4u*)(lds + QD + o1) = q1; if (n > 0 || sr >= NMETA) *(LAS v4u*)(lds + KI + o0) = k0; *(LAS v4u*)(lds + KI + o1) = k1; *(LAS v4u*)(lds + VI + o0) = v0; *(LAS v4u*)(lds + VI + o1) = v1; }
        if (tid < 128 && n > 0) dec[tid] = dcv;
        __syncthreads();
        if (n < 32) {
            const bf16* rp = P + (size_t)(b * SEQ + 64 * n + sr) * NIN + h * 128 + sch * 8; const size_t r32o = (size_t)32 * NIN;
            q0 = *(const GAS v4u*)(rp + C_HQ); q1 = *(const GAS v4u*)(rp + C_HQ + r32o); k0 = *(const GAS v4u*)(rp + C_HF); k1 = *(const GAS v4u*)(rp + C_HF + r32o);
            v0 = *(const GAS v4u*)(rp + C_HI); v1 = *(const GAS v4u*)(rp + C_HI + r32o);
            if (tid < 128) dcv = DEC[(size_t)(b * 32 + n) * WHD + h * 128 + tid];
        }
        unsigned long long gw[4] = {0ull, 0ull, 0ull, 0ull};
        if (n > 0) { const bf16* gp = P + (size_t)(b * SEQ + 64 * (n - 1) + 32 * tb + r32) * NIN + C_HG + h * 128 + 32 * eb + 4 * hi;
#pragma unroll
            for (int g = 0; g < 4; ++g) gw[g] = *(const GAS unsigned long long*)(gp + 8 * g); }
        bf16x8 vf[4];
#pragma unroll
        for (int ks = 0; ks < 4; ++ks) vf[ks] = cat(vtr(lds + VI + ioff(16 * ks + 4 * hi + q4, 4 * eb + trc) + trb), vtr(lds + VI + ioff(16 * ks + 8 + 4 * hi + q4, 4 * eb + trc) + trb));
        f32x16 o = {};
        if (n > 0) {
#pragma unroll
            for (int sb = 0; sb < 2; ++sb) if (sb <= tb) {
                f32x16 X = {};
#pragma unroll
                for (int ds = 0; ds < 8; ++ds) { const bf16x8 A = *(const LAS bf16x8*)(lds + KI + ioff(32 * sb + r32, 2 * ds + hi)), B = *(const LAS bf16x8*)(lds + QD + ioff(32 * tb + r32, 2 * ds + hi));
                    X = __builtin_amdgcn_mfma_f32_32x32x16_bf16(A, B, X, 0, 0, 0); }
                if (sb == tb) {
#pragma unroll
                    for (int r = 0; r < 16; ++r) if (crow(r, hi) > r32) X[r] = 0.f; }
                o = __builtin_amdgcn_mfma_f32_32x32x16_bf16(vf[2 * sb], pack8(X, 0), o, 0, 0, 0);
                o = __builtin_amdgcn_mfma_f32_32x32x16_bf16(vf[2 * sb + 1], pack8(X, 8), o, 0, 0, 0);
            }
#pragma unroll
            for (int ds = 0; ds < 8; ++ds) { const bf16x8 A = cat(vtr(lds + SI + ioff(16 * ds + 8 * hi + q4, 4 * eb + trc) + trb), vtr(lds + SI + ioff(16 * ds + 8 * hi + 4 + q4, 4 * eb + trc) + trb));
                const bf16x8 B = *(const LAS bf16x8*)(lds + QD + ioff(32 * tb + r32, 2 * ds + hi));
                o = __builtin_amdgcn_mfma_f32_32x32x16_bf16(A, B, o, 0, 0, 0); }
            float ss = 0.f;
#pragma unroll
            for (int r = 0; r < 16; ++r) ss += o[r] * o[r];
            ss = pl_sum(ss);
            if (hi == 0) ssq[eb * 64 + 32 * tb + r32] = ss;
        }
#pragma unroll
        for (int ks = 0; ks < 4; ++ks) {
            const bf16x8 B0 = cat(vtr(lds + KI + ioff(16 * ks + 4 * hi + q4, 4 * (2 * tb) + trc) + trb), vtr(lds + KI + ioff(16 * ks + 8 + 4 * hi + q4, 4 * (2 * tb) + trc) + trb));
            const bf16x8 B1 = cat(vtr(lds + KI + ioff(16 * ks + 4 * hi + q4, 4 * (2 * tb + 1) + trc) + trb), vtr(lds + KI + ioff(16 * ks + 8 + 4 * hi + q4, 4 * (2 * tb + 1) + trc) + trb));
            acc0 = __builtin_amdgcn_mfma_f32_32x32x16_bf16(vf[ks], B0, acc0, 0, 0, 0); acc1 = __builtin_amdgcn_mfma_f32_32x32x16_bf16(vf[ks], B1, acc1, 0, 0, 0); }
        { const float d0 = dec[32 * (2 * tb) + r32], d1 = dec[32 * (2 * tb + 1) + r32];
#pragma unroll
          for (int r = 0; r < 16; ++r) { acc0[r] *= d0; acc1[r] *= d1; } }
        __syncthreads();
#pragma unroll
        for (int g = 0; g < 4; ++g) {
            *(LAS unsigned long long*)(lds + SI + ioff(32 * (2 * tb) + r32, 4 * eb + g) + 8 * hi) = (unsigned long long)pg8::cvt_pk_bf16(acc0[4 * g], acc0[4 * g + 1]) | ((unsigned long long)pg8::cvt_pk_bf16(acc0[4 * g + 2], acc0[4 * g + 3]) << 32);
            *(LAS unsigned long long*)(lds + SI + ioff(32 * (2 * tb + 1) + r32, 4 * eb + g) + 8 * hi) = (unsigned long long)pg8::cvt_pk_bf16(acc1[4 * g], acc1[4 * g + 1]) | ((unsigned long long)pg8::cvt_pk_bf16(acc1[4 * g + 2], acc1[4 * g + 3]) << 32); }
        if (n > 0) {
            const int t = 32 * tb + r32; const float tot = (ssq[t] + ssq[64 + t]) + (ssq[128 + t] + ssq[192 + t]);
            const float rstd = 1.f / sqrtf(tot * (1.f / 128.f) + EPS);
            const size_t row = (size_t)(b * SEQ + 64 * (n - 1) + t);
#pragma unroll
            for (int g = 0; g < 4; ++g) { const int e = 32 * eb + 8 * g + 4 * hi;
                const unsigned g01 = (unsigned)gw[g], g23 = (unsigned)(gw[g] >> 32);
                const f32x4 on = *(const GAS f32x4*)(onorm + e);
                const float y0 = o[4 * g] * rstd * on.x * sigmoidf_(bflo(g01)), y1 = o[4 * g + 1] * rstd * on.y * sigmoidf_(bfhi(g01)), y2 = o[4 * g + 2] * rstd * on.z * sigmoidf_(bflo(g23)), y3 = o[4 * g + 3] * rstd * on.w * sigmoidf_(bfhi(g23));
                const unsigned w0 = pg8::cvt_pk_bf16(y0, y1);
                const unsigned w1 = pg8::cvt_pk_bf16(y2, y3);
                *(GAS unsigned long long*)(YB + row * YP + h * 128 + e) = (unsigned long long)w0 | ((unsigned long long)w1 << 32); }
        }
    }
    __syncthreads();
}
}

#define PHASE_PTRS unsigned char* ws = (unsigned char*)ldp(lds, 20); \
    gu32* ctl = (gu32*)(ws + WS_CTL); \
    const float* x = (const float*)ldp(lds, 0); const float* meta = (const float*)ldp(lds, 1); const float* norm_mix = (const float*)ldp(lds, 2); const float* w_in = (const float*)ldp(lds, 3); \
    const float* q_norm = (const float*)ldp(lds, 4); const float* k_norm = (const float*)ldp(lds, 5); \
    const float* lq1 = (const float*)ldp(lds, 6); const float* lk1 = (const float*)ldp(lds, 7); const float* lq2 = (const float*)ldp(lds, 8); const float* lk2 = (const float*)ldp(lds, 9); \
    const float* subln = (const float*)ldp(lds, 10); const float* hg_lb = (const float*)ldp(lds, 11); const float* hg_onorm = (const float*)ldp(lds, 12); \
    const float* w_up_a = (const float*)ldp(lds, 13); const float* w_up_b = (const float*)ldp(lds, 14); const float* w_out = (const float*)ldp(lds, 15); const float* norm_mlp = (const float*)ldp(lds, 16); \
    const float* w_ff1 = (const float*)ldp(lds, 17); const float* w_ff2 = (const float*)ldp(lds, 18); \
    float* out = (float*)ldp(lds, 19); \
    bf16* Wt_in = (bf16*)(ws + WS_WIN); bf16* Wt_upa = (bf16*)(ws + WS_WUPA); bf16* Wt_upb = (bf16*)(ws + WS_WUPB); bf16* Wt_out = (bf16*)(ws + WS_WOUT); \
    bf16* Wt_ff1 = (bf16*)(ws + WS_WFF1); bf16* Wt_ff2 = (bf16*)(ws + WS_WFF2); \
    bf16* U = (bf16*)(ws + WS_U); bf16* Umeta = (bf16*)(ws + WS_UMETA); bf16* Pm = (bf16*)(ws + WS_PM); float* ROPE = (float*)(ws + WS_ROPE); \
    float* RSTD = (float*)(ws + WS_RSTD); float* SSQ = (float*)(ws + WS_SSQ); float* DEC = (float*)(ws + WS_DEC); bf16* P = (bf16*)(ws + WS_P); bf16* HID = (bf16*)(ws + WS_P); \
    unsigned char* MG8 = ws + WS_MG8; unsigned char* WO8 = ws + WS_WO8; float* SMG = (float*)(ws + WS_SO); float* ISMG = SMG + MR; float* SWO = ISMG + MR; float* ISWO = SWO + DM; \
    unsigned char* Y8 = ws + WS_Y8; unsigned char* WUP8 = ws + WS_WUP8; float* SYR = (float*)(ws + WS_SY); float* SYB = SYR + MR; float* SWR = SYB + MR; float* SWB = SWR + DM; \
    unsigned char* U8 = ws + WS_U8; unsigned char* W8 = ws + WS_W8; float* SU = (float*)(ws + WS_SU); float* SW = (float*)(ws + WS_SW); bf16* YA = (bf16*)(ws + WS_YA); bf16* YB = YA + WHD;      bf16* MG = (bf16*)(ws + WS_MG);
__global__ void __launch_bounds__(NWAVES * 64, 2) mk_fwd(Ptrs args) {
    extern __shared__ __attribute__((aligned(16))) unsigned char lds_raw[];
    LAS unsigned char* lds = (LAS unsigned char*)lds_raw;
    volatile LAS unsigned* MISC = (volatile LAS unsigned*)(lds + LDSCTL_OFF);
    const int G = gridDim.x, bx = blockIdx.x;
    const int vcu = (G % 8 == 0) ? (bx % 8) * (G / 8) + bx / 8 : bx;

    { PHASE_IDS
    for (int u = tid; u < (LDS_BYTES - LDSCTL_OFF) / 4; u += NWAVES * 64) ((LAS unsigned*)(lds + LDSCTL_OFF))[u] = 0u;
    __syncthreads();
    if (tid == 0) {
#pragma unroll
        for (int k = 0; k < 21; ++k) { const unsigned long long pv_ = (k < 19) ? (unsigned long long)args.in[k < 19 ? k : 0] : (k == 19 ? (unsigned long long)args.out : (unsigned long long)args.ws);
            MISC[32 + 2 * k] = (unsigned)pv_; MISC[33 + 2 * k] = (unsigned)(pv_ >> 32); } } }
    __syncthreads();
    XcdBarrier bar = xcd_barrier_post((unsigned*)((gu32*)args.ws + CW_BAR), MISC + 8);
    { PHASE_IDS PHASE_PTRS
    if (wave == 0) {
        const float s1 = wave_sum(lq1[lane] * lk1[lane]), s2 = wave_sum(lq2[lane] * lk2[lane]);
        if (lane == 0) ((LAS float*)(lds + LDSCTL_OFF))[16] = expf(s1) - expf(s2) + LAM_INIT;
        const float wqm = wave_max(fabsf(q_norm[lane])), wkm = wave_max(fabsf(k_norm[lane]));
        if (lane == 0) ((LAS float*)(lds + LDSCTL_OFF))[17] = fmaxf(0.f, 64.f * C2 * wqm * wkm - 64.f);
    } }
    __syncthreads();

    { PHASE_IDS PHASE_PTRS
        LAS float* scr = (LAS float*)(lds + wave * 16384);
        const int gw = vcu * NWAVES + wave, NGW = G * NWAVES;
        constexpr int I_QK = (DM / 64) * (NIN / 32);
        for (int it = gw; it < I_QK; it += NGW) p0_transpose_item<true>(w_in, DM, NIN, Wt_in, scr, it, lane, 0, 0, ctl + CW_SWMAX);
        for (int m = gw; m < MR + NMETA; m += NGW) {
            if (m < MR) rms_row_to_bf16(x + (size_t)m * DM, norm_mix, nullptr, lane, U8 + (size_t)m * DM, SU + m);
            else rms_row_to_bf16(meta + (size_t)(m - MR) * DM, norm_mix, Umeta + (size_t)(m - MR) * DM, lane);
        }
        const int gt = tid * G + bx;
        if (gt < TT * 8) {
            const int pos = gt >> 3, j = gt & 7;
            const float invf[8] = {1.0f, 0.1939227432012558f, 0.03760603070259094f, 0.007292664609849453f, 0.0014142135623842478f, 0.00027424818836152554f, 5.3182957344688475e-05f, 1.0313385246263351e-05f};
            float inv = invf[0];
#pragma unroll
            for (int q = 1; q < 8; ++q) inv = (j == q) ? invf[q] : inv;
            const float ang = (float)pos * inv; float sn, cs; sincos_d((double)ang, sn, cs);
            ROPE[pos * 16 + j] = cs; ROPE[pos * 16 + 8 + j] = sn;
        }
    }
    xcd_barrier(bar);

    { PHASE_IDS PHASE_PTRS
        const int gw = vcu * NWAVES + wave, NGW = G * NWAVES;
        for (int r = gw; r < NIN; r += NGW) {
            const float cmax = __uint_as_float(__hip_atomic_load(ctl + CW_SWMAX + r, RLX_AGENT)), inv = cmax > 0.f ? 127.f / cmax : 0.f;
            const GAS v4u* rp = (const GAS v4u*)(Wt_in + (size_t)r * DM) + lane; v4u q[8];
#pragma unroll
            for (int j = 0; j < 8; ++j) q[j] = __builtin_nontemporal_load(rp + 64 * j);
            GAS unsigned long long* op = (GAS unsigned long long*)(W8 + (size_t)r * DM) + lane;
#pragma unroll
            for (int j = 0; j < 8; ++j) op[64 * j] = (unsigned long long)pk4_i8(bflo(q[j].x) * inv, bfhi(q[j].x) * inv, bflo(q[j].y) * inv, bfhi(q[j].y) * inv) | ((unsigned long long)pk4_i8(bflo(q[j].z) * inv, bfhi(q[j].z) * inv, bflo(q[j].w) * inv, bfhi(q[j].w) * inv) << 32);
            if (lane == 0) SW[r] = cmax * (1.f / 127.f);
        }
    }
    xcd_barrier(bar);

    { PHASE_IDS PHASE_PTRS
        { constexpr int UPB = DM * 2 + 16, PART = 16 * UPB;
          for (int i = tid; i < NMETA * DM * 2 / 16; i += NWAVES * 64) { const int r = i >> 9, cch = i & 511; *(LAS v4u*)(lds + r * UPB + cch * 16) = ((const GAS v4u*)Umeta)[i]; }
          __syncthreads();
          const int tsel = wave >> 2, kq = wave & 3, fr = lane & 15, fq = lane >> 4;
#pragma unroll 1
          for (int cb = vcu * 32; cb < 8192; cb += G * 32) {
              const int ci = cb + tsel * 16 + fr; const int c = (ci < 4096) ? (C_K + ci) : (C_HF + (ci - 4096));
              const bf16* wrow = Wt_in + (size_t)wt_row(c) * DM + kq * 1024 + fq * 8;
              LAS const unsigned char* arow = lds + fr * UPB + (kq * 1024 + fq * 8) * 2;
              f32x4 acc = {0.f, 0.f, 0.f, 0.f};
#pragma unroll 1
              for (int kb = 0; kb < 32; kb += 8) {
                  bf16x8 bfr[8];
#pragma unroll
                  for (int i = 0; i < 8; ++i) bfr[i] = *(const GAS bf16x8*)(wrow + (kb + i) * 32);
#pragma unroll
                  for (int i = 0; i < 8; ++i) { const bf16x8 afr = *(LAS const bf16x8*)(arow + (kb + i) * 64); acc = __builtin_amdgcn_mfma_f32_16x16x32_bf16(afr, bfr[i], acc, 0, 0, 0); }
              }
              *(LAS f32x4*)(lds + PART + (wave * 64 + lane) * 16) = acc;
              __syncthreads();
              if (kq == 0) { f32x4 s = acc;
#pragma unroll
                  for (int q = 1; q < 4; ++q) { const f32x4 t = *(LAS const f32x4*)(lds + PART + ((wave + q) * 64 + lane) * 16); s = s + t; }
#pragma unroll
                  for (int reg = 0; reg < 4; ++reg) Pm[(size_t)(4 * fq + reg) * NIN + c] = (bf16)f2bf(s[reg]); }
              __syncthreads();
          }
        }
        { pg8::Gemm g{(const bf16*)U8, (const bf16*)W8, MR, NQK, DM / 2}; pg8::StaticOrder S; S.init(MR, NQK, G, bx);
          EpiProjT<true> E{P, q_norm, k_norm, ROPE, hg_lb, DEC, 0, 1.f, SU, SW};
          pg8::gemm_phase<EpiProjT<true>, pg8::StaticOrder, true, true, false, true>(lds, g, S, E); }
        __syncthreads();
        { pg8::Gemm g{(const bf16*)U8, (const bf16*)(W8 + (size_t)NQK * DM), MR, NIN - NQK, DM / 2}; pg8::StaticOrder S; S.init(MR, NIN - NQK, G, bx);
          EpiProjT<false> E{P, q_norm, k_norm, ROPE, hg_lb, DEC, NQK / 256, 1.f, SU, SW};
          pg8::gemm_phase<EpiProjT<false>, pg8::StaticOrder, true, true, false, true>(lds, g, S, E); }
    }
    xcd_barrier(bar);


    { PHASE_IDS PHASE_PTRS
        { const int nconv = (G > 2 * NCONV) ? NCONV : G, cv = bx - (G - nconv);
          if (cv >= 0) {
              LAS unsigned* scr = (LAS unsigned*)(lds + wave * TSCR_BYTES);
#pragma unroll 1
              for (int it = cv * NWAVES + wave; it < TI_ALL; it += nconv * NWAVES) { const TItem t = t_decode(lds, it); t_convert(t, scr, lane); }
              __syncthreads();
          } }
        gu32* qh_h = ctl + CW_QHEAD; gu32* qh_a = ctl + CW_QHEAD + 64; const float lam = ((volatile LAS float*)(lds + LDSCTL_OFF))[16], mfix = ((volatile LAS float*)(lds + LDSCTL_OFF))[17];
#pragma unroll 1
        for (;;) {
            if (tid == 0) MISC[20] = __hip_atomic_fetch_add(qh_h, 1u, RLX_AGENT);
            __syncthreads();
            const int it = (int)MISC[20];
            __syncthreads();
            if (it >= 64) break;
            hg::unit(lds, P, Pm, YB, DEC, hg_onorm, hg_lb, it >> 4, it & 15, tid, wave, lane);
        }
#pragma unroll 1
        for (;;) {
            if (tid == 0) MISC[20] = __hip_atomic_fetch_add(qh_a, 1u, RLX_AGENT);
            __syncthreads();
            const int u = (int)MISC[20];
            __syncthreads();
            if (u >= NB * NH * 16) break;
            const int qb = 15 - (u >> 6), bh = u & 63;
            da::unit(lds, P, Pm, YA, subln, k_norm, ROPE, lam, mfix, bh >> 4, bh & 15, qb, tid, wave, lane);
        }
    }
    xcd_barrier(bar);

    { PHASE_IDS
        unsigned char* ws = (unsigned char*)ldp(lds, 20);
        const int gw = vcu * NWAVES + wave, NGW = G * NWAVES, NR = MR + 2 * DM;
        auto ldrow = [&](v4u (&q)[8], int r) {
            const size_t so = (r < MR) ? WS_YA + (size_t)r * (YP * 2) : ((r < MR + DM) ? WS_WUPA + (size_t)(r - MR) * (YP * 2) : WS_WOUT + (size_t)(r - MR - DM) * (YP * 2));
            const GAS v4u* rp = (const GAS v4u*)(ws + so) + lane;
#pragma unroll
            for (int j = 0; j < 8; ++j) q[j] = rp[64 * j]; };
        auto dorow = [&](const v4u (&q)[8], int r) {
            const bool isy = r < MR, iso = r >= MR + DM; const int rr = isy ? r : (iso ? r - MR - DM : r - MR);
            unsigned ma_ = 0u, mb_ = 0u;
#pragma unroll
            for (int j = 0; j < 8; ++j)
#pragma unroll
                for (int e = 0; e < 4; ++e) { const unsigned w = q[j][e]; const unsigned hi_ = w & 0x7fff0000u, lo_ = (w << 16) & 0x7fff0000u; const unsigned mx = hi_ > lo_ ? hi_ : lo_;
                    if (j < 4) ma_ = ma_ > mx ? ma_ : mx; else mb_ = mb_ > mx ? mb_ : mx; }
            float ma = wave_max(__uint_as_float(ma_)), mb = wave_max(__uint_as_float(mb_));
            if (iso) { ma = fmaxf(ma, mb); mb = ma; }
            const float sa = ma > 0.f ? ma * (1.f / 127.f) : 1.f, sb = mb > 0.f ? mb * (1.f / 127.f) : 1.f, ia = ma > 0.f ? 127.f / ma : 0.f, ib = mb > 0.f ? 127.f / mb : 0.f;
            const size_t dofs = (isy ? WS_Y8 : (iso ? WS_WO8 : WS_WUP8)) + (size_t)rr * YP;
            GAS unsigned long long* op = (GAS unsigned long long*)(ws + dofs) + lane;
#pragma unroll
            for (int j = 0; j < 8; ++j) { const float inv = j < 4 ? ia : ib;
                op[64 * j] = (unsigned long long)pk4_i8(bflo(q[j].x) * inv, bfhi(q[j].x) * inv, bflo(q[j].y) * inv, bfhi(q[j].y) * inv) | ((unsigned long long)pk4_i8(bflo(q[j].z) * inv, bfhi(q[j].z) * inv, bflo(q[j].w) * inv, bfhi(q[j].w) * inv) << 32); }
            if (lane == 0) {
                if (iso) { float* so_ = (float*)(ws + WS_SO) + 2 * MR; so_[rr] = sb; so_[DM + rr] = 1.f / sb; }
                else { float* sy_ = (float*)(ws + WS_SY) + (isy ? 0 : 2 * MR); const int n_ = isy ? MR : DM; sy_[rr] = sa / sb; sy_[n_ + rr] = sb; } } };
        int r = gw;
        if (r < NR) {
            v4u qa[8], qb[8]; ldrow(qa, r);
#pragma unroll 1
            for (;;) {
                const int r1 = r + NGW; ldrow(qb, r1 < NR ? r1 : r);
                dorow(qa, r);
                if (r1 >= NR) break;
                const int r2 = r1 + NGW; ldrow(qa, r2 < NR ? r2 : r1);
                dorow(qb, r1);
                if (r2 >= NR) break;
                r = r2;
            }
        }
    }
    xcd_barrier(bar);
    { PHASE_IDS PHASE_PTRS
        pg8::Gemm g{(const bf16*)Y8, (const bf16*)WUP8, MR, DM, YP / 2}; HalfOrder8 S; S.init(MR, DM, G, bx); EpiUp8 E{P, MG, SYR, SYB, SWR, SWB};
        pg8::gemm_phase<EpiUp8, HalfOrder8, true, true, false, true>(lds, g, S, E);
    }
    xcd_barrier(bar);

    { PHASE_IDS PHASE_PTRS
        const int gw = vcu * NWAVES + wave, NGW = G * NWAVES;
        auto ldrow = [&](v4u (&q)[8], int r) { const GAS v4u* rp = (const GAS v4u*)(MG + (size_t)r * DM) + lane;
#pragma unroll
            for (int j = 0; j < 8; ++j) q[j] = rp[64 * j]; };
        auto dorow = [&](const v4u (&q)[8], int r) {
            unsigned mb_ = 0u;
#pragma unroll
            for (int j = 0; j < 8; ++j)
#pragma unroll
                for (int e = 0; e < 4; ++e) { const unsigned w = q[j][e]; const unsigned hi_ = w & 0x7fff0000u, lo_ = (w << 16) & 0x7fff0000u; mb_ = mb_ > hi_ ? mb_ : hi_; mb_ = mb_ > lo_ ? mb_ : lo_; }
            const float m = wave_max(__uint_as_float(mb_)), sc = m > 0.f ? m * (1.f / 127.f) : 1.f, inv = m > 0.f ? 127.f / m : 0.f;
            GAS unsigned long long* op = (GAS unsigned long long*)(MG8 + (size_t)r * DM) + lane;
#pragma unroll
            for (int j = 0; j < 8; ++j) op[64 * j] = (unsigned long long)pk4_i8(bflo(q[j].x) * inv, bfhi(q[j].x) * inv, bflo(q[j].y) * inv, bfhi(q[j].y) * inv) | ((unsigned long long)pk4_i8(bflo(q[j].z) * inv, bfhi(q[j].z) * inv, bflo(q[j].w) * inv, bfhi(q[j].w) * inv) << 32);
            if (lane == 0) { SMG[r] = sc; ISMG[r] = 1.f / sc; } };
        int r = gw;
        if (r < MR) {
            v4u qa[8], qb[8]; ldrow(qa, r);
#pragma unroll 1
            for (;;) {
                const int r1 = r + NGW; ldrow(qb, r1 < MR ? r1 : r);
                dorow(qa, r);
                if (r1 >= MR) break;
                const int r2 = r1 + NGW; ldrow(qa, r2 < MR ? r2 : r1);
                dorow(qb, r1);
                if (r2 >= MR) break;
                r = r2;
            }
        }
    }
    xcd_barrier(bar);
    { PHASE_IDS PHASE_PTRS
        pg8::Gemm g{(const bf16*)MG8, (const bf16*)WO8, MR, DM, DM / 2}; pg8::StaticOrder S; S.init(MR, DM, G, bx); EpiOut8 E{x, U, SSQ, SMG, ISMG, SWO, ISWO};
        pg8::gemm_phase<EpiOut8, pg8::StaticOrder, true, true, false, true>(lds, g, S, E);
    }
    xcd_barrier(bar);

    { PHASE_IDS PHASE_PTRS
        { const int gt = bx * (NWAVES * 64) + tid;
          for (int row = gt; row < MR; row += G * NWAVES * 64) { float s = 0.f;
#pragma unroll
              for (int i = 0; i < 16; ++i) { const f32x4 v = *(const GAS f32x4*)(SSQ + (size_t)row * 64 + i * 4); s += (v.x + v.y) + (v.z + v.w); }
              RSTD[row] = 1.f / sqrtf(s * (1.f / DM) + EPS); } }
        pg8::Gemm g{U, Wt_ff1, MR, DFF, DM}; pg8::StaticOrder S; S.init(MR, DFF, G, bx); EpiFf1 E{HID};
        pg8::gemm_phase<EpiFf1, pg8::StaticOrder, true, true>(lds, g, S, E);
    }
    xcd_barrier(bar);

    { PHASE_IDS PHASE_PTRS
        pg8::Gemm g{HID, Wt_ff2, MR, DM, DFF}; pg8::StaticOrder S; S.init(MR, DM, G, bx); EpiFf2 E{out, RSTD, U};
        pg8::gemm_phase<EpiFf2, pg8::StaticOrder, true, true>(lds, g, S, E);
    }
}

extern "C" void kernel_launch(void* const* d_in, const int* in_sizes, int n_in, void* d_out, int out_size, void* d_ws, size_t ws_size, hipStream_t stream) {
    static int grid = 0;
    if (grid == 0) {
        if (n_in != 19 || out_size != MR * DM || ws_size < WS_END) { fprintf(stderr, "kernel_launch: unexpected shapes (n_in %d out %d ws %zu)\n", n_in, out_size, ws_size); grid = -1; return; }
        int dev = 0, cus = 0, per_cu = 0;
        if (hipGetDevice(&dev) != hipSuccess || hipDeviceGetAttribute(&cus, hipDeviceAttributeMultiprocessorCount, dev) != hipSuccess) { grid = -1; return; }
        if (hipFuncSetAttribute((const void*)mk_fwd, hipFuncAttributeMaxDynamicSharedMemorySize, LDS_BYTES) != hipSuccess) { fprintf(stderr, "kernel_launch: hipFuncSetAttribute failed\n"); grid = -1; return; }
        if (hipOccupancyMaxActiveBlocksPerMultiprocessor(&per_cu, (const void*)mk_fwd, NWAVES * 64, LDS_BYTES) != hipSuccess || per_cu < 1) { fprintf(stderr, "kernel_launch: occupancy query says %d\n", per_cu); }
        (void)hipGetLastError();
        grid = cus;
    }
    if (grid < 0) return;
    if (hipMemsetAsync((char*)d_ws + WS_CTL, 0, CTL_ZERO_BYTES, stream) != hipSuccess) return;
    Ptrs a{};
    for (int i = 0; i < 19; ++i) a.in[i] = (const float*)d_in[i];
    a.out = (float*)d_out; a.ws = (unsigned char*)d_ws;
    hipLaunchKernelGGL(mk_fwd, dim3(grid), dim3(NWAVES * 64), LDS_BYTES, stream, a);
}
```
